# Optimizing an MI355X kernel written in HIP

```python
import jax, jax.numpy as jnp
from jax import lax
import numpy as np

D_MODEL = 1024
BATCH = 2
SEQ = 8192
DEPTH = 4

GRID_W = 64
CTX_LEN = 256
HEAD_DIM = 64
ROPE_PAIRS = HEAD_DIM // 4
ROPE_BASE = 10000.0
RET_HEADS = 4
RET_CHUNK = 128
RET_W = RET_HEADS * HEAD_DIM
RET_SCALE = HEAD_DIM ** -0.5
SGU_GROUPS = 4
SGU_CHUNK = 128
SGU_W = SGU_GROUPS * HEAD_DIM
ATT_Q_HEADS = 8
ATT_KV_HEADS = 2
GQA_GROUP = ATT_Q_HEADS // ATT_KV_HEADS
WINDOW = 128
ATT_QW = ATT_Q_HEADS * HEAD_DIM
ATT_KVW = ATT_KV_HEADS * HEAD_DIM
ATT_SCALE = HEAD_DIM ** -0.5
IN_WIDTHS = (RET_W, RET_W, RET_W, RET_W, SGU_W, SGU_W, ATT_QW, ATT_KVW, ATT_KVW)
D_IN = sum(IN_WIDTHS)
D_MIX = RET_W + SGU_W + ATT_QW
PEER_HEADS = 8
PEER_NKEYS = 128
PEER_N = PEER_NKEYS * PEER_NKEYS
PEER_QDIM = 256
PEER_TOPK = 16
PEER_CHUNK = 128
LN_EPS = 1e-5
DEEPNORM_ALPHA = (2 * DEPTH) ** 0.25
DEEPNORM_BETA = (8 * DEPTH) ** -0.25

kernel_name = 'hybrid_dit_retention_sgu_swa_peer'


def layer_norm(x, g=None, b=None):
    xf = x.astype(jnp.float32)
    mu = jnp.mean(xf, -1, keepdims=True)
    var = jnp.mean(jnp.square(xf - mu), -1, keepdims=True)
    y = (xf - mu) * lax.rsqrt(var + LN_EPS)
    if g is not None:
        y = y * g.astype(jnp.float32) + b.astype(jnp.float32)
    return y.astype(x.dtype)


def modulate(x, shift, scale):
    return (layer_norm(x) * (1 + scale) + shift).astype(x.dtype)


def _heads(t, n):
    return t.reshape(t.shape[:-1] + (n, HEAD_DIM))


def _gqa(t):
    return t.reshape(t.shape[:-1] + (ATT_KV_HEADS, GQA_GROUP, HEAD_DIM))


def axial_rope_tables(n_tokens):
    rows = n_tokens // GRID_W
    row_id = jnp.repeat(jnp.arange(rows), GRID_W).astype(jnp.float32)
    col_id = jnp.tile(jnp.arange(GRID_W), rows).astype(jnp.float32)
    inv = jnp.power(ROPE_BASE, -jnp.arange(ROPE_PAIRS, dtype=jnp.float32) / ROPE_PAIRS)
    ang_r = row_id[:, None] * inv
    ang_c = col_id[:, None] * inv
    return (jnp.cos(ang_r), jnp.sin(ang_r), jnp.cos(ang_c), jnp.sin(ang_c))


def _rot(x, cos, sin):
    x1, x2 = jnp.split(x, 2, axis=-1)
    return jnp.concatenate([x1 * cos - x2 * sin, x2 * cos + x1 * sin], -1)


def apply_axial_rope(x, tabs):
    shape = (x.shape[1],) + (1,) * (x.ndim - 3) + (ROPE_PAIRS,)
    cr, sr, cc, sc = [t.reshape(shape) for t in tabs]
    half = HEAD_DIM // 2
    out = jnp.concatenate([_rot(x[..., :half], cr, sr), _rot(x[..., half:], cc, sc)], -1)
    return out.astype(x.dtype)


def retention_scan(q, k, v, log_g, s0):
    B, L, H, _ = q.shape
    dv = v.shape[-1]
    C = RET_CHUNK
    n = L // C

    def to_chunks(t):
        return t.astype(jnp.float32).reshape(B, n, C, H, t.shape[-1]).transpose(1, 0, 3, 2, 4)

    i = jnp.arange(C, dtype=jnp.float32)
    rel = i[:, None] - i[None, :]
    intra = jnp.exp(jnp.maximum(rel, 0.0)[None] * log_g[:, None, None]) * (rel >= 0)[None]
    q_dec = jnp.exp((i + 1)[None, :] * log_g[:, None])
    k_dec = jnp.exp((C - 1 - i)[None, :] * log_g[:, None])
    c_dec = jnp.exp(C * log_g)

    def step(state, qkv):
        qc, kc, vc = qkv
        att = jnp.einsum('bhid,bhjd->bhij', qc, kc) * intra
        o = (jnp.einsum('bhij,bhjv->bhiv', att, vc)
             + jnp.einsum('bhid,bhdv->bhiv', qc * q_dec[..., None], state))
        state = state * c_dec[:, None, None] + jnp.einsum('bhjd,bhjv->bhdv', kc * k_dec[..., None], vc)
        return state, o

    state, o = lax.scan(step, s0, (to_chunks(q), to_chunks(k), to_chunks(v)))
    o = o.transpose(1, 0, 3, 2, 4).reshape(B, L, H, dv)
    return o, state


def retention_state(k, v, log_g):
    L = k.shape[1]
    w = jnp.exp(jnp.arange(L - 1, -1, -1, dtype=jnp.float32)[None, :] * log_g[:, None])
    return jnp.einsum('blhd,hl,blhv->bhdv', k.astype(jnp.float32), w, v.astype(jnp.float32))


def bidir_retention(q_lat, k_lat, v_lat, q_ctx, k_ctx, v_ctx, logit_f, logit_b, ctx_out):
    lg_f = jax.nn.log_sigmoid(logit_f.astype(jnp.float32))
    lg_b = jax.nn.log_sigmoid(logit_b.astype(jnp.float32))
    B = q_lat.shape[0]
    s0 = jnp.zeros((B, RET_HEADS, HEAD_DIM, HEAD_DIM), jnp.float32)
    flip = lambda t: t[:, ::-1]
    if ctx_out:
        oc_f, s_f = retention_scan(q_ctx, k_ctx, v_ctx, lg_f, s0)
        oc_b, s_b = retention_scan(flip(q_ctx), flip(k_ctx), flip(v_ctx), lg_b, s0)
        o_ctx = oc_f + flip(oc_b)
    else:
        s_f = retention_state(k_ctx, v_ctx, lg_f)
        s_b = retention_state(flip(k_ctx), flip(v_ctx), lg_b)
        o_ctx = None
    ol_f, _ = retention_scan(q_lat, k_lat, v_lat, lg_f, s_f)
    ol_b, _ = retention_scan(flip(q_lat), flip(k_lat), flip(v_lat), lg_b, s_b)
    return o_ctx, ol_f + flip(ol_b)


def retention_output(o, gate):
    B, L = o.shape[:2]
    y = layer_norm(o) * jax.nn.silu(_heads(gate, RET_HEADS).astype(jnp.float32))
    return y.reshape(B, L, RET_W).astype(gate.dtype)


def chunk_token_mlp(u, v, w_s, b_s):
    B, L = u.shape[:2]
    n = L // SGU_CHUNK
    u = jax.nn.gelu(u).reshape(B, n, SGU_CHUNK, SGU_GROUPS, HEAD_DIM)
    v = layer_norm(_heads(jax.nn.gelu(v), SGU_GROUPS)).reshape(B, n, SGU_CHUNK, SGU_GROUPS, HEAD_DIM)
    mix = jnp.einsum('gij,bnjgd->bnigd', w_s, v) + b_s.T[:, :, None]
    return (u * mix).reshape(B, L, SGU_W).astype(u.dtype)


def window_attention(q, k, v, k_ctx, v_ctx, sink):
    B, S = q.shape[:2]
    W = WINDOW
    n = S // W
    qb = q.reshape(B, n, W, ATT_KV_HEADS, GQA_GROUP, HEAD_DIM)

    def banded(t):
        tp = jnp.pad(t, ((0, 0), (W, W), (0, 0), (0, 0))).reshape(B, n + 2, W, ATT_KV_HEADS, HEAD_DIM)
        return jnp.concatenate([tp[:, :-2], tp[:, 1:-1], tp[:, 2:]], axis=2)

    kb, vb = banded(k), banded(v)
    qi = jnp.arange(W)
    kj = jnp.arange(3 * W)
    blk = jnp.arange(n)
    rel = kj[None, :] - W - qi[:, None]
    kpos = blk[:, None] * W - W + kj[None, :]
    mask = (jnp.abs(rel) <= W)[None] & ((kpos >= 0) & (kpos < S))[:, None, :]
    s_loc = jnp.einsum('bnqhgd,bnkhd->bnhgqk', qb, kb).astype(jnp.float32)
    s_loc = jnp.where(mask[None, :, None, None], s_loc, -jnp.inf)
    s_ctx = jnp.einsum('bnqhgd,bchd->bnhgqc', qb, k_ctx).astype(jnp.float32)
    s_sink = jnp.broadcast_to(sink.astype(jnp.float32)[None, None, :, :, None, None], s_loc.shape[:-1] + (1,))
    p = jax.nn.softmax(jnp.concatenate([s_loc, s_ctx, s_sink], -1), axis=-1).astype(v.dtype)
    n_loc = 3 * W
    n_ctx = k_ctx.shape[1]
    o = (jnp.einsum('bnhgqk,bnkhd->bnqhgd', p[..., :n_loc], vb)
         + jnp.einsum('bnhgqc,bchd->bnqhgd', p[..., n_loc:n_loc + n_ctx], v_ctx))
    return o.reshape(B, S, ATT_QW)


def context_attention(q, k, v, sink):
    s = jnp.einsum('bqhgd,bkhd->bhgqk', q, k).astype(jnp.float32)
    s_sink = jnp.broadcast_to(sink.astype(jnp.float32)[None, :, :, None, None], s.shape[:-1] + (1,))
    p = jax.nn.softmax(jnp.concatenate([s, s_sink], -1), axis=-1)[..., :-1].astype(v.dtype)
    o = jnp.einsum('bhgqk,bkhd->bqhgd', p, v)
    return o.reshape(o.shape[:2] + (ATT_QW,))


def mix_sublayer(h_lat, h_ctx, w_in, w_out, ret_logit_f, ret_logit_b, sgu_w, sgu_b, sink, rope, ctx_out):
    points = np.cumsum(IN_WIDTHS)[:-1].tolist()
    rq, rk, rv, rg, su, sv, aq, ak, av = jnp.split(h_lat @ w_in, points, axis=-1)
    cq, ck, cv, cg, csu, csv, caq, cak, cav = jnp.split(h_ctx @ w_in, points, axis=-1)
    o_ctx_a, o_lat_a = bidir_retention(
        apply_axial_rope(_heads(rq, RET_HEADS), rope),
        apply_axial_rope(_heads(rk, RET_HEADS), rope) * RET_SCALE,
        _heads(rv, RET_HEADS),
        _heads(cq, RET_HEADS), _heads(ck, RET_HEADS) * RET_SCALE, _heads(cv, RET_HEADS),
        ret_logit_f, ret_logit_b, ctx_out)
    a_lat = retention_output(o_lat_a, rg)
    b_lat = chunk_token_mlp(su, sv, sgu_w, sgu_b)
    ctx_k = _heads(cak, ATT_KV_HEADS)
    ctx_v = _heads(cav, ATT_KV_HEADS)
    sink_g = sink.reshape(ATT_KV_HEADS, GQA_GROUP)
    c_lat = window_attention(apply_axial_rope(_gqa(aq), rope) * ATT_SCALE,
                             apply_axial_rope(_heads(ak, ATT_KV_HEADS), rope),
                             _heads(av, ATT_KV_HEADS), ctx_k, ctx_v, sink_g)
    y_lat = jnp.concatenate([a_lat, b_lat, c_lat], -1) @ w_out
    if not ctx_out:
        return None, y_lat
    a_ctx = retention_output(o_ctx_a, cg)
    b_ctx = chunk_token_mlp(csu, csv, sgu_w, sgu_b)
    att_ctx = context_attention(_gqa(caq) * ATT_SCALE, ctx_k, ctx_v, sink_g)
    y_ctx = jnp.concatenate([a_ctx, b_ctx, att_ctx], -1) @ w_out
    return y_ctx, y_lat


def peer_ffn(h, wq, k1, k2, u_tab, v_tab):
    shp = h.shape
    t = h.reshape(-1, D_MODEL)
    T = t.shape[0]
    q = (t @ wq).reshape(T, PEER_HEADS, PEER_QDIM).astype(jnp.float32)
    q1, q2 = jnp.split(q, 2, axis=-1)
    s1 = jnp.einsum('thd,kd->thk', q1, k1.astype(jnp.float32))
    s2 = jnp.einsum('thd,kd->thk', q2, k2.astype(jnp.float32))
    v1, i1 = lax.top_k(s1, PEER_TOPK)
    v2, i2 = lax.top_k(s2, PEER_TOPK)
    cand = (v1[..., :, None] + v2[..., None, :]).reshape(T, PEER_HEADS, PEER_TOPK * PEER_TOPK)
    cidx = (i1[..., :, None] * PEER_NKEYS + i2[..., None, :]).reshape(T, PEER_HEADS, PEER_TOPK * PEER_TOPK)
    top, sel = lax.top_k(cand, PEER_TOPK)
    eidx = jnp.take_along_axis(cidx, sel, axis=-1)
    gate = jax.nn.softmax(top, axis=-1).astype(h.dtype)
    n = T // PEER_CHUNK
    n_sel = PEER_HEADS * PEER_TOPK

    def expert_block(args):
        xb, eb, gb = args
        act = jax.nn.gelu(jnp.einsum('td,tkd->tk', xb, u_tab[eb]))
        return jnp.einsum('tk,tkd->td', gb * act, v_tab[eb])

    out = lax.map(expert_block, (t.reshape(n, PEER_CHUNK, D_MODEL),
                                 eidx.reshape(n, PEER_CHUNK, n_sel),
                                 gate.reshape(n, PEER_CHUNK, n_sel)))
    return out.reshape(shp)


def setup_inputs(seed: int = 0) -> dict:
    key = jax.random.key(seed)
    ks = jax.random.split(key, 24)
    f32 = jnp.float32

    def nrm(k, shape, scale):
        return jax.random.normal(k, shape, f32) * scale

    ret_base = jnp.asarray(np.log(2.0 ** (5 + np.arange(RET_HEADS)) - 1.0), f32)
    return {
        'x': nrm(ks[0], (BATCH, SEQ, D_MODEL), 1.0),
        'c': nrm(ks[1], (BATCH, D_MODEL), 1.0),
        'ctx': nrm(ks[2], (BATCH, CTX_LEN, D_MODEL), 1.0),
        'c_ctx': nrm(ks[3], (D_MODEL,), 1.0),
        'w_mod': nrm(ks[4], (DEPTH, D_MODEL, 6 * D_MODEL), 0.5 * D_MODEL ** -0.5),
        'b_mod': nrm(ks[5], (DEPTH, 6 * D_MODEL), 0.02),
        'w_in': nrm(ks[6], (DEPTH, D_MODEL, D_IN), D_MODEL ** -0.5),
        'w_out': nrm(ks[7], (DEPTH, D_MIX, D_MODEL), DEEPNORM_BETA * D_MIX ** -0.5),
        'ret_decay_fwd': ret_base + nrm(ks[8], (DEPTH, RET_HEADS), 0.05),
        'ret_decay_bwd': ret_base + nrm(ks[9], (DEPTH, RET_HEADS), 0.05),
        'sgu_w': nrm(ks[10], (DEPTH, SGU_GROUPS, SGU_CHUNK, SGU_CHUNK), SGU_CHUNK ** -0.5),
        'sgu_b': 1.0 + nrm(ks[11], (DEPTH, SGU_GROUPS, SGU_CHUNK), 0.01),
        'attn_sink': nrm(ks[12], (DEPTH, ATT_Q_HEADS), 0.5),
        'ln_mix_g': 1.0 + nrm(ks[13], (DEPTH, D_MODEL), 0.02),
        'ln_mix_b': nrm(ks[14], (DEPTH, D_MODEL), 0.02),
        'peer_wq': nrm(ks[15], (DEPTH, D_MODEL, PEER_HEADS * PEER_QDIM), D_MODEL ** -0.5),
        'peer_k1': nrm(ks[16], (DEPTH, PEER_NKEYS, PEER_QDIM // 2), (PEER_QDIM // 2) ** -0.5),
        'peer_k2': nrm(ks[17], (DEPTH, PEER_NKEYS, PEER_QDIM // 2), (PEER_QDIM // 2) ** -0.5),
        'peer_u': nrm(ks[18], (DEPTH, PEER_N, D_MODEL), D_MODEL ** -0.5),
        'peer_v': nrm(ks[19], (DEPTH, PEER_N, D_MODEL), DEEPNORM_BETA),
        'ln_ffn_g': 1.0 + nrm(ks[20], (DEPTH, D_MODEL), 0.02),
        'ln_ffn_b': nrm(ks[21], (DEPTH, D_MODEL), 0.02),
    }


def reference(x, c, ctx, c_ctx, w_mod, b_mod, w_in, w_out, ret_decay_fwd, ret_decay_bwd,
              sgu_w, sgu_b, attn_sink, ln_mix_g, ln_mix_b, peer_wq, peer_k1, peer_k2,
              peer_u, peer_v, ln_ffn_g, ln_ffn_b):
    rope = axial_rope_tables(x.shape[1])
    x_lat, x_ctx = x, ctx
    for l in range(DEPTH):
        ctx_out = l < DEPTH - 1
        mod_l = (jax.nn.silu(c) @ w_mod[l] + b_mod[l])[:, None, :]
        mod_c = jax.nn.silu(c_ctx) @ w_mod[l] + b_mod[l]
        sh1, sc1, g1, sh2, sc2, g2 = jnp.split(mod_l, 6, axis=-1)
        csh1, csc1, cg1, csh2, csc2, cg2 = jnp.split(mod_c, 6, axis=-1)
        y_ctx, y_lat = mix_sublayer(modulate(x_lat, sh1, sc1), modulate(x_ctx, csh1, csc1),
                                    w_in[l], w_out[l], ret_decay_fwd[l], ret_decay_bwd[l],
                                    sgu_w[l], sgu_b[l], attn_sink[l], rope, ctx_out)
        x_lat = layer_norm(DEEPNORM_ALPHA * x_lat + g1 * y_lat, ln_mix_g[l], ln_mix_b[l])
        f_lat = peer_ffn(modulate(x_lat, sh2, sc2), peer_wq[l], peer_k1[l], peer_k2[l], peer_u[l], peer_v[l])
        x_lat = layer_norm(DEEPNORM_ALPHA * x_lat + g2 * f_lat, ln_ffn_g[l], ln_ffn_b[l])
        if ctx_out:
            x_ctx = layer_norm(DEEPNORM_ALPHA * x_ctx + cg1 * y_ctx, ln_mix_g[l], ln_mix_b[l])
            f_ctx = peer_ffn(modulate(x_ctx, csh2, csc2), peer_wq[l], peer_k1[l], peer_k2[l], peer_u[l], peer_v[l])
            x_ctx = layer_norm(DEEPNORM_ALPHA * x_ctx + cg2 * f_ctx, ln_ffn_g[l], ln_ffn_b[l])
    return x_lat
```

```cpp
#include <hip/hip_runtime.h>
#include <hip/hip_cooperative_groups.h>
#include <cstdio>
#include <cstdint>
namespace cg = cooperative_groups;

constexpr int D = 1024, NB = 2, SEQ = 8192, DEPTH = 4, LC = 256, HD = 64;
constexpr int TL = NB * SEQ, TC = NB * LC, T = TL + TC;
constexpr int DIN = 2304;
constexpr int C_RQ = 0, C_RK = 256, C_RV = 512, C_RG = 768, C_SU = 1024, C_SV = 1280, C_AQ = 1536, C_AK = 2048, C_AV = 2176;
constexpr int NPOS = 66;
constexpr int PEER_N = 16384, NSEL = 128;
constexpr float LN_EPS = 1e-5f;
constexpr float ALPHA = 1.681792830507429f;
constexpr int NT = 256;

struct Params {
    const float *x, *c, *ctx, *c_ctx, *w_mod, *b_mod, *w_in, *w_out, *rdf, *rdb, *sgu_w, *sgu_b, *sink, *lnm_g, *lnm_b, *wq, *k1, *k2, *pu, *pv, *lnf_g, *lnf_b;
    float* out;
    float *modp, *mod, *X, *H, *P, *KV, *ST, *MIX, *Y, *X1, *Q, *GATE, *V1;
    int *EIDX, *I1;
};

__device__ __forceinline__ float gelu_tanh(float x) {
    const float k0 = 0.7978845608028654f, k1 = 0.044715f;
    float u = k0 * (x + k1 * x * x * x);
    return 0.5f * x * (1.0f + tanhf(u));
}
__device__ __forceinline__ float silu_f(float x) { return x / (1.0f + expf(-x)); }
__device__ __forceinline__ float wave_sum(float v) {
#pragma unroll
    for (int o = 32; o >= 1; o >>= 1) v += __shfl_xor(v, o);
    return v;
}
__device__ __forceinline__ int chunk_row0(int b, int pos) { return pos < 2 ? TL + b * LC + pos * 128 : b * SEQ + (pos - 2) * 128; }
__device__ __forceinline__ int mod_idx(int r) { return r < TL ? r / SEQ : 2; }

__device__ void phase_mod1(const Params& p, int bid, int nb) {
    __shared__ float red[3][4][64];
    const int t = threadIdx.x, cn = t & 63, kg = t >> 6;
    for (int u = bid; u < DEPTH * 96 * 16; u += nb) {
        const int ks = u & 15, nblk = (u >> 4) % 96, l = u / (16 * 96);
        const int n = nblk * 64 + cn;
        float a0 = 0.f, a1 = 0.f, a2 = 0.f;
        for (int kk = 0; kk < 16; ++kk) {
            const int k = ks * 64 + kg * 16 + kk;
            const float w = p.w_mod[((size_t)l * D + k) * 6144 + n];
            a0 += silu_f(p.c[k]) * w; a1 += silu_f(p.c[D + k]) * w; a2 += silu_f(p.c_ctx[k]) * w;
        }
        red[0][kg][cn] = a0; red[1][kg][cn] = a1; red[2][kg][cn] = a2;
        __syncthreads();
        if (t < 192) {
            const int v = t >> 6;
            const float s = red[v][0][cn] + red[v][1][cn] + red[v][2][cn] + red[v][3][cn];
            p.modp[(((size_t)ks * DEPTH + l) * 3 + v) * 6144 + n] = s;
        }
        __syncthreads();
    }
}
__device__ void phase_mod2(const Params& p, int bid, int nb) {
    for (int i = bid * NT + threadIdx.x; i < DEPTH * 3 * 6144; i += nb * NT) {
        const int n = i % 6144, l = i / (3 * 6144);
        float s = p.b_mod[l * 6144 + n];
        for (int ks = 0; ks < 16; ++ks) s += p.modp[(size_t)ks * DEPTH * 3 * 6144 + i];
        p.mod[i] = s;
    }
}

__device__ __forceinline__ void row_load(const float* src, float (&v)[16], int lane) {
#pragma unroll
    for (int i = 0; i < 4; ++i) { const float4 q = *(const float4*)(src + i * 256 + lane * 4); v[i * 4 + 0] = q.x; v[i * 4 + 1] = q.y; v[i * 4 + 2] = q.z; v[i * 4 + 3] = q.w; }
}
__device__ __forceinline__ void row_store(float* dst, const float (&v)[16], int lane) {
#pragma unroll
    for (int i = 0; i < 4; ++i) *(float4*)(dst + i * 256 + lane * 4) = make_float4(v[i * 4 + 0], v[i * 4 + 1], v[i * 4 + 2], v[i * 4 + 3]);
}
__device__ __forceinline__ void row_ln(float (&v)[16]) {
    float s = 0.f;
#pragma unroll
    for (int i = 0; i < 16; ++i) s += v[i];
    const float mu = wave_sum(s) * (1.0f / D);
    float q = 0.f;
#pragma unroll
    for (int i = 0; i < 16; ++i) { v[i] -= mu; q += v[i] * v[i]; }
    const float rstd = rsqrtf(wave_sum(q) * (1.0f / D) + LN_EPS);
#pragma unroll
    for (int i = 0; i < 16; ++i) v[i] *= rstd;
}
__device__ __forceinline__ const float* x_row(const Params& p, int l, int r) {
    if (l == 0) return r < TL ? p.x + (size_t)r * D : p.ctx + (size_t)(r - TL) * D;
    return p.X + (size_t)r * D;
}

__device__ void phase_lnmod(const Params& p, int l, int bid, int nb) {
    const int lane = threadIdx.x & 63, w = threadIdx.x >> 6;
    for (int r = bid * 4 + w; r < T; r += nb * 4) {
        float v[16], sh[16], sc[16];
        row_load(x_row(p, l, r), v, lane);
        const float* m = p.mod + ((size_t)l * 3 + mod_idx(r)) * 6144;
        row_load(m, sh, lane); row_load(m + 1024, sc, lane);
        row_ln(v);
#pragma unroll
        for (int i = 0; i < 16; ++i) v[i] = v[i] * (1.0f + sc[i]) + sh[i];
        row_store(p.H + (size_t)r * D, v, lane);
    }
}

__device__ void phase_gemm(const float* __restrict__ A, const float* __restrict__ B, float* __restrict__ C, int M, int N, int K, int bid, int nb, float* lds) {
    float (*As)[68] = (float (*)[68])lds;
    float (*Bs)[64] = (float (*)[64])(lds + 16 * 68);
    const int t = threadIdx.x, ty = t >> 4, tx = t & 15;
    const int tn = N / 64, tiles = (M / 64) * tn;
    for (int tile = bid; tile < tiles; tile += nb) {
        const int m0 = (tile / tn) * 64, n0 = (tile % tn) * 64;
        float acc[4][4];
#pragma unroll
        for (int i = 0; i < 4; ++i)
#pragma unroll
            for (int j = 0; j < 4; ++j) acc[i][j] = 0.f;
        for (int k0 = 0; k0 < K; k0 += 16) {
            const float4 a = *(const float4*)(A + (size_t)(m0 + (t >> 2)) * K + k0 + (t & 3) * 4);
            const float4 b = *(const float4*)(B + (size_t)(k0 + (t >> 4)) * N + n0 + (t & 15) * 4);
            __syncthreads();
            As[(t & 3) * 4 + 0][t >> 2] = a.x; As[(t & 3) * 4 + 1][t >> 2] = a.y; As[(t & 3) * 4 + 2][t >> 2] = a.z; As[(t & 3) * 4 + 3][t >> 2] = a.w;
            *(float4*)&Bs[t >> 4][(t & 15) * 4] = b;
            __syncthreads();
#pragma unroll
            for (int k = 0; k < 16; ++k) {
                const float4 av = *(const float4*)&As[k][ty * 4];
                const float4 bv = *(const float4*)&Bs[k][tx * 4];
                const float aa[4] = {av.x, av.y, av.z, av.w}, bb[4] = {bv.x, bv.y, bv.z, bv.w};
#pragma unroll
                for (int i = 0; i < 4; ++i)
#pragma unroll
                    for (int j = 0; j < 4; ++j) acc[i][j] += aa[i] * bb[j];
            }
        }
#pragma unroll
        for (int i = 0; i < 4; ++i) *(float4*)(C + (size_t)(m0 + ty * 4 + i) * N + n0 + tx * 4) = make_float4(acc[i][0], acc[i][1], acc[i][2], acc[i][3]);
    }
    __syncthreads();
}

__device__ void phase_rope(const Params& p, int bid, int nb) {
    for (size_t i = (size_t)bid * NT + threadIdx.x; i < (size_t)TL * 576; i += (size_t)nb * NT) {
        const int r = (int)(i / 576), q = (int)(i % 576), slot = q >> 5, pi = q & 31;
        int cb; float scale = 1.0f;
        if (slot < 4) cb = C_RQ + slot * 64;
        else if (slot < 8) { cb = C_RK + (slot - 4) * 64; scale = 0.125f; }
        else if (slot < 16) { cb = C_AQ + (slot - 8) * 64; scale = 0.125f; }
        else cb = C_AK + (slot - 16) * 64;
        const int s = r % SEQ, rowid = s >> 6, colid = s & 63;
        const int f = pi & 15;
        const float inv = powf(10000.0f, -(float)f / 16.0f);
        const float ang = (pi < 16 ? (float)rowid : (float)colid) * inv;
        const float cs = cosf(ang), sn = sinf(ang);
        const int d1 = (pi < 16 ? 0 : 32) + f, d2 = d1 + 16;
        float* row = p.P + (size_t)r * DIN + cb;
        const float x1 = row[d1], x2 = row[d2];
        row[d1] = (x1 * cs - x2 * sn) * scale;
        row[d2] = (x2 * cs + x1 * sn) * scale;
    }
    for (int i = bid * NT + threadIdx.x; i < TC * 768; i += nb * NT) {
        const int r = TL + i / 768, q = i % 768;
        const int col = q < 256 ? C_RK + q : C_AQ + (q - 256);
        p.P[(size_t)r * DIN + col] *= 0.125f;
    }
}

__device__ __forceinline__ float log_sigmoid_f(float x) { return -log1pf(expf(-x)); }

__device__ __forceinline__ size_t kv_off(int dir, int b, int pos, int h) { return ((((size_t)dir * NB + b) * NPOS + pos) * 4 + h) * 4096; }
__device__ void ret_kv_unit(const Params& p, int l, int u, float* lds) {
    const int h = u & 3, pos = (u >> 2) % NPOS, b = u / (4 * NPOS);
    float (*ks)[64] = (float (*)[64])lds;
    float (*vs)[64] = (float (*)[64])(lds + 32 * 64);
    const int t = threadIdx.x, dk = t >> 2, dv0 = (t & 3) * 16;
    const float lgf = log_sigmoid_f(p.rdf[l * 4 + h]), lgb = log_sigmoid_f(p.rdb[l * 4 + h]);
    const int r0 = chunk_row0(b, pos);
    float af[16], ab[16];
#pragma unroll
    for (int d = 0; d < 16; ++d) { af[d] = 0.f; ab[d] = 0.f; }
    for (int j0 = 0; j0 < 128; j0 += 32) {
        __syncthreads();
        for (int e = t; e < 32 * 64; e += NT) {
            const int j = e >> 6, d = e & 63;
            ks[j][d] = p.P[(size_t)(r0 + j0 + j) * DIN + C_RK + h * 64 + d];
            vs[j][d] = p.P[(size_t)(r0 + j0 + j) * DIN + C_RV + h * 64 + d];
        }
        __syncthreads();
        for (int j = 0; j < 32; ++j) {
            const int jl = j0 + j;
            const float kf = ks[j][dk] * expf(lgf * (float)(127 - jl)), kb = ks[j][dk] * expf(lgb * (float)jl);
#pragma unroll
            for (int d = 0; d < 16; ++d) { const float v = vs[j][dv0 + d]; af[d] += kf * v; ab[d] += kb * v; }
        }
    }
    float* of = p.KV + kv_off(0, b, pos, h) + dk * 64 + dv0;
    float* ob = p.KV + kv_off(1, b, pos, h) + dk * 64 + dv0;
#pragma unroll
    for (int d = 0; d < 16; ++d) { of[d] = af[d]; ob[d] = ab[d]; }
}

__device__ void phase_ret_scan(const Params& p, int l, int bid, int nb) {
    for (int i = bid * NT + threadIdx.x; i < 2 * NB * 4 * 4096; i += nb * NT) {
        const int e = i & 4095, h = (i >> 12) & 3, b = (i >> 14) & 1, dir = i >> 15;
        const float lg = log_sigmoid_f(dir ? p.rdb[l * 4 + h] : p.rdf[l * 4 + h]);
        const float cdec = expf(128.0f * lg);
        float s = 0.f;
        for (int step = 0; step < NPOS; ++step) {
            const int pos = dir == 0 ? step : (step == 0 ? 1 : (step == 1 ? 0 : 67 - step));
            const size_t o = kv_off(dir, b, pos, h) + e;
            p.ST[o] = s;
            s = s * cdec + p.KV[o];
        }
    }
}

__device__ void ret_out_unit(const Params& p, int l, int u, float* lds) {
    const int h = u & 3, pos = (u >> 2) % NPOS, b = u / (4 * NPOS);
    float (*ks)[64] = (float (*)[64])lds;
    float (*vs)[64] = (float (*)[64])(lds + 128 * 64);
    float* pf = lds + 2 * 128 * 64;
    float* pb = pf + 132;
    const int t = threadIdx.x, i = t >> 1, half = t & 1;
    const float lgf = log_sigmoid_f(p.rdf[l * 4 + h]), lgb = log_sigmoid_f(p.rdb[l * 4 + h]);
    const int r0 = chunk_row0(b, pos);
    __syncthreads();
    for (int e = t; e < 128 * 64; e += NT) {
        const int j = e >> 6, d = e & 63;
        ks[j][d] = p.P[(size_t)(r0 + j) * DIN + C_RK + h * 64 + d];
        vs[j][d] = p.P[(size_t)(r0 + j) * DIN + C_RV + h * 64 + d];
    }
    if (t < 129) { pf[t] = expf(lgf * (float)t); pb[t] = expf(lgb * (float)t); }
    __syncthreads();
    float q[64], acc[32];
    const float* qrow = p.P + (size_t)(r0 + i) * DIN + C_RQ + h * 64;
#pragma unroll
    for (int d = 0; d < 64; ++d) q[d] = qrow[d];
#pragma unroll
    for (int d = 0; d < 32; ++d) acc[d] = 0.f;
    for (int j = 0; j < 128; ++j) {
        float s = 0.f;
#pragma unroll
        for (int d = 0; d < 64; ++d) s += q[d] * ks[j][d];
        const int rel = i - j;
        const float w = rel > 0 ? pf[rel] : (rel < 0 ? pb[-rel] : 2.0f);
        s *= w;
#pragma unroll
        for (int d = 0; d < 32; ++d) acc[d] += s * vs[j][half * 32 + d];
    }
    const float qf = pf[i + 1], qb = pb[128 - i];
    const float* Sf = p.ST + kv_off(0, b, pos, h) + half * 32;
    const float* Sb = p.ST + kv_off(1, b, pos, h) + half * 32;
    for (int dk = 0; dk < 64; ++dk) {
        const float qv = qrow[dk];
        const float a = qv * qf, c = qv * qb;
#pragma unroll
        for (int d = 0; d < 32; ++d) acc[d] += a * Sf[dk * 64 + d] + c * Sb[dk * 64 + d];
    }
    float s = 0.f;
#pragma unroll
    for (int d = 0; d < 32; ++d) s += acc[d];
    s += __shfl_xor(s, 1);
    const float mu = s * (1.0f / 64.0f);
    float qq = 0.f;
#pragma unroll
    for (int d = 0; d < 32; ++d) { acc[d] -= mu; qq += acc[d] * acc[d]; }
    qq += __shfl_xor(qq, 1);
    const float rstd = rsqrtf(qq * (1.0f / 64.0f) + LN_EPS);
    const float* grow = p.P + (size_t)(r0 + i) * DIN + C_RG + h * 64 + half * 32;
    float* orow = p.MIX + (size_t)(r0 + i) * D + h * 64 + half * 32;
#pragma unroll
    for (int d = 0; d < 32; ++d) orow[d] = acc[d] * rstd * silu_f(grow[d]);
}

__device__ void sgu_unit(const Params& p, int l, int u, float* lds) {
    const int g = u & 3, pos = (u >> 2) % NPOS, b = u / (4 * NPOS);
    float (*vn)[64] = (float (*)[64])lds;
    const int t = threadIdx.x, i = t >> 1, half = t & 1;
    const int r0 = chunk_row0(b, pos);
    __syncthreads();
    {
        float v[32];
        const float* src = p.P + (size_t)(r0 + i) * DIN + C_SV + g * 64 + half * 32;
        float s = 0.f;
#pragma unroll
        for (int d = 0; d < 32; ++d) { v[d] = gelu_tanh(src[d]); s += v[d]; }
        s += __shfl_xor(s, 1);
        const float mu = s * (1.0f / 64.0f);
        float qq = 0.f;
#pragma unroll
        for (int d = 0; d < 32; ++d) { v[d] -= mu; qq += v[d] * v[d]; }
        qq += __shfl_xor(qq, 1);
        const float rstd = rsqrtf(qq * (1.0f / 64.0f) + LN_EPS);
#pragma unroll
        for (int d = 0; d < 32; ++d) vn[i][half * 32 + d] = v[d] * rstd;
    }
    __syncthreads();
    float acc[32];
#pragma unroll
    for (int d = 0; d < 32; ++d) acc[d] = 0.f;
    const float* wrow = p.sgu_w + (((size_t)l * 4 + g) * 128 + i) * 128;
    for (int j = 0; j < 128; ++j) {
        const float w = wrow[j];
#pragma unroll
        for (int d = 0; d < 32; ++d) acc[d] += w * vn[j][half * 32 + d];
    }
    const float bs = p.sgu_b[((size_t)l * 4 + g) * 128 + i];
    const float* urow = p.P + (size_t)(r0 + i) * DIN + C_SU + g * 64 + half * 32;
    float* orow = p.MIX + (size_t)(r0 + i) * D + 256 + g * 64 + half * 32;
#pragma unroll
    for (int d = 0; d < 32; ++d) orow[d] = gelu_tanh(urow[d]) * (acc[d] + bs);
}

__device__ void att_unit(const Params& p, int l, int u, float* lds) {
    const int hq = u & 7, blk = (u >> 3) % 66, b = u / (8 * 66);
    const int hkv = hq >> 2;
    float (*ks)[64] = (float (*)[64])lds;
    float (*vs)[64] = (float (*)[64])(lds + 128 * 64);
    const int t = threadIdx.x, i = t >> 1, half = t & 1;
    const bool lat = blk < 64;
    const int qrow0 = lat ? b * SEQ + blk * 128 : TL + b * LC + (blk - 64) * 128;
    const int qpos = blk * 128 + i;
    float q[64], acc[32];
    const float* qrow = p.P + (size_t)(qrow0 + i) * DIN + C_AQ + hq * 64;
#pragma unroll
    for (int d = 0; d < 64; ++d) q[d] = qrow[d];
#pragma unroll
    for (int d = 0; d < 32; ++d) acc[d] = 0.f;
    float m = p.sink[l * 8 + hq], den = 1.0f;
    for (int kt = 0; kt < 5; ++kt) {
        int krow0, kpos0 = 0; bool band = false;
        if (kt < 3) {
            if (!lat) continue;
            const int kb = blk - 1 + kt;
            if (kb < 0 || kb >= 64) continue;
            krow0 = b * SEQ + kb * 128; kpos0 = kb * 128; band = true;
        } else krow0 = TL + b * LC + (kt - 3) * 128;
        __syncthreads();
        for (int e = t; e < 128 * 64; e += NT) {
            const int j = e >> 6, d = e & 63;
            ks[j][d] = p.P[(size_t)(krow0 + j) * DIN + C_AK + hkv * 64 + d];
            vs[j][d] = p.P[(size_t)(krow0 + j) * DIN + C_AV + hkv * 64 + d];
        }
        __syncthreads();
        for (int j = 0; j < 128; ++j) {
            if (band) { const int rel = kpos0 + j - qpos; if (rel > 128 || rel < -128) continue; }
            float s = 0.f;
#pragma unroll
            for (int d = 0; d < 64; ++d) s += q[d] * ks[j][d];
            const float mn = fmaxf(m, s);
            const float sc = expf(m - mn), pe = expf(s - mn);
            den = den * sc + pe;
#pragma unroll
            for (int d = 0; d < 32; ++d) acc[d] = acc[d] * sc + pe * vs[j][half * 32 + d];
            m = mn;
        }
    }
    const float inv = 1.0f / den;
    float* orow = p.MIX + (size_t)(qrow0 + i) * D + 512 + hq * 64 + half * 32;
#pragma unroll
    for (int d = 0; d < 32; ++d) orow[d] = acc[d] * inv;
}

__device__ void phase_mix_a(const Params& p, int l, int bid, int nb, float* lds) {
    const int n_kv = NB * NPOS * 4, n_sgu = NB * NPOS * 4, n_att = NB * 66 * 8;
    for (int u = bid; u < n_kv + n_sgu + n_att; u += nb) {
        if (u < n_kv) ret_kv_unit(p, l, u, lds);
        else if (u < n_kv + n_sgu) sgu_unit(p, l, u - n_kv, lds);
        else att_unit(p, l, u - n_kv - n_sgu, lds);
    }
    __syncthreads();
}
__device__ void phase_ret_out(const Params& p, int l, int bid, int nb, float* lds) {
    for (int u = bid; u < NB * NPOS * 4; u += nb) ret_out_unit(p, l, u, lds);
    __syncthreads();
}

__device__ void phase_ln1(const Params& p, int l, int bid, int nb) {
    const int lane = threadIdx.x & 63, w = threadIdx.x >> 6;
    for (int r = bid * 4 + w; r < T; r += nb * 4) {
        float v[16], a[16], c[16];
        row_load(x_row(p, l, r), v, lane);
        row_load(p.Y + (size_t)r * D, a, lane);
        const float* m = p.mod + ((size_t)l * 3 + mod_idx(r)) * 6144;
        row_load(m + 2048, c, lane);
#pragma unroll
        for (int i = 0; i < 16; ++i) v[i] = ALPHA * v[i] + c[i] * a[i];
        row_ln(v);
        row_load(p.lnm_g + l * D, a, lane); row_load(p.lnm_b + l * D, c, lane);
#pragma unroll
        for (int i = 0; i < 16; ++i) v[i] = v[i] * a[i] + c[i];
        row_store(p.X1 + (size_t)r * D, v, lane);
        row_ln(v);
        row_load(m + 3072, a, lane); row_load(m + 4096, c, lane);
#pragma unroll
        for (int i = 0; i < 16; ++i) v[i] = v[i] * (1.0f + c[i]) + a[i];
        row_store(p.H + (size_t)r * D, v, lane);
    }
}

__device__ __forceinline__ void wave_argmax(float& bv, int& bi) {
#pragma unroll
    for (int o = 32; o >= 1; o >>= 1) {
        const float ov = __shfl_xor(bv, o); const int oi = __shfl_xor(bi, o);
        if (ov > bv || (ov == bv && oi < bi)) { bv = ov; bi = oi; }
    }
}
__device__ void phase_topk(const Params& p, int l, int bid, int nb, float* lds) {
    float (*kt)[129] = (float (*)[129])lds;
    float* qs_all = lds + 128 * 129;
    float* sc_all = qs_all + 4 * 128;
    const int t = threadIdx.x, lane = t & 63, w = t >> 6;
    float* qs = qs_all + w * 128;
    float* scv = sc_all + w * 64;
    int* sci = (int*)scv;
    for (int pass = 0; pass < 2; ++pass) {
        __syncthreads();
        const float* ktab = (pass == 0 ? p.k1 : p.k2) + (size_t)l * 128 * 128;
        for (int e = t; e < 128 * 128; e += NT) kt[e >> 7][e & 127] = ktab[e];
        __syncthreads();
        for (int it = bid * 4 + w; it < T * 8; it += nb * 4) {
            const int r = it >> 3, h = it & 7;
            const float* qp = p.Q + (size_t)r * 2048 + h * 256 + pass * 128;
            qs[lane] = qp[lane]; qs[lane + 64] = qp[lane + 64];
            __builtin_amdgcn_wave_barrier();
            float a0 = 0.f, a1 = 0.f;
            for (int d = 0; d < 128; ++d) { const float qd = qs[d]; a0 += qd * kt[lane][d]; a1 += qd * kt[lane + 64][d]; }
            float tv[16]; int ti[16];
#pragma unroll
            for (int rr = 0; rr < 16; ++rr) {
                float bv; int bi;
                if (a0 >= a1) { bv = a0; bi = lane; } else { bv = a1; bi = lane + 64; }
                wave_argmax(bv, bi);
                if (bi == lane) a0 = -INFINITY;
                if (bi == lane + 64) a1 = -INFINITY;
                tv[rr] = bv; ti[rr] = bi;
            }
            if (pass == 0) {
                if (lane < 16) {
                    float vv = 0.f; int ii = 0;
#pragma unroll
                    for (int rr = 0; rr < 16; ++rr) if (lane == rr) { vv = tv[rr]; ii = ti[rr]; }
                    p.V1[(size_t)it * 16 + lane] = vv; p.I1[(size_t)it * 16 + lane] = ii;
                }
            } else {
                if (lane < 16) {
                    float vv = 0.f; int ii = 0;
#pragma unroll
                    for (int rr = 0; rr < 16; ++rr) if (lane == rr) { vv = tv[rr]; ii = ti[rr]; }
                    scv[32 + lane] = vv; sci[48 + lane] = ii;
                    scv[lane] = p.V1[(size_t)it * 16 + lane]; sci[16 + lane] = p.I1[(size_t)it * 16 + lane];
                }
                __builtin_amdgcn_wave_barrier();
                float cv[4];
#pragma unroll
                for (int rr = 0; rr < 4; ++rr) cv[rr] = scv[lane >> 2] + scv[32 + (lane & 3) * 4 + rr];
                float topv[16]; int topc[16];
#pragma unroll
                for (int rr = 0; rr < 16; ++rr) {
                    float bv = cv[0]; int bi = lane * 4;
#pragma unroll
                    for (int k = 1; k < 4; ++k) if (cv[k] > bv) { bv = cv[k]; bi = lane * 4 + k; }
                    wave_argmax(bv, bi);
#pragma unroll
                    for (int k = 0; k < 4; ++k) if (bi == lane * 4 + k) cv[k] = -INFINITY;
                    topv[rr] = bv; topc[rr] = bi;
                }
                float den = 0.f;
#pragma unroll
                for (int rr = 0; rr < 16; ++rr) den += expf(topv[rr] - topv[0]);
                if (lane < 16) {
                    float vv = 0.f; int cc = 0;
#pragma unroll
                    for (int rr = 0; rr < 16; ++rr) if (lane == rr) { vv = topv[rr]; cc = topc[rr]; }
                    const int e = sci[16 + (cc >> 4)] * 128 + sci[48 + (cc & 15)];
                    p.EIDX[(size_t)r * NSEL + h * 16 + lane] = e;
                    p.GATE[(size_t)r * NSEL + h * 16 + lane] = expf(vv - topv[0]) / den;
                }
                __builtin_amdgcn_wave_barrier();
            }
        }
    }
    __syncthreads();
}

__device__ void phase_expert(const Params& p, int l, int bid, int nb) {
    const int lane = threadIdx.x & 63, w = threadIdx.x >> 6;
    const float* U = p.pu + (size_t)l * PEER_N * D;
    const float* V = p.pv + (size_t)l * PEER_N * D;
    for (int r = bid * 4 + w; r < T; r += nb * 4) {
        float x[16], acc[16];
        row_load(p.H + (size_t)r * D, x, lane);
#pragma unroll
        for (int i = 0; i < 16; ++i) acc[i] = 0.f;
#pragma unroll 2
        for (int s = 0; s < NSEL; ++s) {
            const int e = p.EIDX[(size_t)r * NSEL + s];
            const float g = p.GATE[(size_t)r * NSEL + s];
            float uu[16], vv[16];
            row_load(U + (size_t)e * D, uu, lane);
            row_load(V + (size_t)e * D, vv, lane);
            float d = 0.f;
#pragma unroll
            for (int i = 0; i < 16; ++i) d += x[i] * uu[i];
            d = wave_sum(d);
            const float a = gelu_tanh(d) * g;
#pragma unroll
            for (int i = 0; i < 16; ++i) acc[i] += a * vv[i];
        }
        row_store(p.Y + (size_t)r * D, acc, lane);
    }
}

__device__ void phase_ln2(const Params& p, int l, int bid, int nb) {
    const int lane = threadIdx.x & 63, w = threadIdx.x >> 6;
    for (int r = bid * 4 + w; r < T; r += nb * 4) {
        float v[16], a[16], c[16];
        row_load(p.X1 + (size_t)r * D, v, lane);
        row_load(p.Y + (size_t)r * D, a, lane);
        const float* m = p.mod + ((size_t)l * 3 + mod_idx(r)) * 6144;
        row_load(m + 5120, c, lane);
#pragma unroll
        for (int i = 0; i < 16; ++i) v[i] = ALPHA * v[i] + c[i] * a[i];
        row_ln(v);
        row_load(p.lnf_g + l * D, a, lane); row_load(p.lnf_b + l * D, c, lane);
#pragma unroll
        for (int i = 0; i < 16; ++i) v[i] = v[i] * a[i] + c[i];
        if (l == DEPTH - 1) { if (r < TL) row_store(p.out + (size_t)r * D, v, lane); }
        else row_store(p.X + (size_t)r * D, v, lane);
    }
}

constexpr int LDS_FLOATS = 128 * 129 + 4 * 128 + 4 * 64 + 64;
__global__ void __launch_bounds__(NT) mega(Params p) {
    __shared__ __attribute__((aligned(16))) float lds[LDS_FLOATS];
    cg::grid_group grid = cg::this_grid();
    const int bid = blockIdx.x, nb = gridDim.x;
    phase_mod1(p, bid, nb);
    grid.sync();
    phase_mod2(p, bid, nb);
    grid.sync();
    for (int l = 0; l < DEPTH; ++l) {
        phase_lnmod(p, l, bid, nb);
        grid.sync();
        phase_gemm(p.H, p.w_in + (size_t)l * D * DIN, p.P, T, DIN, D, bid, nb, lds);
        grid.sync();
        phase_rope(p, bid, nb);
        grid.sync();
        phase_mix_a(p, l, bid, nb, lds);
        grid.sync();
        phase_ret_scan(p, l, bid, nb);
        grid.sync();
        phase_ret_out(p, l, bid, nb, lds);
        grid.sync();
        phase_gemm(p.MIX, p.w_out + (size_t)l * D * D, p.Y, T, D, D, bid, nb, lds);
        grid.sync();
        phase_ln1(p, l, bid, nb);
        grid.sync();
        phase_gemm(p.H, p.wq + (size_t)l * D * 2048, p.Q, T, 2048, D, bid, nb, lds);
        grid.sync();
        phase_topk(p, l, bid, nb, lds);
        grid.sync();
        phase_expert(p, l, bid, nb);
        grid.sync();
        phase_ln2(p, l, bid, nb);
        grid.sync();
    }
}

extern "C" void kernel_launch(void* const* d_in, const int* in_sizes, int n_in, void* d_out, int out_size, void* d_ws, size_t ws_size, hipStream_t stream) {
    static int grid_blocks = 0;
    if (!grid_blocks) {
        int dev = 0, cus = 0, per_cu = 0;
        hipGetDevice(&dev);
        hipDeviceGetAttribute(&cus, hipDeviceAttributeMultiprocessorCount, dev);
        hipOccupancyMaxActiveBlocksPerMultiprocessor(&per_cu, mega, NT, 0);
        if (per_cu > 2) per_cu = 2;
        if (per_cu < 1) per_cu = 1;
        grid_blocks = cus * per_cu;
    }
    Params p{};
    const float** ins = (const float**)&p;
    for (int i = 0; i < 22; ++i) ins[i] = (const float*)d_in[i];
    p.out = (float*)d_out;
    char* ws = (char*)d_ws;
    size_t off = 0;
    auto carve = [&](size_t bytes) { void* r = ws + off; off += (bytes + 255) & ~(size_t)255; return r; };
    p.modp = (float*)carve((size_t)16 * DEPTH * 3 * 6144 * 4);
    p.mod = (float*)carve((size_t)DEPTH * 3 * 6144 * 4);
    p.X = (float*)carve((size_t)T * D * 4);
    p.H = (float*)carve((size_t)T * D * 4);
    p.P = (float*)carve((size_t)T * DIN * 4);
    p.KV = (float*)carve((size_t)2 * NB * NPOS * 4 * 4096 * 4);
    p.ST = (float*)carve((size_t)2 * NB * NPOS * 4 * 4096 * 4);
    p.MIX = (float*)carve((size_t)T * D * 4);
    p.Y = (float*)carve((size_t)T * D * 4);
    p.X1 = (float*)carve((size_t)T * D * 4);
    p.Q = (float*)carve((size_t)T * 2048 * 4);
    p.GATE = (float*)carve((size_t)T * NSEL * 4);
    p.V1 = (float*)carve((size_t)T * 8 * 16 * 4);
    p.EIDX = (int*)carve((size_t)T * NSEL * 4);
    p.I1 = (int*)carve((size_t)T * 8 * 16 * 4);
    if (off > ws_size) { fprintf(stderr, "workspace too small: need %zu have %zu\n", off, ws_size); return; }
    void* args[] = {&p};
    hipError_t e = hipLaunchCooperativeKernel((void*)mega, dim3(grid_blocks), dim3(NT), args, 0, stream);
    if (e != hipSuccess) fprintf(stderr, "cooperative launch failed: %s (grid %d)\n", hipGetErrorString(e), grid_blocks);
}
```

```cpp
#include <hip/hip_runtime.h>
#include <hip/hip_cooperative_groups.h>
#include <cstdio>
#include <cstdint>
namespace cg = cooperative_groups;

constexpr int D = 1024, NB = 2, SEQ = 8192, DEPTH = 4, LC = 256, HD = 64;
constexpr int TL = NB * SEQ, TC = NB * LC, T = TL + TC;
constexpr int DIN = 2304;
constexpr int C_RQ = 0, C_RK = 256, C_RV = 512, C_RG = 768, C_SU = 1024, C_SV = 1280, C_AQ = 1536, C_AK = 2048, C_AV = 2176;
constexpr int NPOS = 66;
constexpr int PEER_N = 16384, NSEL = 128;
constexpr float LN_EPS = 1e-5f;
constexpr float ALPHA = 1.681792830507429f;
constexpr int NT = 512;
constexpr int NW = 8;
constexpr int LDS_BYTES = 147456;
constexpr int MISC_OFF = 131072 + 320;

typedef unsigned short bf16;
#define LAS __attribute__((address_space(3)))

struct Params {
    const float *x, *c, *ctx, *c_ctx, *w_mod, *b_mod, *w_in, *w_out, *rdf, *rdb, *sgu_w, *sgu_b, *sink, *lnm_g, *lnm_b, *wq, *k1, *k2, *pu, *pv, *lnf_g, *lnf_b;
    float* out;
    unsigned* ctl;
    float *modp, *mod, *rope, *X, *KV, *ST, *Y, *X1, *Q, *GATE, *V1;
    bf16 *WtIn, *WtOut, *WtQ, *H, *P, *MIX;
    int *EIDX, *I1;
};

__device__ __forceinline__ unsigned f2bf(float f) { unsigned u = __builtin_bit_cast(unsigned, f); return (u + 0x7fffu + ((u >> 16) & 1u)) >> 16; }
__device__ __forceinline__ unsigned pk2(float lo, float hi) { return f2bf(lo) | (f2bf(hi) << 16); }
__device__ __forceinline__ float bf2f(bf16 v) { return __builtin_bit_cast(float, (unsigned)v << 16); }
__device__ __forceinline__ float bflo(unsigned w) { return __builtin_bit_cast(float, w << 16); }
__device__ __forceinline__ float bfhi(unsigned w) { return __builtin_bit_cast(float, w & 0xffff0000u); }

__device__ __forceinline__ float gelu_tanh(float x) {
    const float k0 = 0.7978845608028654f, k1 = 0.044715f;
    float u = k0 * (x + k1 * x * x * x);
    return 0.5f * x * (1.0f + tanhf(u));
}
__device__ __forceinline__ float silu_f(float x) { return x / (1.0f + expf(-x)); }
__device__ __forceinline__ float wave_sum(float v) {
#pragma unroll
    for (int o = 32; o >= 1; o >>= 1) v += __shfl_xor(v, o);
    return v;
}
__device__ __forceinline__ int chunk_row0(int b, int pos) { return pos < 2 ? TL + b * LC + pos * 128 : b * SEQ + (pos - 2) * 128; }
__device__ __forceinline__ int mod_idx(int r) { return r < TL ? r / SEQ : 2; }
__device__ __forceinline__ float log_sigmoid_f(float x) { return -log1pf(expf(-x)); }
typedef const __attribute__((address_space(4))) Params* KP;
__device__ __forceinline__ KP kparams() { KP k = (KP)__builtin_amdgcn_kernarg_segment_ptr(); asm volatile("" : "+s"(k)); return k; }
__device__ __forceinline__ int tid_opaque() { int t = threadIdx.x; asm volatile("" : "+v"(t)); return t; }

namespace pg8 {
#define PG8_LAS __attribute__((address_space(3)))
typedef unsigned short bf16_t;
typedef short bf16x8 __attribute__((ext_vector_type(8)));
typedef float f32x4 __attribute__((ext_vector_type(4)));
typedef unsigned u32x4 __attribute__((ext_vector_type(4)));
constexpr int BM = 256, BK = 64, HALF = 128, HTB = HALF * BK * 2  , STAGE_BYTES = 8 * HTB, NXCD = 8, WGM = 8;

__host__ __device__ __forceinline__ int lds_byte(int r, int c) { const int st = (r >> 4) * 2 + (c >> 5), rr = r & 15, cc = c & 31, ob = rr * 64 + cc * 2; return st * 1024 + (ob ^ (((ob >> 9) & 1) << 5)); }
__host__ __device__ __forceinline__ void stage_rc(int b, int& R, int& C) { const int st = b / 1024, sb = b % 1024, swz = sb ^ (((sb >> 9) & 1) << 5); R = (st >> 1) * 16 + swz / 64; C = (st & 1) * 32 + (swz % 64) / 2; }
__host__ __device__ __forceinline__ int perm32(int rho) { const int n = rho >> 4, i = rho & 15; return 8 * (i >> 2) + 4 * n + (i & 3); }

struct Unit { int pm, pn; };
struct Gemm { const bf16_t* A; const bf16_t* Bt; int M, N, K; };

struct StaticOrder {
    int nM, nN, nwg, G, c;
    __host__ __device__ void init(int M, int N, int G_, int c_) { nM = M / BM; nN = N / BM; nwg = nM * nN; G = G_; c = c_; }
    __host__ __device__ bool next(int i, Unit& u) const {
        const long L = (long)i * G + c; if (L >= nwg) return false;
        int wgid = (int)L; { const int q = nwg / NXCD, r = nwg % NXCD, xcd = wgid % NXCD, off = wgid / NXCD; wgid = (xcd < r ? xcd * (q + 1) : r * (q + 1) + (xcd - r) * q) + off; }
        const int nig = WGM * nN, gid = wgid / nig, fm = gid * WGM, gsz = (nM - fm) < WGM ? (nM - fm) : WGM;
        u.pm = fm + ((wgid % nig) % gsz); u.pn = (wgid % nig) / gsz; return true;
    }
    __device__ __forceinline__ void a_ready(const Unit&) const {}
    __device__ __forceinline__ void done(const Unit&) const {}
};

__device__ __forceinline__ unsigned cvt_pk_bf16(float lo, float hi) { unsigned r; asm volatile("v_cvt_pk_bf16_f32 %0, %1, %2" : "=v"(r) : "v"(lo), "v"(hi)); return r; }
struct EpiInProj {
    static constexpr bool PERM = true, AFTER_DRAIN = false;
    bf16_t* P; const float* rope;
    __device__ __forceinline__ void operator()(const f32x4 (&acc)[2][2][4][2], const Unit& u, int wr, int wc, int fr, int fq) const {
        const int pn = u.pn; const bool lat = u.pm < 64;
        const float sc = (pn == 1 || pn == 6 || pn == 7) ? 0.125f : 1.0f;
        const float sgn = fq < 2 ? -1.0f : 1.0f;
#pragma unroll
        for (int bj = 0; bj < 2; ++bj) {
            const bool roped = lat && (pn == 0 || pn == 1 || pn == 6 || pn == 7 || (pn == 8 && bj == 0));
#pragma unroll
            for (int ai = 0; ai < 2; ++ai)
#pragma unroll
                for (int m = 0; m < 4; ++m) {
                    const int row = u.pm * BM + ai * HALF + wr * 64 + m * 16 + fr;
                    f32x4 v0 = acc[ai][bj][m][0], v1 = acc[ai][bj][m][1];
                    if (roped) {
                        const int pos = row & 8191, idx = (wc & 1) ? 128 + (pos & 63) : (pos >> 6);
                        const float2* tb = (const float2*)rope + idx * 16 + 8 * (fq & 1);
#pragma unroll
                        for (int e = 0; e < 4; ++e) {
                            const float p0 = __shfl_xor(v0[e], 32), p1 = __shfl_xor(v1[e], 32);
                            const float2 c0 = tb[e], c1 = tb[4 + e];
                            v0[e] = v0[e] * c0.x + sgn * p0 * c0.y;
                            v1[e] = v1[e] * c1.x + sgn * p1 * c1.y;
                        }
                    }
                    v0 = v0 * sc; v1 = v1 * sc;
                    u32x4 w; w.x = cvt_pk_bf16(v0[0], v0[1]); w.y = cvt_pk_bf16(v0[2], v0[3]); w.z = cvt_pk_bf16(v1[0], v1[1]); w.w = cvt_pk_bf16(v1[2], v1[3]);
                    *(u32x4*)(P + (size_t)row * 2304 + pn * BM + bj * HALF + wc * 32 + fq * 8) = w;
                    __builtin_amdgcn_sched_barrier(0);
                }
        }
    }
};
struct EpiF32 {
    static constexpr bool PERM = false, AFTER_DRAIN = false;
    float* O; int ldc;
    __device__ __forceinline__ void operator()(const f32x4 (&acc)[2][2][4][2], const Unit& u, int wr, int wc, int fr, int fq) const {
#pragma unroll
        for (int ai = 0; ai < 2; ++ai)
#pragma unroll
            for (int m = 0; m < 4; ++m) {
                float* rowp = O + (size_t)(u.pm * BM + ai * HALF + wr * 64 + m * 16 + fr) * ldc + u.pn * BM + wc * 32 + fq * 4;
#pragma unroll
                for (int bj = 0; bj < 2; ++bj)
#pragma unroll
                    for (int n = 0; n < 2; ++n) *(f32x4*)(rowp + bj * HALF + n * 16) = acc[ai][bj][m][n];
            }
    }
};


template <class Epi, class Sched, bool ALIGN_EPI = false, bool SP2 = false>
__device__ __forceinline__ void gemm_phase(PG8_LAS unsigned char* lds, const Gemm g, const Sched& S, const Epi& E) {
    int tid_ = threadIdx.x; asm volatile("" : "+v"(tid_));
    const int tid = tid_, wid = __builtin_amdgcn_readfirstlane(tid >> 6), lane = tid & 63, wr = wid >> 2, wc = wid & 3, fr = lane & 15, fq = lane >> 4;
    const int K = g.K, nt = K / BK;
    unsigned voffA[2], voffB[2];
#pragma unroll
    for (int i = 0; i < 2; ++i) { int R, C; stage_rc(tid * 16 + i * 8192, R, C); const int Rb = Epi::PERM ? ((R & ~31) + perm32(R & 31)) : R;
        voffA[i] = (unsigned)(R * K + C) * 2u; voffB[i] = (unsigned)(Rb * K + C) * 2u; }
    const size_t kstep = (size_t)(BK * 2);
    const size_t hstep = (size_t)HALF * K * 2;
    const size_t tstep = 2 * hstep;
    const unsigned ldsw = (unsigned)wid * 1024u;
    const int aoff = lds_byte(wr * 64 + fr, fq * 8), boff = lds_byte(wc * 32 + fr, fq * 8);
#define PG8_SA(b, h) (((b) * 2 + (h)) * HTB)
#define PG8_SB(b, h) ((4 + (b) * 2 + (h)) * HTB)
#define PG8_STAGE(bufoff, gbase, voff) do { _Pragma("unroll") for (int _i = 0; _i < 2; ++_i) \
        __builtin_amdgcn_global_load_lds((const unsigned*)((const char*)(gbase) + (voff)[_i]), (PG8_LAS unsigned*)(lds + (bufoff) + ldsw + _i * 8192), 16, 0, 0); } while (0)
#define PG8_LDA(dst, b, h) do { _Pragma("unroll") for (int m = 0; m < 4; ++m) _Pragma("unroll") for (int k = 0; k < 2; ++k) dst[m][k] = *(const PG8_LAS bf16x8*)(lds + PG8_SA(b, h) + aoff + m * 2048 + k * 1024); } while (0)
#define PG8_LDB(dst, b, h) do { _Pragma("unroll") for (int n = 0; n < 2; ++n) _Pragma("unroll") for (int k = 0; k < 2; ++k) dst[n][k] = *(const PG8_LAS bf16x8*)(lds + PG8_SB(b, h) + boff + n * 2048 + k * 1024); } while (0)
#define PG8_MMA(ai, bj, At, Bt) do { __builtin_amdgcn_s_setprio(1); _Pragma("unroll") for (int m = 0; m < 4; ++m) _Pragma("unroll") for (int n = 0; n < 2; ++n) _Pragma("unroll") for (int k = 0; k < 2; ++k) \
        acc[ai][bj][m][n] = __builtin_amdgcn_mfma_f32_16x16x32_bf16(Bt[n][k], At[m][k], acc[ai][bj][m][n], 0, 0, 0); __builtin_amdgcn_s_setprio(0); } while (0)
#define PG8_WAIT_V(n) asm volatile("s_waitcnt vmcnt(" #n ")" ::: "memory")
#define PG8_WAIT_L(n) asm volatile("s_waitcnt lgkmcnt(" #n ")" ::: "memory")
#define PG8_BAR __builtin_amdgcn_s_barrier()
#define PG8_SCHED __builtin_amdgcn_sched_barrier(0)
    Unit cur, nxt; int ui = 0;
    if (!S.next(0, cur)) return;
    f32x4 acc[2][2][4][2];
#pragma unroll
    for (int a = 0; a < 2; ++a)
#pragma unroll
        for (int b = 0; b < 2; ++b)
#pragma unroll
            for (int m = 0; m < 4; ++m)
#pragma unroll
                for (int n = 0; n < 2; ++n) acc[a][b][m][n] = (f32x4){0.f, 0.f, 0.f, 0.f};
    bf16x8 At[4][2], B0[2][2], B1[2][2];
    const char* cA = (const char*)g.A + (size_t)cur.pm * tstep; const char* cB = (const char*)g.Bt + (size_t)cur.pn * tstep;
    S.a_ready(cur);
    if constexpr (SP2) {
        PG8_STAGE(PG8_SB(0, 0), cB, voffB); PG8_STAGE(PG8_SB(0, 1), cB + hstep, voffB); PG8_STAGE(PG8_SA(0, 0), cA, voffA); PG8_STAGE(PG8_SA(0, 1), cA + hstep, voffA);
        if (wr == 1) PG8_BAR;
        PG8_WAIT_V(2); PG8_BAR;
        PG8_STAGE(PG8_SB(1, 0), cB + kstep, voffB); PG8_STAGE(PG8_SA(1, 0), cA + kstep, voffA); PG8_STAGE(PG8_SB(1, 1), cB + hstep + kstep, voffB);
        PG8_WAIT_V(6); PG8_BAR;
    } else {
        PG8_STAGE(PG8_SB(0, 0), cB, voffB); PG8_STAGE(PG8_SA(0, 0), cA, voffA); PG8_STAGE(PG8_SB(0, 1), cB + hstep, voffB); PG8_STAGE(PG8_SA(0, 1), cA + hstep, voffA);
        if (wr == 1) PG8_BAR;
        PG8_WAIT_V(4); PG8_BAR;
        PG8_STAGE(PG8_SB(1, 0), cB + kstep, voffB); PG8_STAGE(PG8_SA(1, 0), cA + kstep, voffA); PG8_STAGE(PG8_SB(1, 1), cB + hstep + kstep, voffB);
        PG8_WAIT_V(6); PG8_BAR;
    }
    for (;;) {
        const bool has_next = S.next(ui + 1, nxt);
        const char* nA = has_next ? (const char*)g.A + (size_t)nxt.pm * tstep : cA; const char* nB = has_next ? (const char*)g.Bt + (size_t)nxt.pn * tstep : cB;
        for (int t = 0; t < nt; t += 2) {
            const bool last = (t == nt - 2);
            const char* a1 = cA + (size_t)(t + 1) * kstep;
            const char* a2 = last ? nA : cA + (size_t)(t + 2) * kstep; const char* b2 = last ? nB : cB + (size_t)(t + 2) * kstep;
            const char* a3 = a2 + kstep; const char* b3 = b2 + kstep;
            if (last && has_next) S.a_ready(nxt);
            if constexpr (SP2) {
            PG8_LDB(B0, 0, 0); PG8_LDB(B1, 0, 1); PG8_SCHED; PG8_LDA(At, 0, 0); PG8_STAGE(PG8_SA(1, 1), a1 + hstep, voffA);
            PG8_WAIT_V(8); PG8_WAIT_L(0); PG8_BAR; PG8_MMA(0, 0, At, B0); PG8_MMA(0, 1, At, B1); PG8_BAR; PG8_SCHED;
            PG8_LDA(At, 0, 1); PG8_STAGE(PG8_SB(0, 0), b2, voffB); PG8_STAGE(PG8_SB(0, 1), b2 + hstep, voffB); PG8_STAGE(PG8_SA(0, 0), a2, voffA);
            PG8_WAIT_V(8); PG8_WAIT_L(0); PG8_BAR; PG8_MMA(1, 0, At, B0); PG8_MMA(1, 1, At, B1); PG8_BAR; PG8_SCHED;
            PG8_LDB(B0, 1, 0); PG8_LDB(B1, 1, 1); PG8_SCHED; PG8_LDA(At, 1, 0); PG8_STAGE(PG8_SA(0, 1), a2 + hstep, voffA);
            PG8_WAIT_V(8); PG8_WAIT_L(0); PG8_BAR; PG8_MMA(0, 0, At, B0); PG8_MMA(0, 1, At, B1); PG8_BAR; PG8_SCHED;
            PG8_LDA(At, 1, 1); PG8_STAGE(PG8_SB(1, 0), b3, voffB); PG8_STAGE(PG8_SB(1, 1), b3 + hstep, voffB); PG8_STAGE(PG8_SA(1, 0), a3, voffA);
            PG8_WAIT_V(8); PG8_WAIT_L(0); PG8_BAR; PG8_MMA(1, 0, At, B0); PG8_MMA(1, 1, At, B1); PG8_BAR; PG8_SCHED;
            } else {
            PG8_LDB(B0, 0, 0); PG8_SCHED; PG8_LDA(At, 0, 0); PG8_STAGE(PG8_SA(1, 1), a1 + hstep, voffA);
            PG8_WAIT_L(8); PG8_BAR; PG8_WAIT_L(0); PG8_MMA(0, 0, At, B0); PG8_BAR; PG8_SCHED;
            PG8_LDB(B1, 0, 1); PG8_STAGE(PG8_SB(0, 0), b2, voffB);
            PG8_BAR; PG8_WAIT_L(0); PG8_MMA(0, 1, At, B1); PG8_BAR;
            PG8_LDA(At, 0, 1); PG8_STAGE(PG8_SA(0, 0), a2, voffA);
            PG8_BAR; PG8_WAIT_L(0); PG8_MMA(1, 0, At, B0); PG8_BAR; PG8_SCHED;
            PG8_STAGE(PG8_SB(0, 1), b2 + hstep, voffB);
            PG8_WAIT_V(6); PG8_BAR; PG8_MMA(1, 1, At, B1); PG8_BAR;
            PG8_LDB(B0, 1, 0); PG8_SCHED; PG8_LDA(At, 1, 0); PG8_STAGE(PG8_SA(0, 1), a2 + hstep, voffA);
            PG8_WAIT_L(8); PG8_BAR; PG8_WAIT_L(0); PG8_MMA(0, 0, At, B0); PG8_BAR; PG8_SCHED;
            PG8_LDB(B1, 1, 1); PG8_STAGE(PG8_SB(1, 0), b3, voffB);
            PG8_BAR; PG8_WAIT_L(0); PG8_MMA(0, 1, At, B1); PG8_BAR;
            PG8_LDA(At, 1, 1); PG8_STAGE(PG8_SA(1, 0), a3, voffA);
            PG8_BAR; PG8_WAIT_L(0); PG8_MMA(1, 0, At, B0); PG8_BAR; PG8_SCHED;
            PG8_STAGE(PG8_SB(1, 1), b3 + hstep, voffB);
            PG8_WAIT_V(6); PG8_BAR; PG8_MMA(1, 1, At, B1); PG8_BAR;
            }
        }
        if constexpr (ALIGN_EPI) { if (wr == 0) PG8_BAR; }
        if constexpr (!Epi::AFTER_DRAIN) { E(acc, cur, wr, wc, fr, fq); S.done(cur); }
        if (!has_next) break;
#pragma unroll
        for (int a = 0; a < 2; ++a)
#pragma unroll
            for (int b = 0; b < 2; ++b)
#pragma unroll
                for (int m = 0; m < 4; ++m)
#pragma unroll
                    for (int n = 0; n < 2; ++n) acc[a][b][m][n] = (f32x4){0.f, 0.f, 0.f, 0.f};
        cur = nxt; cA = nA; cB = nB; ++ui;
        if constexpr (ALIGN_EPI) { if (wr == 1) PG8_BAR; }
    }
    PG8_WAIT_V(0);
    if constexpr (!ALIGN_EPI) { if (wr == 0) PG8_BAR; }
    PG8_BAR;
    if constexpr (Epi::AFTER_DRAIN) { E.fused(acc, cur, wr, wc, fr, fq, lds, wid, lane); S.done(cur); }
#undef PG8_SA
#undef PG8_SB
#undef PG8_STAGE
#undef PG8_LDA
#undef PG8_LDB
#undef PG8_MMA
#undef PG8_WAIT_V
#undef PG8_WAIT_L
#undef PG8_BAR
#undef PG8_SCHED
}
}
constexpr int CW_BAR = 4096;
constexpr size_t CTL_BYTES = 65536;
#define XB_TMO      128
#define XB_XCNT(j)  (256  + 64 * (j))
#define XB_XSUB(j)  (1280 + 64 * (j))
#define XB_XGEN(j)  (2304 + 64 * (j))
#define XB_TOP      3328
#define XB_TOPGEN   3392
#define XCD_BAR_WORDS 3456
#define XB_SPIN_CAP (1u << 18)

__device__ __forceinline__ unsigned xb_ld(unsigned* p)              { return __hip_atomic_load(p, __ATOMIC_RELAXED, __HIP_MEMORY_SCOPE_AGENT); }
__device__ __forceinline__ unsigned xb_add(unsigned* p, unsigned v) { return __hip_atomic_fetch_add(p, v, __ATOMIC_RELAXED, __HIP_MEMORY_SCOPE_AGENT); }
__device__ __forceinline__ unsigned xb_xcc_id() { return (unsigned)__builtin_amdgcn_s_getreg((3 << 11) | 20) & 0xFu; }
#define XB_SPIN(cond, bar) do { unsigned _sp = 0; while (cond) { __builtin_amdgcn_s_sleep(1); \
    if ((++_sp & 255u) == 0u) { if (xb_ld(&(bar)[XB_TMO])) break; if (_sp > XB_SPIN_CAP) { atomicAdd(&(bar)[XB_TMO], 1u); break; } } } } while (0)

struct XcdBarrier {
    unsigned* bar; unsigned x;
    volatile LAS unsigned* st;
};

__device__ __forceinline__ XcdBarrier xcd_barrier_post(unsigned* bar, volatile LAS unsigned* st) {
    XcdBarrier b; b.bar = bar; b.x = xb_xcc_id(); b.st = st;
    if (threadIdx.x == 0) (void)xb_add(&bar[XB_XCNT(b.x)], 1u);
    return b;
}
__device__ __forceinline__ void xcd_barrier_complete(unsigned* bar, unsigned x, unsigned& nloc, unsigned& nx) {
    const unsigned G = gridDim.x * gridDim.y * gridDim.z;
    unsigned sum, cnt, mine, sp = 0u;
    for (;;) {
        sum = 0u; cnt = 0u; mine = 0u;
#pragma unroll
        for (unsigned j = 0; j < 16; ++j) { const unsigned c = xb_ld(&bar[XB_XCNT(j)]); sum += c; cnt += (c > 0u) ? 1u : 0u; mine = (j == x) ? c : mine; }
        if (sum == G) break;
        __builtin_amdgcn_s_sleep(1);
        if ((++sp & 255u) == 0u) { if (xb_ld(&bar[XB_TMO])) break; if (sp > XB_SPIN_CAP) { atomicAdd(&bar[XB_TMO], 1u); break; } }
    }
    nloc = mine > 0u ? mine : 1u; nx = cnt > 0u ? cnt : 1u;
}

__device__ __forceinline__ void xcd_barrier(const XcdBarrier& b) {
    asm volatile("s_waitcnt vmcnt(0)" ::: "memory");
    __syncthreads();
    if (threadIdx.x == 0) {
        unsigned* bar = b.bar;
        __builtin_amdgcn_s_waitcnt(0);
        unsigned nloc = b.st[0], nx = b.st[1];
        if (nloc == 0u) { xcd_barrier_complete(bar, b.x, nloc, nx); b.st[0] = nloc; b.st[1] = nx; }
        const unsigned old = xb_add(&bar[XB_XSUB(b.x)], 1u);
        const unsigned gen = old / nloc;
        if (old + 1u == (gen + 1u) * nloc) {
            __builtin_amdgcn_fence(__ATOMIC_RELEASE, "agent");
            asm volatile("s_waitcnt vmcnt(0)" ::: "memory");
            const unsigned og = xb_add(&bar[XB_TOP], 1u);
            const unsigned tg = og / nx;
            if (og + 1u == (tg + 1u) * nx) xb_add(&bar[XB_TOPGEN], 1u);
            else XB_SPIN(xb_ld(&bar[XB_TOPGEN]) == tg, bar);
            __builtin_amdgcn_fence(__ATOMIC_ACQUIRE, "agent");
            xb_add(&bar[XB_XGEN(b.x)], 1u);
            asm volatile("s_waitcnt vmcnt(0)" ::: "memory");
        } else {
            XB_SPIN(xb_ld(&bar[XB_XGEN(b.x)]) == gen, bar);
            __builtin_amdgcn_fence(__ATOMIC_ACQUIRE, "agent");
            asm volatile("s_waitcnt vmcnt(0)" ::: "memory");
        }
    }
    __syncthreads();
}


__device__ __forceinline__ void phase_mod1(KP p, int bid, int nb, float* lds) {
    float (*red)[8][64] = (float (*)[8][64])lds;
    const int t = tid_opaque(), cn = t & 63, kg = t >> 6;
    for (int u = bid; u < DEPTH * 96 * 16; u += nb) {
        const int ks = u & 15, nblk = (u >> 4) % 96, l = u / (16 * 96);
        const int n = nblk * 64 + cn;
        float a0 = 0.f, a1 = 0.f, a2 = 0.f;
#pragma unroll
        for (int kk = 0; kk < 8; ++kk) {
            const int k = ks * 64 + kg * 8 + kk;
            const float w = p->w_mod[((size_t)l * D + k) * 6144 + n];
            a0 += silu_f(p->c[k]) * w; a1 += silu_f(p->c[D + k]) * w; a2 += silu_f(p->c_ctx[k]) * w;
        }
        __syncthreads();
        red[0][kg][cn] = a0; red[1][kg][cn] = a1; red[2][kg][cn] = a2;
        __syncthreads();
        if (t < 192) {
            const int v = t >> 6;
            float s = 0.f;
#pragma unroll
            for (int g = 0; g < 8; ++g) s += red[v][g][cn];
            p->modp[(((size_t)ks * DEPTH + l) * 3 + v) * 6144 + n] = s;
        }
    }
    __syncthreads();
}
__device__ __forceinline__ void phase_mod2(KP p, int bid, int nb) {
    for (int i = bid * NT + tid_opaque(); i < DEPTH * 3 * 6144; i += nb * NT) {
        const int n = i % 6144, l = i / (3 * 6144);
        float s = p->b_mod[l * 6144 + n];
        for (int ks = 0; ks < 16; ++ks) s += p->modp[(size_t)ks * DEPTH * 3 * 6144 + i];
        p->mod[i] = s;
    }
}
__device__ __forceinline__ void transpose_item(const float* W, int K, int N, bf16* WT, float* scr, int item, int lane) {
    const int nblk = N / 32, kb = item / nblk, nbk = item % nblk, k0 = 64 * kb, n0 = 32 * nbk;
#pragma unroll 8
    for (int i = 0; i < 32; ++i) { const int kk = 2 * i + (lane >> 5); scr[kk * 33 + (lane & 31)] = W[(size_t)(k0 + kk) * N + n0 + (lane & 31)]; }
    __builtin_amdgcn_wave_barrier();
    const int c = lane & 7;
#pragma unroll
    for (int j = 0; j < 4; ++j) { const int n = (lane >> 3) + 8 * j; const float* s = scr + (8 * c) * 33 + n;
        uint4 o; o.x = pk2(s[0 * 33], s[1 * 33]); o.y = pk2(s[2 * 33], s[3 * 33]); o.z = pk2(s[4 * 33], s[5 * 33]); o.w = pk2(s[6 * 33], s[7 * 33]);
        *(uint4*)(WT + (size_t)(n0 + n) * K + k0 + 8 * c) = o; }
    __builtin_amdgcn_wave_barrier();
}
__device__ __forceinline__ void phase_weights(KP p, int bid, int nb, float* lds) {
    const int lane = tid_opaque() & 63, w = tid_opaque() >> 6;
    float* scr = lds + 2048 + w * (64 * 33 + 16);
    constexpr int I_IN = 16 * 72, I_OUT = 16 * 32, I_Q = 16 * 64;
    constexpr int NITEMS = DEPTH * (I_IN + I_OUT + I_Q);
    for (int it = bid * NW + w; it < NITEMS; it += nb * NW) {
        int r = it;
        if (r < DEPTH * I_IN) { const int l = r / I_IN; transpose_item(p->w_in + (size_t)l * D * DIN, D, DIN, p->WtIn + (size_t)l * DIN * D, scr, r % I_IN, lane); continue; } r -= DEPTH * I_IN;
        if (r < DEPTH * I_OUT) { const int l = r / I_OUT; transpose_item(p->w_out + (size_t)l * D * D, D, D, p->WtOut + (size_t)l * D * D, scr, r % I_OUT, lane); continue; } r -= DEPTH * I_OUT;
        { const int l = r / I_Q; transpose_item(p->wq + (size_t)l * D * 2048, D, 2048, p->WtQ + (size_t)l * 2048 * D, scr, r % I_Q, lane); }
    }
    for (int i = bid * NT + tid_opaque(); i < 192 * 16; i += nb * NT) {
        const int idx = i >> 4, f = i & 15;
        const float inv = powf(10000.0f, -(float)f / 16.0f);
        const float ang = (float)(idx < 128 ? idx : idx - 128) * inv;
        p->rope[2 * i] = cosf(ang); p->rope[2 * i + 1] = sinf(ang);
    }
}

__device__ __forceinline__ void row_load(const float* src, float (&v)[16], int lane) {
#pragma unroll
    for (int i = 0; i < 4; ++i) { const float4 q = *(const float4*)(src + i * 256 + lane * 4); v[i * 4 + 0] = q.x; v[i * 4 + 1] = q.y; v[i * 4 + 2] = q.z; v[i * 4 + 3] = q.w; }
}
__device__ __forceinline__ void row_store(float* dst, const float (&v)[16], int lane) {
#pragma unroll
    for (int i = 0; i < 4; ++i) *(float4*)(dst + i * 256 + lane * 4) = make_float4(v[i * 4 + 0], v[i * 4 + 1], v[i * 4 + 2], v[i * 4 + 3]);
}
__device__ __forceinline__ void row_store_bf(bf16* dst, const float (&v)[16], int lane) {
#pragma unroll
    for (int i = 0; i < 4; ++i) *(uint2*)(dst + i * 256 + lane * 4) = make_uint2(pk2(v[i * 4 + 0], v[i * 4 + 1]), pk2(v[i * 4 + 2], v[i * 4 + 3]));
}
__device__ __forceinline__ void row_load_bf(const bf16* src, float (&v)[16], int lane) {
#pragma unroll
    for (int i = 0; i < 4; ++i) { const uint2 q = *(const uint2*)(src + i * 256 + lane * 4); v[i * 4 + 0] = bflo(q.x); v[i * 4 + 1] = bfhi(q.x); v[i * 4 + 2] = bflo(q.y); v[i * 4 + 3] = bfhi(q.y); }
}
__device__ __forceinline__ void row_ln(float (&v)[16]) {
    float s = 0.f;
#pragma unroll
    for (int i = 0; i < 16; ++i) s += v[i];
    const float mu = wave_sum(s) * (1.0f / D);
    float q = 0.f;
#pragma unroll
    for (int i = 0; i < 16; ++i) { v[i] -= mu; q += v[i] * v[i]; }
    const float rstd = rsqrtf(wave_sum(q) * (1.0f / D) + LN_EPS);
#pragma unroll
    for (int i = 0; i < 16; ++i) v[i] *= rstd;
}
__device__ __forceinline__ const float* x_row(KP p, int l, int r) {
    if (l == 0) return r < TL ? p->x + (size_t)r * D : p->ctx + (size_t)(r - TL) * D;
    return p->X + (size_t)r * D;
}

__device__ __forceinline__ void phase_lnmod(KP p, int l, int bid, int nb) {
    const int lane = tid_opaque() & 63, w = tid_opaque() >> 6;
    for (int r = bid * NW + w; r < T; r += nb * NW) {
        float v[16], sh[16], sc[16];
        row_load(x_row(p, l, r), v, lane);
        const float* m = p->mod + ((size_t)l * 3 + mod_idx(r)) * 6144;
        row_load(m, sh, lane); row_load(m + 1024, sc, lane);
        row_ln(v);
#pragma unroll
        for (int i = 0; i < 16; ++i) v[i] = v[i] * (1.0f + sc[i]) + sh[i];
        row_store_bf(p->H + (size_t)r * D, v, lane);
    }
}

__device__ __forceinline__ size_t kv_off(int dir, int b, int pos, int h) { return ((((size_t)dir * NB + b) * NPOS + pos) * 4 + h) * 4096; }
__device__ __forceinline__ void ret_kv_unit(KP p, int l, int u, float* lds) {
    const int h = u & 3, pos = (u >> 2) % NPOS, b = u / (4 * NPOS);
    float (*ks)[64] = (float (*)[64])lds;
    float (*vs)[64] = (float (*)[64])(lds + 64 * 64);
    const int t = tid_opaque(), dk = t >> 3, dv0 = (t & 7) * 8;
    const float lgf = log_sigmoid_f(p->rdf[l * 4 + h]), lgb = log_sigmoid_f(p->rdb[l * 4 + h]);
    const int r0 = chunk_row0(b, pos);
    float af[8], ab[8];
#pragma unroll
    for (int d = 0; d < 8; ++d) { af[d] = 0.f; ab[d] = 0.f; }
    for (int j0 = 0; j0 < 128; j0 += 64) {
        __syncthreads();
        for (int e = t; e < 64 * 64; e += NT) {
            const int j = e >> 6, d = e & 63;
            ks[j][d] = bf2f(p->P[(size_t)(r0 + j0 + j) * DIN + C_RK + h * 64 + d]);
            vs[j][d] = bf2f(p->P[(size_t)(r0 + j0 + j) * DIN + C_RV + h * 64 + d]);
        }
        __syncthreads();
        for (int j = 0; j < 64; ++j) {
            const int jl = j0 + j;
            const float kf = ks[j][dk] * expf(lgf * (float)(127 - jl)), kb = ks[j][dk] * expf(lgb * (float)jl);
#pragma unroll
            for (int d = 0; d < 8; ++d) { const float v = vs[j][dv0 + d]; af[d] += kf * v; ab[d] += kb * v; }
        }
    }
    float* of = p->KV + kv_off(0, b, pos, h) + dk * 64 + dv0;
    float* ob = p->KV + kv_off(1, b, pos, h) + dk * 64 + dv0;
#pragma unroll
    for (int d = 0; d < 8; ++d) { of[d] = af[d]; ob[d] = ab[d]; }
}

__device__ __forceinline__ void phase_ret_scan(KP p, int l, int bid, int nb) {
    for (int i = bid * NT + tid_opaque(); i < 2 * NB * 4 * 4096; i += nb * NT) {
        const int e = i & 4095, h = (i >> 12) & 3, b = (i >> 14) & 1, dir = i >> 15;
        const float lg = log_sigmoid_f(dir ? p->rdb[l * 4 + h] : p->rdf[l * 4 + h]);
        const float cdec = expf(128.0f * lg);
        float s = 0.f;
        for (int step = 0; step < NPOS; ++step) {
            const int pos = dir == 0 ? step : (step == 0 ? 1 : (step == 1 ? 0 : 67 - step));
            const size_t o = kv_off(dir, b, pos, h) + e;
            p->ST[o] = s;
            s = s * cdec + p->KV[o];
        }
    }
}

__device__ __forceinline__ void ret_out_unit(KP p, int l, int u, float* lds) {
    const int h = u & 3, pos = (u >> 2) % NPOS, b = u / (4 * NPOS);
    float (*ks)[68] = (float (*)[68])lds;
    float (*vs)[64] = (float (*)[64])(lds + 128 * 68);
    float* pf = lds + 128 * 68 + 128 * 64;
    float* pb = pf + 132;
    const int t = tid_opaque(), i = t >> 2, qd = t & 3;
    const float lgf = log_sigmoid_f(p->rdf[l * 4 + h]), lgb = log_sigmoid_f(p->rdb[l * 4 + h]);
    const int r0 = chunk_row0(b, pos);
    __syncthreads();
    for (int e = t; e < 128 * 64; e += NT) {
        const int j = e >> 6, d = e & 63;
        ks[j][d] = bf2f(p->P[(size_t)(r0 + j) * DIN + C_RK + h * 64 + d]);
        vs[j][d] = bf2f(p->P[(size_t)(r0 + j) * DIN + C_RV + h * 64 + d]);
    }
    if (t < 129) { pf[t] = expf(lgf * (float)t); pb[t] = expf(lgb * (float)t); }
    __syncthreads();
    float q[16], acc[16];
    const bf16* qrow = p->P + (size_t)(r0 + i) * DIN + C_RQ + h * 64;
#pragma unroll
    for (int d = 0; d < 16; ++d) q[d] = bf2f(qrow[qd * 16 + d]);
#pragma unroll
    for (int d = 0; d < 16; ++d) acc[d] = 0.f;
    for (int j = 0; j < 128; ++j) {
        float s = 0.f;
#pragma unroll
        for (int d = 0; d < 16; ++d) s += q[d] * ks[j][qd * 16 + d];
        s += __shfl_xor(s, 1); s += __shfl_xor(s, 2);
        const int rel = i - j;
        const float w = rel > 0 ? pf[rel] : (rel < 0 ? pb[-rel] : 2.0f);
        s *= w;
#pragma unroll
        for (int d = 0; d < 16; ++d) acc[d] += s * vs[j][qd * 16 + d];
    }
    const float qf = pf[i + 1], qb = pb[128 - i];
    const float* Sf = p->ST + kv_off(0, b, pos, h) + qd * 16;
    const float* Sb = p->ST + kv_off(1, b, pos, h) + qd * 16;
    for (int dk = 0; dk < 64; ++dk) {
        const float qv = bf2f(qrow[dk]);
        const float a = qv * qf, c = qv * qb;
#pragma unroll
        for (int d = 0; d < 16; ++d) acc[d] += a * Sf[dk * 64 + d] + c * Sb[dk * 64 + d];
    }
    float s = 0.f;
#pragma unroll
    for (int d = 0; d < 16; ++d) s += acc[d];
    s += __shfl_xor(s, 1); s += __shfl_xor(s, 2);
    const float mu = s * (1.0f / 64.0f);
    float qq = 0.f;
#pragma unroll
    for (int d = 0; d < 16; ++d) { acc[d] -= mu; qq += acc[d] * acc[d]; }
    qq += __shfl_xor(qq, 1); qq += __shfl_xor(qq, 2);
    const float rstd = rsqrtf(qq * (1.0f / 64.0f) + LN_EPS);
    const bf16* grow = p->P + (size_t)(r0 + i) * DIN + C_RG + h * 64 + qd * 16;
    bf16* orow = p->MIX + (size_t)(r0 + i) * D + h * 64 + qd * 16;
#pragma unroll
    for (int d = 0; d < 16; ++d) orow[d] = (bf16)f2bf(acc[d] * rstd * silu_f(bf2f(grow[d])));
}

__device__ __forceinline__ void sgu_unit(KP p, int l, int u, float* lds) {
    const int g = u & 3, pos = (u >> 2) % NPOS, b = u / (4 * NPOS);
    float (*vn)[64] = (float (*)[64])lds;
    const int t = tid_opaque(), i = t >> 2, qd = t & 3;
    const int r0 = chunk_row0(b, pos);
    __syncthreads();
    {
        float v[16];
        const bf16* src = p->P + (size_t)(r0 + i) * DIN + C_SV + g * 64 + qd * 16;
        float s = 0.f;
#pragma unroll
        for (int d = 0; d < 16; ++d) { v[d] = gelu_tanh(bf2f(src[d])); s += v[d]; }
        s += __shfl_xor(s, 1); s += __shfl_xor(s, 2);
        const float mu = s * (1.0f / 64.0f);
        float qq = 0.f;
#pragma unroll
        for (int d = 0; d < 16; ++d) { v[d] -= mu; qq += v[d] * v[d]; }
        qq += __shfl_xor(qq, 1); qq += __shfl_xor(qq, 2);
        const float rstd = rsqrtf(qq * (1.0f / 64.0f) + LN_EPS);
#pragma unroll
        for (int d = 0; d < 16; ++d) vn[i][qd * 16 + d] = v[d] * rstd;
    }
    __syncthreads();
    float acc[16];
#pragma unroll
    for (int d = 0; d < 16; ++d) acc[d] = 0.f;
    const float* wrow = p->sgu_w + (((size_t)l * 4 + g) * 128 + i) * 128;
    for (int j = 0; j < 128; ++j) {
        const float w = wrow[j];
#pragma unroll
        for (int d = 0; d < 16; ++d) acc[d] += w * vn[j][qd * 16 + d];
    }
    const float bs = p->sgu_b[((size_t)l * 4 + g) * 128 + i];
    const bf16* urow = p->P + (size_t)(r0 + i) * DIN + C_SU + g * 64 + qd * 16;
    bf16* orow = p->MIX + (size_t)(r0 + i) * D + 256 + g * 64 + qd * 16;
#pragma unroll
    for (int d = 0; d < 16; ++d) orow[d] = (bf16)f2bf(gelu_tanh(bf2f(urow[d])) * (acc[d] + bs));
}

__device__ __forceinline__ void att_unit(KP p, int l, int u, float* lds) {
    const int hq = u & 7, blk = (u >> 3) % 66, b = u / (8 * 66);
    const int hkv = hq >> 2;
    float (*ks)[68] = (float (*)[68])lds;
    float (*vs)[64] = (float (*)[64])(lds + 128 * 68);
    const int t = tid_opaque(), i = t >> 2, qd = t & 3;
    const bool lat = blk < 64;
    const int qrow0 = lat ? b * SEQ + blk * 128 : TL + b * LC + (blk - 64) * 128;
    const int qpos = blk * 128 + i;
    float q[16], acc[16];
    const bf16* qrow = p->P + (size_t)(qrow0 + i) * DIN + C_AQ + hq * 64 + qd * 16;
#pragma unroll
    for (int d = 0; d < 16; ++d) q[d] = bf2f(qrow[d]);
#pragma unroll
    for (int d = 0; d < 16; ++d) acc[d] = 0.f;
    float m = p->sink[l * 8 + hq], den = 1.0f;
    for (int kt = 0; kt < 5; ++kt) {
        int krow0, kpos0 = 0; bool band = false;
        if (kt < 3) {
            if (!lat) continue;
            const int kb = blk - 1 + kt;
            if (kb < 0 || kb >= 64) continue;
            krow0 = b * SEQ + kb * 128; kpos0 = kb * 128; band = true;
        } else krow0 = TL + b * LC + (kt - 3) * 128;
        __syncthreads();
        for (int e = t; e < 128 * 64; e += NT) {
            const int j = e >> 6, d = e & 63;
            ks[j][d] = bf2f(p->P[(size_t)(krow0 + j) * DIN + C_AK + hkv * 64 + d]);
            vs[j][d] = bf2f(p->P[(size_t)(krow0 + j) * DIN + C_AV + hkv * 64 + d]);
        }
        __syncthreads();
        for (int j = 0; j < 128; ++j) {
            float s = 0.f;
#pragma unroll
            for (int d = 0; d < 16; ++d) s += q[d] * ks[j][qd * 16 + d];
            s += __shfl_xor(s, 1); s += __shfl_xor(s, 2);
            if (band) { const int rel = kpos0 + j - qpos; if (rel > 128 || rel < -128) continue; }
            const float mn = fmaxf(m, s);
            const float sc = expf(m - mn), pe = expf(s - mn);
            den = den * sc + pe;
#pragma unroll
            for (int d = 0; d < 16; ++d) acc[d] = acc[d] * sc + pe * vs[j][qd * 16 + d];
            m = mn;
        }
    }
    const float inv = 1.0f / den;
    bf16* orow = p->MIX + (size_t)(qrow0 + i) * D + 512 + hq * 64 + qd * 16;
#pragma unroll
    for (int d = 0; d < 16; ++d) orow[d] = (bf16)f2bf(acc[d] * inv);
}

__device__ __forceinline__ void phase_mix_a(KP p, int l, int bid, int nb, float* lds) {
    const int n_kv = NB * NPOS * 4, n_sgu = NB * NPOS * 4, n_att = NB * 66 * 8;
    for (int u = bid; u < n_kv + n_sgu + n_att; u += nb) {
        if (u < n_kv) ret_kv_unit(p, l, u, lds);
        else if (u < n_kv + n_sgu) sgu_unit(p, l, u - n_kv, lds);
        else att_unit(p, l, u - n_kv - n_sgu, lds);
    }
    __syncthreads();
}
__device__ __forceinline__ void phase_ret_out(KP p, int l, int bid, int nb, float* lds) {
    for (int u = bid; u < NB * NPOS * 4; u += nb) ret_out_unit(p, l, u, lds);
    __syncthreads();
}

__device__ __forceinline__ void phase_ln1(KP p, int l, int bid, int nb) {
    const int lane = tid_opaque() & 63, w = tid_opaque() >> 6;
    for (int r = bid * NW + w; r < T; r += nb * NW) {
        float v[16], a[16], c[16];
        row_load(x_row(p, l, r), v, lane);
        row_load(p->Y + (size_t)r * D, a, lane);
        const float* m = p->mod + ((size_t)l * 3 + mod_idx(r)) * 6144;
        row_load(m + 2048, c, lane);
#pragma unroll
        for (int i = 0; i < 16; ++i) v[i] = ALPHA * v[i] + c[i] * a[i];
        row_ln(v);
        row_load(p->lnm_g + l * D, a, lane); row_load(p->lnm_b + l * D, c, lane);
#pragma unroll
        for (int i = 0; i < 16; ++i) v[i] = v[i] * a[i] + c[i];
        row_store(p->X1 + (size_t)r * D, v, lane);
        row_ln(v);
        row_load(m + 3072, a, lane); row_load(m + 4096, c, lane);
#pragma unroll
        for (int i = 0; i < 16; ++i) v[i] = v[i] * (1.0f + c[i]) + a[i];
        row_store_bf(p->H + (size_t)r * D, v, lane);
    }
}

__device__ __forceinline__ void wave_argmax(float& bv, int& bi) {
#pragma unroll
    for (int o = 32; o >= 1; o >>= 1) {
        const float ov = __shfl_xor(bv, o); const int oi = __shfl_xor(bi, o);
        if (ov > bv || (ov == bv && oi < bi)) { bv = ov; bi = oi; }
    }
}
__device__ __forceinline__ void phase_topk(KP p, int l, int bid, int nb, float* lds) {
    float (*kt)[129] = (float (*)[129])lds;
    float* qs_all = lds + 128 * 129;
    float* sc_all = qs_all + NW * 128;
    const int t = tid_opaque(), lane = t & 63, w = t >> 6;
    float* qs = qs_all + w * 128;
    float* scv = sc_all + w * 64;
    int* sci = (int*)scv;
    for (int pass = 0; pass < 2; ++pass) {
        __syncthreads();
        const float* ktab = (pass == 0 ? p->k1 : p->k2) + (size_t)l * 128 * 128;
        for (int e = t; e < 128 * 128; e += NT) kt[e >> 7][e & 127] = ktab[e];
        __syncthreads();
        for (int it = bid * NW + w; it < T * 8; it += nb * NW) {
            const int r = it >> 3, h = it & 7;
            const float* qp = p->Q + (size_t)r * 2048 + h * 256 + pass * 128;
            qs[lane] = qp[lane]; qs[lane + 64] = qp[lane + 64];
            __builtin_amdgcn_wave_barrier();
            float a0 = 0.f, a1 = 0.f;
            for (int d = 0; d < 128; ++d) { const float qd = qs[d]; a0 += qd * kt[lane][d]; a1 += qd * kt[lane + 64][d]; }
            float tv[16]; int ti[16];
#pragma unroll
            for (int rr = 0; rr < 16; ++rr) {
                float bv; int bi;
                if (a0 >= a1) { bv = a0; bi = lane; } else { bv = a1; bi = lane + 64; }
                wave_argmax(bv, bi);
                if (bi == lane) a0 = -INFINITY;
                if (bi == lane + 64) a1 = -INFINITY;
                tv[rr] = bv; ti[rr] = bi;
            }
            if (pass == 0) {
                if (lane < 16) {
                    float vv = 0.f; int ii = 0;
#pragma unroll
                    for (int rr = 0; rr < 16; ++rr) if (lane == rr) { vv = tv[rr]; ii = ti[rr]; }
                    p->V1[(size_t)it * 16 + lane] = vv; p->I1[(size_t)it * 16 + lane] = ii;
                }
            } else {
                if (lane < 16) {
                    float vv = 0.f; int ii = 0;
#pragma unroll
                    for (int rr = 0; rr < 16; ++rr) if (lane == rr) { vv = tv[rr]; ii = ti[rr]; }
                    scv[32 + lane] = vv; sci[48 + lane] = ii;
                    scv[lane] = p->V1[(size_t)it * 16 + lane]; sci[16 + lane] = p->I1[(size_t)it * 16 + lane];
                }
                __builtin_amdgcn_wave_barrier();
                float cv[4];
#pragma unroll
                for (int rr = 0; rr < 4; ++rr) cv[rr] = scv[lane >> 2] + scv[32 + (lane & 3) * 4 + rr];
                float topv[16]; int topc[16];
#pragma unroll
                for (int rr = 0; rr < 16; ++rr) {
                    float bv = cv[0]; int bi = lane * 4;
#pragma unroll
                    for (int k = 1; k < 4; ++k) if (cv[k] > bv) { bv = cv[k]; bi = lane * 4 + k; }
                    wave_argmax(bv, bi);
#pragma unroll
                    for (int k = 0; k < 4; ++k) if (bi == lane * 4 + k) cv[k] = -INFINITY;
                    topv[rr] = bv; topc[rr] = bi;
                }
                float den = 0.f;
#pragma unroll
                for (int rr = 0; rr < 16; ++rr) den += expf(topv[rr] - topv[0]);
                if (lane < 16) {
                    float vv = 0.f; int cc = 0;
#pragma unroll
                    for (int rr = 0; rr < 16; ++rr) if (lane == rr) { vv = topv[rr]; cc = topc[rr]; }
                    const int e = sci[16 + (cc >> 4)] * 128 + sci[48 + (cc & 15)];
                    p->EIDX[(size_t)r * NSEL + h * 16 + lane] = e;
                    p->GATE[(size_t)r * NSEL + h * 16 + lane] = expf(vv - topv[0]) / den;
                }
                __builtin_amdgcn_wave_barrier();
            }
        }
    }
    __syncthreads();
}

__device__ __forceinline__ void phase_expert(KP p, int l, int bid, int nb) {
    const int lane = tid_opaque() & 63, w = tid_opaque() >> 6;
    const float* U = p->pu + (size_t)l * PEER_N * D;
    const float* V = p->pv + (size_t)l * PEER_N * D;
    for (int r = bid * NW + w; r < T; r += nb * NW) {
        float x[16], acc[16];
        row_load_bf(p->H + (size_t)r * D, x, lane);
#pragma unroll
        for (int i = 0; i < 16; ++i) acc[i] = 0.f;
#pragma unroll 2
        for (int s = 0; s < NSEL; ++s) {
            const int e = p->EIDX[(size_t)r * NSEL + s];
            const float g = p->GATE[(size_t)r * NSEL + s];
            float uu[16], vv[16];
            row_load(U + (size_t)e * D, uu, lane);
            row_load(V + (size_t)e * D, vv, lane);
            float d = 0.f;
#pragma unroll
            for (int i = 0; i < 16; ++i) d += x[i] * uu[i];
            d = wave_sum(d);
            const float a = gelu_tanh(d) * g;
#pragma unroll
            for (int i = 0; i < 16; ++i) acc[i] += a * vv[i];
        }
        row_store(p->Y + (size_t)r * D, acc, lane);
    }
}

__device__ __forceinline__ void phase_ln2(KP p, int l, int bid, int nb) {
    const int lane = tid_opaque() & 63, w = tid_opaque() >> 6;
    for (int r = bid * NW + w; r < T; r += nb * NW) {
        float v[16], a[16], c[16];
        row_load(p->X1 + (size_t)r * D, v, lane);
        row_load(p->Y + (size_t)r * D, a, lane);
        const float* m = p->mod + ((size_t)l * 3 + mod_idx(r)) * 6144;
        row_load(m + 5120, c, lane);
#pragma unroll
        for (int i = 0; i < 16; ++i) v[i] = ALPHA * v[i] + c[i] * a[i];
        row_ln(v);
        row_load(p->lnf_g + l * D, a, lane); row_load(p->lnf_b + l * D, c, lane);
#pragma unroll
        for (int i = 0; i < 16; ++i) v[i] = v[i] * a[i] + c[i];
        if (l == DEPTH - 1) { if (r < TL) row_store(p->out + (size_t)r * D, v, lane); continue; }
        row_store(p->X + (size_t)r * D, v, lane);
        const float* m2 = p->mod + ((size_t)(l + 1) * 3 + mod_idx(r)) * 6144;
        row_ln(v);
        row_load(m2, a, lane); row_load(m2 + 1024, c, lane);
#pragma unroll
        for (int i = 0; i < 16; ++i) v[i] = v[i] * (1.0f + c[i]) + a[i];
        row_store_bf(p->H + (size_t)r * D, v, lane);
    }
}

__global__ void __launch_bounds__(NT, 2) mega(Params p_unused) {
    extern __shared__ __attribute__((aligned(16))) unsigned char lds_raw[];
    cg::grid_group grid = cg::this_grid();
    const int bid = blockIdx.x, nb = gridDim.x;
    float* lds = (float*)lds_raw;
    LAS unsigned char* ldsl = (LAS unsigned char*)lds_raw;
    volatile LAS unsigned* MISC = (volatile LAS unsigned*)(ldsl + MISC_OFF);
    for (int u = threadIdx.x; u < (LDS_BYTES - 131072) / 4; u += NT) ((LAS unsigned*)(ldsl + 131072))[u] = 0u;
    __syncthreads();
    XcdBarrier bar = xcd_barrier_post(kparams()->ctl + CW_BAR, MISC + 8);

    phase_mod1(kparams(), bid, nb, lds);
    phase_weights(kparams(), bid, nb, lds);
    grid.sync();
    phase_mod2(kparams(), bid, nb);
    xcd_barrier(bar);
    phase_lnmod(kparams(), 0, bid, nb);
    xcd_barrier(bar);
    for (int l = 0; l < DEPTH; ++l) {
        { KP p = kparams();
            pg8::Gemm g{p->H, p->WtIn + (size_t)l * DIN * D, T, DIN, D}; pg8::StaticOrder S; S.init(T, DIN, nb, bid);
            pg8::EpiInProj E{p->P, p->rope};
            pg8::gemm_phase<pg8::EpiInProj, pg8::StaticOrder, true, true>(ldsl, g, S, E);
        }
        xcd_barrier(bar);
        phase_mix_a(kparams(), l, bid, nb, lds);
        xcd_barrier(bar);
        phase_ret_scan(kparams(), l, bid, nb);
        xcd_barrier(bar);
        phase_ret_out(kparams(), l, bid, nb, lds);
        xcd_barrier(bar);
        { KP p = kparams();
            pg8::Gemm g{p->MIX, p->WtOut + (size_t)l * D * D, T, D, D}; pg8::StaticOrder S; S.init(T, D, nb, bid);
            pg8::EpiF32 E{p->Y, D};
            pg8::gemm_phase<pg8::EpiF32, pg8::StaticOrder, true, true>(ldsl, g, S, E);
        }
        xcd_barrier(bar);
        phase_ln1(kparams(), l, bid, nb);
        xcd_barrier(bar);
        { KP p = kparams();
            pg8::Gemm g{p->H, p->WtQ + (size_t)l * 2048 * D, T, 2048, D}; pg8::StaticOrder S; S.init(T, 2048, nb, bid);
            pg8::EpiF32 E{p->Q, 2048};
            pg8::gemm_phase<pg8::EpiF32, pg8::StaticOrder, true, true>(ldsl, g, S, E);
        }
        xcd_barrier(bar);
        phase_topk(kparams(), l, bid, nb, lds);
        xcd_barrier(bar);
        phase_expert(kparams(), l, bid, nb);
        xcd_barrier(bar);
        phase_ln2(kparams(), l, bid, nb);
        if (l + 1 < DEPTH) xcd_barrier(bar);
    }
}

extern "C" void kernel_launch(void* const* d_in, const int* in_sizes, int n_in, void* d_out, int out_size, void* d_ws, size_t ws_size, hipStream_t stream) {
    static int grid_blocks = 0;
    if (!grid_blocks) {
        int dev = 0, cus = 0, per_cu = 0;
        (void)hipGetDevice(&dev);
        (void)hipDeviceGetAttribute(&cus, hipDeviceAttributeMultiprocessorCount, dev);
        (void)hipFuncSetAttribute((const void*)mega, hipFuncAttributeMaxDynamicSharedMemorySize, LDS_BYTES);
        (void)hipOccupancyMaxActiveBlocksPerMultiprocessor(&per_cu, mega, NT, LDS_BYTES);
        if (per_cu < 1) { fprintf(stderr, "occupancy query says %d blocks per CU\n", per_cu); per_cu = 1; }
        grid_blocks = cus;
    }
    Params p{};
    const float** ins = (const float**)&p;
    for (int i = 0; i < 22; ++i) ins[i] = (const float*)d_in[i];
    p.out = (float*)d_out;
    char* ws = (char*)d_ws;
    size_t off = 0;
    auto carve = [&](size_t bytes) { void* r = ws + off; off += (bytes + 255) & ~(size_t)255; return r; };
    p.ctl = (unsigned*)carve(CTL_BYTES);
    p.modp = (float*)carve((size_t)16 * DEPTH * 3 * 6144 * 4);
    p.mod = (float*)carve((size_t)DEPTH * 3 * 6144 * 4);
    p.rope = (float*)carve((size_t)192 * 16 * 2 * 4);
    p.WtIn = (bf16*)carve((size_t)DEPTH * DIN * D * 2);
    p.WtOut = (bf16*)carve((size_t)DEPTH * D * D * 2);
    p.WtQ = (bf16*)carve((size_t)DEPTH * 2048 * D * 2);
    p.X = (float*)carve((size_t)T * D * 4);
    p.H = (bf16*)carve((size_t)T * D * 2);
    p.P = (bf16*)carve((size_t)T * DIN * 2);
    p.KV = (float*)carve((size_t)2 * NB * NPOS * 4 * 4096 * 4);
    p.ST = (float*)carve((size_t)2 * NB * NPOS * 4 * 4096 * 4);
    p.MIX = (bf16*)carve((size_t)T * D * 2);
    p.Y = (float*)carve((size_t)T * D * 4);
    p.X1 = (float*)carve((size_t)T * D * 4);
    p.Q = (float*)carve((size_t)T * 2048 * 4);
    p.GATE = (float*)carve((size_t)T * NSEL * 4);
    p.V1 = (float*)carve((size_t)T * 8 * 16 * 4);
    p.EIDX = (int*)carve((size_t)T * NSEL * 4);
    p.I1 = (int*)carve((size_t)T * 8 * 16 * 4);
    if (off > ws_size) { fprintf(stderr, "workspace too small: need %zu have %zu\n", off, ws_size); return; }
    (void)hipMemsetAsync(p.ctl, 0, CTL_BYTES, stream);
    void* args[] = {&p};
    hipError_t e = hipLaunchCooperativeKernel((void*)mega, dim3(grid_blocks), dim3(NT), args, LDS_BYTES, stream);
    if (e != hipSuccess) fprintf(stderr, "cooperative launch failed: %s (grid %d)\n", hipGetErrorString(e), grid_blocks);
}
```

```cpp
#include <hip/hip_runtime.h>
#include <hip/hip_cooperative_groups.h>
#include <cstdio>
#include <cstdint>
namespace cg = cooperative_groups;

constexpr int D = 1024, NB = 2, SEQ = 8192, DEPTH = 4, LC = 256, HD = 64;
constexpr int TL = NB * SEQ, TC = NB * LC, T = TL + TC;
constexpr int DIN = 2304;
constexpr int C_RQ = 0, C_RK = 256, C_RV = 512, C_RG = 768, C_SU = 1024, C_SV = 1280, C_AQ = 1536, C_AK = 2048, C_AV = 2176;
constexpr int NPOS = 66;
constexpr int PEER_N = 16384, NSEL = 128;
constexpr float LN_EPS = 1e-5f;
constexpr float ALPHA = 1.681792830507429f;
constexpr int NT = 512;
constexpr int NW = 8;
constexpr int LDS_BYTES = 147456;
constexpr int MISC_OFF = 131072 + 320;

typedef unsigned short bf16;
#define LAS __attribute__((address_space(3)))

struct Params {
    const float *x, *c, *ctx, *c_ctx, *w_mod, *b_mod, *w_in, *w_out, *rdf, *rdb, *sgu_w, *sgu_b, *sink, *lnm_g, *lnm_b, *wq, *k1, *k2, *pu, *pv, *lnf_g, *lnf_b;
    float* out;
    unsigned* ctl;
    float *modp, *mod, *rope, *X, *KV, *ST, *Y, *X1, *Q, *GATE, *V1;
    bf16 *WtIn, *WtOut, *WtQ, *H, *P, *MIX, *U16, *V16, *Qb;
    int *EIDX, *I1;
};

__device__ __forceinline__ unsigned f2bf(float f) { unsigned u = __builtin_bit_cast(unsigned, f); return (u + 0x7fffu + ((u >> 16) & 1u)) >> 16; }
__device__ __forceinline__ unsigned pk2(float lo, float hi) { return f2bf(lo) | (f2bf(hi) << 16); }
__device__ __forceinline__ float bf2f(bf16 v) { return __builtin_bit_cast(float, (unsigned)v << 16); }
__device__ __forceinline__ float bflo(unsigned w) { return __builtin_bit_cast(float, w << 16); }
__device__ __forceinline__ float bfhi(unsigned w) { return __builtin_bit_cast(float, w & 0xffff0000u); }

__device__ __forceinline__ float gelu_tanh(float x) {
    const float k0 = 0.7978845608028654f, k1 = 0.044715f;
    float u = k0 * (x + k1 * x * x * x);
    return 0.5f * x * (1.0f + tanhf(u));
}
__device__ __forceinline__ float silu_f(float x) { return x / (1.0f + expf(-x)); }
__device__ __forceinline__ float wave_sum(float v) {
#pragma unroll
    for (int o = 32; o >= 1; o >>= 1) v += __shfl_xor(v, o);
    return v;
}
__device__ __forceinline__ int chunk_row0(int b, int pos) { return pos < 2 ? TL + b * LC + pos * 128 : b * SEQ + (pos - 2) * 128; }
__device__ __forceinline__ int mod_idx(int r) { return r < TL ? r / SEQ : 2; }
__device__ __forceinline__ float log_sigmoid_f(float x) { return -log1pf(expf(-x)); }
typedef const __attribute__((address_space(4))) Params* KP;
__device__ __forceinline__ KP kparams() { KP k = (KP)__builtin_amdgcn_kernarg_segment_ptr(); asm volatile("" : "+s"(k)); return k; }
__device__ __forceinline__ int tid_opaque() { int t = threadIdx.x; asm volatile("" : "+v"(t)); return t; }

namespace pg8 {
#define PG8_LAS __attribute__((address_space(3)))
typedef unsigned short bf16_t;
typedef short bf16x8 __attribute__((ext_vector_type(8)));
typedef float f32x4 __attribute__((ext_vector_type(4)));
typedef unsigned u32x4 __attribute__((ext_vector_type(4)));
constexpr int BM = 256, BK = 64, HALF = 128, HTB = HALF * BK * 2  , STAGE_BYTES = 8 * HTB, NXCD = 8, WGM = 8;

__host__ __device__ __forceinline__ int lds_byte(int r, int c) { const int st = (r >> 4) * 2 + (c >> 5), rr = r & 15, cc = c & 31, ob = rr * 64 + cc * 2; return st * 1024 + (ob ^ (((ob >> 9) & 1) << 5)); }
__host__ __device__ __forceinline__ void stage_rc(int b, int& R, int& C) { const int st = b / 1024, sb = b % 1024, swz = sb ^ (((sb >> 9) & 1) << 5); R = (st >> 1) * 16 + swz / 64; C = (st & 1) * 32 + (swz % 64) / 2; }
__host__ __device__ __forceinline__ int perm32(int rho) { const int n = rho >> 4, i = rho & 15; return 8 * (i >> 2) + 4 * n + (i & 3); }

struct Unit { int pm, pn; };
struct Gemm { const bf16_t* A; const bf16_t* Bt; int M, N, K; };

struct StaticOrder {
    int nM, nN, nwg, G, c;
    __host__ __device__ void init(int M, int N, int G_, int c_) { nM = M / BM; nN = N / BM; nwg = nM * nN; G = G_; c = c_; }
    __host__ __device__ bool next(int i, Unit& u) const {
        const long L = (long)i * G + c; if (L >= nwg) return false;
        int wgid = (int)L; { const int q = nwg / NXCD, r = nwg % NXCD, xcd = wgid % NXCD, off = wgid / NXCD; wgid = (xcd < r ? xcd * (q + 1) : r * (q + 1) + (xcd - r) * q) + off; }
        const int nig = WGM * nN, gid = wgid / nig, fm = gid * WGM, gsz = (nM - fm) < WGM ? (nM - fm) : WGM;
        u.pm = fm + ((wgid % nig) % gsz); u.pn = (wgid % nig) / gsz; return true;
    }
    __device__ __forceinline__ void a_ready(const Unit&) const {}
    __device__ __forceinline__ void done(const Unit&) const {}
};

__device__ __forceinline__ unsigned cvt_pk_bf16(float lo, float hi) { unsigned r; asm volatile("v_cvt_pk_bf16_f32 %0, %1, %2" : "=v"(r) : "v"(lo), "v"(hi)); return r; }
struct EpiInProj {
    static constexpr bool PERM = true, AFTER_DRAIN = false;
    bf16_t* P; const float* rope;
    __device__ __forceinline__ void operator()(const f32x4 (&acc)[2][2][4][2], const Unit& u, int wr, int wc, int fr, int fq) const {
        const int pn = u.pn; const bool lat = u.pm < 64;
        const float sc = (pn == 1 || pn == 6 || pn == 7) ? 0.125f : 1.0f;
        const float sgn = fq < 2 ? -1.0f : 1.0f;
#pragma unroll
        for (int bj = 0; bj < 2; ++bj) {
            const bool roped = lat && (pn == 0 || pn == 1 || pn == 6 || pn == 7 || (pn == 8 && bj == 0));
#pragma unroll
            for (int ai = 0; ai < 2; ++ai)
#pragma unroll
                for (int m = 0; m < 4; ++m) {
                    const int row = u.pm * BM + ai * HALF + wr * 64 + m * 16 + fr;
                    f32x4 v0 = acc[ai][bj][m][0], v1 = acc[ai][bj][m][1];
                    if (roped) {
                        const int pos = row & 8191, idx = (wc & 1) ? 128 + (pos & 63) : (pos >> 6);
                        const float2* tb = (const float2*)rope + idx * 16 + 8 * (fq & 1);
#pragma unroll
                        for (int e = 0; e < 4; ++e) {
                            const float p0 = __shfl_xor(v0[e], 32), p1 = __shfl_xor(v1[e], 32);
                            const float2 c0 = tb[e], c1 = tb[4 + e];
                            v0[e] = v0[e] * c0.x + sgn * p0 * c0.y;
                            v1[e] = v1[e] * c1.x + sgn * p1 * c1.y;
                        }
                    }
                    v0 = v0 * sc; v1 = v1 * sc;
                    u32x4 w; w.x = cvt_pk_bf16(v0[0], v0[1]); w.y = cvt_pk_bf16(v0[2], v0[3]); w.z = cvt_pk_bf16(v1[0], v1[1]); w.w = cvt_pk_bf16(v1[2], v1[3]);
                    *(u32x4*)(P + (size_t)row * 2304 + pn * BM + bj * HALF + wc * 32 + fq * 8) = w;
                    __builtin_amdgcn_sched_barrier(0);
                }
        }
    }
};
struct EpiF32 {
    static constexpr bool PERM = false, AFTER_DRAIN = false;
    float* O; int ldc;
    __device__ __forceinline__ void operator()(const f32x4 (&acc)[2][2][4][2], const Unit& u, int wr, int wc, int fr, int fq) const {
#pragma unroll
        for (int ai = 0; ai < 2; ++ai)
#pragma unroll
            for (int m = 0; m < 4; ++m) {
                float* rowp = O + (size_t)(u.pm * BM + ai * HALF + wr * 64 + m * 16 + fr) * ldc + u.pn * BM + wc * 32 + fq * 4;
#pragma unroll
                for (int bj = 0; bj < 2; ++bj)
#pragma unroll
                    for (int n = 0; n < 2; ++n) *(f32x4*)(rowp + bj * HALF + n * 16) = acc[ai][bj][m][n];
            }
    }
};


struct EpiBf16Plain {
    static constexpr bool PERM = true, AFTER_DRAIN = false;
    bf16_t* O; int ldc;
    __device__ __forceinline__ void operator()(const f32x4 (&acc)[2][2][4][2], const Unit& u, int wr, int wc, int fr, int fq) const {
#pragma unroll
        for (int ai = 0; ai < 2; ++ai)
#pragma unroll
            for (int m = 0; m < 4; ++m) {
                bf16_t* rowp = O + (size_t)(u.pm * BM + ai * HALF + wr * 64 + m * 16 + fr) * ldc + u.pn * BM + wc * 32 + fq * 8;
#pragma unroll
                for (int bj = 0; bj < 2; ++bj) {
                    const f32x4 v0 = acc[ai][bj][m][0], v1 = acc[ai][bj][m][1];
                    u32x4 w; w.x = cvt_pk_bf16(v0[0], v0[1]); w.y = cvt_pk_bf16(v0[2], v0[3]); w.z = cvt_pk_bf16(v1[0], v1[1]); w.w = cvt_pk_bf16(v1[2], v1[3]);
                    *(u32x4*)(rowp + bj * HALF) = w;
                }
            }
    }
};
template <class Epi, class Sched, bool ALIGN_EPI = false, bool SP2 = false>
__device__ __forceinline__ void gemm_phase(PG8_LAS unsigned char* lds, const Gemm g, const Sched& S, const Epi& E) {
    int tid_ = threadIdx.x; asm volatile("" : "+v"(tid_));
    const int tid = tid_, wid = __builtin_amdgcn_readfirstlane(tid >> 6), lane = tid & 63, wr = wid >> 2, wc = wid & 3, fr = lane & 15, fq = lane >> 4;
    const int K = g.K, nt = K / BK;
    unsigned voffA[2], voffB[2];
#pragma unroll
    for (int i = 0; i < 2; ++i) { int R, C; stage_rc(tid * 16 + i * 8192, R, C); const int Rb = Epi::PERM ? ((R & ~31) + perm32(R & 31)) : R;
        voffA[i] = (unsigned)(R * K + C) * 2u; voffB[i] = (unsigned)(Rb * K + C) * 2u; }
    const size_t kstep = (size_t)(BK * 2);
    const size_t hstep = (size_t)HALF * K * 2;
    const size_t tstep = 2 * hstep;
    const unsigned ldsw = (unsigned)wid * 1024u;
    const int aoff = lds_byte(wr * 64 + fr, fq * 8), boff = lds_byte(wc * 32 + fr, fq * 8);
#define PG8_SA(b, h) (((b) * 2 + (h)) * HTB)
#define PG8_SB(b, h) ((4 + (b) * 2 + (h)) * HTB)
#define PG8_STAGE(bufoff, gbase, voff) do { _Pragma("unroll") for (int _i = 0; _i < 2; ++_i) \
        __builtin_amdgcn_global_load_lds((const unsigned*)((const char*)(gbase) + (voff)[_i]), (PG8_LAS unsigned*)(lds + (bufoff) + ldsw + _i * 8192), 16, 0, 0); } while (0)
#define PG8_LDA(dst, b, h) do { _Pragma("unroll") for (int m = 0; m < 4; ++m) _Pragma("unroll") for (int k = 0; k < 2; ++k) dst[m][k] = *(const PG8_LAS bf16x8*)(lds + PG8_SA(b, h) + aoff + m * 2048 + k * 1024); } while (0)
#define PG8_LDB(dst, b, h) do { _Pragma("unroll") for (int n = 0; n < 2; ++n) _Pragma("unroll") for (int k = 0; k < 2; ++k) dst[n][k] = *(const PG8_LAS bf16x8*)(lds + PG8_SB(b, h) + boff + n * 2048 + k * 1024); } while (0)
#define PG8_MMA(ai, bj, At, Bt) do { __builtin_amdgcn_s_setprio(1); _Pragma("unroll") for (int m = 0; m < 4; ++m) _Pragma("unroll") for (int n = 0; n < 2; ++n) _Pragma("unroll") for (int k = 0; k < 2; ++k) \
        acc[ai][bj][m][n] = __builtin_amdgcn_mfma_f32_16x16x32_bf16(Bt[n][k], At[m][k], acc[ai][bj][m][n], 0, 0, 0); __builtin_amdgcn_s_setprio(0); } while (0)
#define PG8_WAIT_V(n) asm volatile("s_waitcnt vmcnt(" #n ")" ::: "memory")
#define PG8_WAIT_L(n) asm volatile("s_waitcnt lgkmcnt(" #n ")" ::: "memory")
#define PG8_BAR __builtin_amdgcn_s_barrier()
#define PG8_SCHED __builtin_amdgcn_sched_barrier(0)
    Unit cur, nxt; int ui = 0;
    if (!S.next(0, cur)) return;
    f32x4 acc[2][2][4][2];
#pragma unroll
    for (int a = 0; a < 2; ++a)
#pragma unroll
        for (int b = 0; b < 2; ++b)
#pragma unroll
            for (int m = 0; m < 4; ++m)
#pragma unroll
                for (int n = 0; n < 2; ++n) acc[a][b][m][n] = (f32x4){0.f, 0.f, 0.f, 0.f};
    bf16x8 At[4][2], B0[2][2], B1[2][2];
    const char* cA = (const char*)g.A + (size_t)cur.pm * tstep; const char* cB = (const char*)g.Bt + (size_t)cur.pn * tstep;
    S.a_ready(cur);
    if constexpr (SP2) {
        PG8_STAGE(PG8_SB(0, 0), cB, voffB); PG8_STAGE(PG8_SB(0, 1), cB + hstep, voffB); PG8_STAGE(PG8_SA(0, 0), cA, voffA); PG8_STAGE(PG8_SA(0, 1), cA + hstep, voffA);
        if (wr == 1) PG8_BAR;
        PG8_WAIT_V(2); PG8_BAR;
        PG8_STAGE(PG8_SB(1, 0), cB + kstep, voffB); PG8_STAGE(PG8_SA(1, 0), cA + kstep, voffA); PG8_STAGE(PG8_SB(1, 1), cB + hstep + kstep, voffB);
        PG8_WAIT_V(6); PG8_BAR;
    } else {
        PG8_STAGE(PG8_SB(0, 0), cB, voffB); PG8_STAGE(PG8_SA(0, 0), cA, voffA); PG8_STAGE(PG8_SB(0, 1), cB + hstep, voffB); PG8_STAGE(PG8_SA(0, 1), cA + hstep, voffA);
        if (wr == 1) PG8_BAR;
        PG8_WAIT_V(4); PG8_BAR;
        PG8_STAGE(PG8_SB(1, 0), cB + kstep, voffB); PG8_STAGE(PG8_SA(1, 0), cA + kstep, voffA); PG8_STAGE(PG8_SB(1, 1), cB + hstep + kstep, voffB);
        PG8_WAIT_V(6); PG8_BAR;
    }
    for (;;) {
        const bool has_next = S.next(ui + 1, nxt);
        const char* nA = has_next ? (const char*)g.A + (size_t)nxt.pm * tstep : cA; const char* nB = has_next ? (const char*)g.Bt + (size_t)nxt.pn * tstep : cB;
        for (int t = 0; t < nt; t += 2) {
            const bool last = (t == nt - 2);
            const char* a1 = cA + (size_t)(t + 1) * kstep;
            const char* a2 = last ? nA : cA + (size_t)(t + 2) * kstep; const char* b2 = last ? nB : cB + (size_t)(t + 2) * kstep;
            const char* a3 = a2 + kstep; const char* b3 = b2 + kstep;
            if (last && has_next) S.a_ready(nxt);
            if constexpr (SP2) {
            PG8_LDB(B0, 0, 0); PG8_LDB(B1, 0, 1); PG8_SCHED; PG8_LDA(At, 0, 0); PG8_STAGE(PG8_SA(1, 1), a1 + hstep, voffA);
            PG8_WAIT_V(8); PG8_WAIT_L(0); PG8_BAR; PG8_MMA(0, 0, At, B0); PG8_MMA(0, 1, At, B1); PG8_BAR; PG8_SCHED;
            PG8_LDA(At, 0, 1); PG8_STAGE(PG8_SB(0, 0), b2, voffB); PG8_STAGE(PG8_SB(0, 1), b2 + hstep, voffB); PG8_STAGE(PG8_SA(0, 0), a2, voffA);
            PG8_WAIT_V(8); PG8_WAIT_L(0); PG8_BAR; PG8_MMA(1, 0, At, B0); PG8_MMA(1, 1, At, B1); PG8_BAR; PG8_SCHED;
            PG8_LDB(B0, 1, 0); PG8_LDB(B1, 1, 1); PG8_SCHED; PG8_LDA(At, 1, 0); PG8_STAGE(PG8_SA(0, 1), a2 + hstep, voffA);
            PG8_WAIT_V(8); PG8_WAIT_L(0); PG8_BAR; PG8_MMA(0, 0, At, B0); PG8_MMA(0, 1, At, B1); PG8_BAR; PG8_SCHED;
            PG8_LDA(At, 1, 1); PG8_STAGE(PG8_SB(1, 0), b3, voffB); PG8_STAGE(PG8_SB(1, 1), b3 + hstep, voffB); PG8_STAGE(PG8_SA(1, 0), a3, voffA);
            PG8_WAIT_V(8); PG8_WAIT_L(0); PG8_BAR; PG8_MMA(1, 0, At, B0); PG8_MMA(1, 1, At, B1); PG8_BAR; PG8_SCHED;
            } else {
            PG8_LDB(B0, 0, 0); PG8_SCHED; PG8_LDA(At, 0, 0); PG8_STAGE(PG8_SA(1, 1), a1 + hstep, voffA);
            PG8_WAIT_L(8); PG8_BAR; PG8_WAIT_L(0); PG8_MMA(0, 0, At, B0); PG8_BAR; PG8_SCHED;
            PG8_LDB(B1, 0, 1); PG8_STAGE(PG8_SB(0, 0), b2, voffB);
            PG8_BAR; PG8_WAIT_L(0); PG8_MMA(0, 1, At, B1); PG8_BAR;
            PG8_LDA(At, 0, 1); PG8_STAGE(PG8_SA(0, 0), a2, voffA);
            PG8_BAR; PG8_WAIT_L(0); PG8_MMA(1, 0, At, B0); PG8_BAR; PG8_SCHED;
            PG8_STAGE(PG8_SB(0, 1), b2 + hstep, voffB);
            PG8_WAIT_V(6); PG8_BAR; PG8_MMA(1, 1, At, B1); PG8_BAR;
            PG8_LDB(B0, 1, 0); PG8_SCHED; PG8_LDA(At, 1, 0); PG8_STAGE(PG8_SA(0, 1), a2 + hstep, voffA);
            PG8_WAIT_L(8); PG8_BAR; PG8_WAIT_L(0); PG8_MMA(0, 0, At, B0); PG8_BAR; PG8_SCHED;
            PG8_LDB(B1, 1, 1); PG8_STAGE(PG8_SB(1, 0), b3, voffB);
            PG8_BAR; PG8_WAIT_L(0); PG8_MMA(0, 1, At, B1); PG8_BAR;
            PG8_LDA(At, 1, 1); PG8_STAGE(PG8_SA(1, 0), a3, voffA);
            PG8_BAR; PG8_WAIT_L(0); PG8_MMA(1, 0, At, B0); PG8_BAR; PG8_SCHED;
            PG8_STAGE(PG8_SB(1, 1), b3 + hstep, voffB);
            PG8_WAIT_V(6); PG8_BAR; PG8_MMA(1, 1, At, B1); PG8_BAR;
            }
        }
        if constexpr (ALIGN_EPI) { if (wr == 0) PG8_BAR; }
        if constexpr (!Epi::AFTER_DRAIN) { E(acc, cur, wr, wc, fr, fq); S.done(cur); }
        if (!has_next) break;
#pragma unroll
        for (int a = 0; a < 2; ++a)
#pragma unroll
            for (int b = 0; b < 2; ++b)
#pragma unroll
                for (int m = 0; m < 4; ++m)
#pragma unroll
                    for (int n = 0; n < 2; ++n) acc[a][b][m][n] = (f32x4){0.f, 0.f, 0.f, 0.f};
        cur = nxt; cA = nA; cB = nB; ++ui;
        if constexpr (ALIGN_EPI) { if (wr == 1) PG8_BAR; }
    }
    PG8_WAIT_V(0);
    if constexpr (!ALIGN_EPI) { if (wr == 0) PG8_BAR; }
    PG8_BAR;
    if constexpr (Epi::AFTER_DRAIN) { E.fused(acc, cur, wr, wc, fr, fq, lds, wid, lane); S.done(cur); }
#undef PG8_SA
#undef PG8_SB
#undef PG8_STAGE
#undef PG8_LDA
#undef PG8_LDB
#undef PG8_MMA
#undef PG8_WAIT_V
#undef PG8_WAIT_L
#undef PG8_BAR
#undef PG8_SCHED
}
}
constexpr int CW_BAR = 4096;
constexpr size_t CTL_BYTES = 65536;
#define XB_TMO      128
#define XB_XCNT(j)  (256  + 64 * (j))
#define XB_XSUB(j)  (1280 + 64 * (j))
#define XB_XGEN(j)  (2304 + 64 * (j))
#define XB_TOP      3328
#define XB_TOPGEN   3392
#define XCD_BAR_WORDS 3456
#define XB_SPIN_CAP (1u << 18)

__device__ __forceinline__ unsigned xb_ld(unsigned* p)              { return __hip_atomic_load(p, __ATOMIC_RELAXED, __HIP_MEMORY_SCOPE_AGENT); }
__device__ __forceinline__ unsigned xb_add(unsigned* p, unsigned v) { return __hip_atomic_fetch_add(p, v, __ATOMIC_RELAXED, __HIP_MEMORY_SCOPE_AGENT); }
__device__ __forceinline__ unsigned xb_xcc_id() { return (unsigned)__builtin_amdgcn_s_getreg((3 << 11) | 20) & 0xFu; }
#define XB_SPIN(cond, bar) do { unsigned _sp = 0; while (cond) { __builtin_amdgcn_s_sleep(1); \
    if ((++_sp & 255u) == 0u) { if (xb_ld(&(bar)[XB_TMO])) break; if (_sp > XB_SPIN_CAP) { atomicAdd(&(bar)[XB_TMO], 1u); break; } } } } while (0)

struct XcdBarrier {
    unsigned* bar; unsigned x;
    volatile LAS unsigned* st;
};

__device__ __forceinline__ XcdBarrier xcd_barrier_post(unsigned* bar, volatile LAS unsigned* st) {
    XcdBarrier b; b.bar = bar; b.x = xb_xcc_id(); b.st = st;
    if (threadIdx.x == 0) (void)xb_add(&bar[XB_XCNT(b.x)], 1u);
    return b;
}
__device__ __forceinline__ void xcd_barrier_complete(unsigned* bar, unsigned x, unsigned& nloc, unsigned& nx) {
    const unsigned G = gridDim.x * gridDim.y * gridDim.z;
    unsigned sum, cnt, mine, sp = 0u;
    for (;;) {
        sum = 0u; cnt = 0u; mine = 0u;
#pragma unroll
        for (unsigned j = 0; j < 16; ++j) { const unsigned c = xb_ld(&bar[XB_XCNT(j)]); sum += c; cnt += (c > 0u) ? 1u : 0u; mine = (j == x) ? c : mine; }
        if (sum == G) break;
        __builtin_amdgcn_s_sleep(1);
        if ((++sp & 255u) == 0u) { if (xb_ld(&bar[XB_TMO])) break; if (sp > XB_SPIN_CAP) { atomicAdd(&bar[XB_TMO], 1u); break; } }
    }
    nloc = mine > 0u ? mine : 1u; nx = cnt > 0u ? cnt : 1u;
}

__device__ __forceinline__ void xcd_barrier(const XcdBarrier& b) {
    asm volatile("s_waitcnt vmcnt(0)" ::: "memory");
    __syncthreads();
    if (threadIdx.x == 0) {
        unsigned* bar = b.bar;
        __builtin_amdgcn_s_waitcnt(0);
        unsigned nloc = b.st[0], nx = b.st[1];
        if (nloc == 0u) { xcd_barrier_complete(bar, b.x, nloc, nx); b.st[0] = nloc; b.st[1] = nx; }
        const unsigned old = xb_add(&bar[XB_XSUB(b.x)], 1u);
        const unsigned gen = old / nloc;
        if (old + 1u == (gen + 1u) * nloc) {
            __builtin_amdgcn_fence(__ATOMIC_RELEASE, "agent");
            asm volatile("s_waitcnt vmcnt(0)" ::: "memory");
            const unsigned og = xb_add(&bar[XB_TOP], 1u);
            const unsigned tg = og / nx;
            if (og + 1u == (tg + 1u) * nx) xb_add(&bar[XB_TOPGEN], 1u);
            else XB_SPIN(xb_ld(&bar[XB_TOPGEN]) == tg, bar);
            __builtin_amdgcn_fence(__ATOMIC_ACQUIRE, "agent");
            xb_add(&bar[XB_XGEN(b.x)], 1u);
            asm volatile("s_waitcnt vmcnt(0)" ::: "memory");
        } else {
            XB_SPIN(xb_ld(&bar[XB_XGEN(b.x)]) == gen, bar);
            __builtin_amdgcn_fence(__ATOMIC_ACQUIRE, "agent");
            asm volatile("s_waitcnt vmcnt(0)" ::: "memory");
        }
    }
    __syncthreads();
}


__device__ __forceinline__ void phase_mod1(KP p, int bid, int nb, float* lds) {
    float (*red)[8][64] = (float (*)[8][64])lds;
    const int t = tid_opaque(), cn = t & 63, kg = t >> 6;
    for (int u = bid; u < DEPTH * 96 * 16; u += nb) {
        const int ks = u & 15, nblk = (u >> 4) % 96, l = u / (16 * 96);
        const int n = nblk * 64 + cn;
        float a0 = 0.f, a1 = 0.f, a2 = 0.f;
#pragma unroll
        for (int kk = 0; kk < 8; ++kk) {
            const int k = ks * 64 + kg * 8 + kk;
            const float w = p->w_mod[((size_t)l * D + k) * 6144 + n];
            a0 += silu_f(p->c[k]) * w; a1 += silu_f(p->c[D + k]) * w; a2 += silu_f(p->c_ctx[k]) * w;
        }
        __syncthreads();
        red[0][kg][cn] = a0; red[1][kg][cn] = a1; red[2][kg][cn] = a2;
        __syncthreads();
        if (t < 192) {
            const int v = t >> 6;
            float s = 0.f;
#pragma unroll
            for (int g = 0; g < 8; ++g) s += red[v][g][cn];
            p->modp[(((size_t)ks * DEPTH + l) * 3 + v) * 6144 + n] = s;
        }
    }
    __syncthreads();
}
__device__ __forceinline__ void phase_mod2(KP p, int bid, int nb) {
    for (int i = bid * NT + tid_opaque(); i < DEPTH * 3 * 6144; i += nb * NT) {
        const int n = i % 6144, l = i / (3 * 6144);
        float s = p->b_mod[l * 6144 + n];
        for (int ks = 0; ks < 16; ++ks) s += p->modp[(size_t)ks * DEPTH * 3 * 6144 + i];
        p->mod[i] = s;
    }
}
__device__ __forceinline__ void transpose_item(const float* W, int K, int N, bf16* WT, float* scr, int item, int lane) {
    const int nblk = N / 32, kb = item / nblk, nbk = item % nblk, k0 = 64 * kb, n0 = 32 * nbk;
#pragma unroll 8
    for (int i = 0; i < 32; ++i) { const int kk = 2 * i + (lane >> 5); scr[kk * 33 + (lane & 31)] = W[(size_t)(k0 + kk) * N + n0 + (lane & 31)]; }
    __builtin_amdgcn_wave_barrier();
    const int c = lane & 7;
#pragma unroll
    for (int j = 0; j < 4; ++j) { const int n = (lane >> 3) + 8 * j; const float* s = scr + (8 * c) * 33 + n;
        uint4 o; o.x = pk2(s[0 * 33], s[1 * 33]); o.y = pk2(s[2 * 33], s[3 * 33]); o.z = pk2(s[4 * 33], s[5 * 33]); o.w = pk2(s[6 * 33], s[7 * 33]);
        *(uint4*)(WT + (size_t)(n0 + n) * K + k0 + 8 * c) = o; }
    __builtin_amdgcn_wave_barrier();
}
__device__ __forceinline__ void phase_weights(KP p, int bid, int nb, float* lds) {
    const int lane = tid_opaque() & 63, w = tid_opaque() >> 6;
    float* scr = lds + 2048 + w * (64 * 33 + 16);
    constexpr int I_IN = 16 * 72, I_OUT = 16 * 32, I_Q = 16 * 64;
    constexpr int NITEMS = DEPTH * (I_IN + I_OUT + I_Q);
    for (int it = bid * NW + w; it < NITEMS; it += nb * NW) {
        int r = it;
        if (r < DEPTH * I_IN) { const int l = r / I_IN; transpose_item(p->w_in + (size_t)l * D * DIN, D, DIN, p->WtIn + (size_t)l * DIN * D, scr, r % I_IN, lane); continue; } r -= DEPTH * I_IN;
        if (r < DEPTH * I_OUT) { const int l = r / I_OUT; transpose_item(p->w_out + (size_t)l * D * D, D, D, p->WtOut + (size_t)l * D * D, scr, r % I_OUT, lane); continue; } r -= DEPTH * I_OUT;
        { const int l = r / I_Q; transpose_item(p->wq + (size_t)l * D * 2048, D, 2048, p->WtQ + (size_t)l * 2048 * D, scr, r % I_Q, lane); }
    }
    {
        const size_t n8 = (size_t)DEPTH * PEER_N * D / 8;
        for (size_t i = (size_t)bid * NT + tid_opaque(); i < 2 * n8; i += (size_t)nb * NT) {
            const bool isv = i >= n8; const size_t k = isv ? i - n8 : i;
            const float4* src = (const float4*)(isv ? p->pv : p->pu) + 2 * k;
            const float4 a = src[0], b = src[1];
            uint4 o; o.x = pk2(a.x, a.y); o.y = pk2(a.z, a.w); o.z = pk2(b.x, b.y); o.w = pk2(b.z, b.w);
            ((uint4*)(isv ? p->V16 : p->U16))[k] = o;
        }
    }
    for (int i = bid * NT + tid_opaque(); i < 192 * 16; i += nb * NT) {
        const int idx = i >> 4, f = i & 15;
        const float inv = powf(10000.0f, -(float)f / 16.0f);
        const float ang = (float)(idx < 128 ? idx : idx - 128) * inv;
        p->rope[2 * i] = cosf(ang); p->rope[2 * i + 1] = sinf(ang);
    }
}

__device__ __forceinline__ void row_load(const float* src, float (&v)[16], int lane) {
#pragma unroll
    for (int i = 0; i < 4; ++i) { const float4 q = *(const float4*)(src + i * 256 + lane * 4); v[i * 4 + 0] = q.x; v[i * 4 + 1] = q.y; v[i * 4 + 2] = q.z; v[i * 4 + 3] = q.w; }
}
__device__ __forceinline__ void row_store(float* dst, const float (&v)[16], int lane) {
#pragma unroll
    for (int i = 0; i < 4; ++i) *(float4*)(dst + i * 256 + lane * 4) = make_float4(v[i * 4 + 0], v[i * 4 + 1], v[i * 4 + 2], v[i * 4 + 3]);
}
__device__ __forceinline__ void row_store_bf(bf16* dst, const float (&v)[16], int lane) {
#pragma unroll
    for (int i = 0; i < 4; ++i) *(uint2*)(dst + i * 256 + lane * 4) = make_uint2(pk2(v[i * 4 + 0], v[i * 4 + 1]), pk2(v[i * 4 + 2], v[i * 4 + 3]));
}
__device__ __forceinline__ void row_load_bf(const bf16* src, float (&v)[16], int lane) {
#pragma unroll
    for (int i = 0; i < 4; ++i) { const uint2 q = *(const uint2*)(src + i * 256 + lane * 4); v[i * 4 + 0] = bflo(q.x); v[i * 4 + 1] = bfhi(q.x); v[i * 4 + 2] = bflo(q.y); v[i * 4 + 3] = bfhi(q.y); }
}
__device__ __forceinline__ void row_ln(float (&v)[16]) {
    float s = 0.f;
#pragma unroll
    for (int i = 0; i < 16; ++i) s += v[i];
    const float mu = wave_sum(s) * (1.0f / D);
    float q = 0.f;
#pragma unroll
    for (int i = 0; i < 16; ++i) { v[i] -= mu; q += v[i] * v[i]; }
    const float rstd = rsqrtf(wave_sum(q) * (1.0f / D) + LN_EPS);
#pragma unroll
    for (int i = 0; i < 16; ++i) v[i] *= rstd;
}
__device__ __forceinline__ const float* x_row(KP p, int l, int r) {
    if (l == 0) return r < TL ? p->x + (size_t)r * D : p->ctx + (size_t)(r - TL) * D;
    return p->X + (size_t)r * D;
}

__device__ __forceinline__ void phase_lnmod(KP p, int l, int bid, int nb) {
    const int lane = tid_opaque() & 63, w = tid_opaque() >> 6;
    for (int r = bid * NW + w; r < T; r += nb * NW) {
        float v[16], sh[16], sc[16];
        row_load(x_row(p, l, r), v, lane);
        const float* m = p->mod + ((size_t)l * 3 + mod_idx(r)) * 6144;
        row_load(m, sh, lane); row_load(m + 1024, sc, lane);
        row_ln(v);
#pragma unroll
        for (int i = 0; i < 16; ++i) v[i] = v[i] * (1.0f + sc[i]) + sh[i];
        row_store_bf(p->H + (size_t)r * D, v, lane);
    }
}

__device__ __forceinline__ size_t kv_off(int dir, int b, int pos, int h) { return ((((size_t)dir * NB + b) * NPOS + pos) * 4 + h) * 4096; }
__device__ __forceinline__ void ret_kv_unit(KP p, int l, int u, float* lds) {
    const int h = u & 3, pos = (u >> 2) % NPOS, b = u / (4 * NPOS);
    float (*ks)[64] = (float (*)[64])lds;
    float (*vs)[64] = (float (*)[64])(lds + 64 * 64);
    const int t = tid_opaque(), dk = t >> 3, dv0 = (t & 7) * 8;
    const float lgf = log_sigmoid_f(p->rdf[l * 4 + h]), lgb = log_sigmoid_f(p->rdb[l * 4 + h]);
    const int r0 = chunk_row0(b, pos);
    float af[8], ab[8];
#pragma unroll
    for (int d = 0; d < 8; ++d) { af[d] = 0.f; ab[d] = 0.f; }
    for (int j0 = 0; j0 < 128; j0 += 64) {
        __syncthreads();
        for (int e = t; e < 64 * 64; e += NT) {
            const int j = e >> 6, d = e & 63;
            ks[j][d] = bf2f(p->P[(size_t)(r0 + j0 + j) * DIN + C_RK + h * 64 + d]);
            vs[j][d] = bf2f(p->P[(size_t)(r0 + j0 + j) * DIN + C_RV + h * 64 + d]);
        }
        __syncthreads();
        for (int j = 0; j < 64; ++j) {
            const int jl = j0 + j;
            const float kf = ks[j][dk] * expf(lgf * (float)(127 - jl)), kb = ks[j][dk] * expf(lgb * (float)jl);
#pragma unroll
            for (int d = 0; d < 8; ++d) { const float v = vs[j][dv0 + d]; af[d] += kf * v; ab[d] += kb * v; }
        }
    }
    float* of = p->KV + kv_off(0, b, pos, h) + dk * 64 + dv0;
    float* ob = p->KV + kv_off(1, b, pos, h) + dk * 64 + dv0;
#pragma unroll
    for (int d = 0; d < 8; ++d) { of[d] = af[d]; ob[d] = ab[d]; }
}

__device__ __forceinline__ void phase_ret_scan(KP p, int l, int bid, int nb) {
    for (int i = bid * NT + tid_opaque(); i < 2 * NB * 4 * 4096; i += nb * NT) {
        const int e = i & 4095, h = (i >> 12) & 3, b = (i >> 14) & 1, dir = i >> 15;
        const float lg = log_sigmoid_f(dir ? p->rdb[l * 4 + h] : p->rdf[l * 4 + h]);
        const float cdec = expf(128.0f * lg);
        float s = 0.f;
        for (int step = 0; step < NPOS; ++step) {
            const int pos = dir == 0 ? step : (step == 0 ? 1 : (step == 1 ? 0 : 67 - step));
            const size_t o = kv_off(dir, b, pos, h) + e;
            p->ST[o] = s;
            s = s * cdec + p->KV[o];
        }
    }
}

__device__ __forceinline__ void ret_out_unit(KP p, int l, int u, float* lds) {
    const int h = u & 3, pos = (u >> 2) % NPOS, b = u / (4 * NPOS);
    float (*ks)[68] = (float (*)[68])lds;
    float (*vs)[64] = (float (*)[64])(lds + 128 * 68);
    float* pf = lds + 128 * 68 + 128 * 64;
    float* pb = pf + 132;
    const int t = tid_opaque(), i = t >> 2, qd = t & 3;
    const float lgf = log_sigmoid_f(p->rdf[l * 4 + h]), lgb = log_sigmoid_f(p->rdb[l * 4 + h]);
    const int r0 = chunk_row0(b, pos);
    __syncthreads();
    for (int e = t; e < 128 * 64; e += NT) {
        const int j = e >> 6, d = e & 63;
        ks[j][d] = bf2f(p->P[(size_t)(r0 + j) * DIN + C_RK + h * 64 + d]);
        vs[j][d] = bf2f(p->P[(size_t)(r0 + j) * DIN + C_RV + h * 64 + d]);
    }
    if (t < 129) { pf[t] = expf(lgf * (float)t); pb[t] = expf(lgb * (float)t); }
    __syncthreads();
    float q[16], acc[16];
    const bf16* qrow = p->P + (size_t)(r0 + i) * DIN + C_RQ + h * 64;
#pragma unroll
    for (int d = 0; d < 16; ++d) q[d] = bf2f(qrow[qd * 16 + d]);
#pragma unroll
    for (int d = 0; d < 16; ++d) acc[d] = 0.f;
    for (int j = 0; j < 128; ++j) {
        float s = 0.f;
#pragma unroll
        for (int d = 0; d < 16; ++d) s += q[d] * ks[j][qd * 16 + d];
        s += __shfl_xor(s, 1); s += __shfl_xor(s, 2);
        const int rel = i - j;
        const float w = rel > 0 ? pf[rel] : (rel < 0 ? pb[-rel] : 2.0f);
        s *= w;
#pragma unroll
        for (int d = 0; d < 16; ++d) acc[d] += s * vs[j][qd * 16 + d];
    }
    const float qf = pf[i + 1], qb = pb[128 - i];
    const float* Sf = p->ST + kv_off(0, b, pos, h) + qd * 16;
    const float* Sb = p->ST + kv_off(1, b, pos, h) + qd * 16;
    for (int dk = 0; dk < 64; ++dk) {
        const float qv = bf2f(qrow[dk]);
        const float a = qv * qf, c = qv * qb;
#pragma unroll
        for (int d = 0; d < 16; ++d) acc[d] += a * Sf[dk * 64 + d] + c * Sb[dk * 64 + d];
    }
    float s = 0.f;
#pragma unroll
    for (int d = 0; d < 16; ++d) s += acc[d];
    s += __shfl_xor(s, 1); s += __shfl_xor(s, 2);
    const float mu = s * (1.0f / 64.0f);
    float qq = 0.f;
#pragma unroll
    for (int d = 0; d < 16; ++d) { acc[d] -= mu; qq += acc[d] * acc[d]; }
    qq += __shfl_xor(qq, 1); qq += __shfl_xor(qq, 2);
    const float rstd = rsqrtf(qq * (1.0f / 64.0f) + LN_EPS);
    const bf16* grow = p->P + (size_t)(r0 + i) * DIN + C_RG + h * 64 + qd * 16;
    bf16* orow = p->MIX + (size_t)(r0 + i) * D + h * 64 + qd * 16;
#pragma unroll
    for (int d = 0; d < 16; ++d) orow[d] = (bf16)f2bf(acc[d] * rstd * silu_f(bf2f(grow[d])));
}

__device__ __forceinline__ void sgu_unit(KP p, int l, int u, float* lds) {
    const int g = u & 3, pos = (u >> 2) % NPOS, b = u / (4 * NPOS);
    float (*vn)[64] = (float (*)[64])lds;
    const int t = tid_opaque(), i = t >> 2, qd = t & 3;
    const int r0 = chunk_row0(b, pos);
    __syncthreads();
    {
        float v[16];
        const bf16* src = p->P + (size_t)(r0 + i) * DIN + C_SV + g * 64 + qd * 16;
        float s = 0.f;
#pragma unroll
        for (int d = 0; d < 16; ++d) { v[d] = gelu_tanh(bf2f(src[d])); s += v[d]; }
        s += __shfl_xor(s, 1); s += __shfl_xor(s, 2);
        const float mu = s * (1.0f / 64.0f);
        float qq = 0.f;
#pragma unroll
        for (int d = 0; d < 16; ++d) { v[d] -= mu; qq += v[d] * v[d]; }
        qq += __shfl_xor(qq, 1); qq += __shfl_xor(qq, 2);
        const float rstd = rsqrtf(qq * (1.0f / 64.0f) + LN_EPS);
#pragma unroll
        for (int d = 0; d < 16; ++d) vn[i][qd * 16 + d] = v[d] * rstd;
    }
    __syncthreads();
    float acc[16];
#pragma unroll
    for (int d = 0; d < 16; ++d) acc[d] = 0.f;
    const float* wrow = p->sgu_w + (((size_t)l * 4 + g) * 128 + i) * 128;
    for (int j = 0; j < 128; ++j) {
        const float w = wrow[j];
#pragma unroll
        for (int d = 0; d < 16; ++d) acc[d] += w * vn[j][qd * 16 + d];
    }
    const float bs = p->sgu_b[((size_t)l * 4 + g) * 128 + i];
    const bf16* urow = p->P + (size_t)(r0 + i) * DIN + C_SU + g * 64 + qd * 16;
    bf16* orow = p->MIX + (size_t)(r0 + i) * D + 256 + g * 64 + qd * 16;
#pragma unroll
    for (int d = 0; d < 16; ++d) orow[d] = (bf16)f2bf(gelu_tanh(bf2f(urow[d])) * (acc[d] + bs));
}

__device__ __forceinline__ void att_unit(KP p, int l, int u, float* lds) {
    const int hq = u & 7, blk = (u >> 3) % 66, b = u / (8 * 66);
    const int hkv = hq >> 2;
    float (*ks)[68] = (float (*)[68])lds;
    float (*vs)[64] = (float (*)[64])(lds + 128 * 68);
    const int t = tid_opaque(), i = t >> 2, qd = t & 3;
    const bool lat = blk < 64;
    const int qrow0 = lat ? b * SEQ + blk * 128 : TL + b * LC + (blk - 64) * 128;
    const int qpos = blk * 128 + i;
    float q[16], acc[16];
    const bf16* qrow = p->P + (size_t)(qrow0 + i) * DIN + C_AQ + hq * 64 + qd * 16;
#pragma unroll
    for (int d = 0; d < 16; ++d) q[d] = bf2f(qrow[d]);
#pragma unroll
    for (int d = 0; d < 16; ++d) acc[d] = 0.f;
    float m = p->sink[l * 8 + hq], den = 1.0f;
    for (int kt = 0; kt < 5; ++kt) {
        int krow0, kpos0 = 0; bool band = false;
        if (kt < 3) {
            if (!lat) continue;
            const int kb = blk - 1 + kt;
            if (kb < 0 || kb >= 64) continue;
            krow0 = b * SEQ + kb * 128; kpos0 = kb * 128; band = true;
        } else krow0 = TL + b * LC + (kt - 3) * 128;
        __syncthreads();
        for (int e = t; e < 128 * 64; e += NT) {
            const int j = e >> 6, d = e & 63;
            ks[j][d] = bf2f(p->P[(size_t)(krow0 + j) * DIN + C_AK + hkv * 64 + d]);
            vs[j][d] = bf2f(p->P[(size_t)(krow0 + j) * DIN + C_AV + hkv * 64 + d]);
        }
        __syncthreads();
        for (int j = 0; j < 128; ++j) {
            float s = 0.f;
#pragma unroll
            for (int d = 0; d < 16; ++d) s += q[d] * ks[j][qd * 16 + d];
            s += __shfl_xor(s, 1); s += __shfl_xor(s, 2);
            if (band) { const int rel = kpos0 + j - qpos; if (rel > 128 || rel < -128) continue; }
            const float mn = fmaxf(m, s);
            const float sc = expf(m - mn), pe = expf(s - mn);
            den = den * sc + pe;
#pragma unroll
            for (int d = 0; d < 16; ++d) acc[d] = acc[d] * sc + pe * vs[j][qd * 16 + d];
            m = mn;
        }
    }
    const float inv = 1.0f / den;
    bf16* orow = p->MIX + (size_t)(qrow0 + i) * D + 512 + hq * 64 + qd * 16;
#pragma unroll
    for (int d = 0; d < 16; ++d) orow[d] = (bf16)f2bf(acc[d] * inv);
}

__device__ __forceinline__ void phase_mix_a(KP p, int l, int bid, int nb, float* lds) {
    const int n_kv = NB * NPOS * 4, n_sgu = NB * NPOS * 4, n_att = NB * 66 * 8;
    for (int u = bid; u < n_kv + n_sgu + n_att; u += nb) {
        if (u < n_kv) ret_kv_unit(p, l, u, lds);
        else if (u < n_kv + n_sgu) sgu_unit(p, l, u - n_kv, lds);
        else att_unit(p, l, u - n_kv - n_sgu, lds);
    }
    __syncthreads();
}
__device__ __forceinline__ void phase_ret_out(KP p, int l, int bid, int nb, float* lds) {
    for (int u = bid; u < NB * NPOS * 4; u += nb) ret_out_unit(p, l, u, lds);
    __syncthreads();
}

__device__ __forceinline__ void phase_ln1(KP p, int l, int bid, int nb) {
    const int lane = tid_opaque() & 63, w = tid_opaque() >> 6;
    for (int r = bid * NW + w; r < T; r += nb * NW) {
        float v[16], a[16], c[16];
        row_load(x_row(p, l, r), v, lane);
        row_load(p->Y + (size_t)r * D, a, lane);
        const float* m = p->mod + ((size_t)l * 3 + mod_idx(r)) * 6144;
        row_load(m + 2048, c, lane);
#pragma unroll
        for (int i = 0; i < 16; ++i) v[i] = ALPHA * v[i] + c[i] * a[i];
        row_ln(v);
        row_load(p->lnm_g + l * D, a, lane); row_load(p->lnm_b + l * D, c, lane);
#pragma unroll
        for (int i = 0; i < 16; ++i) v[i] = v[i] * a[i] + c[i];
        row_store(p->X1 + (size_t)r * D, v, lane);
        row_ln(v);
        row_load(m + 3072, a, lane); row_load(m + 4096, c, lane);
#pragma unroll
        for (int i = 0; i < 16; ++i) v[i] = v[i] * (1.0f + c[i]) + a[i];
        row_store_bf(p->H + (size_t)r * D, v, lane);
    }
}

typedef short bf16x8_t __attribute__((ext_vector_type(8)));
typedef float f32x4_t __attribute__((ext_vector_type(4)));
template <int NV, class IdFn>
__device__ __forceinline__ void select_top16(const float (&v)[NV], IdFn idf, float* lv, int* li, int lane) {
    float mx = v[0], mn = v[0];
#pragma unroll
    for (int e = 1; e < NV; ++e) { mx = fmaxf(mx, v[e]); mn = fminf(mn, v[e]); }
    mx = fmaxf(mx, __shfl_xor(mx, 16)); mx = fmaxf(mx, __shfl_xor(mx, 32));
    mn = fminf(mn, __shfl_xor(mn, 16)); mn = fminf(mn, __shfl_xor(mn, 32));
    float lo = mn - 1.0f, hi = mx, tau = lo;
    bool done = false;
    for (int iter = 0; iter < 48; ++iter) {
        const float mid = 0.5f * (lo + hi);
        int cnt = 0;
#pragma unroll
        for (int e = 0; e < NV; ++e) cnt += (v[e] > mid) ? 1 : 0;
        cnt += __shfl_xor(cnt, 16); cnt += __shfl_xor(cnt, 32);
        if (!done) {
            if (cnt == 16) { tau = mid; done = true; }
            else if (cnt > 16) { lo = mid; tau = mid; } else hi = mid;
            if (!(mid > lo || mid < hi)) done = true;
        }
        if (__all(done)) break;
    }
    int c = 0;
#pragma unroll
    for (int e = 0; e < NV; ++e) c += (v[e] > tau) ? 1 : 0;
    const int base = lane & 15, g = lane >> 4;
    const int c0 = __shfl(c, base), c1 = __shfl(c, base + 16), c2 = __shfl(c, base + 32);
    int pos = (g > 0 ? c0 : 0) + (g > 1 ? c1 : 0) + (g > 2 ? c2 : 0);
#pragma unroll
    for (int e = 0; e < NV; ++e) {
        if (v[e] > tau && pos < 16) { lv[base * 16 + pos] = v[e]; li[base * 16 + pos] = idf(e); ++pos; }
    }
}
constexpr int KS_STRIDE = 136;
__device__ __forceinline__ void phase_topk(KP p, int l, int bid, int nb, float* lds) {
    bf16* k1s = (bf16*)lds;
    bf16* k2s = k1s + 128 * KS_STRIDE;
    const int t = tid_opaque(), lane = t & 63, w = t >> 6;
    float* lists = lds + (2 * 128 * KS_STRIDE * 2) / 4 + w * 1536;
    float* v1 = lists; int* i1 = (int*)(lists + 256); float* v2 = lists + 512; int* i2 = (int*)(lists + 768); float* v3 = lists + 1024; int* c3 = (int*)(lists + 1280);
    __syncthreads();
    for (int e = t; e < 2 * 128 * 16; e += NT) {
        const int tab = e >> 11, r = (e >> 4) & 127, c8 = e & 15;
        const float* src = (tab ? p->k2 : p->k1) + (size_t)l * 128 * 128 + r * 128 + c8 * 8;
        const float4 a = *(const float4*)src, b = *(const float4*)(src + 4);
        uint4 o; o.x = pk2(a.x, a.y); o.y = pk2(a.z, a.w); o.z = pk2(b.x, b.y); o.w = pk2(b.z, b.w);
        *(uint4*)((tab ? k2s : k1s) + r * KS_STRIDE + c8 * 8) = o;
    }
    __syncthreads();
    const int fr = lane & 15, fq = lane >> 4;
    for (int task = bid * NW + w; task < T * 8 / 16; task += nb * NW) {
        const int it0 = task * 16;
        const bf16* qrow = p->Qb + (size_t)(it0 + fr) * 256 + fq * 8;
        bf16x8_t bq[8];
#pragma unroll
        for (int ks = 0; ks < 8; ++ks) bq[ks] = *(const bf16x8_t*)(qrow + ks * 32);
        float s[32];
#pragma unroll
        for (int kt = 0; kt < 8; ++kt) {
            f32x4_t acc = {0.f, 0.f, 0.f, 0.f};
#pragma unroll
            for (int ks = 0; ks < 4; ++ks) {
                const bf16x8_t a = *(const bf16x8_t*)(k1s + (kt * 16 + fr) * KS_STRIDE + ks * 32 + fq * 8);
                acc = __builtin_amdgcn_mfma_f32_16x16x32_bf16(a, bq[ks], acc, 0, 0, 0);
            }
            s[kt * 4 + 0] = acc[0]; s[kt * 4 + 1] = acc[1]; s[kt * 4 + 2] = acc[2]; s[kt * 4 + 3] = acc[3];
        }
        select_top16<32>(s, [fq](int e) { return (e >> 2) * 16 + fq * 4 + (e & 3); }, v1, i1, lane);
#pragma unroll
        for (int kt = 0; kt < 8; ++kt) {
            f32x4_t acc = {0.f, 0.f, 0.f, 0.f};
#pragma unroll
            for (int ks = 0; ks < 4; ++ks) {
                const bf16x8_t a = *(const bf16x8_t*)(k2s + (kt * 16 + fr) * KS_STRIDE + ks * 32 + fq * 8);
                acc = __builtin_amdgcn_mfma_f32_16x16x32_bf16(a, bq[4 + ks], acc, 0, 0, 0);
            }
            s[kt * 4 + 0] = acc[0]; s[kt * 4 + 1] = acc[1]; s[kt * 4 + 2] = acc[2]; s[kt * 4 + 3] = acc[3];
        }
        select_top16<32>(s, [fq](int e) { return (e >> 2) * 16 + fq * 4 + (e & 3); }, v2, i2, lane);
        __builtin_amdgcn_wave_barrier();
        float cv[64];
#pragma unroll
        for (int a = 0; a < 4; ++a) {
            const float va = v1[fr * 16 + fq * 4 + a];
#pragma unroll
            for (int b = 0; b < 16; ++b) cv[a * 16 + b] = va + v2[fr * 16 + b];
        }
        select_top16<64>(cv, [fq](int e) { return (fq * 4 + (e >> 4)) * 16 + (e & 15); }, v3, c3, lane);
        __builtin_amdgcn_wave_barrier();
        float tv[4]; int tc[4];
#pragma unroll
        for (int k = 0; k < 4; ++k) { tv[k] = v3[fr * 16 + fq * 4 + k]; tc[k] = c3[fr * 16 + fq * 4 + k]; }
        float mx = fmaxf(fmaxf(tv[0], tv[1]), fmaxf(tv[2], tv[3]));
        mx = fmaxf(mx, __shfl_xor(mx, 16)); mx = fmaxf(mx, __shfl_xor(mx, 32));
        float ex[4], den = 0.f;
#pragma unroll
        for (int k = 0; k < 4; ++k) { ex[k] = expf(tv[k] - mx); den += ex[k]; }
        den += __shfl_xor(den, 16); den += __shfl_xor(den, 32);
        const float inv = 1.0f / den;
        int4 eo; float4 go;
        eo.x = i1[fr * 16 + (tc[0] >> 4)] * 128 + i2[fr * 16 + (tc[0] & 15)];
        eo.y = i1[fr * 16 + (tc[1] >> 4)] * 128 + i2[fr * 16 + (tc[1] & 15)];
        eo.z = i1[fr * 16 + (tc[2] >> 4)] * 128 + i2[fr * 16 + (tc[2] & 15)];
        eo.w = i1[fr * 16 + (tc[3] >> 4)] * 128 + i2[fr * 16 + (tc[3] & 15)];
        go = make_float4(ex[0] * inv, ex[1] * inv, ex[2] * inv, ex[3] * inv);
        *(int4*)(p->EIDX + (size_t)(it0 + fr) * 16 + fq * 4) = eo;
        *(float4*)(p->GATE + (size_t)(it0 + fr) * 16 + fq * 4) = go;
        __builtin_amdgcn_wave_barrier();
    }
    __syncthreads();
}

typedef unsigned u32x4_t __attribute__((ext_vector_type(4)));
using bf16x2_t = __attribute__((ext_vector_type(2))) __bf16;
__device__ __forceinline__ float dot2bf(unsigned a, unsigned b, float acc) { return __builtin_amdgcn_fdot2_f32_bf16(__builtin_bit_cast(bf16x2_t, a), __builtin_bit_cast(bf16x2_t, b), acc, false); }
struct RowBf { u32x4_t a, b; };
__device__ __forceinline__ RowBf ld_row(const bf16* tab, int e, int lane) {
    const u32x4_t* r = (const u32x4_t*)(tab + (size_t)e * D) + lane;
    RowBf x; x.a = r[0]; x.b = r[64]; return x;
}
__device__ __forceinline__ float row_dot(const RowBf& x, const RowBf& u) {
    float d = 0.f;
#pragma unroll
    for (int k = 0; k < 4; ++k) { d = dot2bf(x.a[k], u.a[k], d); d = dot2bf(x.b[k], u.b[k], d); }
    return d;
}
__device__ __forceinline__ void row_axpy(float (&acc)[16], float a, const RowBf& v) {
#pragma unroll
    for (int k = 0; k < 4; ++k) {
        acc[2 * k] += a * bflo(v.a[k]); acc[2 * k + 1] += a * bfhi(v.a[k]);
        acc[8 + 2 * k] += a * bflo(v.b[k]); acc[8 + 2 * k + 1] += a * bfhi(v.b[k]);
    }
}
__device__ __forceinline__ float transpose_reduce16(float (&part)[16], int lane) {
#pragma unroll
    for (int st = 32, n = 8; n >= 1; st >>= 1, n >>= 1) {
        const bool up = (lane & st) != 0;
#pragma unroll
        for (int s = 0; s < n; ++s) {
            const float lo = part[s], hi = part[s + n];
            const float recv = __shfl_xor(up ? lo : hi, st);
            part[s] = (up ? hi : lo) + recv;
        }
    }
    float v = part[0];
    v += __shfl_xor(v, 1); v += __shfl_xor(v, 2);
    return v;
}
__device__ __forceinline__ void phase_expert(KP p, int l, int bid, int nb) {
    const int lane = tid_opaque() & 63, w = __builtin_amdgcn_readfirstlane(tid_opaque() >> 6);
    const bf16* U = p->U16 + (size_t)l * PEER_N * D;
    const bf16* V = p->V16 + (size_t)l * PEER_N * D;
    const int myslot = 16 * (lane & 3) + (lane >> 2);
    for (int r = bid * NW + w; r < T; r += nb * NW) {
        const RowBf x = ld_row(p->H, r, lane);
        const int* er = p->EIDX + (size_t)r * NSEL;
        float acc[16];
#pragma unroll
        for (int i = 0; i < 16; ++i) acc[i] = 0.f;
#pragma unroll 1
        for (int half = 0; half < 2; ++half) {
            const int* eh = er + half * 64;
            const float gate = p->GATE[(size_t)r * NSEL + half * 64 + myslot];
            RowBf buf[2][4];
#pragma unroll
            for (int j = 0; j < 4; ++j) buf[0][j] = ld_row(U, eh[j], lane);
            float dsel = 0.f;
#pragma unroll 1
            for (int g = 0; g < 4; ++g) {
                float part[16];
#pragma unroll
                for (int b = 0; b < 4; ++b) {
                    const int nxt = g * 16 + (b + 1) * 4;
                    const bf16* tn = nxt < 64 ? U : V;
#pragma unroll
                    for (int j = 0; j < 4; ++j) buf[(b + 1) & 1][j] = ld_row(tn, eh[(nxt & 63) + j], lane);
#pragma unroll
                    for (int j = 0; j < 4; ++j) part[b * 4 + j] = row_dot(x, buf[b & 1][j]);
                }
                const float val = transpose_reduce16(part, lane);
                if ((lane & 3) == g) dsel = val;
            }
            const int act = __builtin_bit_cast(int, gelu_tanh(dsel) * gate);
#pragma unroll 1
            for (int g = 0; g < 4; ++g) {
#pragma unroll
                for (int b = 0; b < 4; ++b) {
                    const int nxt = g * 16 + (b + 1) * 4;
                    if (nxt < 64) {
#pragma unroll
                        for (int j = 0; j < 4; ++j) buf[(b + 1) & 1][j] = ld_row(V, eh[nxt + j], lane);
                    }
#pragma unroll
                    for (int j = 0; j < 4; ++j) {
                        const float a = __builtin_bit_cast(float, __builtin_amdgcn_readlane(act, 4 * (b * 4 + j) + g));
                        row_axpy(acc, a, buf[b & 1][j]);
                    }
                }
            }
        }
        float* yr = p->Y + (size_t)r * D;
        *(float4*)(yr + lane * 8) = make_float4(acc[0], acc[1], acc[2], acc[3]);
        *(float4*)(yr + lane * 8 + 4) = make_float4(acc[4], acc[5], acc[6], acc[7]);
        *(float4*)(yr + 512 + lane * 8) = make_float4(acc[8], acc[9], acc[10], acc[11]);
        *(float4*)(yr + 512 + lane * 8 + 4) = make_float4(acc[12], acc[13], acc[14], acc[15]);
    }
}

__device__ __forceinline__ void phase_ln2(KP p, int l, int bid, int nb) {
    const int lane = tid_opaque() & 63, w = tid_opaque() >> 6;
    for (int r = bid * NW + w; r < T; r += nb * NW) {
        float v[16], a[16], c[16];
        row_load(p->X1 + (size_t)r * D, v, lane);
        row_load(p->Y + (size_t)r * D, a, lane);
        const float* m = p->mod + ((size_t)l * 3 + mod_idx(r)) * 6144;
        row_load(m + 5120, c, lane);
#pragma unroll
        for (int i = 0; i < 16; ++i) v[i] = ALPHA * v[i] + c[i] * a[i];
        row_ln(v);
        row_load(p->lnf_g + l * D, a, lane); row_load(p->lnf_b + l * D, c, lane);
#pragma unroll
        for (int i = 0; i < 16; ++i) v[i] = v[i] * a[i] + c[i];
        if (l == DEPTH - 1) { if (r < TL) row_store(p->out + (size_t)r * D, v, lane); continue; }
        row_store(p->X + (size_t)r * D, v, lane);
        const float* m2 = p->mod + ((size_t)(l + 1) * 3 + mod_idx(r)) * 6144;
        row_ln(v);
        row_load(m2, a, lane); row_load(m2 + 1024, c, lane);
#pragma unroll
        for (int i = 0; i < 16; ++i) v[i] = v[i] * (1.0f + c[i]) + a[i];
        row_store_bf(p->H + (size_t)r * D, v, lane);
    }
}

constexpr int REP_MIXA = 1, REP_TOPK = 1, REP_EXP = 1, REP_RETOUT = 1;
__global__ void __launch_bounds__(NT, 2) mega(Params p_unused) {
    extern __shared__ __attribute__((aligned(16))) unsigned char lds_raw[];
    cg::grid_group grid = cg::this_grid();
    const int bid = blockIdx.x, nb = gridDim.x;
    float* lds = (float*)lds_raw;
    LAS unsigned char* ldsl = (LAS unsigned char*)lds_raw;
    volatile LAS unsigned* MISC = (volatile LAS unsigned*)(ldsl + MISC_OFF);
    for (int u = threadIdx.x; u < (LDS_BYTES - 131072) / 4; u += NT) ((LAS unsigned*)(ldsl + 131072))[u] = 0u;
    __syncthreads();
    (void)xcd_barrier_post(kparams()->ctl + CW_BAR, MISC + 8);
#define GRID_BAR() do { XcdBarrier b_; b_.bar = kparams()->ctl + CW_BAR; b_.x = xb_xcc_id(); b_.st = MISC + 8; xcd_barrier(b_); } while (0)

    phase_mod1(kparams(), bid, nb, lds);
    phase_weights(kparams(), bid, nb, lds);
    grid.sync();
    phase_mod2(kparams(), bid, nb);
    GRID_BAR();
    phase_lnmod(kparams(), 0, bid, nb);
    GRID_BAR();
#define LAYER_BODY(l) do { \
        { KP p = kparams(); \
            pg8::Gemm g{p->H, p->WtIn + (size_t)l * DIN * D, T, DIN, D}; pg8::StaticOrder S; S.init(T, DIN, nb, bid); \
            pg8::EpiInProj E{p->P, p->rope}; \
            pg8::gemm_phase<pg8::EpiInProj, pg8::StaticOrder, true, true>(ldsl, g, S, E); \
        } \
        GRID_BAR(); \
        for (int rep = 0; rep < REP_MIXA; ++rep) phase_mix_a(kparams(), l, bid, nb, lds); \
        GRID_BAR(); \
        phase_ret_scan(kparams(), l, bid, nb); \
        GRID_BAR(); \
        for (int rep = 0; rep < REP_RETOUT; ++rep) phase_ret_out(kparams(), l, bid, nb, lds); \
        GRID_BAR(); \
        { KP p = kparams(); \
            pg8::Gemm g{p->MIX, p->WtOut + (size_t)l * D * D, T, D, D}; pg8::StaticOrder S; S.init(T, D, nb, bid); \
            pg8::EpiF32 E{p->Y, D}; \
            pg8::gemm_phase<pg8::EpiF32, pg8::StaticOrder, true, true>(ldsl, g, S, E); \
        } \
        GRID_BAR(); \
        phase_ln1(kparams(), l, bid, nb); \
        GRID_BAR(); \
        { KP p = kparams(); \
            pg8::Gemm g{p->H, p->WtQ + (size_t)l * 2048 * D, T, 2048, D}; pg8::StaticOrder S; S.init(T, 2048, nb, bid); \
            pg8::EpiBf16Plain E{p->Qb, 2048}; \
            pg8::gemm_phase<pg8::EpiBf16Plain, pg8::StaticOrder, true, true>(ldsl, g, S, E); \
        } \
        GRID_BAR(); \
        for (int rep = 0; rep < REP_TOPK; ++rep) phase_topk(kparams(), l, bid, nb, lds); \
        GRID_BAR(); \
        for (int rep = 0; rep < REP_EXP; ++rep) phase_expert(kparams(), l, bid, nb); \
        GRID_BAR(); \
        phase_ln2(kparams(), l, bid, nb); \
        if (l + 1 < DEPTH) GRID_BAR(); \
    } while (0)
    LAYER_BODY(0); LAYER_BODY(1); LAYER_BODY(2); LAYER_BODY(3);
#undef LAYER_BODY
}

extern "C" void kernel_launch(void* const* d_in, const int* in_sizes, int n_in, void* d_out, int out_size, void* d_ws, size_t ws_size, hipStream_t stream) {
    static int grid_blocks = 0;
    if (!grid_blocks) {
        int dev = 0, cus = 0, per_cu = 0;
        (void)hipGetDevice(&dev);
        (void)hipDeviceGetAttribute(&cus, hipDeviceAttributeMultiprocessorCount, dev);
        (void)hipFuncSetAttribute((const void*)mega, hipFuncAttributeMaxDynamicSharedMemorySize, LDS_BYTES);
        (void)hipOccupancyMaxActiveBlocksPerMultiprocessor(&per_cu, mega, NT, LDS_BYTES);
        if (per_cu < 1) { fprintf(stderr, "occupancy query says %d blocks per CU\n", per_cu); per_cu = 1; }
        grid_blocks = cus;
    }
    Params p{};
    const float** ins = (const float**)&p;
    for (int i = 0; i < 22; ++i) ins[i] = (const float*)d_in[i];
    p.out = (float*)d_out;
    char* ws = (char*)d_ws;
    size_t off = 0;
    auto carve = [&](size_t bytes) { void* r = ws + off; off += (bytes + 255) & ~(size_t)255; return r; };
    p.ctl = (unsigned*)carve(CTL_BYTES);
    p.modp = (float*)carve((size_t)16 * DEPTH * 3 * 6144 * 4);
    p.mod = (float*)carve((size_t)DEPTH * 3 * 6144 * 4);
    p.rope = (float*)carve((size_t)192 * 16 * 2 * 4);
    p.WtIn = (bf16*)carve((size_t)DEPTH * DIN * D * 2);
    p.WtOut = (bf16*)carve((size_t)DEPTH * D * D * 2);
    p.WtQ = (bf16*)carve((size_t)DEPTH * 2048 * D * 2);
    p.X = (float*)carve((size_t)T * D * 4);
    p.H = (bf16*)carve((size_t)T * D * 2);
    p.P = (bf16*)carve((size_t)T * DIN * 2);
    p.KV = (float*)carve((size_t)2 * NB * NPOS * 4 * 4096 * 4);
    p.ST = (float*)carve((size_t)2 * NB * NPOS * 4 * 4096 * 4);
    p.MIX = (bf16*)carve((size_t)T * D * 2);
    p.Qb = (bf16*)carve((size_t)T * 2048 * 2);
    p.U16 = (bf16*)carve((size_t)DEPTH * PEER_N * D * 2);
    p.V16 = (bf16*)carve((size_t)DEPTH * PEER_N * D * 2);
    p.Y = (float*)carve((size_t)T * D * 4);
    p.X1 = (float*)carve((size_t)T * D * 4);
    p.Q = (float*)carve((size_t)T * 2048 * 4);
    p.GATE = (float*)carve((size_t)T * NSEL * 4);
    p.V1 = (float*)carve((size_t)T * 8 * 16 * 4);
    p.EIDX = (int*)carve((size_t)T * NSEL * 4);
    p.I1 = (int*)carve((size_t)T * 8 * 16 * 4);
    if (off > ws_size) { fprintf(stderr, "workspace too small: need %zu have %zu\n", off, ws_size); return; }
    (void)hipMemsetAsync(p.ctl, 0, CTL_BYTES, stream);
    void* args[] = {&p};
    hipError_t e = hipLaunchCooperativeKernel((void*)mega, dim3(grid_blocks), dim3(NT), args, LDS_BYTES, stream);
    if (e != hipSuccess) fprintf(stderr, "cooperative launch failed: %s (grid %d)\n", hipGetErrorString(e), grid_blocks);
}
```

```cpp
#include <hip/hip_runtime.h>
#include <hip/hip_cooperative_groups.h>
#include <cstdio>
#include <cstdint>
namespace cg = cooperative_groups;

constexpr int D = 1024, NB = 2, SEQ = 8192, DEPTH = 4, LC = 256, HD = 64;
constexpr int TL = NB * SEQ, TC = NB * LC, T = TL + TC;
constexpr int DIN = 2304;
constexpr int C_RQ = 0, C_RK = 256, C_RV = 512, C_RG = 768, C_SU = 1024, C_SV = 1280, C_AQ = 1536, C_AK = 2048, C_AV = 2176;
constexpr int NPOS = 66;
constexpr int PEER_N = 16384, NSEL = 128;
constexpr float LN_EPS = 1e-5f;
constexpr float ALPHA = 1.681792830507429f;
constexpr int NT = 512;
constexpr int NW = 8;
constexpr int LDS_BYTES = 147456;
constexpr int MISC_OFF = 131072 + 320;

typedef unsigned short bf16;
#define LAS __attribute__((address_space(3)))

struct Params {
    const float *x, *c, *ctx, *c_ctx, *w_mod, *b_mod, *w_in, *w_out, *rdf, *rdb, *sgu_w, *sgu_b, *sink, *lnm_g, *lnm_b, *wq, *k1, *k2, *pu, *pv, *lnf_g, *lnf_b;
    float* out;
    unsigned* ctl;
    float *modp, *mod, *rope, *X, *KV, *ST, *Y, *X1, *Q, *GATE, *V1, *ACT;
    bf16 *WtIn, *WtOut, *WtQ, *H, *P, *MIX, *U16, *V16, *Qb, *ST16;
    int *EIDX, *I1;
};

__device__ __forceinline__ unsigned f2bf(float f) { unsigned u = __builtin_bit_cast(unsigned, f); return (u + 0x7fffu + ((u >> 16) & 1u)) >> 16; }
__device__ __forceinline__ unsigned pk2(float lo, float hi) { return f2bf(lo) | (f2bf(hi) << 16); }
__device__ __forceinline__ float bf2f(bf16 v) { return __builtin_bit_cast(float, (unsigned)v << 16); }
__device__ __forceinline__ float bflo(unsigned w) { return __builtin_bit_cast(float, w << 16); }
__device__ __forceinline__ float bfhi(unsigned w) { return __builtin_bit_cast(float, w & 0xffff0000u); }

__device__ __forceinline__ float gelu_tanh(float x) {
    const float k0 = 0.7978845608028654f, k1 = 0.044715f;
    float u = k0 * (x + k1 * x * x * x);
    return 0.5f * x * (1.0f + tanhf(u));
}
__device__ __forceinline__ float silu_f(float x) { return x / (1.0f + expf(-x)); }
__device__ __forceinline__ float wave_sum(float v) {
#pragma unroll
    for (int o = 32; o >= 1; o >>= 1) v += __shfl_xor(v, o);
    return v;
}
__device__ __forceinline__ int chunk_row0(int b, int pos) { return pos < 2 ? TL + b * LC + pos * 128 : b * SEQ + (pos - 2) * 128; }
__device__ __forceinline__ int mod_idx(int r) { return r < TL ? r / SEQ : 2; }
__device__ __forceinline__ float log_sigmoid_f(float x) { return -log1pf(expf(-x)); }
typedef const __attribute__((address_space(4))) Params* KP;
__device__ __forceinline__ KP kparams() { KP k = (KP)__builtin_amdgcn_kernarg_segment_ptr(); asm volatile("" : "+s"(k)); return k; }
__device__ __forceinline__ int tid_opaque() { int t = threadIdx.x; asm volatile("" : "+v"(t)); return t; }

namespace pg8 {
#define PG8_LAS __attribute__((address_space(3)))
typedef unsigned short bf16_t;
typedef short bf16x8 __attribute__((ext_vector_type(8)));
typedef float f32x4 __attribute__((ext_vector_type(4)));
typedef unsigned u32x4 __attribute__((ext_vector_type(4)));
constexpr int BM = 256, BK = 64, HALF = 128, HTB = HALF * BK * 2  , STAGE_BYTES = 8 * HTB, NXCD = 8, WGM = 8;

__host__ __device__ __forceinline__ int lds_byte(int r, int c) { const int st = (r >> 4) * 2 + (c >> 5), rr = r & 15, cc = c & 31, ob = rr * 64 + cc * 2; return st * 1024 + (ob ^ (((ob >> 9) & 1) << 5)); }
__host__ __device__ __forceinline__ void stage_rc(int b, int& R, int& C) { const int st = b / 1024, sb = b % 1024, swz = sb ^ (((sb >> 9) & 1) << 5); R = (st >> 1) * 16 + swz / 64; C = (st & 1) * 32 + (swz % 64) / 2; }
__host__ __device__ __forceinline__ int perm32(int rho) { const int n = rho >> 4, i = rho & 15; return 8 * (i >> 2) + 4 * n + (i & 3); }

struct Unit { int pm, pn; };
struct Gemm { const bf16_t* A; const bf16_t* Bt; int M, N, K; };

struct StaticOrder {
    int nM, nN, nwg, G, c;
    __host__ __device__ void init(int M, int N, int G_, int c_) { nM = M / BM; nN = N / BM; nwg = nM * nN; G = G_; c = c_; }
    __host__ __device__ bool next(int i, Unit& u) const {
        const long L = (long)i * G + c; if (L >= nwg) return false;
        int wgid = (int)L; { const int q = nwg / NXCD, r = nwg % NXCD, xcd = wgid % NXCD, off = wgid / NXCD; wgid = (xcd < r ? xcd * (q + 1) : r * (q + 1) + (xcd - r) * q) + off; }
        const int nig = WGM * nN, gid = wgid / nig, fm = gid * WGM, gsz = (nM - fm) < WGM ? (nM - fm) : WGM;
        u.pm = fm + ((wgid % nig) % gsz); u.pn = (wgid % nig) / gsz; return true;
    }
    __device__ __forceinline__ void a_ready(const Unit&) const {}
    __device__ __forceinline__ void done(const Unit&) const {}
};

__device__ __forceinline__ unsigned cvt_pk_bf16(float lo, float hi) { unsigned r; asm volatile("v_cvt_pk_bf16_f32 %0, %1, %2" : "=v"(r) : "v"(lo), "v"(hi)); return r; }
struct EpiInProj {
    static constexpr bool PERM = true, AFTER_DRAIN = false;
    bf16_t* P; const float* rope;
    __device__ __forceinline__ void operator()(const f32x4 (&acc)[2][2][4][2], const Unit& u, int wr, int wc, int fr, int fq) const {
        const int pn = u.pn; const bool lat = u.pm < 64;
        const float sc = (pn == 1 || pn == 6 || pn == 7) ? 0.125f : 1.0f;
        const float sgn = fq < 2 ? -1.0f : 1.0f;
#pragma unroll
        for (int bj = 0; bj < 2; ++bj) {
            const bool roped = lat && (pn == 0 || pn == 1 || pn == 6 || pn == 7 || (pn == 8 && bj == 0));
#pragma unroll
            for (int ai = 0; ai < 2; ++ai)
#pragma unroll
                for (int m = 0; m < 4; ++m) {
                    const int row = u.pm * BM + ai * HALF + wr * 64 + m * 16 + fr;
                    f32x4 v0 = acc[ai][bj][m][0], v1 = acc[ai][bj][m][1];
                    if (roped) {
                        const int pos = row & 8191, idx = (wc & 1) ? 128 + (pos & 63) : (pos >> 6);
                        const float2* tb = (const float2*)rope + idx * 16 + 8 * (fq & 1);
#pragma unroll
                        for (int e = 0; e < 4; ++e) {
                            const float p0 = __shfl_xor(v0[e], 32), p1 = __shfl_xor(v1[e], 32);
                            const float2 c0 = tb[e], c1 = tb[4 + e];
                            v0[e] = v0[e] * c0.x + sgn * p0 * c0.y;
                            v1[e] = v1[e] * c1.x + sgn * p1 * c1.y;
                        }
                    }
                    v0 = v0 * sc; v1 = v1 * sc;
                    u32x4 w; w.x = cvt_pk_bf16(v0[0], v0[1]); w.y = cvt_pk_bf16(v0[2], v0[3]); w.z = cvt_pk_bf16(v1[0], v1[1]); w.w = cvt_pk_bf16(v1[2], v1[3]);
                    *(u32x4*)(P + (size_t)row * 2304 + pn * BM + bj * HALF + wc * 32 + fq * 8) = w;
                    __builtin_amdgcn_sched_barrier(0);
                }
        }
    }
};
struct EpiF32 {
    static constexpr bool PERM = false, AFTER_DRAIN = false;
    float* O; int ldc;
    __device__ __forceinline__ void operator()(const f32x4 (&acc)[2][2][4][2], const Unit& u, int wr, int wc, int fr, int fq) const {
#pragma unroll
        for (int ai = 0; ai < 2; ++ai)
#pragma unroll
            for (int m = 0; m < 4; ++m) {
                float* rowp = O + (size_t)(u.pm * BM + ai * HALF + wr * 64 + m * 16 + fr) * ldc + u.pn * BM + wc * 32 + fq * 4;
#pragma unroll
                for (int bj = 0; bj < 2; ++bj)
#pragma unroll
                    for (int n = 0; n < 2; ++n) *(f32x4*)(rowp + bj * HALF + n * 16) = acc[ai][bj][m][n];
            }
    }
};


struct EpiBf16Plain {
    static constexpr bool PERM = true, AFTER_DRAIN = false;
    bf16_t* O; int ldc;
    __device__ __forceinline__ void operator()(const f32x4 (&acc)[2][2][4][2], const Unit& u, int wr, int wc, int fr, int fq) const {
#pragma unroll
        for (int ai = 0; ai < 2; ++ai)
#pragma unroll
            for (int m = 0; m < 4; ++m) {
                bf16_t* rowp = O + (size_t)(u.pm * BM + ai * HALF + wr * 64 + m * 16 + fr) * ldc + u.pn * BM + wc * 32 + fq * 8;
#pragma unroll
                for (int bj = 0; bj < 2; ++bj) {
                    const f32x4 v0 = acc[ai][bj][m][0], v1 = acc[ai][bj][m][1];
                    u32x4 w; w.x = cvt_pk_bf16(v0[0], v0[1]); w.y = cvt_pk_bf16(v0[2], v0[3]); w.z = cvt_pk_bf16(v1[0], v1[1]); w.w = cvt_pk_bf16(v1[2], v1[3]);
                    *(u32x4*)(rowp + bj * HALF) = w;
                }
            }
    }
};
template <class Epi, class Sched, bool ALIGN_EPI = false, bool SP2 = false>
__device__ __forceinline__ void gemm_phase(PG8_LAS unsigned char* lds, const Gemm g, const Sched& S, const Epi& E) {
    int tid_ = threadIdx.x; asm volatile("" : "+v"(tid_));
    const int tid = tid_, wid = __builtin_amdgcn_readfirstlane(tid >> 6), lane = tid & 63, wr = wid >> 2, wc = wid & 3, fr = lane & 15, fq = lane >> 4;
    const int K = g.K, nt = K / BK;
    unsigned voffA[2], voffB[2];
#pragma unroll
    for (int i = 0; i < 2; ++i) { int R, C; stage_rc(tid * 16 + i * 8192, R, C); const int Rb = Epi::PERM ? ((R & ~31) + perm32(R & 31)) : R;
        voffA[i] = (unsigned)(R * K + C) * 2u; voffB[i] = (unsigned)(Rb * K + C) * 2u; }
    const size_t kstep = (size_t)(BK * 2);
    const size_t hstep = (size_t)HALF * K * 2;
    const size_t tstep = 2 * hstep;
    const unsigned ldsw = (unsigned)wid * 1024u;
    const int aoff = lds_byte(wr * 64 + fr, fq * 8), boff = lds_byte(wc * 32 + fr, fq * 8);
#define PG8_SA(b, h) (((b) * 2 + (h)) * HTB)
#define PG8_SB(b, h) ((4 + (b) * 2 + (h)) * HTB)
#define PG8_STAGE(bufoff, gbase, voff) do { _Pragma("unroll") for (int _i = 0; _i < 2; ++_i) \
        __builtin_amdgcn_global_load_lds((const unsigned*)((const char*)(gbase) + (voff)[_i]), (PG8_LAS unsigned*)(lds + (bufoff) + ldsw + _i * 8192), 16, 0, 0); } while (0)
#define PG8_LDA(dst, b, h) do { _Pragma("unroll") for (int m = 0; m < 4; ++m) _Pragma("unroll") for (int k = 0; k < 2; ++k) dst[m][k] = *(const PG8_LAS bf16x8*)(lds + PG8_SA(b, h) + aoff + m * 2048 + k * 1024); } while (0)
#define PG8_LDB(dst, b, h) do { _Pragma("unroll") for (int n = 0; n < 2; ++n) _Pragma("unroll") for (int k = 0; k < 2; ++k) dst[n][k] = *(const PG8_LAS bf16x8*)(lds + PG8_SB(b, h) + boff + n * 2048 + k * 1024); } while (0)
#define PG8_MMA(ai, bj, At, Bt) do { __builtin_amdgcn_s_setprio(1); _Pragma("unroll") for (int m = 0; m < 4; ++m) _Pragma("unroll") for (int n = 0; n < 2; ++n) _Pragma("unroll") for (int k = 0; k < 2; ++k) \
        acc[ai][bj][m][n] = __builtin_amdgcn_mfma_f32_16x16x32_bf16(Bt[n][k], At[m][k], acc[ai][bj][m][n], 0, 0, 0); __builtin_amdgcn_s_setprio(0); } while (0)
#define PG8_WAIT_V(n) asm volatile("s_waitcnt vmcnt(" #n ")" ::: "memory")
#define PG8_WAIT_L(n) asm volatile("s_waitcnt lgkmcnt(" #n ")" ::: "memory")
#define PG8_BAR __builtin_amdgcn_s_barrier()
#define PG8_SCHED __builtin_amdgcn_sched_barrier(0)
    Unit cur, nxt; int ui = 0;
    if (!S.next(0, cur)) return;
    f32x4 acc[2][2][4][2];
#pragma unroll
    for (int a = 0; a < 2; ++a)
#pragma unroll
        for (int b = 0; b < 2; ++b)
#pragma unroll
            for (int m = 0; m < 4; ++m)
#pragma unroll
                for (int n = 0; n < 2; ++n) acc[a][b][m][n] = (f32x4){0.f, 0.f, 0.f, 0.f};
    bf16x8 At[4][2], B0[2][2], B1[2][2];
    const char* cA = (const char*)g.A + (size_t)cur.pm * tstep; const char* cB = (const char*)g.Bt + (size_t)cur.pn * tstep;
    S.a_ready(cur);
    if constexpr (SP2) {
        PG8_STAGE(PG8_SB(0, 0), cB, voffB); PG8_STAGE(PG8_SB(0, 1), cB + hstep, voffB); PG8_STAGE(PG8_SA(0, 0), cA, voffA); PG8_STAGE(PG8_SA(0, 1), cA + hstep, voffA);
        if (wr == 1) PG8_BAR;
        PG8_WAIT_V(2); PG8_BAR;
        PG8_STAGE(PG8_SB(1, 0), cB + kstep, voffB); PG8_STAGE(PG8_SA(1, 0), cA + kstep, voffA); PG8_STAGE(PG8_SB(1, 1), cB + hstep + kstep, voffB);
        PG8_WAIT_V(6); PG8_BAR;
    } else {
        PG8_STAGE(PG8_SB(0, 0), cB, voffB); PG8_STAGE(PG8_SA(0, 0), cA, voffA); PG8_STAGE(PG8_SB(0, 1), cB + hstep, voffB); PG8_STAGE(PG8_SA(0, 1), cA + hstep, voffA);
        if (wr == 1) PG8_BAR;
        PG8_WAIT_V(4); PG8_BAR;
        PG8_STAGE(PG8_SB(1, 0), cB + kstep, voffB); PG8_STAGE(PG8_SA(1, 0), cA + kstep, voffA); PG8_STAGE(PG8_SB(1, 1), cB + hstep + kstep, voffB);
        PG8_WAIT_V(6); PG8_BAR;
    }
    for (;;) {
        const bool has_next = S.next(ui + 1, nxt);
        const char* nA = has_next ? (const char*)g.A + (size_t)nxt.pm * tstep : cA; const char* nB = has_next ? (const char*)g.Bt + (size_t)nxt.pn * tstep : cB;
        for (int t = 0; t < nt; t += 2) {
            const bool last = (t == nt - 2);
            const char* a1 = cA + (size_t)(t + 1) * kstep;
            const char* a2 = last ? nA : cA + (size_t)(t + 2) * kstep; const char* b2 = last ? nB : cB + (size_t)(t + 2) * kstep;
            const char* a3 = a2 + kstep; const char* b3 = b2 + kstep;
            if (last && has_next) S.a_ready(nxt);
            if constexpr (SP2) {
            PG8_LDB(B0, 0, 0); PG8_LDB(B1, 0, 1); PG8_SCHED; PG8_LDA(At, 0, 0); PG8_STAGE(PG8_SA(1, 1), a1 + hstep, voffA);
            PG8_WAIT_V(8); PG8_WAIT_L(0); PG8_BAR; PG8_MMA(0, 0, At, B0); PG8_MMA(0, 1, At, B1); PG8_BAR; PG8_SCHED;
            PG8_LDA(At, 0, 1); PG8_STAGE(PG8_SB(0, 0), b2, voffB); PG8_STAGE(PG8_SB(0, 1), b2 + hstep, voffB); PG8_STAGE(PG8_SA(0, 0), a2, voffA);
            PG8_WAIT_V(8); PG8_WAIT_L(0); PG8_BAR; PG8_MMA(1, 0, At, B0); PG8_MMA(1, 1, At, B1); PG8_BAR; PG8_SCHED;
            PG8_LDB(B0, 1, 0); PG8_LDB(B1, 1, 1); PG8_SCHED; PG8_LDA(At, 1, 0); PG8_STAGE(PG8_SA(0, 1), a2 + hstep, voffA);
            PG8_WAIT_V(8); PG8_WAIT_L(0); PG8_BAR; PG8_MMA(0, 0, At, B0); PG8_MMA(0, 1, At, B1); PG8_BAR; PG8_SCHED;
            PG8_LDA(At, 1, 1); PG8_STAGE(PG8_SB(1, 0), b3, voffB); PG8_STAGE(PG8_SB(1, 1), b3 + hstep, voffB); PG8_STAGE(PG8_SA(1, 0), a3, voffA);
            PG8_WAIT_V(8); PG8_WAIT_L(0); PG8_BAR; PG8_MMA(1, 0, At, B0); PG8_MMA(1, 1, At, B1); PG8_BAR; PG8_SCHED;
            } else {
            PG8_LDB(B0, 0, 0); PG8_SCHED; PG8_LDA(At, 0, 0); PG8_STAGE(PG8_SA(1, 1), a1 + hstep, voffA);
            PG8_WAIT_L(8); PG8_BAR; PG8_WAIT_L(0); PG8_MMA(0, 0, At, B0); PG8_BAR; PG8_SCHED;
            PG8_LDB(B1, 0, 1); PG8_STAGE(PG8_SB(0, 0), b2, voffB);
            PG8_BAR; PG8_WAIT_L(0); PG8_MMA(0, 1, At, B1); PG8_BAR;
            PG8_LDA(At, 0, 1); PG8_STAGE(PG8_SA(0, 0), a2, voffA);
            PG8_BAR; PG8_WAIT_L(0); PG8_MMA(1, 0, At, B0); PG8_BAR; PG8_SCHED;
            PG8_STAGE(PG8_SB(0, 1), b2 + hstep, voffB);
            PG8_WAIT_V(6); PG8_BAR; PG8_MMA(1, 1, At, B1); PG8_BAR;
            PG8_LDB(B0, 1, 0); PG8_SCHED; PG8_LDA(At, 1, 0); PG8_STAGE(PG8_SA(0, 1), a2 + hstep, voffA);
            PG8_WAIT_L(8); PG8_BAR; PG8_WAIT_L(0); PG8_MMA(0, 0, At, B0); PG8_BAR; PG8_SCHED;
            PG8_LDB(B1, 1, 1); PG8_STAGE(PG8_SB(1, 0), b3, voffB);
            PG8_BAR; PG8_WAIT_L(0); PG8_MMA(0, 1, At, B1); PG8_BAR;
            PG8_LDA(At, 1, 1); PG8_STAGE(PG8_SA(1, 0), a3, voffA);
            PG8_BAR; PG8_WAIT_L(0); PG8_MMA(1, 0, At, B0); PG8_BAR; PG8_SCHED;
            PG8_STAGE(PG8_SB(1, 1), b3 + hstep, voffB);
            PG8_WAIT_V(6); PG8_BAR; PG8_MMA(1, 1, At, B1); PG8_BAR;
            }
        }
        if constexpr (ALIGN_EPI) { if (wr == 0) PG8_BAR; }
        if constexpr (!Epi::AFTER_DRAIN) { E(acc, cur, wr, wc, fr, fq); S.done(cur); }
        if (!has_next) break;
#pragma unroll
        for (int a = 0; a < 2; ++a)
#pragma unroll
            for (int b = 0; b < 2; ++b)
#pragma unroll
                for (int m = 0; m < 4; ++m)
#pragma unroll
                    for (int n = 0; n < 2; ++n) acc[a][b][m][n] = (f32x4){0.f, 0.f, 0.f, 0.f};
        cur = nxt; cA = nA; cB = nB; ++ui;
        if constexpr (ALIGN_EPI) { if (wr == 1) PG8_BAR; }
    }
    PG8_WAIT_V(0);
    if constexpr (!ALIGN_EPI) { if (wr == 0) PG8_BAR; }
    PG8_BAR;
    if constexpr (Epi::AFTER_DRAIN) { E.fused(acc, cur, wr, wc, fr, fq, lds, wid, lane); S.done(cur); }
#undef PG8_SA
#undef PG8_SB
#undef PG8_STAGE
#undef PG8_LDA
#undef PG8_LDB
#undef PG8_MMA
#undef PG8_WAIT_V
#undef PG8_WAIT_L
#undef PG8_BAR
#undef PG8_SCHED
}
}
constexpr int CW_BAR = 4096;
constexpr size_t CTL_BYTES = 65536;
#define XB_TMO      128
#define XB_XCNT(j)  (256  + 64 * (j))
#define XB_XSUB(j)  (1280 + 64 * (j))
#define XB_XGEN(j)  (2304 + 64 * (j))
#define XB_TOP      3328
#define XB_TOPGEN   3392
#define XCD_BAR_WORDS 3456
#define XB_SPIN_CAP (1u << 18)

__device__ __forceinline__ unsigned xb_ld(unsigned* p)              { return __hip_atomic_load(p, __ATOMIC_RELAXED, __HIP_MEMORY_SCOPE_AGENT); }
__device__ __forceinline__ unsigned xb_add(unsigned* p, unsigned v) { return __hip_atomic_fetch_add(p, v, __ATOMIC_RELAXED, __HIP_MEMORY_SCOPE_AGENT); }
__device__ __forceinline__ unsigned xb_xcc_id() { return (unsigned)__builtin_amdgcn_s_getreg((3 << 11) | 20) & 0xFu; }
#define XB_SPIN(cond, bar) do { unsigned _sp = 0; while (cond) { __builtin_amdgcn_s_sleep(1); \
    if ((++_sp & 255u) == 0u) { if (xb_ld(&(bar)[XB_TMO])) break; if (_sp > XB_SPIN_CAP) { atomicAdd(&(bar)[XB_TMO], 1u); break; } } } } while (0)

struct XcdBarrier {
    unsigned* bar; unsigned x;
    volatile LAS unsigned* st;
};

__device__ __forceinline__ XcdBarrier xcd_barrier_post(unsigned* bar, volatile LAS unsigned* st) {
    XcdBarrier b; b.bar = bar; b.x = xb_xcc_id(); b.st = st;
    if (threadIdx.x == 0) (void)xb_add(&bar[XB_XCNT(b.x)], 1u);
    return b;
}
__device__ __forceinline__ void xcd_barrier_complete(unsigned* bar, unsigned x, unsigned& nloc, unsigned& nx) {
    const unsigned G = gridDim.x * gridDim.y * gridDim.z;
    unsigned sum, cnt, mine, sp = 0u;
    for (;;) {
        sum = 0u; cnt = 0u; mine = 0u;
#pragma unroll
        for (unsigned j = 0; j < 16; ++j) { const unsigned c = xb_ld(&bar[XB_XCNT(j)]); sum += c; cnt += (c > 0u) ? 1u : 0u; mine = (j == x) ? c : mine; }
        if (sum == G) break;
        __builtin_amdgcn_s_sleep(1);
        if ((++sp & 255u) == 0u) { if (xb_ld(&bar[XB_TMO])) break; if (sp > XB_SPIN_CAP) { atomicAdd(&bar[XB_TMO], 1u); break; } }
    }
    nloc = mine > 0u ? mine : 1u; nx = cnt > 0u ? cnt : 1u;
}

__device__ __forceinline__ void xcd_barrier(const XcdBarrier& b) {
    asm volatile("s_waitcnt vmcnt(0)" ::: "memory");
    __syncthreads();
    if (threadIdx.x == 0) {
        unsigned* bar = b.bar;
        __builtin_amdgcn_s_waitcnt(0);
        unsigned nloc = b.st[0], nx = b.st[1];
        if (nloc == 0u) { xcd_barrier_complete(bar, b.x, nloc, nx); b.st[0] = nloc; b.st[1] = nx; }
        const unsigned old = xb_add(&bar[XB_XSUB(b.x)], 1u);
        const unsigned gen = old / nloc;
        if (old + 1u == (gen + 1u) * nloc) {
            __builtin_amdgcn_fence(__ATOMIC_RELEASE, "agent");
            asm volatile("s_waitcnt vmcnt(0)" ::: "memory");
            const unsigned og = xb_add(&bar[XB_TOP], 1u);
            const unsigned tg = og / nx;
            if (og + 1u == (tg + 1u) * nx) xb_add(&bar[XB_TOPGEN], 1u);
            else XB_SPIN(xb_ld(&bar[XB_TOPGEN]) == tg, bar);
            __builtin_amdgcn_fence(__ATOMIC_ACQUIRE, "agent");
            xb_add(&bar[XB_XGEN(b.x)], 1u);
            asm volatile("s_waitcnt vmcnt(0)" ::: "memory");
        } else {
            XB_SPIN(xb_ld(&bar[XB_XGEN(b.x)]) == gen, bar);
            __builtin_amdgcn_fence(__ATOMIC_ACQUIRE, "agent");
            asm volatile("s_waitcnt vmcnt(0)" ::: "memory");
        }
    }
    __syncthreads();
}


__device__ __forceinline__ void phase_mod1(KP p, int bid, int nb, float* lds) {
    float (*red)[8][64] = (float (*)[8][64])lds;
    const int t = tid_opaque(), cn = t & 63, kg = t >> 6;
    for (int u = bid; u < DEPTH * 96 * 16; u += nb) {
        const int ks = u & 15, nblk = (u >> 4) % 96, l = u / (16 * 96);
        const int n = nblk * 64 + cn;
        float a0 = 0.f, a1 = 0.f, a2 = 0.f;
#pragma unroll
        for (int kk = 0; kk < 8; ++kk) {
            const int k = ks * 64 + kg * 8 + kk;
            const float w = p->w_mod[((size_t)l * D + k) * 6144 + n];
            a0 += silu_f(p->c[k]) * w; a1 += silu_f(p->c[D + k]) * w; a2 += silu_f(p->c_ctx[k]) * w;
        }
        __syncthreads();
        red[0][kg][cn] = a0; red[1][kg][cn] = a1; red[2][kg][cn] = a2;
        __syncthreads();
        if (t < 192) {
            const int v = t >> 6;
            float s = 0.f;
#pragma unroll
            for (int g = 0; g < 8; ++g) s += red[v][g][cn];
            p->modp[(((size_t)ks * DEPTH + l) * 3 + v) * 6144 + n] = s;
        }
    }
    __syncthreads();
}
__device__ __forceinline__ void phase_mod2(KP p, int bid, int nb) {
    for (int i = bid * NT + tid_opaque(); i < DEPTH * 3 * 6144; i += nb * NT) {
        const int n = i % 6144, l = i / (3 * 6144);
        float s = p->b_mod[l * 6144 + n];
        for (int ks = 0; ks < 16; ++ks) s += p->modp[(size_t)ks * DEPTH * 3 * 6144 + i];
        p->mod[i] = s;
    }
}
__device__ __forceinline__ void transpose_item(const float* W, int K, int N, bf16* WT, float* scr, int item, int lane) {
    const int nblk = N / 32, kb = item / nblk, nbk = item % nblk, k0 = 64 * kb, n0 = 32 * nbk;
#pragma unroll 8
    for (int i = 0; i < 32; ++i) { const int kk = 2 * i + (lane >> 5); scr[kk * 33 + (lane & 31)] = W[(size_t)(k0 + kk) * N + n0 + (lane & 31)]; }
    __builtin_amdgcn_wave_barrier();
    const int c = lane & 7;
#pragma unroll
    for (int j = 0; j < 4; ++j) { const int n = (lane >> 3) + 8 * j; const float* s = scr + (8 * c) * 33 + n;
        uint4 o; o.x = pk2(s[0 * 33], s[1 * 33]); o.y = pk2(s[2 * 33], s[3 * 33]); o.z = pk2(s[4 * 33], s[5 * 33]); o.w = pk2(s[6 * 33], s[7 * 33]);
        *(uint4*)(WT + (size_t)(n0 + n) * K + k0 + 8 * c) = o; }
    __builtin_amdgcn_wave_barrier();
}
__device__ __forceinline__ void phase_weights(KP p, int bid, int nb, float* lds) {
    const int lane = tid_opaque() & 63, w = tid_opaque() >> 6;
    float* scr = lds + 2048 + w * (64 * 33 + 16);
    constexpr int I_IN = 16 * 72, I_OUT = 16 * 32, I_Q = 16 * 64;
    constexpr int NITEMS = DEPTH * (I_IN + I_OUT + I_Q);
    for (int it = bid * NW + w; it < NITEMS; it += nb * NW) {
        int r = it;
        if (r < DEPTH * I_IN) { const int l = r / I_IN; transpose_item(p->w_in + (size_t)l * D * DIN, D, DIN, p->WtIn + (size_t)l * DIN * D, scr, r % I_IN, lane); continue; } r -= DEPTH * I_IN;
        if (r < DEPTH * I_OUT) { const int l = r / I_OUT; transpose_item(p->w_out + (size_t)l * D * D, D, D, p->WtOut + (size_t)l * D * D, scr, r % I_OUT, lane); continue; } r -= DEPTH * I_OUT;
        { const int l = r / I_Q; transpose_item(p->wq + (size_t)l * D * 2048, D, 2048, p->WtQ + (size_t)l * 2048 * D, scr, r % I_Q, lane); }
    }
    {
        const size_t n8 = (size_t)DEPTH * PEER_N * D / 8;
        for (size_t i = (size_t)bid * NT + tid_opaque(); i < 2 * n8; i += (size_t)nb * NT) {
            const bool isv = i >= n8; const size_t k = isv ? i - n8 : i;
            const float4* src = (const float4*)(isv ? p->pv : p->pu) + 2 * k;
            const float4 a = src[0], b = src[1];
            uint4 o; o.x = pk2(a.x, a.y); o.y = pk2(a.z, a.w); o.z = pk2(b.x, b.y); o.w = pk2(b.z, b.w);
            ((uint4*)(isv ? p->V16 : p->U16))[k] = o;
        }
    }
    for (int i = bid * NT + tid_opaque(); i < 192 * 16; i += nb * NT) {
        const int idx = i >> 4, f = i & 15;
        const float inv = powf(10000.0f, -(float)f / 16.0f);
        const float ang = (float)(idx < 128 ? idx : idx - 128) * inv;
        p->rope[2 * i] = cosf(ang); p->rope[2 * i + 1] = sinf(ang);
    }
}

__device__ __forceinline__ void row_load(const float* src, float (&v)[16], int lane) {
#pragma unroll
    for (int i = 0; i < 4; ++i) { const float4 q = *(const float4*)(src + i * 256 + lane * 4); v[i * 4 + 0] = q.x; v[i * 4 + 1] = q.y; v[i * 4 + 2] = q.z; v[i * 4 + 3] = q.w; }
}
__device__ __forceinline__ void row_store(float* dst, const float (&v)[16], int lane) {
#pragma unroll
    for (int i = 0; i < 4; ++i) *(float4*)(dst + i * 256 + lane * 4) = make_float4(v[i * 4 + 0], v[i * 4 + 1], v[i * 4 + 2], v[i * 4 + 3]);
}
__device__ __forceinline__ void row_store_bf(bf16* dst, const float (&v)[16], int lane) {
#pragma unroll
    for (int i = 0; i < 4; ++i) *(uint2*)(dst + i * 256 + lane * 4) = make_uint2(pk2(v[i * 4 + 0], v[i * 4 + 1]), pk2(v[i * 4 + 2], v[i * 4 + 3]));
}
__device__ __forceinline__ void row_load_bf(const bf16* src, float (&v)[16], int lane) {
#pragma unroll
    for (int i = 0; i < 4; ++i) { const uint2 q = *(const uint2*)(src + i * 256 + lane * 4); v[i * 4 + 0] = bflo(q.x); v[i * 4 + 1] = bfhi(q.x); v[i * 4 + 2] = bflo(q.y); v[i * 4 + 3] = bfhi(q.y); }
}
__device__ __forceinline__ void row_ln(float (&v)[16]) {
    float s = 0.f;
#pragma unroll
    for (int i = 0; i < 16; ++i) s += v[i];
    const float mu = wave_sum(s) * (1.0f / D);
    float q = 0.f;
#pragma unroll
    for (int i = 0; i < 16; ++i) { v[i] -= mu; q += v[i] * v[i]; }
    const float rstd = rsqrtf(wave_sum(q) * (1.0f / D) + LN_EPS);
#pragma unroll
    for (int i = 0; i < 16; ++i) v[i] *= rstd;
}
__device__ __forceinline__ const float* x_row(KP p, int l, int r) {
    if (l == 0) return r < TL ? p->x + (size_t)r * D : p->ctx + (size_t)(r - TL) * D;
    return p->X + (size_t)r * D;
}

__device__ __forceinline__ void phase_lnmod(KP p, int l, int bid, int nb) {
    const int lane = tid_opaque() & 63, w = tid_opaque() >> 6;
    for (int r = bid * NW + w; r < T; r += nb * NW) {
        float v[16], sh[16], sc[16];
        row_load(x_row(p, l, r), v, lane);
        const float* m = p->mod + ((size_t)l * 3 + mod_idx(r)) * 6144;
        row_load(m, sh, lane); row_load(m + 1024, sc, lane);
        row_ln(v);
#pragma unroll
        for (int i = 0; i < 16; ++i) v[i] = v[i] * (1.0f + sc[i]) + sh[i];
        row_store_bf(p->H + (size_t)r * D, v, lane);
    }
}

typedef short bf16x8_t __attribute__((ext_vector_type(8)));
typedef short bf16x4_t __attribute__((ext_vector_type(4)));
typedef float f32x4_t __attribute__((ext_vector_type(4)));
#define MFMA16(a, b, c) __builtin_amdgcn_mfma_f32_16x16x32_bf16((a), (b), (c), 0, 0, 0)
constexpr int KROW = 72;
constexpr int TROW = 136;
__device__ __forceinline__ bf16x8_t lds_frag16(const bf16* p) { return *(const bf16x8_t*)p; }
__device__ __forceinline__ bf16x8_t lds_frag8x2(const bf16* p0, const bf16* p1) {
    const bf16x4_t a = *(const bf16x4_t*)p0, b = *(const bf16x4_t*)p1;
    bf16x8_t o; o[0] = a[0]; o[1] = a[1]; o[2] = a[2]; o[3] = a[3]; o[4] = b[0]; o[5] = b[1]; o[6] = b[2]; o[7] = b[3]; return o;
}
__device__ __forceinline__ bf16x8_t pack_p(const f32x4_t& x, const f32x4_t& y) {
    uint4 w; w.x = pk2(x[0], x[1]); w.y = pk2(x[2], x[3]); w.z = pk2(y[0], y[1]); w.w = pk2(y[2], y[3]);
    return __builtin_bit_cast(bf16x8_t, w);
}
__device__ __forceinline__ void st_tr8(bf16* dst_col0, int stride, const uint4& v) {
    dst_col0[0 * stride] = (bf16)(v.x & 0xffffu); dst_col0[1 * stride] = (bf16)(v.x >> 16);
    dst_col0[2 * stride] = (bf16)(v.y & 0xffffu); dst_col0[3 * stride] = (bf16)(v.y >> 16);
    dst_col0[4 * stride] = (bf16)(v.z & 0xffffu); dst_col0[5 * stride] = (bf16)(v.z >> 16);
    dst_col0[6 * stride] = (bf16)(v.w & 0xffffu); dst_col0[7 * stride] = (bf16)(v.w >> 16);
}

constexpr int ATT_BUF = 128 * KROW + 64 * TROW;
__device__ __forceinline__ void att_unit(KP p, int l, int u, bf16* lds) {
    const int t = tid_opaque(), lane = t & 63, w = t >> 6, r = lane & 15, g = lane >> 4;
    const bool lat = u < 256;
    int b, n, hkv;
    if (lat) { hkv = u & 1; n = (u >> 1) & 63; b = u >> 7; } else { const int v = u - 256; hkv = v & 1; n = (v >> 1) & 1; b = v >> 2; }
    const int hq = hkv * 4 + (w >> 1), qh = w & 1;
    const int qrow0 = (lat ? b * SEQ + n * 128 : TL + b * LC + n * 128) + qh * 64;
    int kb_lo = 0, kb_hi = -1;
    if (lat) { kb_lo = n > 0 ? n - 1 : 0; kb_hi = n < 63 ? n + 1 : 63; }
    const int nloc = kb_hi - kb_lo + 1, nblk = nloc + 2;
    const bf16* P = p->P;
    bf16x8_t qf[4][2];
#pragma unroll
    for (int qt = 0; qt < 4; ++qt)
#pragma unroll
        for (int ks = 0; ks < 2; ++ks) qf[qt][ks] = *(const bf16x8_t*)(P + (size_t)(qrow0 + qt * 16 + r) * DIN + C_AQ + hq * 64 + ks * 32 + g * 8);
    const float LOG2E = 1.4426950408889634f;
    const float sink2 = p->sink[l * 8 + hq] * LOG2E;
    float m[4], lsum[4];
    f32x4_t ot[4][4];
#pragma unroll
    for (int qt = 0; qt < 4; ++qt) { m[qt] = sink2; lsum[qt] = g == 0 ? 1.0f : 0.0f; }
#pragma unroll
    for (int dt = 0; dt < 4; ++dt)
#pragma unroll
        for (int qt = 0; qt < 4; ++qt) ot[dt][qt] = (f32x4_t){0.f, 0.f, 0.f, 0.f};
    uint4 kreg0, kreg1, vreg0, vreg1;
#define ATT_ROW0(bi) ((bi) < nloc ? b * SEQ + (kb_lo + (bi)) * 128 : TL + b * LC + ((bi) - nloc) * 128)
    const int key0 = t >> 3, key1 = key0 + 64, c8 = t & 7;
#define ATT_ISSUE(bi) do { const bf16* src_ = P + (size_t)(ATT_ROW0(bi) + key0) * DIN + hkv * 64 + c8 * 8; \
        kreg0 = *(const uint4*)(src_ + C_AK); vreg0 = *(const uint4*)(src_ + C_AV); \
        kreg1 = *(const uint4*)(src_ + 64 * DIN + C_AK); vreg1 = *(const uint4*)(src_ + 64 * DIN + C_AV); } while (0)
#define ATT_STAGE(buf) do { \
        *(uint4*)((buf) + key0 * KROW + c8 * 8) = kreg0; *(uint4*)((buf) + key1 * KROW + c8 * 8) = kreg1; \
        st_tr8((buf) + 128 * KROW + (c8 * 8) * TROW + key0, TROW, vreg0); st_tr8((buf) + 128 * KROW + (c8 * 8) * TROW + key1, TROW, vreg1); } while (0)
    __syncthreads();
    ATT_ISSUE(0);
    for (int bi = 0; bi < nblk; ++bi) {
        bf16* buf = lds + (bi & 1) * ATT_BUF;
        ATT_STAGE(buf);
        __syncthreads();
        if (bi + 1 < nblk) ATT_ISSUE(bi + 1);
        const bf16* Ks = buf; const bf16* Vt = buf + 128 * KROW;
        const int band = (bi < nloc) ? (kb_lo + bi) - n : 0;
#pragma unroll 1
        for (int sub = 0; sub < 2; ++sub) {
            f32x4_t st[4][4];
#pragma unroll
            for (int kt = 0; kt < 4; ++kt) {
#pragma unroll
                for (int qt = 0; qt < 4; ++qt) st[kt][qt] = (f32x4_t){0.f, 0.f, 0.f, 0.f};
#pragma unroll
                for (int ks = 0; ks < 2; ++ks) {
                    const bf16x8_t a = lds_frag16(Ks + (sub * 64 + kt * 16 + r) * KROW + ks * 32 + g * 8);
#pragma unroll
                    for (int qt = 0; qt < 4; ++qt) st[kt][qt] = MFMA16(a, qf[qt][ks], st[kt][qt]);
                }
            }
#pragma unroll
            for (int qt = 0; qt < 4; ++qt) {
                const int il = qh * 64 + qt * 16 + r;
                float mloc = -INFINITY;
#pragma unroll
                for (int kt = 0; kt < 4; ++kt)
#pragma unroll
                    for (int i = 0; i < 4; ++i) {
                        const int jl = sub * 64 + kt * 16 + g * 4 + i;
                        float s = st[kt][qt][i] * LOG2E;
                        if (band < 0) { if (jl < il) s = -INFINITY; } else if (band > 0) { if (jl > il) s = -INFINITY; }
                        st[kt][qt][i] = s; mloc = fmaxf(mloc, s);
                    }
                mloc = fmaxf(mloc, __shfl_xor(mloc, 16)); mloc = fmaxf(mloc, __shfl_xor(mloc, 32));
                const float mnew = fmaxf(m[qt], mloc);
                const float alpha = __builtin_amdgcn_exp2f(m[qt] - mnew);
                m[qt] = mnew;
                float ps = 0.f;
#pragma unroll
                for (int kt = 0; kt < 4; ++kt)
#pragma unroll
                    for (int i = 0; i < 4; ++i) { const float e = __builtin_amdgcn_exp2f(st[kt][qt][i] - mnew); st[kt][qt][i] = e; ps += e; }
                lsum[qt] = lsum[qt] * alpha + ps;
#pragma unroll
                for (int dt = 0; dt < 4; ++dt) ot[dt][qt] = ot[dt][qt] * alpha;
            }
#pragma unroll
            for (int kp = 0; kp < 2; ++kp) {
                bf16x8_t pf[4];
#pragma unroll
                for (int qt = 0; qt < 4; ++qt) pf[qt] = pack_p(st[2 * kp][qt], st[2 * kp + 1][qt]);
#pragma unroll
                for (int dt = 0; dt < 4; ++dt) {
                    const bf16* vrow = Vt + (dt * 16 + r) * TROW + sub * 64 + g * 4;
                    const bf16x8_t a = lds_frag8x2(vrow + (2 * kp) * 16, vrow + (2 * kp + 1) * 16);
#pragma unroll
                    for (int qt = 0; qt < 4; ++qt) ot[dt][qt] = MFMA16(a, pf[qt], ot[dt][qt]);
                }
            }
        }
    }
#pragma unroll
    for (int qt = 0; qt < 4; ++qt) {
        float ls = lsum[qt]; ls += __shfl_xor(ls, 16); ls += __shfl_xor(ls, 32);
        const float inv = 1.0f / ls;
        bf16* orow = p->MIX + (size_t)(qrow0 + qt * 16 + r) * D + 512 + hq * 64 + g * 4;
#pragma unroll
        for (int dt = 0; dt < 4; ++dt) {
            const f32x4_t o = ot[dt][qt] * inv;
            *(uint2*)(orow + dt * 16) = make_uint2(pk2(o[0], o[1]), pk2(o[2], o[3]));
        }
    }
}

__device__ __forceinline__ size_t kv_off(int dir, int b, int pos, int h) { return ((((size_t)dir * NB + b) * NPOS + pos) * 4 + h) * 4096; }
__device__ __forceinline__ void ret_kv_unit(KP p, int l, int u, bf16* lds) {
    const int h = u & 3, pos = (u >> 2) % NPOS, b = u / (4 * NPOS);
    const int t = tid_opaque(), lane = t & 63, w = t >> 6, r = lane & 15, g = lane >> 4;
    bf16* Ktf = lds; bf16* Ktb = lds + 64 * TROW; bf16* Vt = lds + 2 * 64 * TROW;
    const float lgf = log_sigmoid_f(p->rdf[l * 4 + h]), lgb = log_sigmoid_f(p->rdb[l * 4 + h]);
    const int r0 = chunk_row0(b, pos);
    const bf16* P = p->P;
    __syncthreads();
#pragma unroll
    for (int q = 0; q < 2; ++q) {
        const int pc = t + q * NT, j = pc >> 3, c8 = pc & 7;
        const bf16* src = P + (size_t)(r0 + j) * DIN + h * 64 + c8 * 8;
        const uint4 kv = *(const uint4*)(src + C_RK), vv = *(const uint4*)(src + C_RV);
        const float wf = expf(lgf * (float)(127 - j)), wb = expf(lgb * (float)j);
        uint4 kf, kb;
        kf.x = pk2(bflo(kv.x) * wf, bfhi(kv.x) * wf); kf.y = pk2(bflo(kv.y) * wf, bfhi(kv.y) * wf); kf.z = pk2(bflo(kv.z) * wf, bfhi(kv.z) * wf); kf.w = pk2(bflo(kv.w) * wf, bfhi(kv.w) * wf);
        kb.x = pk2(bflo(kv.x) * wb, bfhi(kv.x) * wb); kb.y = pk2(bflo(kv.y) * wb, bfhi(kv.y) * wb); kb.z = pk2(bflo(kv.z) * wb, bfhi(kv.z) * wb); kb.w = pk2(bflo(kv.w) * wb, bfhi(kv.w) * wb);
        st_tr8(Ktf + (c8 * 8) * TROW + j, TROW, kf);
        st_tr8(Ktb + (c8 * 8) * TROW + j, TROW, kb);
        st_tr8(Vt + (c8 * 8) * TROW + j, TROW, vv);
    }
    __syncthreads();
    const int dir = w >> 2, dvt = w & 3;
    const bf16* Kt = dir ? Ktb : Ktf;
    f32x4_t acc[4];
#pragma unroll
    for (int dkt = 0; dkt < 4; ++dkt) acc[dkt] = (f32x4_t){0.f, 0.f, 0.f, 0.f};
#pragma unroll
    for (int ks = 0; ks < 4; ++ks) {
        const bf16x8_t a = lds_frag16(Vt + (dvt * 16 + r) * TROW + ks * 32 + g * 8);
#pragma unroll
        for (int dkt = 0; dkt < 4; ++dkt) acc[dkt] = MFMA16(a, lds_frag16(Kt + (dkt * 16 + r) * TROW + ks * 32 + g * 8), acc[dkt]);
    }
    float* o = p->KV + kv_off(dir, b, pos, h);
#pragma unroll
    for (int dkt = 0; dkt < 4; ++dkt)
#pragma unroll
        for (int i = 0; i < 4; ++i) o[(dvt * 16 + g * 4 + i) * 64 + dkt * 16 + r] = acc[dkt][i];
}

__device__ __forceinline__ void phase_ret_scan(KP p, int l, int bid, int nb) {
    for (int i = bid * NT + tid_opaque(); i < 2 * NB * 4 * 4096; i += nb * NT) {
        const int e = i & 4095, h = (i >> 12) & 3, b = (i >> 14) & 1, dir = i >> 15;
        const float lg = log_sigmoid_f(dir ? p->rdb[l * 4 + h] : p->rdf[l * 4 + h]);
        const float cdec = expf(128.0f * lg);
        const float* kv = p->KV; bf16* st = p->ST16;
        float v[NPOS];
#pragma unroll
        for (int step = 0; step < NPOS; ++step) {
            const int pos = dir == 0 ? step : (step == 0 ? 1 : (step == 1 ? 0 : 67 - step));
            v[step] = kv[kv_off(dir, b, pos, h) + e];
        }
        float s = 0.f;
#pragma unroll
        for (int step = 0; step < NPOS; ++step) {
            const int pos = dir == 0 ? step : (step == 0 ? 1 : (step == 1 ? 0 : 67 - step));
            st[kv_off(dir, b, pos, h) + e] = (bf16)f2bf(s);
            s = s * cdec + v[step];
        }
    }
}

constexpr int RO_HEAD = 128 * KROW + 64 * TROW + 2 * 64 * KROW;
constexpr int RO_TAB = 2 * RO_HEAD;
__device__ __forceinline__ void ret_out_unit(KP p, int l, int u, bf16* lds) {
    const int hp = u & 1, pos = (u >> 1) % NPOS, b = u / (2 * NPOS);
    const int t = tid_opaque(), lane = t & 63, w = t >> 6, r = lane & 15, g = lane >> 4;
    const int r0 = chunk_row0(b, pos);
    const bf16* P = p->P;
    float* tabs = (float*)(lds + RO_TAB);
    __syncthreads();
#pragma unroll
    for (int q = 0; q < 4; ++q) {
        const int pc = t + q * NT, hh = pc >> 10, j = (pc >> 3) & 127, c8 = pc & 7, h = hp * 2 + hh;
        bf16* base = lds + hh * RO_HEAD;
        const bf16* src = P + (size_t)(r0 + j) * DIN + h * 64 + c8 * 8;
        *(uint4*)(base + j * KROW + c8 * 8) = *(const uint4*)(src + C_RK);
        const uint4 vv = *(const uint4*)(src + C_RV);
        st_tr8(base + 128 * KROW + (c8 * 8) * TROW + j, TROW, vv);
    }
#pragma unroll
    for (int q = 0; q < 4; ++q) {
        const int pc = t + q * NT, hh = pc >> 10, dir = (pc >> 9) & 1, dv = (pc >> 3) & 63, c8 = pc & 7, h = hp * 2 + hh;
        const uint4 sv = *(const uint4*)(p->ST16 + kv_off(dir, b, pos, h) + dv * 64 + c8 * 8);
        *(uint4*)(lds + hh * RO_HEAD + 128 * KROW + 64 * TROW + dir * 64 * KROW + dv * KROW + c8 * 8) = sv;
    }
    if (t < 4 * 132) {
        const int hh = t / 264, dir = (t / 132) & 1, k = t % 132, h = hp * 2 + hh;
        const float lg = log_sigmoid_f(dir ? p->rdb[l * 4 + h] : p->rdf[l * 4 + h]);
        tabs[(hh * 2 + dir) * 132 + k] = expf(lg * (float)k);
    }
    __syncthreads();
    const int hh = w >> 2, h = hp * 2 + hh, qw = w & 3;
    const bf16* Ks = lds + hh * RO_HEAD; const bf16* Vt = Ks + 128 * KROW; const bf16* Sft = Vt + 64 * TROW; const bf16* Sbt = Sft + 64 * KROW;
    const float* pf = tabs + (hh * 2) * 132; const float* pb = pf + 132;
    bf16x8_t qf[2][2];
#pragma unroll
    for (int qt = 0; qt < 2; ++qt)
#pragma unroll
        for (int ks = 0; ks < 2; ++ks) qf[qt][ks] = *(const bf16x8_t*)(P + (size_t)(r0 + qw * 32 + qt * 16 + r) * DIN + C_RQ + h * 64 + ks * 32 + g * 8);
    f32x4_t accI[4][2], accF[4][2], accB[4][2];
#pragma unroll
    for (int dt = 0; dt < 4; ++dt)
#pragma unroll
        for (int qt = 0; qt < 2; ++qt) { accI[dt][qt] = (f32x4_t){0.f, 0.f, 0.f, 0.f}; accF[dt][qt] = accI[dt][qt]; accB[dt][qt] = accI[dt][qt]; }
#pragma unroll
    for (int dt = 0; dt < 4; ++dt)
#pragma unroll
        for (int ks = 0; ks < 2; ++ks) {
            const bf16x8_t af = lds_frag16(Sft + (dt * 16 + r) * KROW + ks * 32 + g * 8), ab = lds_frag16(Sbt + (dt * 16 + r) * KROW + ks * 32 + g * 8);
#pragma unroll
            for (int qt = 0; qt < 2; ++qt) { accF[dt][qt] = MFMA16(af, qf[qt][ks], accF[dt][qt]); accB[dt][qt] = MFMA16(ab, qf[qt][ks], accB[dt][qt]); }
        }
#pragma unroll 1
    for (int sub = 0; sub < 2; ++sub) {
        f32x4_t st[4][2];
#pragma unroll
        for (int kt = 0; kt < 4; ++kt) {
#pragma unroll
            for (int qt = 0; qt < 2; ++qt) st[kt][qt] = (f32x4_t){0.f, 0.f, 0.f, 0.f};
#pragma unroll
            for (int ks = 0; ks < 2; ++ks) {
                const bf16x8_t a = lds_frag16(Ks + (sub * 64 + kt * 16 + r) * KROW + ks * 32 + g * 8);
#pragma unroll
                for (int qt = 0; qt < 2; ++qt) st[kt][qt] = MFMA16(a, qf[qt][ks], st[kt][qt]);
            }
        }
#pragma unroll
        for (int qt = 0; qt < 2; ++qt) {
            const int il = qw * 32 + qt * 16 + r;
#pragma unroll
            for (int kt = 0; kt < 4; ++kt)
#pragma unroll
                for (int i = 0; i < 4; ++i) {
                    const int rel = il - (sub * 64 + kt * 16 + g * 4 + i);
                    const float wgt = rel > 0 ? pf[rel] : (rel < 0 ? pb[-rel] : 2.0f);
                    st[kt][qt][i] *= wgt;
                }
        }
#pragma unroll
        for (int kp = 0; kp < 2; ++kp) {
            bf16x8_t pfr[2];
#pragma unroll
            for (int qt = 0; qt < 2; ++qt) pfr[qt] = pack_p(st[2 * kp][qt], st[2 * kp + 1][qt]);
#pragma unroll
            for (int dt = 0; dt < 4; ++dt) {
                const bf16* vrow = Vt + (dt * 16 + r) * TROW + sub * 64 + g * 4;
                const bf16x8_t a = lds_frag8x2(vrow + (2 * kp) * 16, vrow + (2 * kp + 1) * 16);
#pragma unroll
                for (int qt = 0; qt < 2; ++qt) accI[dt][qt] = MFMA16(a, pfr[qt], accI[dt][qt]);
            }
        }
    }
#pragma unroll
    for (int qt = 0; qt < 2; ++qt) {
        const int il = qw * 32 + qt * 16 + r;
        const float qfd = pf[il + 1], qbd = pb[128 - il];
        float s = 0.f;
#pragma unroll
        for (int dt = 0; dt < 4; ++dt) { accI[dt][qt] = accI[dt][qt] + accF[dt][qt] * qfd + accB[dt][qt] * qbd; s += (accI[dt][qt][0] + accI[dt][qt][1]) + (accI[dt][qt][2] + accI[dt][qt][3]); }
        s += __shfl_xor(s, 16); s += __shfl_xor(s, 32);
        const float mu = s * (1.0f / 64.0f);
        float qq = 0.f;
#pragma unroll
        for (int dt = 0; dt < 4; ++dt) { accI[dt][qt] = accI[dt][qt] - mu; qq += (accI[dt][qt][0] * accI[dt][qt][0] + accI[dt][qt][1] * accI[dt][qt][1]) + (accI[dt][qt][2] * accI[dt][qt][2] + accI[dt][qt][3] * accI[dt][qt][3]); }
        qq += __shfl_xor(qq, 16); qq += __shfl_xor(qq, 32);
        const float rstd = rsqrtf(qq * (1.0f / 64.0f) + LN_EPS);
        const size_t row = (size_t)(r0 + il);
#pragma unroll
        for (int dt = 0; dt < 4; ++dt) {
            const uint2 gw = *(const uint2*)(P + row * DIN + C_RG + h * 64 + dt * 16 + g * 4);
            const f32x4_t o = accI[dt][qt] * rstd;
            const float o0 = o[0] * silu_f(bflo(gw.x)), o1 = o[1] * silu_f(bfhi(gw.x)), o2 = o[2] * silu_f(bflo(gw.y)), o3 = o[3] * silu_f(bfhi(gw.y));
            *(uint2*)(p->MIX + row * D + h * 64 + dt * 16 + g * 4) = make_uint2(pk2(o0, o1), pk2(o2, o3));
        }
    }
}

__device__ __forceinline__ void sgu_unit(KP p, int l, int u, bf16* lds) {
    const int grp = u & 3, pos = (u >> 2) % NPOS, b = u / (4 * NPOS);
    const int t = tid_opaque(), lane = t & 63, w = t >> 6, r = lane & 15, g = lane >> 4;
    const int r0 = chunk_row0(b, pos);
    const bf16* P = p->P;
    bf16* vnT = lds;
    __syncthreads();
    {
        const int j = t >> 2, qd = t & 3;
        const uint4* src = (const uint4*)(P + (size_t)(r0 + j) * DIN + C_SV + grp * 64 + qd * 16);
        const uint4 a = src[0], c = src[1];
        float v[16] = {bflo(a.x), bfhi(a.x), bflo(a.y), bfhi(a.y), bflo(a.z), bfhi(a.z), bflo(a.w), bfhi(a.w), bflo(c.x), bfhi(c.x), bflo(c.y), bfhi(c.y), bflo(c.z), bfhi(c.z), bflo(c.w), bfhi(c.w)};
        float s = 0.f;
#pragma unroll
        for (int d = 0; d < 16; ++d) { v[d] = gelu_tanh(v[d]); s += v[d]; }
        s += __shfl_xor(s, 1); s += __shfl_xor(s, 2);
        const float mu = s * (1.0f / 64.0f);
        float qq = 0.f;
#pragma unroll
        for (int d = 0; d < 16; ++d) { v[d] -= mu; qq += v[d] * v[d]; }
        qq += __shfl_xor(qq, 1); qq += __shfl_xor(qq, 2);
        const float rstd = rsqrtf(qq * (1.0f / 64.0f) + LN_EPS);
#pragma unroll
        for (int d = 0; d < 16; ++d) vnT[(qd * 16 + d) * TROW + j] = (bf16)f2bf(v[d] * rstd);
    }
    bf16x8_t wf[4];
    {
        const float* wrow = p->sgu_w + (((size_t)l * 4 + grp) * 128 + w * 16 + r) * 128 + g * 8;
#pragma unroll
        for (int ks = 0; ks < 4; ++ks) {
            const float4 a = *(const float4*)(wrow + ks * 32), c = *(const float4*)(wrow + ks * 32 + 4);
            uint4 o; o.x = pk2(a.x, a.y); o.y = pk2(a.z, a.w); o.z = pk2(c.x, c.y); o.w = pk2(c.z, c.w);
            wf[ks] = __builtin_bit_cast(bf16x8_t, o);
        }
    }
    __syncthreads();
    const int i = w * 16 + r;
    const float bs = p->sgu_b[((size_t)l * 4 + grp) * 128 + i];
#pragma unroll
    for (int dt = 0; dt < 4; ++dt) {
        f32x4_t acc = {0.f, 0.f, 0.f, 0.f};
#pragma unroll
        for (int ks = 0; ks < 4; ++ks) acc = MFMA16(lds_frag16(vnT + (dt * 16 + r) * TROW + ks * 32 + g * 8), wf[ks], acc);
        const uint2 uw = *(const uint2*)(P + (size_t)(r0 + i) * DIN + C_SU + grp * 64 + dt * 16 + g * 4);
        const float o0 = gelu_tanh(bflo(uw.x)) * (acc[0] + bs), o1 = gelu_tanh(bfhi(uw.x)) * (acc[1] + bs), o2 = gelu_tanh(bflo(uw.y)) * (acc[2] + bs), o3 = gelu_tanh(bfhi(uw.y)) * (acc[3] + bs);
        *(uint2*)(p->MIX + (size_t)(r0 + i) * D + 256 + grp * 64 + dt * 16 + g * 4) = make_uint2(pk2(o0, o1), pk2(o2, o3));
    }
}

__device__ __forceinline__ void phase_mix_a(KP p, int l, int bid, int nb, float* ldsf) {
    bf16* lds = (bf16*)ldsf;
    const int n_att = 264, n_kv = NB * NPOS * 4, n_sgu = NB * NPOS * 4;
    for (int u = bid; u < n_att + n_kv + n_sgu; u += nb) {
        if (u < n_att) att_unit(p, l, u, lds);
        else if (u < n_att + n_kv) ret_kv_unit(p, l, u - n_att, lds);
        else sgu_unit(p, l, u - n_att - n_kv, lds);
    }
    __syncthreads();
}
__device__ __forceinline__ void phase_ret_out(KP p, int l, int bid, int nb, float* ldsf) {
    bf16* lds = (bf16*)ldsf;
    for (int u = bid; u < NB * NPOS * 2; u += nb) ret_out_unit(p, l, u, lds);
    __syncthreads();
}

__device__ __forceinline__ void phase_ln1(KP p, int l, int bid, int nb) {
    const int lane = tid_opaque() & 63, w = tid_opaque() >> 6;
    for (int r = bid * NW + w; r < T; r += nb * NW) {
        float v[16], a[16], c[16];
        row_load(x_row(p, l, r), v, lane);
        row_load(p->Y + (size_t)r * D, a, lane);
        const float* m = p->mod + ((size_t)l * 3 + mod_idx(r)) * 6144;
        row_load(m + 2048, c, lane);
#pragma unroll
        for (int i = 0; i < 16; ++i) v[i] = ALPHA * v[i] + c[i] * a[i];
        row_ln(v);
        row_load(p->lnm_g + l * D, a, lane); row_load(p->lnm_b + l * D, c, lane);
#pragma unroll
        for (int i = 0; i < 16; ++i) v[i] = v[i] * a[i] + c[i];
        row_store(p->X1 + (size_t)r * D, v, lane);
        row_ln(v);
        row_load(m + 3072, a, lane); row_load(m + 4096, c, lane);
#pragma unroll
        for (int i = 0; i < 16; ++i) v[i] = v[i] * (1.0f + c[i]) + a[i];
        row_store_bf(p->H + (size_t)r * D, v, lane);
    }
}

template <int NV, class IdFn>
__device__ __forceinline__ void select_top16(const float (&v)[NV], IdFn idf, float* lv, int* li, int lane) {
    float mx = v[0], mn = v[0];
#pragma unroll
    for (int e = 1; e < NV; ++e) { mx = fmaxf(mx, v[e]); mn = fminf(mn, v[e]); }
    mx = fmaxf(mx, __shfl_xor(mx, 16)); mx = fmaxf(mx, __shfl_xor(mx, 32));
    mn = fminf(mn, __shfl_xor(mn, 16)); mn = fminf(mn, __shfl_xor(mn, 32));
    float lo = mn - 1.0f, hi = mx, tau = lo;
    bool done = false;
    for (int iter = 0; iter < 48; ++iter) {
        const float mid = 0.5f * (lo + hi);
        int cnt = 0;
#pragma unroll
        for (int e = 0; e < NV; ++e) cnt += (v[e] > mid) ? 1 : 0;
        cnt += __shfl_xor(cnt, 16); cnt += __shfl_xor(cnt, 32);
        if (!done) {
            if (cnt == 16) { tau = mid; done = true; }
            else if (cnt > 16) { lo = mid; tau = mid; } else hi = mid;
            if (!(mid > lo || mid < hi)) done = true;
        }
        if (__all(done)) break;
    }
    int c = 0;
#pragma unroll
    for (int e = 0; e < NV; ++e) c += (v[e] > tau) ? 1 : 0;
    const int base = lane & 15, g = lane >> 4;
    const int c0 = __shfl(c, base), c1 = __shfl(c, base + 16), c2 = __shfl(c, base + 32);
    int pos = (g > 0 ? c0 : 0) + (g > 1 ? c1 : 0) + (g > 2 ? c2 : 0);
#pragma unroll
    for (int e = 0; e < NV; ++e) {
        if (v[e] > tau && pos < 16) { lv[base * 16 + pos] = v[e]; li[base * 16 + pos] = idf(e); ++pos; }
    }
}
constexpr int KS_STRIDE = 136;
__device__ __forceinline__ void phase_topk(KP p, int l, int bid, int nb, float* lds) {
    bf16* k1s = (bf16*)lds;
    bf16* k2s = k1s + 128 * KS_STRIDE;
    const int t = tid_opaque(), lane = t & 63, w = t >> 6;
    float* lists = lds + (2 * 128 * KS_STRIDE * 2) / 4 + w * 1536;
    float* v1 = lists; int* i1 = (int*)(lists + 256); float* v2 = lists + 512; int* i2 = (int*)(lists + 768); float* v3 = lists + 1024; int* c3 = (int*)(lists + 1280);
    __syncthreads();
    for (int e = t; e < 2 * 128 * 16; e += NT) {
        const int tab = e >> 11, r = (e >> 4) & 127, c8 = e & 15;
        const float* src = (tab ? p->k2 : p->k1) + (size_t)l * 128 * 128 + r * 128 + c8 * 8;
        const float4 a = *(const float4*)src, b = *(const float4*)(src + 4);
        uint4 o; o.x = pk2(a.x, a.y); o.y = pk2(a.z, a.w); o.z = pk2(b.x, b.y); o.w = pk2(b.z, b.w);
        *(uint4*)((tab ? k2s : k1s) + r * KS_STRIDE + c8 * 8) = o;
    }
    __syncthreads();
    const int fr = lane & 15, fq = lane >> 4;
    for (int task = bid * NW + w; task < T * 8 / 16; task += nb * NW) {
        const int it0 = task * 16;
        const bf16* qrow = p->Qb + (size_t)(it0 + fr) * 256 + fq * 8;
        bf16x8_t bq[8];
#pragma unroll
        for (int ks = 0; ks < 8; ++ks) bq[ks] = *(const bf16x8_t*)(qrow + ks * 32);
        float s[32];
#pragma unroll
        for (int kt = 0; kt < 8; ++kt) {
            f32x4_t acc = {0.f, 0.f, 0.f, 0.f};
#pragma unroll
            for (int ks = 0; ks < 4; ++ks) {
                const bf16x8_t a = *(const bf16x8_t*)(k1s + (kt * 16 + fr) * KS_STRIDE + ks * 32 + fq * 8);
                acc = __builtin_amdgcn_mfma_f32_16x16x32_bf16(a, bq[ks], acc, 0, 0, 0);
            }
            s[kt * 4 + 0] = acc[0]; s[kt * 4 + 1] = acc[1]; s[kt * 4 + 2] = acc[2]; s[kt * 4 + 3] = acc[3];
        }
        select_top16<32>(s, [fq](int e) { return (e >> 2) * 16 + fq * 4 + (e & 3); }, v1, i1, lane);
#pragma unroll
        for (int kt = 0; kt < 8; ++kt) {
            f32x4_t acc = {0.f, 0.f, 0.f, 0.f};
#pragma unroll
            for (int ks = 0; ks < 4; ++ks) {
                const bf16x8_t a = *(const bf16x8_t*)(k2s + (kt * 16 + fr) * KS_STRIDE + ks * 32 + fq * 8);
                acc = __builtin_amdgcn_mfma_f32_16x16x32_bf16(a, bq[4 + ks], acc, 0, 0, 0);
            }
            s[kt * 4 + 0] = acc[0]; s[kt * 4 + 1] = acc[1]; s[kt * 4 + 2] = acc[2]; s[kt * 4 + 3] = acc[3];
        }
        select_top16<32>(s, [fq](int e) { return (e >> 2) * 16 + fq * 4 + (e & 3); }, v2, i2, lane);
        __builtin_amdgcn_wave_barrier();
        float cv[64];
#pragma unroll
        for (int a = 0; a < 4; ++a) {
            const float va = v1[fr * 16 + fq * 4 + a];
#pragma unroll
            for (int b = 0; b < 16; ++b) cv[a * 16 + b] = va + v2[fr * 16 + b];
        }
        select_top16<64>(cv, [fq](int e) { return (fq * 4 + (e >> 4)) * 16 + (e & 15); }, v3, c3, lane);
        __builtin_amdgcn_wave_barrier();
        float tv[4]; int tc[4];
#pragma unroll
        for (int k = 0; k < 4; ++k) { tv[k] = v3[fr * 16 + fq * 4 + k]; tc[k] = c3[fr * 16 + fq * 4 + k]; }
        float mx = fmaxf(fmaxf(tv[0], tv[1]), fmaxf(tv[2], tv[3]));
        mx = fmaxf(mx, __shfl_xor(mx, 16)); mx = fmaxf(mx, __shfl_xor(mx, 32));
        float ex[4], den = 0.f;
#pragma unroll
        for (int k = 0; k < 4; ++k) { ex[k] = expf(tv[k] - mx); den += ex[k]; }
        den += __shfl_xor(den, 16); den += __shfl_xor(den, 32);
        const float inv = 1.0f / den;
        int4 eo; float4 go;
        eo.x = i1[fr * 16 + (tc[0] >> 4)] * 128 + i2[fr * 16 + (tc[0] & 15)];
        eo.y = i1[fr * 16 + (tc[1] >> 4)] * 128 + i2[fr * 16 + (tc[1] & 15)];
        eo.z = i1[fr * 16 + (tc[2] >> 4)] * 128 + i2[fr * 16 + (tc[2] & 15)];
        eo.w = i1[fr * 16 + (tc[3] >> 4)] * 128 + i2[fr * 16 + (tc[3] & 15)];
        go = make_float4(ex[0] * inv, ex[1] * inv, ex[2] * inv, ex[3] * inv);
        *(int4*)(p->EIDX + (size_t)(it0 + fr) * 16 + fq * 4) = eo;
        *(float4*)(p->GATE + (size_t)(it0 + fr) * 16 + fq * 4) = go;
        __builtin_amdgcn_wave_barrier();
    }
    __syncthreads();
}

typedef unsigned u32x4_t __attribute__((ext_vector_type(4)));
using bf16x2_t = __attribute__((ext_vector_type(2))) __bf16;
__device__ __forceinline__ float dot2bf(unsigned a, unsigned b, float acc) { return __builtin_amdgcn_fdot2_f32_bf16(__builtin_bit_cast(bf16x2_t, a), __builtin_bit_cast(bf16x2_t, b), acc, false); }
struct RowBf { u32x4_t a, b; };
__device__ __forceinline__ RowBf ld_row(const bf16* tab, int e, int lane) {
    const u32x4_t* r = (const u32x4_t*)(tab + (size_t)e * D) + lane;
    RowBf x; x.a = r[0]; x.b = r[64]; return x;
}
__device__ __forceinline__ float row_dot(const RowBf& x, const RowBf& u) {
    float d = 0.f;
#pragma unroll
    for (int k = 0; k < 4; ++k) { d = dot2bf(x.a[k], u.a[k], d); d = dot2bf(x.b[k], u.b[k], d); }
    return d;
}
__device__ __forceinline__ void row_axpy(float (&acc)[16], float a, const RowBf& v) {
#pragma unroll
    for (int k = 0; k < 4; ++k) {
        acc[2 * k] += a * bflo(v.a[k]); acc[2 * k + 1] += a * bfhi(v.a[k]);
        acc[8 + 2 * k] += a * bflo(v.b[k]); acc[8 + 2 * k + 1] += a * bfhi(v.b[k]);
    }
}
__device__ __forceinline__ float transpose_reduce8(float (&part)[8], int lane) {
#pragma unroll
    for (int st = 32, n = 4; n >= 1; st >>= 1, n >>= 1) {
        const bool up = (lane & st) != 0;
#pragma unroll
        for (int s = 0; s < n; ++s) {
            const float lo = part[s], hi = part[s + n];
            const float recv = __shfl_xor(up ? lo : hi, st);
            part[s] = (up ? hi : lo) + recv;
        }
    }
    float v = part[0];
    v += __shfl_xor(v, 4); v += __shfl_xor(v, 2); v += __shfl_xor(v, 1);
    return v;
}
__device__ __forceinline__ void phase_expert_u(KP p, int l, int bid, int nb, float* lds) {
    const int lane = tid_opaque() & 63, w = __builtin_amdgcn_readfirstlane(tid_opaque() >> 6);
    const int G8 = nb >> 3;
    if (bid >= G8 * 8) return;
    const int rng = bid & 7;
    const bf16* U = p->U16 + (size_t)l * PEER_N * D;
    int* le = (int*)lds + w * 384; int* ls = le + 128; float* lg = (float*)(le + 256);
    const unsigned long long ltmask = (1ull << lane) - 1ull;
    for (int t = (bid >> 3) * NW + w; t < T; t += G8 * NW) {
        const RowBf x = ld_row(p->H, t, lane);
        const int e0 = p->EIDX[(size_t)t * NSEL + lane], e1 = p->EIDX[(size_t)t * NSEL + 64 + lane];
        const float g0 = p->GATE[(size_t)t * NSEL + lane], g1 = p->GATE[(size_t)t * NSEL + 64 + lane];
        const bool in0 = (e0 >> 11) == rng, in1 = (e1 >> 11) == rng;
        const unsigned long long m0 = __ballot(in0), m1 = __ballot(in1);
        const int c0 = __popcll(m0), n = c0 + __popcll(m1);
        if (in0) { const int pos = __popcll(m0 & ltmask); le[pos] = e0; ls[pos] = lane; lg[pos] = g0; }
        if (in1) { const int pos = c0 + __popcll(m1 & ltmask); le[pos] = e1; ls[pos] = lane + 64; lg[pos] = g1; }
        __builtin_amdgcn_wave_barrier();
        for (int base = 0; base < n; base += 8) {
            RowBf rows[8];
#pragma unroll
            for (int k = 0; k < 8; ++k) {
                const int idx = base + k < n ? base + k : base;
                const int e = __builtin_amdgcn_readfirstlane(le[idx]);
                rows[k] = ld_row(U, e, lane);
            }
            float part[8];
#pragma unroll
            for (int k = 0; k < 8; ++k) part[k] = row_dot(x, rows[k]);
            const float val = transpose_reduce8(part, lane);
            const int ent = base + (lane >> 3);
            if ((lane & 7) == 0 && ent < n) p->ACT[(size_t)t * NSEL + ls[ent]] = gelu_tanh(val) * lg[ent];
        }
        __builtin_amdgcn_wave_barrier();
    }
}
__device__ __forceinline__ void phase_expert_v(KP p, int l, int bid, int nb) {
    const int lane = tid_opaque() & 63, w = __builtin_amdgcn_readfirstlane(tid_opaque() >> 6);
    const int G8 = nb >> 3;
    if (bid >= G8 * 8) return;
    const int sl = bid & 7, q = lane >> 4, c = lane & 15;
    const bf16* V = p->V16 + (size_t)l * PEER_N * D + sl * 128 + c * 8;
    for (int t = (bid >> 3) * NW + w; t < T; t += G8 * NW) {
        const int e0 = p->EIDX[(size_t)t * NSEL + lane], e1 = p->EIDX[(size_t)t * NSEL + 64 + lane];
        const float a0 = p->ACT[(size_t)t * NSEL + lane], a1 = p->ACT[(size_t)t * NSEL + 64 + lane];
        float acc[8];
#pragma unroll
        for (int k = 0; k < 8; ++k) acc[k] = 0.f;
#pragma unroll
        for (int ib = 0; ib < 32; ib += 8) {
            u32x4_t rv[8]; float av[8];
#pragma unroll
            for (int k = 0; k < 8; ++k) {
                const int i = ib + k;
                const int e = i < 16 ? __shfl(e0, 4 * i + q) : __shfl(e1, 4 * (i - 16) + q);
                av[k] = i < 16 ? __shfl(a0, 4 * i + q) : __shfl(a1, 4 * (i - 16) + q);
                rv[k] = *(const u32x4_t*)(V + (size_t)e * D);
            }
#pragma unroll
            for (int k = 0; k < 8; ++k) {
                acc[0] += av[k] * bflo(rv[k][0]); acc[1] += av[k] * bfhi(rv[k][0]); acc[2] += av[k] * bflo(rv[k][1]); acc[3] += av[k] * bfhi(rv[k][1]);
                acc[4] += av[k] * bflo(rv[k][2]); acc[5] += av[k] * bfhi(rv[k][2]); acc[6] += av[k] * bflo(rv[k][3]); acc[7] += av[k] * bfhi(rv[k][3]);
            }
        }
#pragma unroll
        for (int k = 0; k < 8; ++k) { acc[k] += __shfl_xor(acc[k], 16); acc[k] += __shfl_xor(acc[k], 32); }
        if (q == 0) {
            float* yr = p->Y + (size_t)t * D + sl * 128 + c * 8;
            *(float4*)yr = make_float4(acc[0], acc[1], acc[2], acc[3]);
            *(float4*)(yr + 4) = make_float4(acc[4], acc[5], acc[6], acc[7]);
        }
    }
}

__device__ __forceinline__ void phase_ln2(KP p, int l, int bid, int nb) {
    const int lane = tid_opaque() & 63, w = tid_opaque() >> 6;
    for (int r = bid * NW + w; r < T; r += nb * NW) {
        float v[16], a[16], c[16];
        row_load(p->X1 + (size_t)r * D, v, lane);
        row_load(p->Y + (size_t)r * D, a, lane);
        const float* m = p->mod + ((size_t)l * 3 + mod_idx(r)) * 6144;
        row_load(m + 5120, c, lane);
#pragma unroll
        for (int i = 0; i < 16; ++i) v[i] = ALPHA * v[i] + c[i] * a[i];
        row_ln(v);
        row_load(p->lnf_g + l * D, a, lane); row_load(p->lnf_b + l * D, c, lane);
#pragma unroll
        for (int i = 0; i < 16; ++i) v[i] = v[i] * a[i] + c[i];
        if (l == DEPTH - 1) { if (r < TL) row_store(p->out + (size_t)r * D, v, lane); continue; }
        row_store(p->X + (size_t)r * D, v, lane);
        const float* m2 = p->mod + ((size_t)(l + 1) * 3 + mod_idx(r)) * 6144;
        row_ln(v);
        row_load(m2, a, lane); row_load(m2 + 1024, c, lane);
#pragma unroll
        for (int i = 0; i < 16; ++i) v[i] = v[i] * (1.0f + c[i]) + a[i];
        row_store_bf(p->H + (size_t)r * D, v, lane);
    }
}

constexpr int REP_MIXA = 1, REP_TOPK = 1, REP_EXP = 1, REP_RETOUT = 1;
__global__ void __launch_bounds__(NT, 2) mega(Params p_unused) {
    extern __shared__ __attribute__((aligned(16))) unsigned char lds_raw[];
    cg::grid_group grid = cg::this_grid();
    const int bid = blockIdx.x, nb = gridDim.x;
    float* lds = (float*)lds_raw;
    LAS unsigned char* ldsl = (LAS unsigned char*)lds_raw;
    volatile LAS unsigned* MISC = (volatile LAS unsigned*)(ldsl + MISC_OFF);
    for (int u = threadIdx.x; u < (LDS_BYTES - 131072) / 4; u += NT) ((LAS unsigned*)(ldsl + 131072))[u] = 0u;
    __syncthreads();
    (void)xcd_barrier_post(kparams()->ctl + CW_BAR, MISC + 8);
#define GRID_BAR() do { XcdBarrier b_; b_.bar = kparams()->ctl + CW_BAR; b_.x = xb_xcc_id(); b_.st = MISC + 8; xcd_barrier(b_); } while (0)

    phase_mod1(kparams(), bid, nb, lds);
    phase_weights(kparams(), bid, nb, lds);
    grid.sync();
    phase_mod2(kparams(), bid, nb);
    GRID_BAR();
    phase_lnmod(kparams(), 0, bid, nb);
    GRID_BAR();
#define LAYER_BODY(l) do { \
        { KP p = kparams(); \
            pg8::Gemm g{p->H, p->WtIn + (size_t)l * DIN * D, T, DIN, D}; pg8::StaticOrder S; S.init(T, DIN, nb, bid); \
            pg8::EpiInProj E{p->P, p->rope}; \
            pg8::gemm_phase<pg8::EpiInProj, pg8::StaticOrder, true, true>(ldsl, g, S, E); \
        } \
        GRID_BAR(); \
        for (int rep = 0; rep < REP_MIXA; ++rep) phase_mix_a(kparams(), l, bid, nb, lds); \
        GRID_BAR(); \
        phase_ret_scan(kparams(), l, bid, nb); \
        GRID_BAR(); \
        for (int rep = 0; rep < REP_RETOUT; ++rep) phase_ret_out(kparams(), l, bid, nb, lds); \
        GRID_BAR(); \
        { KP p = kparams(); \
            pg8::Gemm g{p->MIX, p->WtOut + (size_t)l * D * D, T, D, D}; pg8::StaticOrder S; S.init(T, D, nb, bid); \
            pg8::EpiF32 E{p->Y, D}; \
            pg8::gemm_phase<pg8::EpiF32, pg8::StaticOrder, true, true>(ldsl, g, S, E); \
        } \
        GRID_BAR(); \
        phase_ln1(kparams(), l, bid, nb); \
        GRID_BAR(); \
        { KP p = kparams(); \
            pg8::Gemm g{p->H, p->WtQ + (size_t)l * 2048 * D, T, 2048, D}; pg8::StaticOrder S; S.init(T, 2048, nb, bid); \
            pg8::EpiBf16Plain E{p->Qb, 2048}; \
            pg8::gemm_phase<pg8::EpiBf16Plain, pg8::StaticOrder, true, true>(ldsl, g, S, E); \
        } \
        GRID_BAR(); \
        for (int rep = 0; rep < REP_TOPK; ++rep) phase_topk(kparams(), l, bid, nb, lds); \
        GRID_BAR(); \
        phase_expert_u(kparams(), l, bid, nb, lds); \
        GRID_BAR(); \
        phase_expert_v(kparams(), l, bid, nb); \
        GRID_BAR(); \
        phase_ln2(kparams(), l, bid, nb); \
        if (l + 1 < DEPTH) GRID_BAR(); \
    } while (0)
    LAYER_BODY(0); LAYER_BODY(1); LAYER_BODY(2); LAYER_BODY(3);
#undef LAYER_BODY
}

extern "C" void kernel_launch(void* const* d_in, const int* in_sizes, int n_in, void* d_out, int out_size, void* d_ws, size_t ws_size, hipStream_t stream) {
    static int grid_blocks = 0;
    if (!grid_blocks) {
        int dev = 0, cus = 0, per_cu = 0;
        (void)hipGetDevice(&dev);
        (void)hipDeviceGetAttribute(&cus, hipDeviceAttributeMultiprocessorCount, dev);
        (void)hipFuncSetAttribute((const void*)mega, hipFuncAttributeMaxDynamicSharedMemorySize, LDS_BYTES);
        (void)hipOccupancyMaxActiveBlocksPerMultiprocessor(&per_cu, mega, NT, LDS_BYTES);
        if (per_cu < 1) { fprintf(stderr, "occupancy query says %d blocks per CU\n", per_cu); per_cu = 1; }
        grid_blocks = cus;
    }
    Params p{};
    const float** ins = (const float**)&p;
    for (int i = 0; i < 22; ++i) ins[i] = (const float*)d_in[i];
    p.out = (float*)d_out;
    char* ws = (char*)d_ws;
    size_t off = 0;
    auto carve = [&](size_t bytes) { void* r = ws + off; off += (bytes + 255) & ~(size_t)255; return r; };
    p.ctl = (unsigned*)carve(CTL_BYTES);
    p.modp = (float*)carve((size_t)16 * DEPTH * 3 * 6144 * 4);
    p.mod = (float*)carve((size_t)DEPTH * 3 * 6144 * 4);
    p.rope = (float*)carve((size_t)192 * 16 * 2 * 4);
    p.WtIn = (bf16*)carve((size_t)DEPTH * DIN * D * 2);
    p.WtOut = (bf16*)carve((size_t)DEPTH * D * D * 2);
    p.WtQ = (bf16*)carve((size_t)DEPTH * 2048 * D * 2);
    p.X = (float*)carve((size_t)T * D * 4);
    p.H = (bf16*)carve((size_t)T * D * 2);
    p.P = (bf16*)carve((size_t)T * DIN * 2);
    p.KV = (float*)carve((size_t)2 * NB * NPOS * 4 * 4096 * 4);
    p.ST = (float*)carve((size_t)2 * NB * NPOS * 4 * 4096 * 4);
    p.MIX = (bf16*)carve((size_t)T * D * 2);
    p.ST16 = (bf16*)carve((size_t)2 * NB * NPOS * 4 * 4096 * 2);
    p.Qb = (bf16*)carve((size_t)T * 2048 * 2);
    p.U16 = (bf16*)carve((size_t)DEPTH * PEER_N * D * 2);
    p.V16 = (bf16*)carve((size_t)DEPTH * PEER_N * D * 2);
    p.Y = (float*)carve((size_t)T * D * 4);
    p.X1 = (float*)carve((size_t)T * D * 4);
    p.Q = (float*)carve((size_t)T * 2048 * 4);
    p.GATE = (float*)carve((size_t)T * NSEL * 4);
    p.ACT = (float*)carve((size_t)T * NSEL * 4);
    p.V1 = (float*)carve((size_t)T * 8 * 16 * 4);
    p.EIDX = (int*)carve((size_t)T * NSEL * 4);
    p.I1 = (int*)carve((size_t)T * 8 * 16 * 4);
    if (off > ws_size) { fprintf(stderr, "workspace too small: need %zu have %zu\n", off, ws_size); return; }
    (void)hipMemsetAsync(p.ctl, 0, CTL_BYTES, stream);
    void* args[] = {&p};
    hipError_t e = hipLaunchCooperativeKernel((void*)mega, dim3(grid_blocks), dim3(NT), args, LDS_BYTES, stream);
    if (e != hipSuccess) fprintf(stderr, "cooperative launch failed: %s (grid %d)\n", hipGetErrorString(e), grid_blocks);
}
```

```cpp
#include <hip/hip_runtime.h>
#include <hip/hip_cooperative_groups.h>
#include <cstdio>
#include <cstdint>
namespace cg = cooperative_groups;

constexpr int D = 1024, NB = 2, SEQ = 8192, DEPTH = 4, LC = 256, HD = 64;
constexpr int TL = NB * SEQ, TC = NB * LC, T = TL + TC;
constexpr int DIN = 2304;
constexpr int C_RQ = 0, C_RK = 256, C_RV = 512, C_RG = 768, C_SU = 1024, C_SV = 1280, C_AQ = 1536, C_AK = 2048, C_AV = 2176;
constexpr int NPOS = 66;
constexpr int PEER_N = 16384, NSEL = 128;
constexpr float LN_EPS = 1e-5f;
constexpr float ALPHA = 1.681792830507429f;
constexpr int NT = 512;
constexpr int NW = 8;
constexpr int LDS_BYTES = 147456;
constexpr int MISC_OFF = 131072 + 320;

typedef unsigned short bf16;
#define LAS __attribute__((address_space(3)))

struct Params {
    const float *x, *c, *ctx, *c_ctx, *w_mod, *b_mod, *w_in, *w_out, *rdf, *rdb, *sgu_w, *sgu_b, *sink, *lnm_g, *lnm_b, *wq, *k1, *k2, *pu, *pv, *lnf_g, *lnf_b;
    float* out;
    unsigned* ctl;
    float *modp, *mod, *rope, *X, *KV, *ST, *Y, *X1, *Q, *GATE, *V1, *ACT;
    bf16 *WtIn, *WtOut, *WtQ, *H, *P, *MIX, *Qb, *ST16;
    unsigned char *U8, *V8, *XQ;
    float *SU, *SV, *SX;
    int *EIDX, *I1;
};

__device__ __forceinline__ unsigned f2bf(float f) { unsigned u = __builtin_bit_cast(unsigned, f); return (u + 0x7fffu + ((u >> 16) & 1u)) >> 16; }
__device__ __forceinline__ unsigned pk2(float lo, float hi) { return f2bf(lo) | (f2bf(hi) << 16); }
__device__ __forceinline__ float bf2f(bf16 v) { return __builtin_bit_cast(float, (unsigned)v << 16); }
__device__ __forceinline__ float bflo(unsigned w) { return __builtin_bit_cast(float, w << 16); }
__device__ __forceinline__ float bfhi(unsigned w) { return __builtin_bit_cast(float, w & 0xffff0000u); }

__device__ __forceinline__ float gelu_tanh(float x) {
    const float k0 = 0.7978845608028654f, k1 = 0.044715f;
    float u = k0 * (x + k1 * x * x * x);
    return 0.5f * x * (1.0f + tanhf(u));
}
__device__ __forceinline__ float silu_f(float x) { return x / (1.0f + expf(-x)); }
__device__ __forceinline__ int chunk_row0(int b, int pos) { return pos < 2 ? TL + b * LC + pos * 128 : b * SEQ + (pos - 2) * 128; }
__device__ __forceinline__ int mod_idx(int r) { return r < TL ? r / SEQ : 2; }
__device__ __forceinline__ float log_sigmoid_f(float x) { return -log1pf(expf(-x)); }
typedef const __attribute__((address_space(4))) Params* KP;
__device__ __forceinline__ KP kparams() { KP k = (KP)__builtin_amdgcn_kernarg_segment_ptr(); asm volatile("" : "+s"(k)); return k; }
__device__ __forceinline__ float shx(float v, int m, int lane) { return __builtin_bit_cast(float, __builtin_amdgcn_ds_bpermute((lane ^ m) << 2, __builtin_bit_cast(int, v))); }
__device__ __forceinline__ int shx(int v, int m, int lane) { return __builtin_amdgcn_ds_bpermute((lane ^ m) << 2, v); }
__device__ __forceinline__ float shf(float v, int src) { return __builtin_bit_cast(float, __builtin_amdgcn_ds_bpermute(src << 2, __builtin_bit_cast(int, v))); }
__device__ __forceinline__ int shf(int v, int src) { return __builtin_amdgcn_ds_bpermute(src << 2, v); }
__device__ __forceinline__ float wave_sum(float v, int lane) {
#pragma unroll
    for (int o = 32; o >= 1; o >>= 1) v += shx(v, o, lane);
    return v;
}
__device__ __forceinline__ int lane_opaque() { unsigned m = ~0u; asm volatile("" : "+s"(m)); return (int)__builtin_amdgcn_mbcnt_hi(m, __builtin_amdgcn_mbcnt_lo(m, 0u)); }
__device__ __forceinline__ int tid_opaque(int wv) { return wv * 64 + lane_opaque(); }

namespace pg8 {
#define PG8_LAS __attribute__((address_space(3)))
typedef unsigned short bf16_t;
typedef short bf16x8 __attribute__((ext_vector_type(8)));
typedef float f32x4 __attribute__((ext_vector_type(4)));
typedef unsigned u32x4 __attribute__((ext_vector_type(4)));
constexpr int BM = 256, BK = 64, HALF = 128, HTB = HALF * BK * 2  , STAGE_BYTES = 8 * HTB, NXCD = 8, WGM = 8;

__host__ __device__ __forceinline__ int lds_byte(int r, int c) { const int st = (r >> 4) * 2 + (c >> 5), rr = r & 15, cc = c & 31, ob = rr * 64 + cc * 2; return st * 1024 + (ob ^ (((ob >> 9) & 1) << 5)); }
__host__ __device__ __forceinline__ void stage_rc(int b, int& R, int& C) { const int st = b / 1024, sb = b % 1024, swz = sb ^ (((sb >> 9) & 1) << 5); R = (st >> 1) * 16 + swz / 64; C = (st & 1) * 32 + (swz % 64) / 2; }
__host__ __device__ __forceinline__ int perm32(int rho) { const int n = rho >> 4, i = rho & 15; return 8 * (i >> 2) + 4 * n + (i & 3); }

struct Unit { int pm, pn; };
struct Gemm { const bf16_t* A; const bf16_t* Bt; int M, N, K; };

struct StaticOrder {
    int nM, nN, nwg, G, c;
    __host__ __device__ void init(int M, int N, int G_, int c_) { nM = M / BM; nN = N / BM; nwg = nM * nN; G = G_; c = c_; }
    __host__ __device__ bool next(int i, Unit& u) const {
        const long L = (long)i * G + c; if (L >= nwg) return false;
        int wgid = (int)L; { const int q = nwg / NXCD, r = nwg % NXCD, xcd = wgid % NXCD, off = wgid / NXCD; wgid = (xcd < r ? xcd * (q + 1) : r * (q + 1) + (xcd - r) * q) + off; }
        const int nig = WGM * nN, gid = wgid / nig, fm = gid * WGM, gsz = (nM - fm) < WGM ? (nM - fm) : WGM;
        u.pm = fm + ((wgid % nig) % gsz); u.pn = (wgid % nig) / gsz; return true;
    }
    __device__ __forceinline__ void a_ready(const Unit&) const {}
    __device__ __forceinline__ void done(const Unit&) const {}
};

__device__ __forceinline__ unsigned cvt_pk_bf16(float lo, float hi) { unsigned r; asm volatile("v_cvt_pk_bf16_f32 %0, %1, %2" : "=v"(r) : "v"(lo), "v"(hi)); return r; }
struct EpiInProj {
    static constexpr bool PERM = true, AFTER_DRAIN = false;
    bf16_t* P; const float* rope;
    __device__ __forceinline__ void operator()(const f32x4 (&acc)[2][2][4][2], const Unit& u, int wr, int wc, int fr, int fq) const {
        const int pn = u.pn; const bool lat = u.pm < 64; const int lane = fq * 16 + fr;
        const float sc = (pn == 1 || pn == 6 || pn == 7) ? 0.125f : 1.0f;
        const float sgn = fq < 2 ? -1.0f : 1.0f;
#pragma unroll
        for (int bj = 0; bj < 2; ++bj) {
            const bool roped = lat && (pn == 0 || pn == 1 || pn == 6 || pn == 7 || (pn == 8 && bj == 0));
#pragma unroll
            for (int ai = 0; ai < 2; ++ai)
#pragma unroll
                for (int m = 0; m < 4; ++m) {
                    const int row = u.pm * BM + ai * HALF + wr * 64 + m * 16 + fr;
                    f32x4 v0 = acc[ai][bj][m][0], v1 = acc[ai][bj][m][1];
                    if (roped) {
                        const int pos = row & 8191, idx = (wc & 1) ? 128 + (pos & 63) : (pos >> 6);
                        const float2* tb = (const float2*)rope + idx * 16 + 8 * (fq & 1);
#pragma unroll
                        for (int e = 0; e < 4; ++e) {
                            const float p0 = shx(v0[e], 32, lane), p1 = shx(v1[e], 32, lane);
                            const float2 c0 = tb[e], c1 = tb[4 + e];
                            v0[e] = v0[e] * c0.x + sgn * p0 * c0.y;
                            v1[e] = v1[e] * c1.x + sgn * p1 * c1.y;
                        }
                    }
                    v0 = v0 * sc; v1 = v1 * sc;
                    u32x4 w; w.x = cvt_pk_bf16(v0[0], v0[1]); w.y = cvt_pk_bf16(v0[2], v0[3]); w.z = cvt_pk_bf16(v1[0], v1[1]); w.w = cvt_pk_bf16(v1[2], v1[3]);
                    *(u32x4*)(P + (size_t)row * 2304 + pn * BM + bj * HALF + wc * 32 + fq * 8) = w;
                    __builtin_amdgcn_sched_barrier(0);
                }
        }
    }
};
struct EpiF32 {
    static constexpr bool PERM = false, AFTER_DRAIN = false;
    float* O; int ldc;
    __device__ __forceinline__ void operator()(const f32x4 (&acc)[2][2][4][2], const Unit& u, int wr, int wc, int fr, int fq) const {
#pragma unroll
        for (int ai = 0; ai < 2; ++ai)
#pragma unroll
            for (int m = 0; m < 4; ++m) {
                float* rowp = O + (size_t)(u.pm * BM + ai * HALF + wr * 64 + m * 16 + fr) * ldc + u.pn * BM + wc * 32 + fq * 4;
#pragma unroll
                for (int bj = 0; bj < 2; ++bj)
#pragma unroll
                    for (int n = 0; n < 2; ++n) *(f32x4*)(rowp + bj * HALF + n * 16) = acc[ai][bj][m][n];
            }
    }
};


struct EpiBf16Plain {
    static constexpr bool PERM = true, AFTER_DRAIN = false;
    bf16_t* O; int ldc;
    __device__ __forceinline__ void operator()(const f32x4 (&acc)[2][2][4][2], const Unit& u, int wr, int wc, int fr, int fq) const {
#pragma unroll
        for (int ai = 0; ai < 2; ++ai)
#pragma unroll
            for (int m = 0; m < 4; ++m) {
                bf16_t* rowp = O + (size_t)(u.pm * BM + ai * HALF + wr * 64 + m * 16 + fr) * ldc + u.pn * BM + wc * 32 + fq * 8;
#pragma unroll
                for (int bj = 0; bj < 2; ++bj) {
                    const f32x4 v0 = acc[ai][bj][m][0], v1 = acc[ai][bj][m][1];
                    u32x4 w; w.x = cvt_pk_bf16(v0[0], v0[1]); w.y = cvt_pk_bf16(v0[2], v0[3]); w.z = cvt_pk_bf16(v1[0], v1[1]); w.w = cvt_pk_bf16(v1[2], v1[3]);
                    *(u32x4*)(rowp + bj * HALF) = w;
                }
            }
    }
};
template <class Epi, class Sched, bool ALIGN_EPI = false, bool SP2 = false>
__device__ __forceinline__ void gemm_phase(PG8_LAS unsigned char* lds, const Gemm g, const Sched& S, const Epi& E, int wv) {
    int tid_ = wv * 64; { unsigned m_ = ~0u; asm volatile("" : "+s"(m_)); tid_ += (int)__builtin_amdgcn_mbcnt_hi(m_, __builtin_amdgcn_mbcnt_lo(m_, 0u)); }
    const int tid = tid_, wid = __builtin_amdgcn_readfirstlane(tid >> 6), lane = tid & 63, wr = wid >> 2, wc = wid & 3, fr = lane & 15, fq = lane >> 4;
    const int K = g.K, nt = K / BK;
    unsigned voffA[2], voffB[2];
#pragma unroll
    for (int i = 0; i < 2; ++i) { int R, C; stage_rc(tid * 16 + i * 8192, R, C); const int Rb = Epi::PERM ? ((R & ~31) + perm32(R & 31)) : R;
        voffA[i] = (unsigned)(R * K + C) * 2u; voffB[i] = (unsigned)(Rb * K + C) * 2u; }
    const size_t kstep = (size_t)(BK * 2);
    const size_t hstep = (size_t)HALF * K * 2;
    const size_t tstep = 2 * hstep;
    const unsigned ldsw = (unsigned)wid * 1024u;
    const int aoff = lds_byte(wr * 64 + fr, fq * 8), boff = lds_byte(wc * 32 + fr, fq * 8);
#define PG8_SA(b, h) (((b) * 2 + (h)) * HTB)
#define PG8_SB(b, h) ((4 + (b) * 2 + (h)) * HTB)
#define PG8_STAGE(bufoff, gbase, voff) do { _Pragma("unroll") for (int _i = 0; _i < 2; ++_i) \
        __builtin_amdgcn_global_load_lds((const unsigned*)((const char*)(gbase) + (voff)[_i]), (PG8_LAS unsigned*)(lds + (bufoff) + ldsw + _i * 8192), 16, 0, 0); } while (0)
#define PG8_LDA(dst, b, h) do { _Pragma("unroll") for (int m = 0; m < 4; ++m) _Pragma("unroll") for (int k = 0; k < 2; ++k) dst[m][k] = *(const PG8_LAS bf16x8*)(lds + PG8_SA(b, h) + aoff + m * 2048 + k * 1024); } while (0)
#define PG8_LDB(dst, b, h) do { _Pragma("unroll") for (int n = 0; n < 2; ++n) _Pragma("unroll") for (int k = 0; k < 2; ++k) dst[n][k] = *(const PG8_LAS bf16x8*)(lds + PG8_SB(b, h) + boff + n * 2048 + k * 1024); } while (0)
#define PG8_MMA(ai, bj, At, Bt) do { __builtin_amdgcn_s_setprio(1); _Pragma("unroll") for (int m = 0; m < 4; ++m) _Pragma("unroll") for (int n = 0; n < 2; ++n) _Pragma("unroll") for (int k = 0; k < 2; ++k) \
        acc[ai][bj][m][n] = __builtin_amdgcn_mfma_f32_16x16x32_bf16(Bt[n][k], At[m][k], acc[ai][bj][m][n], 0, 0, 0); __builtin_amdgcn_s_setprio(0); } while (0)
#define PG8_WAIT_V(n) asm volatile("s_waitcnt vmcnt(" #n ")" ::: "memory")
#define PG8_WAIT_L(n) asm volatile("s_waitcnt lgkmcnt(" #n ")" ::: "memory")
#define PG8_BAR __builtin_amdgcn_s_barrier()
#define PG8_SCHED __builtin_amdgcn_sched_barrier(0)
    Unit cur, nxt; int ui = 0;
    if (!S.next(0, cur)) return;
    f32x4 acc[2][2][4][2];
#pragma unroll
    for (int a = 0; a < 2; ++a)
#pragma unroll
        for (int b = 0; b < 2; ++b)
#pragma unroll
            for (int m = 0; m < 4; ++m)
#pragma unroll
                for (int n = 0; n < 2; ++n) acc[a][b][m][n] = (f32x4){0.f, 0.f, 0.f, 0.f};
    bf16x8 At[4][2], B0[2][2], B1[2][2];
    const char* cA = (const char*)g.A + (size_t)cur.pm * tstep; const char* cB = (const char*)g.Bt + (size_t)cur.pn * tstep;
    S.a_ready(cur);
    if constexpr (SP2) {
        PG8_STAGE(PG8_SB(0, 0), cB, voffB); PG8_STAGE(PG8_SB(0, 1), cB + hstep, voffB); PG8_STAGE(PG8_SA(0, 0), cA, voffA); PG8_STAGE(PG8_SA(0, 1), cA + hstep, voffA);
        if (wr == 1) PG8_BAR;
        PG8_WAIT_V(2); PG8_BAR;
        PG8_STAGE(PG8_SB(1, 0), cB + kstep, voffB); PG8_STAGE(PG8_SA(1, 0), cA + kstep, voffA); PG8_STAGE(PG8_SB(1, 1), cB + hstep + kstep, voffB);
        PG8_WAIT_V(6); PG8_BAR;
    } else {
        PG8_STAGE(PG8_SB(0, 0), cB, voffB); PG8_STAGE(PG8_SA(0, 0), cA, voffA); PG8_STAGE(PG8_SB(0, 1), cB + hstep, voffB); PG8_STAGE(PG8_SA(0, 1), cA + hstep, voffA);
        if (wr == 1) PG8_BAR;
        PG8_WAIT_V(4); PG8_BAR;
        PG8_STAGE(PG8_SB(1, 0), cB + kstep, voffB); PG8_STAGE(PG8_SA(1, 0), cA + kstep, voffA); PG8_STAGE(PG8_SB(1, 1), cB + hstep + kstep, voffB);
        PG8_WAIT_V(6); PG8_BAR;
    }
    for (;;) {
        const bool has_next = S.next(ui + 1, nxt);
        const char* nA = has_next ? (const char*)g.A + (size_t)nxt.pm * tstep : cA; const char* nB = has_next ? (const char*)g.Bt + (size_t)nxt.pn * tstep : cB;
        for (int t = 0; t < nt; t += 2) {
            const bool last = (t == nt - 2);
            const char* a1 = cA + (size_t)(t + 1) * kstep;
            const char* a2 = last ? nA : cA + (size_t)(t + 2) * kstep; const char* b2 = last ? nB : cB + (size_t)(t + 2) * kstep;
            const char* a3 = a2 + kstep; const char* b3 = b2 + kstep;
            if (last && has_next) S.a_ready(nxt);
            if constexpr (SP2) {
            PG8_LDB(B0, 0, 0); PG8_LDB(B1, 0, 1); PG8_SCHED; PG8_LDA(At, 0, 0); PG8_STAGE(PG8_SA(1, 1), a1 + hstep, voffA);
            PG8_WAIT_V(8); PG8_WAIT_L(0); PG8_BAR; PG8_MMA(0, 0, At, B0); PG8_MMA(0, 1, At, B1); PG8_BAR; PG8_SCHED;
            PG8_LDA(At, 0, 1); PG8_STAGE(PG8_SB(0, 0), b2, voffB); PG8_STAGE(PG8_SB(0, 1), b2 + hstep, voffB); PG8_STAGE(PG8_SA(0, 0), a2, voffA);
            PG8_WAIT_V(8); PG8_WAIT_L(0); PG8_BAR; PG8_MMA(1, 0, At, B0); PG8_MMA(1, 1, At, B1); PG8_BAR; PG8_SCHED;
            PG8_LDB(B0, 1, 0); PG8_LDB(B1, 1, 1); PG8_SCHED; PG8_LDA(At, 1, 0); PG8_STAGE(PG8_SA(0, 1), a2 + hstep, voffA);
            PG8_WAIT_V(8); PG8_WAIT_L(0); PG8_BAR; PG8_MMA(0, 0, At, B0); PG8_MMA(0, 1, At, B1); PG8_BAR; PG8_SCHED;
            PG8_LDA(At, 1, 1); PG8_STAGE(PG8_SB(1, 0), b3, voffB); PG8_STAGE(PG8_SB(1, 1), b3 + hstep, voffB); PG8_STAGE(PG8_SA(1, 0), a3, voffA);
            PG8_WAIT_V(8); PG8_WAIT_L(0); PG8_BAR; PG8_MMA(1, 0, At, B0); PG8_MMA(1, 1, At, B1); PG8_BAR; PG8_SCHED;
            } else {
            PG8_LDB(B0, 0, 0); PG8_SCHED; PG8_LDA(At, 0, 0); PG8_STAGE(PG8_SA(1, 1), a1 + hstep, voffA);
            PG8_WAIT_L(8); PG8_BAR; PG8_WAIT_L(0); PG8_MMA(0, 0, At, B0); PG8_BAR; PG8_SCHED;
            PG8_LDB(B1, 0, 1); PG8_STAGE(PG8_SB(0, 0), b2, voffB);
            PG8_BAR; PG8_WAIT_L(0); PG8_MMA(0, 1, At, B1); PG8_BAR;
            PG8_LDA(At, 0, 1); PG8_STAGE(PG8_SA(0, 0), a2, voffA);
            PG8_BAR; PG8_WAIT_L(0); PG8_MMA(1, 0, At, B0); PG8_BAR; PG8_SCHED;
            PG8_STAGE(PG8_SB(0, 1), b2 + hstep, voffB);
            PG8_WAIT_V(6); PG8_BAR; PG8_MMA(1, 1, At, B1); PG8_BAR;
            PG8_LDB(B0, 1, 0); PG8_SCHED; PG8_LDA(At, 1, 0); PG8_STAGE(PG8_SA(0, 1), a2 + hstep, voffA);
            PG8_WAIT_L(8); PG8_BAR; PG8_WAIT_L(0); PG8_MMA(0, 0, At, B0); PG8_BAR; PG8_SCHED;
            PG8_LDB(B1, 1, 1); PG8_STAGE(PG8_SB(1, 0), b3, voffB);
            PG8_BAR; PG8_WAIT_L(0); PG8_MMA(0, 1, At, B1); PG8_BAR;
            PG8_LDA(At, 1, 1); PG8_STAGE(PG8_SA(1, 0), a3, voffA);
            PG8_BAR; PG8_WAIT_L(0); PG8_MMA(1, 0, At, B0); PG8_BAR; PG8_SCHED;
            PG8_STAGE(PG8_SB(1, 1), b3 + hstep, voffB);
            PG8_WAIT_V(6); PG8_BAR; PG8_MMA(1, 1, At, B1); PG8_BAR;
            }
        }
        if constexpr (ALIGN_EPI) { if (wr == 0) PG8_BAR; }
        if constexpr (!Epi::AFTER_DRAIN) { E(acc, cur, wr, wc, fr, fq); S.done(cur); }
        if (!has_next) break;
#pragma unroll
        for (int a = 0; a < 2; ++a)
#pragma unroll
            for (int b = 0; b < 2; ++b)
#pragma unroll
                for (int m = 0; m < 4; ++m)
#pragma unroll
                    for (int n = 0; n < 2; ++n) acc[a][b][m][n] = (f32x4){0.f, 0.f, 0.f, 0.f};
        cur = nxt; cA = nA; cB = nB; ++ui;
        if constexpr (ALIGN_EPI) { if (wr == 1) PG8_BAR; }
    }
    PG8_WAIT_V(0);
    if constexpr (!ALIGN_EPI) { if (wr == 0) PG8_BAR; }
    PG8_BAR;
    if constexpr (Epi::AFTER_DRAIN) { E.fused(acc, cur, wr, wc, fr, fq, lds, wid, lane); S.done(cur); }
#undef PG8_SA
#undef PG8_SB
#undef PG8_STAGE
#undef PG8_LDA
#undef PG8_LDB
#undef PG8_MMA
#undef PG8_WAIT_V
#undef PG8_WAIT_L
#undef PG8_BAR
#undef PG8_SCHED
}
}
constexpr int CW_BAR = 4096;
constexpr size_t CTL_BYTES = 65536;
#define XB_TMO      128
#define XB_XCNT(j)  (256  + 64 * (j))
#define XB_XSUB(j)  (1280 + 64 * (j))
#define XB_XGEN(j)  (2304 + 64 * (j))
#define XB_TOP      3328
#define XB_TOPGEN   3392
#define XCD_BAR_WORDS 3456
#define XB_SPIN_CAP (1u << 18)

__device__ __forceinline__ unsigned xb_ld(unsigned* p)              { return __hip_atomic_load(p, __ATOMIC_RELAXED, __HIP_MEMORY_SCOPE_AGENT); }
__device__ __forceinline__ unsigned xb_add(unsigned* p, unsigned v) { return __hip_atomic_fetch_add(p, v, __ATOMIC_RELAXED, __HIP_MEMORY_SCOPE_AGENT); }
__device__ __forceinline__ unsigned xb_xcc_id() { return (unsigned)__builtin_amdgcn_s_getreg((3 << 11) | 20) & 0xFu; }
#define XB_SPIN(cond, bar) do { unsigned _sp = 0; while (cond) { __builtin_amdgcn_s_sleep(1); \
    if ((++_sp & 255u) == 0u) { if (xb_ld(&(bar)[XB_TMO])) break; if (_sp > XB_SPIN_CAP) { atomicAdd(&(bar)[XB_TMO], 1u); break; } } } } while (0)

struct XcdBarrier {
    unsigned* bar; unsigned x; bool lead;
    volatile LAS unsigned* st;
};

__device__ __forceinline__ XcdBarrier xcd_barrier_post(unsigned* bar, volatile LAS unsigned* st, bool lead) {
    XcdBarrier b; b.bar = bar; b.x = xb_xcc_id(); b.st = st; b.lead = lead;
    if (b.lead) (void)xb_add(&bar[XB_XCNT(b.x)], 1u);
    return b;
}
__device__ __forceinline__ void xcd_barrier_complete(unsigned* bar, unsigned x, unsigned& nloc, unsigned& nx) {
    const unsigned G = gridDim.x * gridDim.y * gridDim.z;
    unsigned sum, cnt, mine, sp = 0u;
    for (;;) {
        sum = 0u; cnt = 0u; mine = 0u;
#pragma unroll
        for (unsigned j = 0; j < 16; ++j) { const unsigned c = xb_ld(&bar[XB_XCNT(j)]); sum += c; cnt += (c > 0u) ? 1u : 0u; mine = (j == x) ? c : mine; }
        if (sum == G) break;
        __builtin_amdgcn_s_sleep(1);
        if ((++sp & 255u) == 0u) { if (xb_ld(&bar[XB_TMO])) break; if (sp > XB_SPIN_CAP) { atomicAdd(&bar[XB_TMO], 1u); break; } }
    }
    nloc = mine > 0u ? mine : 1u; nx = cnt > 0u ? cnt : 1u;
}

__device__ __forceinline__ void xcd_barrier(const XcdBarrier& b) {
    asm volatile("s_waitcnt vmcnt(0)" ::: "memory");
    __syncthreads();
    if (b.lead) {
        unsigned* bar = b.bar;
        __builtin_amdgcn_s_waitcnt(0);
        unsigned nloc = b.st[0], nx = b.st[1];
        if (nloc == 0u) { xcd_barrier_complete(bar, b.x, nloc, nx); b.st[0] = nloc; b.st[1] = nx; }
        const unsigned old = xb_add(&bar[XB_XSUB(b.x)], 1u);
        const unsigned gen = old / nloc;
        if (old + 1u == (gen + 1u) * nloc) {
            __builtin_amdgcn_fence(__ATOMIC_RELEASE, "agent");
            asm volatile("s_waitcnt vmcnt(0)" ::: "memory");
            const unsigned og = xb_add(&bar[XB_TOP], 1u);
            const unsigned tg = og / nx;
            if (og + 1u == (tg + 1u) * nx) xb_add(&bar[XB_TOPGEN], 1u);
            else XB_SPIN(xb_ld(&bar[XB_TOPGEN]) == tg, bar);
            __builtin_amdgcn_fence(__ATOMIC_ACQUIRE, "agent");
            xb_add(&bar[XB_XGEN(b.x)], 1u);
            asm volatile("s_waitcnt vmcnt(0)" ::: "memory");
        } else {
            XB_SPIN(xb_ld(&bar[XB_XGEN(b.x)]) == gen, bar);
            __builtin_amdgcn_fence(__ATOMIC_ACQUIRE, "agent");
            asm volatile("s_waitcnt vmcnt(0)" ::: "memory");
        }
    }
    __syncthreads();
}


__device__ __forceinline__ void phase_mod1(KP p, int wv, int bid, int nb, float* lds) {
    float (*red)[8][64] = (float (*)[8][64])lds;
    const int t = tid_opaque(wv), cn = t & 63, kg = t >> 6;
    for (int u = bid; u < DEPTH * 96 * 16; u += nb) {
        const int ks = u & 15, nblk = (u >> 4) % 96, l = u / (16 * 96);
        const int n = nblk * 64 + cn;
        float a0 = 0.f, a1 = 0.f, a2 = 0.f;
#pragma unroll
        for (int kk = 0; kk < 8; ++kk) {
            const int k = ks * 64 + kg * 8 + kk;
            const float w = p->w_mod[((size_t)l * D + k) * 6144 + n];
            a0 += silu_f(p->c[k]) * w; a1 += silu_f(p->c[D + k]) * w; a2 += silu_f(p->c_ctx[k]) * w;
        }
        __syncthreads();
        red[0][kg][cn] = a0; red[1][kg][cn] = a1; red[2][kg][cn] = a2;
        __syncthreads();
        if (t < 192) {
            const int v = t >> 6;
            float s = 0.f;
#pragma unroll
            for (int g = 0; g < 8; ++g) s += red[v][g][cn];
            p->modp[(((size_t)ks * DEPTH + l) * 3 + v) * 6144 + n] = s;
        }
    }
    __syncthreads();
}
__device__ __forceinline__ void phase_mod2(KP p, int wv, int bid, int nb) {
    for (int i = bid * NT + tid_opaque(wv); i < DEPTH * 3 * 6144; i += nb * NT) {
        const int n = i % 6144, l = i / (3 * 6144);
        float s = p->b_mod[l * 6144 + n];
        for (int ks = 0; ks < 16; ++ks) s += p->modp[(size_t)ks * DEPTH * 3 * 6144 + i];
        p->mod[i] = s;
    }
}
__device__ __forceinline__ void transpose_item(const float* W, int K, int N, bf16* WT, float* scr, int item, int lane) {
    const int nblk = N / 32, kb = item / nblk, nbk = item % nblk, k0 = 64 * kb, n0 = 32 * nbk;
#pragma unroll 8
    for (int i = 0; i < 32; ++i) { const int kk = 2 * i + (lane >> 5); scr[kk * 33 + (lane & 31)] = W[(size_t)(k0 + kk) * N + n0 + (lane & 31)]; }
    __builtin_amdgcn_wave_barrier();
    const int c = lane & 7;
#pragma unroll
    for (int j = 0; j < 4; ++j) { const int n = (lane >> 3) + 8 * j; const float* s = scr + (8 * c) * 33 + n;
        uint4 o; o.x = pk2(s[0 * 33], s[1 * 33]); o.y = pk2(s[2 * 33], s[3 * 33]); o.z = pk2(s[4 * 33], s[5 * 33]); o.w = pk2(s[6 * 33], s[7 * 33]);
        *(uint4*)(WT + (size_t)(n0 + n) * K + k0 + 8 * c) = o; }
    __builtin_amdgcn_wave_barrier();
}
__device__ __forceinline__ void phase_weights(KP p, int wv, int bid, int nb, float* lds) {
    const int lane = tid_opaque(wv) & 63, w = tid_opaque(wv) >> 6;
    float* scr = lds + 2048 + w * (64 * 33 + 16);
    constexpr int I_IN = 16 * 72, I_OUT = 16 * 32, I_Q = 16 * 64;
    constexpr int NITEMS = DEPTH * (I_IN + I_OUT + I_Q);
    for (int it = bid * NW + w; it < NITEMS; it += nb * NW) {
        int r = it;
        if (r < DEPTH * I_IN) { const int l = r / I_IN; transpose_item(p->w_in + (size_t)l * D * DIN, D, DIN, p->WtIn + (size_t)l * DIN * D, scr, r % I_IN, lane); continue; } r -= DEPTH * I_IN;
        if (r < DEPTH * I_OUT) { const int l = r / I_OUT; transpose_item(p->w_out + (size_t)l * D * D, D, D, p->WtOut + (size_t)l * D * D, scr, r % I_OUT, lane); continue; } r -= DEPTH * I_OUT;
        { const int l = r / I_Q; transpose_item(p->wq + (size_t)l * D * 2048, D, 2048, p->WtQ + (size_t)l * 2048 * D, scr, r % I_Q, lane); }
    }
    {
        const int lane_ = tid_opaque(wv) & 63, w_ = tid_opaque(wv) >> 6;
        for (int row = bid * NW + w_; row < 2 * DEPTH * PEER_N; row += nb * NW) {
            const bool isv = row >= DEPTH * PEER_N; const int rr = isv ? row - DEPTH * PEER_N : row;
            float v[16];
            { const float* src_ = (isv ? p->pv : p->pu) + (size_t)rr * D;
#pragma unroll
              for (int i = 0; i < 4; ++i) { const float4 q4 = *(const float4*)(src_ + i * 256 + lane_ * 4); v[i * 4 + 0] = q4.x; v[i * 4 + 1] = q4.y; v[i * 4 + 2] = q4.z; v[i * 4 + 3] = q4.w; } }
            float m = 0.f;
#pragma unroll
            for (int i = 0; i < 16; ++i) m = fmaxf(m, fabsf(v[i]));
#pragma unroll
            for (int o = 32; o >= 1; o >>= 1) m = fmaxf(m, shx(m, o, lane_));
            unsigned* dst = (unsigned*)((isv ? p->V8 : p->U8) + (size_t)rr * D);
            if (!isv) {
                const float inv = m > 0.f ? 127.0f / m : 0.f;
#pragma unroll
                for (int i = 0; i < 4; ++i) {
                    const int q0 = (int)rintf(v[i * 4 + 0] * inv), q1 = (int)rintf(v[i * 4 + 1] * inv), q2 = (int)rintf(v[i * 4 + 2] * inv), q3 = (int)rintf(v[i * 4 + 3] * inv);
                    dst[i * 64 + lane_] = (unsigned)(q0 & 0xff) | ((unsigned)(q1 & 0xff) << 8) | ((unsigned)(q2 & 0xff) << 16) | ((unsigned)(q3 & 0xff) << 24);
                }
                if (lane_ == 0) p->SU[rr] = m * (1.0f / 127.0f);
            } else {
                const float inv = m > 0.f ? 240.0f / m : 0.f;
#pragma unroll
                for (int i = 0; i < 4; ++i) {
                    int pk = __builtin_amdgcn_cvt_pk_fp8_f32(v[i * 4 + 0] * inv, v[i * 4 + 1] * inv, 0, false);
                    pk = __builtin_amdgcn_cvt_pk_fp8_f32(v[i * 4 + 2] * inv, v[i * 4 + 3] * inv, pk, true);
                    dst[i * 64 + lane_] = (unsigned)pk;
                }
                if (lane_ == 0) p->SV[rr] = m * (1.0f / 240.0f);
            }
        }
    }
    for (int i = bid * NT + tid_opaque(wv); i < 192 * 16; i += nb * NT) {
        const int idx = i >> 4, f = i & 15;
        const float inv = powf(10000.0f, -(float)f / 16.0f);
        const float ang = (float)(idx < 128 ? idx : idx - 128) * inv;
        p->rope[2 * i] = cosf(ang); p->rope[2 * i + 1] = sinf(ang);
    }
}

__device__ __forceinline__ void row_load(const float* src, float (&v)[16], int lane) {
#pragma unroll
    for (int i = 0; i < 4; ++i) { const float4 q = *(const float4*)(src + i * 256 + lane * 4); v[i * 4 + 0] = q.x; v[i * 4 + 1] = q.y; v[i * 4 + 2] = q.z; v[i * 4 + 3] = q.w; }
}
__device__ __forceinline__ void row_store(float* dst, const float (&v)[16], int lane) {
#pragma unroll
    for (int i = 0; i < 4; ++i) *(float4*)(dst + i * 256 + lane * 4) = make_float4(v[i * 4 + 0], v[i * 4 + 1], v[i * 4 + 2], v[i * 4 + 3]);
}
__device__ __forceinline__ void row_store_bf(bf16* dst, const float (&v)[16], int lane) {
#pragma unroll
    for (int i = 0; i < 4; ++i) *(uint2*)(dst + i * 256 + lane * 4) = make_uint2(pk2(v[i * 4 + 0], v[i * 4 + 1]), pk2(v[i * 4 + 2], v[i * 4 + 3]));
}
__device__ __forceinline__ void row_load_bf(const bf16* src, float (&v)[16], int lane) {
#pragma unroll
    for (int i = 0; i < 4; ++i) { const uint2 q = *(const uint2*)(src + i * 256 + lane * 4); v[i * 4 + 0] = bflo(q.x); v[i * 4 + 1] = bfhi(q.x); v[i * 4 + 2] = bflo(q.y); v[i * 4 + 3] = bfhi(q.y); }
}
__device__ __forceinline__ void row_ln(float (&v)[16], int lane) {
    float s = 0.f;
#pragma unroll
    for (int i = 0; i < 16; ++i) s += v[i];
    const float mu = wave_sum(s, lane) * (1.0f / D);
    float q = 0.f;
#pragma unroll
    for (int i = 0; i < 16; ++i) { v[i] -= mu; q += v[i] * v[i]; }
    const float rstd = rsqrtf(wave_sum(q, lane) * (1.0f / D) + LN_EPS);
#pragma unroll
    for (int i = 0; i < 16; ++i) v[i] *= rstd;
}
__device__ __forceinline__ const float* x_row(KP p, int l, int r) {
    if (l == 0) return r < TL ? p->x + (size_t)r * D : p->ctx + (size_t)(r - TL) * D;
    return p->X + (size_t)r * D;
}

__device__ __forceinline__ void phase_lnmod(KP p, int wv, int l, int bid, int nb) {
    const int lane = tid_opaque(wv) & 63, w = tid_opaque(wv) >> 6;
    for (int r = bid * NW + w; r < T; r += nb * NW) {
        float v[16], sh[16], sc[16];
        row_load(x_row(p, l, r), v, lane);
        const float* m = p->mod + ((size_t)l * 3 + mod_idx(r)) * 6144;
        row_load(m, sh, lane); row_load(m + 1024, sc, lane);
        row_ln(v, lane);
#pragma unroll
        for (int i = 0; i < 16; ++i) v[i] = v[i] * (1.0f + sc[i]) + sh[i];
        row_store_bf(p->H + (size_t)r * D, v, lane);
    }
}

typedef short bf16x8_t __attribute__((ext_vector_type(8)));
typedef short bf16x4_t __attribute__((ext_vector_type(4)));
typedef float f32x4_t __attribute__((ext_vector_type(4)));
#define MFMA16(a, b, c) __builtin_amdgcn_mfma_f32_16x16x32_bf16((a), (b), (c), 0, 0, 0)
constexpr int KROW = 72;
constexpr int TROW = 136;
__device__ __forceinline__ bf16x8_t lds_frag16(const bf16* p) { return *(const bf16x8_t*)p; }
__device__ __forceinline__ bf16x8_t lds_frag8x2(const bf16* p0, const bf16* p1) {
    const bf16x4_t a = *(const bf16x4_t*)p0, b = *(const bf16x4_t*)p1;
    bf16x8_t o; o[0] = a[0]; o[1] = a[1]; o[2] = a[2]; o[3] = a[3]; o[4] = b[0]; o[5] = b[1]; o[6] = b[2]; o[7] = b[3]; return o;
}
__device__ __forceinline__ bf16x8_t pack_p(const f32x4_t& x, const f32x4_t& y) {
    uint4 w; w.x = pk2(x[0], x[1]); w.y = pk2(x[2], x[3]); w.z = pk2(y[0], y[1]); w.w = pk2(y[2], y[3]);
    return __builtin_bit_cast(bf16x8_t, w);
}
__device__ __forceinline__ void st_tr8(bf16* dst_col0, int stride, const uint4& v) {
    dst_col0[0 * stride] = (bf16)(v.x & 0xffffu); dst_col0[1 * stride] = (bf16)(v.x >> 16);
    dst_col0[2 * stride] = (bf16)(v.y & 0xffffu); dst_col0[3 * stride] = (bf16)(v.y >> 16);
    dst_col0[4 * stride] = (bf16)(v.z & 0xffffu); dst_col0[5 * stride] = (bf16)(v.z >> 16);
    dst_col0[6 * stride] = (bf16)(v.w & 0xffffu); dst_col0[7 * stride] = (bf16)(v.w >> 16);
}

constexpr int ATT_BUF = 128 * KROW + 64 * TROW;
__device__ __forceinline__ void att_unit(KP p, int wv, int l, int u, bf16* lds) {
    const int t = tid_opaque(wv), lane = t & 63, w = t >> 6, r = lane & 15, g = lane >> 4;
    const bool lat = u < 256;
    int b, n, hkv;
    if (lat) { hkv = u & 1; n = (u >> 1) & 63; b = u >> 7; } else { const int v = u - 256; hkv = v & 1; n = (v >> 1) & 1; b = v >> 2; }
    const int hq = hkv * 4 + (w >> 1), qh = w & 1;
    const int qrow0 = (lat ? b * SEQ + n * 128 : TL + b * LC + n * 128) + qh * 64;
    int kb_lo = 0, kb_hi = -1;
    if (lat) { kb_lo = n > 0 ? n - 1 : 0; kb_hi = n < 63 ? n + 1 : 63; }
    const int nloc = kb_hi - kb_lo + 1, nblk = nloc + 2;
    const bf16* P = p->P;
    bf16x8_t qf[4][2];
#pragma unroll
    for (int qt = 0; qt < 4; ++qt)
#pragma unroll
        for (int ks = 0; ks < 2; ++ks) qf[qt][ks] = *(const bf16x8_t*)(P + (size_t)(qrow0 + qt * 16 + r) * DIN + C_AQ + hq * 64 + ks * 32 + g * 8);
    const float LOG2E = 1.4426950408889634f;
    const float sink2 = p->sink[l * 8 + hq] * LOG2E;
    float m[4], lsum[4];
    f32x4_t ot[4][4];
#pragma unroll
    for (int qt = 0; qt < 4; ++qt) { m[qt] = sink2; lsum[qt] = g == 0 ? 1.0f : 0.0f; }
#pragma unroll
    for (int dt = 0; dt < 4; ++dt)
#pragma unroll
        for (int qt = 0; qt < 4; ++qt) ot[dt][qt] = (f32x4_t){0.f, 0.f, 0.f, 0.f};
    uint4 kreg0, kreg1, vreg0, vreg1;
#define ATT_ROW0(bi) ((bi) < nloc ? b * SEQ + (kb_lo + (bi)) * 128 : TL + b * LC + ((bi) - nloc) * 128)
    const int key0 = t >> 3, key1 = key0 + 64, c8 = t & 7;
#define ATT_ISSUE(bi) do { const bf16* src_ = P + (size_t)(ATT_ROW0(bi) + key0) * DIN + hkv * 64 + c8 * 8; \
        kreg0 = *(const uint4*)(src_ + C_AK); vreg0 = *(const uint4*)(src_ + C_AV); \
        kreg1 = *(const uint4*)(src_ + 64 * DIN + C_AK); vreg1 = *(const uint4*)(src_ + 64 * DIN + C_AV); } while (0)
#define ATT_STAGE(buf) do { \
        *(uint4*)((buf) + key0 * KROW + c8 * 8) = kreg0; *(uint4*)((buf) + key1 * KROW + c8 * 8) = kreg1; \
        st_tr8((buf) + 128 * KROW + (c8 * 8) * TROW + key0, TROW, vreg0); st_tr8((buf) + 128 * KROW + (c8 * 8) * TROW + key1, TROW, vreg1); } while (0)
    __syncthreads();
    ATT_ISSUE(0);
    for (int bi = 0; bi < nblk; ++bi) {
        bf16* buf = lds + (bi & 1) * ATT_BUF;
        ATT_STAGE(buf);
        __syncthreads();
        if (bi + 1 < nblk) ATT_ISSUE(bi + 1);
        const bf16* Ks = buf; const bf16* Vt = buf + 128 * KROW;
        const int band = (bi < nloc) ? (kb_lo + bi) - n : 0;
#pragma unroll 1
        for (int sub = 0; sub < 2; ++sub) {
            f32x4_t st[4][4];
#pragma unroll
            for (int kt = 0; kt < 4; ++kt) {
#pragma unroll
                for (int qt = 0; qt < 4; ++qt) st[kt][qt] = (f32x4_t){0.f, 0.f, 0.f, 0.f};
#pragma unroll
                for (int ks = 0; ks < 2; ++ks) {
                    const bf16x8_t a = lds_frag16(Ks + (sub * 64 + kt * 16 + r) * KROW + ks * 32 + g * 8);
#pragma unroll
                    for (int qt = 0; qt < 4; ++qt) st[kt][qt] = MFMA16(a, qf[qt][ks], st[kt][qt]);
                }
            }
#pragma unroll
            for (int qt = 0; qt < 4; ++qt) {
                const int il = qh * 64 + qt * 16 + r;
                float mloc = -INFINITY;
#pragma unroll
                for (int kt = 0; kt < 4; ++kt)
#pragma unroll
                    for (int i = 0; i < 4; ++i) {
                        const int jl = sub * 64 + kt * 16 + g * 4 + i;
                        float s = st[kt][qt][i] * LOG2E;
                        if (band < 0) { if (jl < il) s = -INFINITY; } else if (band > 0) { if (jl > il) s = -INFINITY; }
                        st[kt][qt][i] = s; mloc = fmaxf(mloc, s);
                    }
                mloc = fmaxf(mloc, shx(mloc, 16, lane)); mloc = fmaxf(mloc, shx(mloc, 32, lane));
                const float mnew = fmaxf(m[qt], mloc);
                const float alpha = __builtin_amdgcn_exp2f(m[qt] - mnew);
                m[qt] = mnew;
                float ps = 0.f;
#pragma unroll
                for (int kt = 0; kt < 4; ++kt)
#pragma unroll
                    for (int i = 0; i < 4; ++i) { const float e = __builtin_amdgcn_exp2f(st[kt][qt][i] - mnew); st[kt][qt][i] = e; ps += e; }
                lsum[qt] = lsum[qt] * alpha + ps;
#pragma unroll
                for (int dt = 0; dt < 4; ++dt) ot[dt][qt] = ot[dt][qt] * alpha;
            }
#pragma unroll
            for (int kp = 0; kp < 2; ++kp) {
                bf16x8_t pf[4];
#pragma unroll
                for (int qt = 0; qt < 4; ++qt) pf[qt] = pack_p(st[2 * kp][qt], st[2 * kp + 1][qt]);
#pragma unroll
                for (int dt = 0; dt < 4; ++dt) {
                    const bf16* vrow = Vt + (dt * 16 + r) * TROW + sub * 64 + g * 4;
                    const bf16x8_t a = lds_frag8x2(vrow + (2 * kp) * 16, vrow + (2 * kp + 1) * 16);
#pragma unroll
                    for (int qt = 0; qt < 4; ++qt) ot[dt][qt] = MFMA16(a, pf[qt], ot[dt][qt]);
                }
            }
        }
    }
#pragma unroll
    for (int qt = 0; qt < 4; ++qt) {
        float ls = lsum[qt]; ls += shx(ls, 16, lane); ls += shx(ls, 32, lane);
        const float inv = 1.0f / ls;
        bf16* orow = p->MIX + (size_t)(qrow0 + qt * 16 + r) * D + 512 + hq * 64 + g * 4;
#pragma unroll
        for (int dt = 0; dt < 4; ++dt) {
            const f32x4_t o = ot[dt][qt] * inv;
            *(uint2*)(orow + dt * 16) = make_uint2(pk2(o[0], o[1]), pk2(o[2], o[3]));
        }
    }
}

__device__ __forceinline__ size_t kv_off(int dir, int b, int pos, int h) { return ((((size_t)dir * NB + b) * NPOS + pos) * 4 + h) * 4096; }
__device__ __forceinline__ void ret_kv_unit(KP p, int wv, int l, int u, bf16* lds) {
    const int h = u & 3, pos = (u >> 2) % NPOS, b = u / (4 * NPOS);
    const int t = tid_opaque(wv), lane = t & 63, w = t >> 6, r = lane & 15, g = lane >> 4;
    bf16* Ktf = lds; bf16* Ktb = lds + 64 * TROW; bf16* Vt = lds + 2 * 64 * TROW;
    const float lgf = log_sigmoid_f(p->rdf[l * 4 + h]), lgb = log_sigmoid_f(p->rdb[l * 4 + h]);
    const int r0 = chunk_row0(b, pos);
    const bf16* P = p->P;
    __syncthreads();
#pragma unroll
    for (int q = 0; q < 2; ++q) {
        const int pc = t + q * NT, j = pc >> 3, c8 = pc & 7;
        const bf16* src = P + (size_t)(r0 + j) * DIN + h * 64 + c8 * 8;
        const uint4 kv = *(const uint4*)(src + C_RK), vv = *(const uint4*)(src + C_RV);
        const float wf = expf(lgf * (float)(127 - j)), wb = expf(lgb * (float)j);
        uint4 kf, kb;
        kf.x = pk2(bflo(kv.x) * wf, bfhi(kv.x) * wf); kf.y = pk2(bflo(kv.y) * wf, bfhi(kv.y) * wf); kf.z = pk2(bflo(kv.z) * wf, bfhi(kv.z) * wf); kf.w = pk2(bflo(kv.w) * wf, bfhi(kv.w) * wf);
        kb.x = pk2(bflo(kv.x) * wb, bfhi(kv.x) * wb); kb.y = pk2(bflo(kv.y) * wb, bfhi(kv.y) * wb); kb.z = pk2(bflo(kv.z) * wb, bfhi(kv.z) * wb); kb.w = pk2(bflo(kv.w) * wb, bfhi(kv.w) * wb);
        st_tr8(Ktf + (c8 * 8) * TROW + j, TROW, kf);
        st_tr8(Ktb + (c8 * 8) * TROW + j, TROW, kb);
        st_tr8(Vt + (c8 * 8) * TROW + j, TROW, vv);
    }
    __syncthreads();
    const int dir = w >> 2, dvt = w & 3;
    const bf16* Kt = dir ? Ktb : Ktf;
    f32x4_t acc[4];
#pragma unroll
    for (int dkt = 0; dkt < 4; ++dkt) acc[dkt] = (f32x4_t){0.f, 0.f, 0.f, 0.f};
#pragma unroll
    for (int ks = 0; ks < 4; ++ks) {
        const bf16x8_t a = lds_frag16(Vt + (dvt * 16 + r) * TROW + ks * 32 + g * 8);
#pragma unroll
        for (int dkt = 0; dkt < 4; ++dkt) acc[dkt] = MFMA16(a, lds_frag16(Kt + (dkt * 16 + r) * TROW + ks * 32 + g * 8), acc[dkt]);
    }
    float* o = p->KV + kv_off(dir, b, pos, h);
#pragma unroll
    for (int dkt = 0; dkt < 4; ++dkt)
#pragma unroll
        for (int i = 0; i < 4; ++i) o[(dvt * 16 + g * 4 + i) * 64 + dkt * 16 + r] = acc[dkt][i];
}

__device__ __forceinline__ void phase_ret_scan(KP p, int wv, int l, int bid, int nb) {
    for (int i = bid * NT + tid_opaque(wv); i < 2 * NB * 4 * 4096; i += nb * NT) {
        const int e = i & 4095, h = (i >> 12) & 3, b = (i >> 14) & 1, dir = i >> 15;
        const float lg = log_sigmoid_f(dir ? p->rdb[l * 4 + h] : p->rdf[l * 4 + h]);
        const float cdec = expf(128.0f * lg);
        const float* kv = p->KV; bf16* st = p->ST16;
        float v[NPOS];
#pragma unroll
        for (int step = 0; step < NPOS; ++step) {
            const int pos = dir == 0 ? step : (step == 0 ? 1 : (step == 1 ? 0 : 67 - step));
            v[step] = kv[kv_off(dir, b, pos, h) + e];
        }
        float s = 0.f;
#pragma unroll
        for (int step = 0; step < NPOS; ++step) {
            const int pos = dir == 0 ? step : (step == 0 ? 1 : (step == 1 ? 0 : 67 - step));
            st[kv_off(dir, b, pos, h) + e] = (bf16)f2bf(s);
            s = s * cdec + v[step];
        }
    }
}

constexpr int RO_HEAD = 128 * KROW + 64 * TROW + 2 * 64 * KROW;
constexpr int RO_TAB = 2 * RO_HEAD;
__device__ __forceinline__ void ret_out_unit(KP p, int wv, int l, int u, bf16* lds) {
    const int hp = u & 1, pos = (u >> 1) % NPOS, b = u / (2 * NPOS);
    const int t = tid_opaque(wv), lane = t & 63, w = t >> 6, r = lane & 15, g = lane >> 4;
    const int r0 = chunk_row0(b, pos);
    const bf16* P = p->P;
    float* tabs = (float*)(lds + RO_TAB);
    __syncthreads();
#pragma unroll
    for (int q = 0; q < 4; ++q) {
        const int pc = t + q * NT, hh = pc >> 10, j = (pc >> 3) & 127, c8 = pc & 7, h = hp * 2 + hh;
        bf16* base = lds + hh * RO_HEAD;
        const bf16* src = P + (size_t)(r0 + j) * DIN + h * 64 + c8 * 8;
        *(uint4*)(base + j * KROW + c8 * 8) = *(const uint4*)(src + C_RK);
        const uint4 vv = *(const uint4*)(src + C_RV);
        st_tr8(base + 128 * KROW + (c8 * 8) * TROW + j, TROW, vv);
    }
#pragma unroll
    for (int q = 0; q < 4; ++q) {
        const int pc = t + q * NT, hh = pc >> 10, dir = (pc >> 9) & 1, dv = (pc >> 3) & 63, c8 = pc & 7, h = hp * 2 + hh;
        const uint4 sv = *(const uint4*)(p->ST16 + kv_off(dir, b, pos, h) + dv * 64 + c8 * 8);
        *(uint4*)(lds + hh * RO_HEAD + 128 * KROW + 64 * TROW + dir * 64 * KROW + dv * KROW + c8 * 8) = sv;
    }
    if (t < 4 * 132) {
        const int hh = t / 264, dir = (t / 132) & 1, k = t % 132, h = hp * 2 + hh;
        const float lg = log_sigmoid_f(dir ? p->rdb[l * 4 + h] : p->rdf[l * 4 + h]);
        tabs[(hh * 2 + dir) * 132 + k] = expf(lg * (float)k);
    }
    __syncthreads();
    const int hh = w >> 2, h = hp * 2 + hh, qw = w & 3;
    const bf16* Ks = lds + hh * RO_HEAD; const bf16* Vt = Ks + 128 * KROW; const bf16* Sft = Vt + 64 * TROW; const bf16* Sbt = Sft + 64 * KROW;
    const float* pf = tabs + (hh * 2) * 132; const float* pb = pf + 132;
    bf16x8_t qf[2][2];
#pragma unroll
    for (int qt = 0; qt < 2; ++qt)
#pragma unroll
        for (int ks = 0; ks < 2; ++ks) qf[qt][ks] = *(const bf16x8_t*)(P + (size_t)(r0 + qw * 32 + qt * 16 + r) * DIN + C_RQ + h * 64 + ks * 32 + g * 8);
    f32x4_t accI[4][2], accF[4][2], accB[4][2];
#pragma unroll
    for (int dt = 0; dt < 4; ++dt)
#pragma unroll
        for (int qt = 0; qt < 2; ++qt) { accI[dt][qt] = (f32x4_t){0.f, 0.f, 0.f, 0.f}; accF[dt][qt] = accI[dt][qt]; accB[dt][qt] = accI[dt][qt]; }
#pragma unroll
    for (int dt = 0; dt < 4; ++dt)
#pragma unroll
        for (int ks = 0; ks < 2; ++ks) {
            const bf16x8_t af = lds_frag16(Sft + (dt * 16 + r) * KROW + ks * 32 + g * 8), ab = lds_frag16(Sbt + (dt * 16 + r) * KROW + ks * 32 + g * 8);
#pragma unroll
            for (int qt = 0; qt < 2; ++qt) { accF[dt][qt] = MFMA16(af, qf[qt][ks], accF[dt][qt]); accB[dt][qt] = MFMA16(ab, qf[qt][ks], accB[dt][qt]); }
        }
#pragma unroll 1
    for (int sub = 0; sub < 2; ++sub) {
        f32x4_t st[4][2];
#pragma unroll
        for (int kt = 0; kt < 4; ++kt) {
#pragma unroll
            for (int qt = 0; qt < 2; ++qt) st[kt][qt] = (f32x4_t){0.f, 0.f, 0.f, 0.f};
#pragma unroll
            for (int ks = 0; ks < 2; ++ks) {
                const bf16x8_t a = lds_frag16(Ks + (sub * 64 + kt * 16 + r) * KROW + ks * 32 + g * 8);
#pragma unroll
                for (int qt = 0; qt < 2; ++qt) st[kt][qt] = MFMA16(a, qf[qt][ks], st[kt][qt]);
            }
        }
#pragma unroll
        for (int qt = 0; qt < 2; ++qt) {
            const int il = qw * 32 + qt * 16 + r;
#pragma unroll
            for (int kt = 0; kt < 4; ++kt)
#pragma unroll
                for (int i = 0; i < 4; ++i) {
                    const int rel = il - (sub * 64 + kt * 16 + g * 4 + i);
                    const float wgt = rel > 0 ? pf[rel] : (rel < 0 ? pb[-rel] : 2.0f);
                    st[kt][qt][i] *= wgt;
                }
        }
#pragma unroll
        for (int kp = 0; kp < 2; ++kp) {
            bf16x8_t pfr[2];
#pragma unroll
            for (int qt = 0; qt < 2; ++qt) pfr[qt] = pack_p(st[2 * kp][qt], st[2 * kp + 1][qt]);
#pragma unroll
            for (int dt = 0; dt < 4; ++dt) {
                const bf16* vrow = Vt + (dt * 16 + r) * TROW + sub * 64 + g * 4;
                const bf16x8_t a = lds_frag8x2(vrow + (2 * kp) * 16, vrow + (2 * kp + 1) * 16);
#pragma unroll
                for (int qt = 0; qt < 2; ++qt) accI[dt][qt] = MFMA16(a, pfr[qt], accI[dt][qt]);
            }
        }
    }
#pragma unroll
    for (int qt = 0; qt < 2; ++qt) {
        const int il = qw * 32 + qt * 16 + r;
        const float qfd = pf[il + 1], qbd = pb[128 - il];
        float s = 0.f;
#pragma unroll
        for (int dt = 0; dt < 4; ++dt) { accI[dt][qt] = accI[dt][qt] + accF[dt][qt] * qfd + accB[dt][qt] * qbd; s += (accI[dt][qt][0] + accI[dt][qt][1]) + (accI[dt][qt][2] + accI[dt][qt][3]); }
        s += shx(s, 16, lane); s += shx(s, 32, lane);
        const float mu = s * (1.0f / 64.0f);
        float qq = 0.f;
#pragma unroll
        for (int dt = 0; dt < 4; ++dt) { accI[dt][qt] = accI[dt][qt] - mu; qq += (accI[dt][qt][0] * accI[dt][qt][0] + accI[dt][qt][1] * accI[dt][qt][1]) + (accI[dt][qt][2] * accI[dt][qt][2] + accI[dt][qt][3] * accI[dt][qt][3]); }
        qq += shx(qq, 16, lane); qq += shx(qq, 32, lane);
        const float rstd = rsqrtf(qq * (1.0f / 64.0f) + LN_EPS);
        const size_t row = (size_t)(r0 + il);
#pragma unroll
        for (int dt = 0; dt < 4; ++dt) {
            const uint2 gw = *(const uint2*)(P + row * DIN + C_RG + h * 64 + dt * 16 + g * 4);
            const f32x4_t o = accI[dt][qt] * rstd;
            const float o0 = o[0] * silu_f(bflo(gw.x)), o1 = o[1] * silu_f(bfhi(gw.x)), o2 = o[2] * silu_f(bflo(gw.y)), o3 = o[3] * silu_f(bfhi(gw.y));
            *(uint2*)(p->MIX + row * D + h * 64 + dt * 16 + g * 4) = make_uint2(pk2(o0, o1), pk2(o2, o3));
        }
    }
}

__device__ __forceinline__ void sgu_unit(KP p, int wv, int l, int u, bf16* lds) {
    const int grp = u & 3, pos = (u >> 2) % NPOS, b = u / (4 * NPOS);
    const int t = tid_opaque(wv), lane = t & 63, w = t >> 6, r = lane & 15, g = lane >> 4;
    const int r0 = chunk_row0(b, pos);
    const bf16* P = p->P;
    bf16* vnT = lds;
    __syncthreads();
    {
        const int j = t >> 2, qd = t & 3;
        const uint4* src = (const uint4*)(P + (size_t)(r0 + j) * DIN + C_SV + grp * 64 + qd * 16);
        const uint4 a = src[0], c = src[1];
        float v[16] = {bflo(a.x), bfhi(a.x), bflo(a.y), bfhi(a.y), bflo(a.z), bfhi(a.z), bflo(a.w), bfhi(a.w), bflo(c.x), bfhi(c.x), bflo(c.y), bfhi(c.y), bflo(c.z), bfhi(c.z), bflo(c.w), bfhi(c.w)};
        float s = 0.f;
#pragma unroll
        for (int d = 0; d < 16; ++d) { v[d] = gelu_tanh(v[d]); s += v[d]; }
        s += shx(s, 1, lane); s += shx(s, 2, lane);
        const float mu = s * (1.0f / 64.0f);
        float qq = 0.f;
#pragma unroll
        for (int d = 0; d < 16; ++d) { v[d] -= mu; qq += v[d] * v[d]; }
        qq += shx(qq, 1, lane); qq += shx(qq, 2, lane);
        const float rstd = rsqrtf(qq * (1.0f / 64.0f) + LN_EPS);
#pragma unroll
        for (int d = 0; d < 16; ++d) vnT[(qd * 16 + d) * TROW + j] = (bf16)f2bf(v[d] * rstd);
    }
    bf16x8_t wf[4];
    {
        const float* wrow = p->sgu_w + (((size_t)l * 4 + grp) * 128 + w * 16 + r) * 128 + g * 8;
#pragma unroll
        for (int ks = 0; ks < 4; ++ks) {
            const float4 a = *(const float4*)(wrow + ks * 32), c = *(const float4*)(wrow + ks * 32 + 4);
            uint4 o; o.x = pk2(a.x, a.y); o.y = pk2(a.z, a.w); o.z = pk2(c.x, c.y); o.w = pk2(c.z, c.w);
            wf[ks] = __builtin_bit_cast(bf16x8_t, o);
        }
    }
    __syncthreads();
    const int i = w * 16 + r;
    const float bs = p->sgu_b[((size_t)l * 4 + grp) * 128 + i];
#pragma unroll
    for (int dt = 0; dt < 4; ++dt) {
        f32x4_t acc = {0.f, 0.f, 0.f, 0.f};
#pragma unroll
        for (int ks = 0; ks < 4; ++ks) acc = MFMA16(lds_frag16(vnT + (dt * 16 + r) * TROW + ks * 32 + g * 8), wf[ks], acc);
        const uint2 uw = *(const uint2*)(P + (size_t)(r0 + i) * DIN + C_SU + grp * 64 + dt * 16 + g * 4);
        const float o0 = gelu_tanh(bflo(uw.x)) * (acc[0] + bs), o1 = gelu_tanh(bfhi(uw.x)) * (acc[1] + bs), o2 = gelu_tanh(bflo(uw.y)) * (acc[2] + bs), o3 = gelu_tanh(bfhi(uw.y)) * (acc[3] + bs);
        *(uint2*)(p->MIX + (size_t)(r0 + i) * D + 256 + grp * 64 + dt * 16 + g * 4) = make_uint2(pk2(o0, o1), pk2(o2, o3));
    }
}

__device__ __forceinline__ void phase_mix_a(KP p, int wv, int l, int bid, int nb, float* ldsf) {
    bf16* lds = (bf16*)ldsf;
    const int n_att = 264, n_kv = NB * NPOS * 4, n_sgu = NB * NPOS * 4;
    for (int u = bid; u < n_att + n_kv + n_sgu; u += nb) {
        if (u < n_att) att_unit(p, wv, l, u, lds);
        else if (u < n_att + n_kv) ret_kv_unit(p, wv, l, u - n_att, lds);
        else sgu_unit(p, wv, l, u - n_att - n_kv, lds);
    }
    __syncthreads();
}
__device__ __forceinline__ void phase_ret_out(KP p, int wv, int l, int bid, int nb, float* ldsf) {
    bf16* lds = (bf16*)ldsf;
    for (int u = bid; u < NB * NPOS * 2; u += nb) ret_out_unit(p, wv, l, u, lds);
    __syncthreads();
}

__device__ __forceinline__ void phase_ln1(KP p, int wv, int l, int bid, int nb) {
    const int lane = tid_opaque(wv) & 63, w = tid_opaque(wv) >> 6;
    for (int r = bid * NW + w; r < T; r += nb * NW) {
        float v[16], a[16], c[16];
        row_load(x_row(p, l, r), v, lane);
        row_load(p->Y + (size_t)r * D, a, lane);
        const float* m = p->mod + ((size_t)l * 3 + mod_idx(r)) * 6144;
        row_load(m + 2048, c, lane);
#pragma unroll
        for (int i = 0; i < 16; ++i) v[i] = ALPHA * v[i] + c[i] * a[i];
        row_ln(v, lane);
        row_load(p->lnm_g + l * D, a, lane); row_load(p->lnm_b + l * D, c, lane);
#pragma unroll
        for (int i = 0; i < 16; ++i) v[i] = v[i] * a[i] + c[i];
        row_store(p->X1 + (size_t)r * D, v, lane);
        row_ln(v, lane);
        row_load(m + 3072, a, lane); row_load(m + 4096, c, lane);
#pragma unroll
        for (int i = 0; i < 16; ++i) v[i] = v[i] * (1.0f + c[i]) + a[i];
        row_store_bf(p->H + (size_t)r * D, v, lane);
        float mx = 0.f;
#pragma unroll
        for (int i = 0; i < 16; ++i) mx = fmaxf(mx, fabsf(v[i]));
#pragma unroll
        for (int o = 32; o >= 1; o >>= 1) mx = fmaxf(mx, shx(mx, o, lane));
        const float xinv = mx > 0.f ? 127.0f / mx : 0.f;
        unsigned* xq = (unsigned*)(p->XQ + (size_t)r * D);
#pragma unroll
        for (int i = 0; i < 4; ++i) {
            const int q0 = (int)rintf(v[i * 4 + 0] * xinv), q1 = (int)rintf(v[i * 4 + 1] * xinv), q2 = (int)rintf(v[i * 4 + 2] * xinv), q3 = (int)rintf(v[i * 4 + 3] * xinv);
            xq[i * 64 + lane] = (unsigned)(q0 & 0xff) | ((unsigned)(q1 & 0xff) << 8) | ((unsigned)(q2 & 0xff) << 16) | ((unsigned)(q3 & 0xff) << 24);
        }
        if (lane == 0) p->SX[r] = mx * (1.0f / 127.0f);
    }
}

template <int NV, class IdFn>
__device__ __forceinline__ void select_top16(const float (&v)[NV], IdFn idf, float* lv, int* li, int lane) {
    float mx = v[0], mn = v[0];
#pragma unroll
    for (int e = 1; e < NV; ++e) { mx = fmaxf(mx, v[e]); mn = fminf(mn, v[e]); }
    mx = fmaxf(mx, shx(mx, 16, lane)); mx = fmaxf(mx, shx(mx, 32, lane));
    mn = fminf(mn, shx(mn, 16, lane)); mn = fminf(mn, shx(mn, 32, lane));
    float lo = mn - 1.0f, hi = mx, tau = lo;
    bool done = false;
    for (int iter = 0; iter < 48; ++iter) {
        const float mid = 0.5f * (lo + hi);
        int cnt = 0;
#pragma unroll
        for (int e = 0; e < NV; ++e) cnt += (v[e] > mid) ? 1 : 0;
        cnt += shx(cnt, 16, lane); cnt += shx(cnt, 32, lane);
        if (!done) {
            if (cnt == 16) { tau = mid; done = true; }
            else if (cnt > 16) { lo = mid; tau = mid; } else hi = mid;
            if (!(mid > lo || mid < hi)) done = true;
        }
        if (__all(done)) break;
    }
    int c = 0;
#pragma unroll
    for (int e = 0; e < NV; ++e) c += (v[e] > tau) ? 1 : 0;
    const int base = lane & 15, g = lane >> 4;
    const int c0 = shf(c, base), c1 = shf(c, base + 16), c2 = shf(c, base + 32);
    int pos = (g > 0 ? c0 : 0) + (g > 1 ? c1 : 0) + (g > 2 ? c2 : 0);
#pragma unroll
    for (int e = 0; e < NV; ++e) {
        if (v[e] > tau && pos < 16) { lv[base * 16 + pos] = v[e]; li[base * 16 + pos] = idf(e); ++pos; }
    }
}
constexpr int KS_STRIDE = 136;
__device__ __forceinline__ void phase_topk(KP p, int wv, int l, int bid, int nb, float* lds) {
    bf16* k1s = (bf16*)lds;
    bf16* k2s = k1s + 128 * KS_STRIDE;
    const int t = tid_opaque(wv), lane = t & 63, w = t >> 6;
    float* lists = lds + (2 * 128 * KS_STRIDE * 2) / 4 + w * 1536;
    float* v1 = lists; int* i1 = (int*)(lists + 256); float* v2 = lists + 512; int* i2 = (int*)(lists + 768); float* v3 = lists + 1024; int* c3 = (int*)(lists + 1280);
    __syncthreads();
    for (int e = t; e < 2 * 128 * 16; e += NT) {
        const int tab = e >> 11, r = (e >> 4) & 127, c8 = e & 15;
        const float* src = (tab ? p->k2 : p->k1) + (size_t)l * 128 * 128 + r * 128 + c8 * 8;
        const float4 a = *(const float4*)src, b = *(const float4*)(src + 4);
        uint4 o; o.x = pk2(a.x, a.y); o.y = pk2(a.z, a.w); o.z = pk2(b.x, b.y); o.w = pk2(b.z, b.w);
        *(uint4*)((tab ? k2s : k1s) + r * KS_STRIDE + c8 * 8) = o;
    }
    __syncthreads();
    const int fr = lane & 15, fq = lane >> 4;
    for (int task = bid * NW + w; task < T * 8 / 16; task += nb * NW) {
        const int it0 = task * 16;
        const bf16* qrow = p->Qb + (size_t)(it0 + fr) * 256 + fq * 8;
        bf16x8_t bq[8];
#pragma unroll
        for (int ks = 0; ks < 8; ++ks) bq[ks] = *(const bf16x8_t*)(qrow + ks * 32);
        float s[32];
#pragma unroll
        for (int kt = 0; kt < 8; ++kt) {
            f32x4_t acc = {0.f, 0.f, 0.f, 0.f};
#pragma unroll
            for (int ks = 0; ks < 4; ++ks) {
                const bf16x8_t a = *(const bf16x8_t*)(k1s + (kt * 16 + fr) * KS_STRIDE + ks * 32 + fq * 8);
                acc = __builtin_amdgcn_mfma_f32_16x16x32_bf16(a, bq[ks], acc, 0, 0, 0);
            }
            s[kt * 4 + 0] = acc[0]; s[kt * 4 + 1] = acc[1]; s[kt * 4 + 2] = acc[2]; s[kt * 4 + 3] = acc[3];
        }
        select_top16<32>(s, [fq](int e) { return (e >> 2) * 16 + fq * 4 + (e & 3); }, v1, i1, lane);
#pragma unroll
        for (int kt = 0; kt < 8; ++kt) {
            f32x4_t acc = {0.f, 0.f, 0.f, 0.f};
#pragma unroll
            for (int ks = 0; ks < 4; ++ks) {
                const bf16x8_t a = *(const bf16x8_t*)(k2s + (kt * 16 + fr) * KS_STRIDE + ks * 32 + fq * 8);
                acc = __builtin_amdgcn_mfma_f32_16x16x32_bf16(a, bq[4 + ks], acc, 0, 0, 0);
            }
            s[kt * 4 + 0] = acc[0]; s[kt * 4 + 1] = acc[1]; s[kt * 4 + 2] = acc[2]; s[kt * 4 + 3] = acc[3];
        }
        select_top16<32>(s, [fq](int e) { return (e >> 2) * 16 + fq * 4 + (e & 3); }, v2, i2, lane);
        __builtin_amdgcn_wave_barrier();
        float cv[64];
#pragma unroll
        for (int a = 0; a < 4; ++a) {
            const float va = v1[fr * 16 + fq * 4 + a];
#pragma unroll
            for (int b = 0; b < 16; ++b) cv[a * 16 + b] = va + v2[fr * 16 + b];
        }
        select_top16<64>(cv, [fq](int e) { return (fq * 4 + (e >> 4)) * 16 + (e & 15); }, v3, c3, lane);
        __builtin_amdgcn_wave_barrier();
        float tv[4]; int tc[4];
#pragma unroll
        for (int k = 0; k < 4; ++k) { tv[k] = v3[fr * 16 + fq * 4 + k]; tc[k] = c3[fr * 16 + fq * 4 + k]; }
        float mx = fmaxf(fmaxf(tv[0], tv[1]), fmaxf(tv[2], tv[3]));
        mx = fmaxf(mx, shx(mx, 16, lane)); mx = fmaxf(mx, shx(mx, 32, lane));
        float ex[4], den = 0.f;
#pragma unroll
        for (int k = 0; k < 4; ++k) { ex[k] = expf(tv[k] - mx); den += ex[k]; }
        den += shx(den, 16, lane); den += shx(den, 32, lane);
        const float inv = 1.0f / den;
        int4 eo; float4 go;
        eo.x = i1[fr * 16 + (tc[0] >> 4)] * 128 + i2[fr * 16 + (tc[0] & 15)];
        eo.y = i1[fr * 16 + (tc[1] >> 4)] * 128 + i2[fr * 16 + (tc[1] & 15)];
        eo.z = i1[fr * 16 + (tc[2] >> 4)] * 128 + i2[fr * 16 + (tc[2] & 15)];
        eo.w = i1[fr * 16 + (tc[3] >> 4)] * 128 + i2[fr * 16 + (tc[3] & 15)];
        go = make_float4(ex[0] * inv, ex[1] * inv, ex[2] * inv, ex[3] * inv);
        *(int4*)(p->EIDX + (size_t)(it0 + fr) * 16 + fq * 4) = eo;
        *(float4*)(p->GATE + (size_t)(it0 + fr) * 16 + fq * 4) = go;
        __builtin_amdgcn_wave_barrier();
    }
    __syncthreads();
}

typedef unsigned u32x4_t __attribute__((ext_vector_type(4)));
using bf16x2_t = __attribute__((ext_vector_type(2))) __bf16;
__device__ __forceinline__ float dot2bf(unsigned a, unsigned b, float acc) { return __builtin_amdgcn_fdot2_f32_bf16(__builtin_bit_cast(bf16x2_t, a), __builtin_bit_cast(bf16x2_t, b), acc, false); }
struct RowBf { u32x4_t a, b; };
__device__ __forceinline__ RowBf ld_row(const bf16* tab, int e, int lane) {
    const u32x4_t* r = (const u32x4_t*)(tab + (size_t)e * D) + lane;
    RowBf x; x.a = r[0]; x.b = r[64]; return x;
}
__device__ __forceinline__ float row_dot(const RowBf& x, const RowBf& u) {
    float d = 0.f;
#pragma unroll
    for (int k = 0; k < 4; ++k) { d = dot2bf(x.a[k], u.a[k], d); d = dot2bf(x.b[k], u.b[k], d); }
    return d;
}
__device__ __forceinline__ void row_axpy(float (&acc)[16], float a, const RowBf& v) {
#pragma unroll
    for (int k = 0; k < 4; ++k) {
        acc[2 * k] += a * bflo(v.a[k]); acc[2 * k + 1] += a * bfhi(v.a[k]);
        acc[8 + 2 * k] += a * bflo(v.b[k]); acc[8 + 2 * k + 1] += a * bfhi(v.b[k]);
    }
}
__device__ __forceinline__ float transpose_reduce16(float (&part)[16], int lane) {
#pragma unroll
    for (int st = 32, n = 8; n >= 1; st >>= 1, n >>= 1) {
        const bool up = (lane & st) != 0;
#pragma unroll
        for (int s = 0; s < n; ++s) {
            const float lo = part[s], hi = part[s + n];
            const float recv = shx(up ? lo : hi, st, lane);
            part[s] = (up ? hi : lo) + recv;
        }
    }
    float v = part[0];
    v += shx(v, 2, lane); v += shx(v, 1, lane);
    return v;
}
typedef float f32x2_t __attribute__((ext_vector_type(2)));
__device__ __forceinline__ float transpose_reduce8(float (&part)[8], int lane) {
#pragma unroll
    for (int st = 32, n = 4; n >= 1; st >>= 1, n >>= 1) {
        const bool up = (lane & st) != 0;
#pragma unroll
        for (int s = 0; s < n; ++s) {
            const float lo = part[s], hi = part[s + n];
            const float recv = shx(up ? lo : hi, st, lane);
            part[s] = (up ? hi : lo) + recv;
        }
    }
    float v = part[0];
    v += shx(v, 4, lane); v += shx(v, 2, lane); v += shx(v, 1, lane);
    return v;
}
typedef int v4i_t __attribute__((ext_vector_type(4)));
typedef unsigned u32x4v __attribute__((ext_vector_type(4)));
constexpr int EXU_CAP = 960, EXU_TROW = 1040;
__device__ __forceinline__ void phase_expert_u(KP p, int wv, int l, int bid, int nb, float* lds) {
    const int lane = tid_opaque(wv) & 63, w = __builtin_amdgcn_readfirstlane(tid_opaque(wv) >> 6);
    const int G8 = nb >> 3;
    if (bid >= G8 * 8) return;
    const int rng = bid & 7, r = lane & 15, g = lane >> 4;
    const unsigned char* U = p->U8 + (size_t)l * PEER_N * D;
    const float* SU = p->SU + (size_t)l * PEER_N; const float* SV = p->SV + (size_t)l * PEER_N;
    unsigned char* wl = (unsigned char*)lds + w * 16384;
    unsigned* lpk = (unsigned*)wl; float* lgt = (float*)(wl + 4 * EXU_CAP); unsigned char* tile = wl + 8 * EXU_CAP;
    const unsigned long long ltmask = (1ull << lane) - 1ull;
    const int tstride = G8 * NW, Tn = (l == DEPTH - 1) ? TL : T, t0 = (bid >> 3) * NW + w;
    if (t0 >= Tn) return;
    const int nitem = (Tn - t0 + tstride - 1) / tstride;
    int i0 = 0;
    while (i0 < nitem) {
        const int nt = nitem - i0 < 16 ? nitem - i0 : 16;
        v4i_t afr[16];
        {
            const unsigned char* xa = p->XQ + (size_t)(t0 + (i0 + (r < nt ? r : nt - 1)) * tstride) * D + g * 16;
#pragma unroll
            for (int ks = 0; ks < 16; ++ks) afr[ks] = *(const v4i_t*)(xa + ks * 64);
        }
        const float sxv = p->SX[t0 + (i0 + (lane < nt ? lane : nt - 1)) * tstride];
        int e0[16], e1[16]; float g0[16], g1[16];
#pragma unroll
        for (int j = 0; j < 16; ++j) {
            const size_t tb = (size_t)(t0 + (i0 + (j < nt ? j : nt - 1)) * tstride) * NSEL;
            e0[j] = p->EIDX[tb + lane]; e1[j] = p->EIDX[tb + 64 + lane]; g0[j] = p->GATE[tb + lane]; g1[j] = p->GATE[tb + 64 + lane];
        }
        int cnt = 0, ndone = 0; bool open = true;
#pragma unroll
        for (int j = 0; j < 16; ++j) {
            const bool in0 = (e0[j] >> 11) == rng, in1 = (e1[j] >> 11) == rng;
            const unsigned long long m0 = __ballot(in0), m1 = __ballot(in1);
            const int c0 = __popcll(m0), c = c0 + __popcll(m1);
            open = open && j < nt && cnt + c <= EXU_CAP;
            if (open) {
                if (in0) { const int pos = cnt + __popcll(m0 & ltmask); lpk[pos] = (unsigned)e0[j] | ((unsigned)j << 14) | ((unsigned)lane << 18); lgt[pos] = g0[j]; }
                if (in1) { const int pos = cnt + c0 + __popcll(m1 & ltmask); lpk[pos] = (unsigned)e1[j] | ((unsigned)j << 14) | ((unsigned)(lane + 64) << 18); lgt[pos] = g1[j]; }
                cnt += c; ndone = j + 1;
            }
        }
        __builtin_amdgcn_wave_barrier();
        const int ntile = (cnt + 7) >> 3;
        u32x4v rw[8]; unsigned pkv = 0u; float gtv = 0.f, suv = 0.f, svv = 0.f;
#define EXU_ISSUE(q) do { const int idx_ = 8 * (q) + (lane & 7) < cnt ? 8 * (q) + (lane & 7) : cnt - 1; \
            pkv = lpk[idx_]; gtv = lgt[idx_]; const unsigned e_ = pkv & 0x3fffu; \
            _Pragma("unroll") for (int k = 0; k < 8; ++k) rw[k] = *(const u32x4v*)(U + ((size_t)(__builtin_amdgcn_readlane((int)pkv, k) & 0x3fff) << 10) + lane * 16); \
            suv = SU[e_]; svv = SV[e_]; } while (0)
        if (ntile > 0) EXU_ISSUE(0);
#pragma unroll 1
        for (int q = 0; q < ntile; ++q) {
#pragma unroll
            for (int k = 0; k < 8; ++k) *(u32x4v*)(tile + k * EXU_TROW + lane * 16) = rw[k];
            const unsigned pk = pkv; const float gt = gtv, su = suv, sv = svv;
            __builtin_amdgcn_wave_barrier();
            if (q + 1 < ntile) EXU_ISSUE(q + 1);
            v4i_t acc = {0, 0, 0, 0};
#pragma unroll
            for (int ks = 0; ks < 16; ++ks) {
                const v4i_t b = *(const v4i_t*)(tile + (r & 7) * EXU_TROW + ks * 64 + g * 16);
                acc = __builtin_amdgcn_mfma_i32_16x16x64_i8(afr[ks], b, acc, 0, 0, 0);
            }
            const int j = (int)((pk >> 14) & 15u), slot = (int)(pk >> 18);
            const int d = (j & 2) ? ((j & 1) ? acc[3] : acc[2]) : ((j & 1) ? acc[1] : acc[0]);
            const float sx = shf(sxv, j);
            if (r < 8 && g == (j >> 2) && 8 * q + r < cnt)
                p->ACT[(size_t)(t0 + (i0 + j) * tstride) * NSEL + slot] = gelu_tanh((float)d * su * sx) * gt * sv;
            __builtin_amdgcn_wave_barrier();
        }
#undef EXU_ISSUE
        i0 += ndone > 0 ? ndone : 1;
    }
}
__device__ __forceinline__ void phase_expert_v(KP p, int wv, int l, int bid, int nb) {
    const int lane = tid_opaque(wv) & 63, w = __builtin_amdgcn_readfirstlane(tid_opaque(wv) >> 6);
    const int G8 = nb >> 3;
    if (bid >= G8 * 8) return;
    const int sl = bid & 7, q = lane >> 3, c = lane & 7;
    const __amdgpu_buffer_rsrc_t rsV = __builtin_amdgcn_make_buffer_rsrc((void*)(p->V8 + (size_t)l * PEER_N * D), 0, PEER_N * D, 0x00020000);
    const int coff = sl * 128 + c * 16;
    const int tstride = G8 * NW, Tn = (l == DEPTH - 1) ? TL : T, t0 = (bid >> 3) * NW + w;
    const int nitem = t0 < Tn ? (Tn - t0 + tstride - 1) / tstride : 0;
    for (int j0 = 0; j0 < nitem; j0 += 8) {
        const bool valid = j0 + q < nitem;
        const int t = t0 + (valid ? j0 + q : nitem - 1) * tstride;
        int e[16]; float a[16];
        {
            const int4* ep = (const int4*)(p->EIDX + (size_t)t * NSEL + c * 16); const float4* ap = (const float4*)(p->ACT + (size_t)t * NSEL + c * 16);
#pragma unroll
            for (int k = 0; k < 4; ++k) { const int4 ev = ep[k]; const float4 av = ap[k];
                e[k * 4 + 0] = ev.x << 10; e[k * 4 + 1] = ev.y << 10; e[k * 4 + 2] = ev.z << 10; e[k * 4 + 3] = ev.w << 10;
                a[k * 4 + 0] = av.x; a[k * 4 + 1] = av.y; a[k * 4 + 2] = av.z; a[k * 4 + 3] = av.w; }
        }
        f32x2_t acc[8];
#pragma unroll
        for (int k = 0; k < 8; ++k) acc[k] = (f32x2_t){0.f, 0.f};
#pragma unroll 1
        for (int cc = 0; cc < 8; ++cc) {
            const int baddr = ((lane & 56) | cc) << 2;
#pragma unroll
            for (int hb = 0; hb < 2; ++hb) {
                u32x4v rv[8]; float av[8];
#pragma unroll
                for (int k = 0; k < 8; ++k) {
                    const int j = hb * 8 + k;
                    const int eo = __builtin_amdgcn_ds_bpermute(baddr, e[j]);
                    av[k] = __builtin_bit_cast(float, __builtin_amdgcn_ds_bpermute(baddr, __builtin_bit_cast(int, a[j])));
                    rv[k] = __builtin_amdgcn_raw_buffer_load_b128(rsV, eo + coff, 0, 0);
                }
#pragma unroll
                for (int k = 0; k < 8; ++k) {
                    const f32x2_t a2 = {av[k], av[k]};
                    acc[0] += a2 * __builtin_amdgcn_cvt_pk_f32_fp8((int)rv[k][0], false); acc[1] += a2 * __builtin_amdgcn_cvt_pk_f32_fp8((int)rv[k][0], true);
                    acc[2] += a2 * __builtin_amdgcn_cvt_pk_f32_fp8((int)rv[k][1], false); acc[3] += a2 * __builtin_amdgcn_cvt_pk_f32_fp8((int)rv[k][1], true);
                    acc[4] += a2 * __builtin_amdgcn_cvt_pk_f32_fp8((int)rv[k][2], false); acc[5] += a2 * __builtin_amdgcn_cvt_pk_f32_fp8((int)rv[k][2], true);
                    acc[6] += a2 * __builtin_amdgcn_cvt_pk_f32_fp8((int)rv[k][3], false); acc[7] += a2 * __builtin_amdgcn_cvt_pk_f32_fp8((int)rv[k][3], true);
                    __builtin_amdgcn_sched_barrier(0);
                }
            }
        }
        if (valid) {
            float* yr = p->Y + (size_t)t * D + coff;
            *(float4*)yr = make_float4(acc[0].x, acc[0].y, acc[1].x, acc[1].y);
            *(float4*)(yr + 4) = make_float4(acc[2].x, acc[2].y, acc[3].x, acc[3].y);
            *(float4*)(yr + 8) = make_float4(acc[4].x, acc[4].y, acc[5].x, acc[5].y);
            *(float4*)(yr + 12) = make_float4(acc[6].x, acc[6].y, acc[7].x, acc[7].y);
        }
    }
}

__device__ __forceinline__ void phase_ln2(KP p, int wv, int l, int bid, int nb) {
    const int lane = tid_opaque(wv) & 63, w = tid_opaque(wv) >> 6;
    for (int r = bid * NW + w; r < T; r += nb * NW) {
        float v[16], a[16], c[16];
        row_load(p->X1 + (size_t)r * D, v, lane);
        row_load(p->Y + (size_t)r * D, a, lane);
        const float* m = p->mod + ((size_t)l * 3 + mod_idx(r)) * 6144;
        row_load(m + 5120, c, lane);
#pragma unroll
        for (int i = 0; i < 16; ++i) v[i] = ALPHA * v[i] + c[i] * a[i];
        row_ln(v, lane);
        row_load(p->lnf_g + l * D, a, lane); row_load(p->lnf_b + l * D, c, lane);
#pragma unroll
        for (int i = 0; i < 16; ++i) v[i] = v[i] * a[i] + c[i];
        if (l == DEPTH - 1) { if (r < TL) row_store(p->out + (size_t)r * D, v, lane); continue; }
        row_store(p->X + (size_t)r * D, v, lane);
        const float* m2 = p->mod + ((size_t)(l + 1) * 3 + mod_idx(r)) * 6144;
        row_ln(v, lane);
        row_load(m2, a, lane); row_load(m2 + 1024, c, lane);
#pragma unroll
        for (int i = 0; i < 16; ++i) v[i] = v[i] * (1.0f + c[i]) + a[i];
        row_store_bf(p->H + (size_t)r * D, v, lane);
    }
}

constexpr int REP_MIXA = 1, REP_TOPK = 1, REP_EXPU = 1, REP_EXPV = 1, REP_RETOUT = 1, REP_GEMM = 1, REP_PRO = 1;
__global__ void __launch_bounds__(NT, 2) mega(Params p_unused) {
    extern __shared__ __attribute__((aligned(16))) unsigned char lds_raw[];
    cg::grid_group grid = cg::this_grid();
    const int bid = blockIdx.x, nb = gridDim.x;
    const int wv = __builtin_amdgcn_readfirstlane(threadIdx.x >> 6);
    float* lds = (float*)lds_raw;
    LAS unsigned char* ldsl = (LAS unsigned char*)lds_raw;
    volatile LAS unsigned* MISC = (volatile LAS unsigned*)(ldsl + MISC_OFF);
    for (int u = threadIdx.x; u < (LDS_BYTES - 131072) / 4; u += NT) ((LAS unsigned*)(ldsl + 131072))[u] = 0u;
    __syncthreads();
#define IS_LEAD() (wv == 0 && lane_opaque() == 0)
    (void)xcd_barrier_post(kparams()->ctl + CW_BAR, MISC + 8, IS_LEAD());
#define GRID_BAR() do { XcdBarrier b_; b_.bar = kparams()->ctl + CW_BAR; b_.x = xb_xcc_id(); b_.st = MISC + 8; b_.lead = IS_LEAD(); xcd_barrier(b_); } while (0)

    phase_mod1(kparams(), wv, bid, nb, lds);
    for (int rep = 0; rep < REP_PRO; ++rep) phase_weights(kparams(), wv, bid, nb, lds);
    grid.sync();
    phase_mod2(kparams(), wv, bid, nb);
    GRID_BAR();
    phase_lnmod(kparams(), wv, 0, bid, nb);
    GRID_BAR();
#define LAYER_BODY(l) do { \
        { KP p = kparams(); \
            pg8::Gemm g{p->H, p->WtIn + (size_t)l * DIN * D, T, DIN, D}; pg8::StaticOrder S; S.init(T, DIN, nb, bid); \
            pg8::EpiInProj E{p->P, p->rope}; \
            for (int rep = 0; rep < REP_GEMM; ++rep) pg8::gemm_phase<pg8::EpiInProj, pg8::StaticOrder, true, true>(ldsl, g, S, E, wv); \
        } \
        GRID_BAR(); \
        for (int rep = 0; rep < REP_MIXA; ++rep) phase_mix_a(kparams(), wv, l, bid, nb, lds); \
        GRID_BAR(); \
        phase_ret_scan(kparams(), wv, l, bid, nb); \
        GRID_BAR(); \
        for (int rep = 0; rep < REP_RETOUT; ++rep) phase_ret_out(kparams(), wv, l, bid, nb, lds); \
        GRID_BAR(); \
        { KP p = kparams(); \
            pg8::Gemm g{p->MIX, p->WtOut + (size_t)l * D * D, T, D, D}; pg8::StaticOrder S; S.init(T, D, nb, bid); \
            pg8::EpiF32 E{p->Y, D}; \
            for (int rep = 0; rep < REP_GEMM; ++rep) pg8::gemm_phase<pg8::EpiF32, pg8::StaticOrder, true, true>(ldsl, g, S, E, wv); \
        } \
        GRID_BAR(); \
        phase_ln1(kparams(), wv, l, bid, nb); \
        GRID_BAR(); \
        { KP p = kparams(); \
            pg8::Gemm g{p->H, p->WtQ + (size_t)l * 2048 * D, T, 2048, D}; pg8::StaticOrder S; S.init(T, 2048, nb, bid); \
            pg8::EpiBf16Plain E{p->Qb, 2048}; \
            for (int rep = 0; rep < REP_GEMM; ++rep) pg8::gemm_phase<pg8::EpiBf16Plain, pg8::StaticOrder, true, true>(ldsl, g, S, E, wv); \
        } \
        GRID_BAR(); \
        for (int rep = 0; rep < REP_TOPK; ++rep) phase_topk(kparams(), wv, l, bid, nb, lds); \
        GRID_BAR(); \
        for (int rep = 0; rep < REP_EXPU; ++rep) phase_expert_u(kparams(), wv, l, bid, nb, lds); \
        GRID_BAR(); \
        for (int rep = 0; rep < REP_EXPV; ++rep) phase_expert_v(kparams(), wv, l, bid, nb); \
        GRID_BAR(); \
        phase_ln2(kparams(), wv, l, bid, nb); \
        if (l + 1 < DEPTH) GRID_BAR(); \
    } while (0)
    LAYER_BODY(0); LAYER_BODY(1); LAYER_BODY(2); LAYER_BODY(3);
#undef LAYER_BODY
}

extern "C" void kernel_launch(void* const* d_in, const int* in_sizes, int n_in, void* d_out, int out_size, void* d_ws, size_t ws_size, hipStream_t stream) {
    static int grid_blocks = 0;
    if (!grid_blocks) {
        int dev = 0, cus = 0, per_cu = 0;
        (void)hipGetDevice(&dev);
        (void)hipDeviceGetAttribute(&cus, hipDeviceAttributeMultiprocessorCount, dev);
        (void)hipFuncSetAttribute((const void*)mega, hipFuncAttributeMaxDynamicSharedMemorySize, LDS_BYTES);
        (void)hipOccupancyMaxActiveBlocksPerMultiprocessor(&per_cu, mega, NT, LDS_BYTES);
        if (per_cu < 1) { fprintf(stderr, "occupancy query says %d blocks per CU\n", per_cu); per_cu = 1; }
        grid_blocks = cus;
    }
    Params p{};
    const float** ins = (const float**)&p;
    for (int i = 0; i < 22; ++i) ins[i] = (const float*)d_in[i];
    p.out = (float*)d_out;
    char* ws = (char*)d_ws;
    size_t off = 0;
    auto carve = [&](size_t bytes) { void* r = ws + off; off += (bytes + 255) & ~(size_t)255; return r; };
    p.ctl = (unsigned*)carve(CTL_BYTES);
    p.modp = (float*)carve((size_t)16 * DEPTH * 3 * 6144 * 4);
    p.mod = (float*)carve((size_t)DEPTH * 3 * 6144 * 4);
    p.rope = (float*)carve((size_t)192 * 16 * 2 * 4);
    p.WtIn = (bf16*)carve((size_t)DEPTH * DIN * D * 2);
    p.WtOut = (bf16*)carve((size_t)DEPTH * D * D * 2);
    p.WtQ = (bf16*)carve((size_t)DEPTH * 2048 * D * 2);
    p.X = (float*)carve((size_t)T * D * 4);
    p.H = (bf16*)carve((size_t)T * D * 2);
    p.P = (bf16*)carve((size_t)T * DIN * 2);
    p.KV = (float*)carve((size_t)2 * NB * NPOS * 4 * 4096 * 4);
    p.ST = (float*)carve((size_t)2 * NB * NPOS * 4 * 4096 * 4);
    p.MIX = (bf16*)carve((size_t)T * D * 2);
    p.ST16 = (bf16*)carve((size_t)2 * NB * NPOS * 4 * 4096 * 2);
    p.Qb = (bf16*)carve((size_t)T * 2048 * 2);
    p.U8 = (unsigned char*)carve((size_t)DEPTH * PEER_N * D);
    p.V8 = (unsigned char*)carve((size_t)DEPTH * PEER_N * D);
    p.XQ = (unsigned char*)carve((size_t)T * D);
    p.SX = (float*)carve((size_t)T * 4);
    p.SU = (float*)carve((size_t)DEPTH * PEER_N * 4);
    p.SV = (float*)carve((size_t)DEPTH * PEER_N * 4);
    p.Y = (float*)carve((size_t)T * D * 4);
    p.X1 = (float*)carve((size_t)T * D * 4);
    p.Q = (float*)carve((size_t)T * 2048 * 4);
    p.GATE = (float*)carve((size_t)T * NSEL * 4);
    p.ACT = (float*)carve((size_t)T * NSEL * 4);
    p.V1 = (float*)carve((size_t)T * 8 * 16 * 4);
    p.EIDX = (int*)carve((size_t)T * NSEL * 4);
    p.I1 = (int*)carve((size_t)T * 8 * 16 * 4);
    if (off > ws_size) { fprintf(stderr, "workspace too small: need %zu have %zu\n", off, ws_size); return; }
    (void)hipMemsetAsync(p.ctl, 0, CTL_BYTES, stream);
    void* args[] = {&p};
    hipError_t e = hipLaunchCooperativeKernel((void*)mega, dim3(grid_blocks), dim3(NT), args, LDS_BYTES, stream);
    if (e != hipSuccess) fprintf(stderr, "cooperative launch failed: %s (grid %d)\n", hipGetErrorString(e), grid_blocks);
}
```

```cpp
#include <hip/hip_runtime.h>
#include <hip/hip_cooperative_groups.h>
#include <cstdio>
#include <cstdint>
namespace cg = cooperative_groups;

constexpr int D = 1024, NB = 2, SEQ = 8192, DEPTH = 4, LC = 256, HD = 64;
constexpr int TL = NB * SEQ, TC = NB * LC, T = TL + TC;
constexpr int DIN = 2304;
constexpr int C_RQ = 0, C_RK = 256, C_RV = 512, C_RG = 768, C_SU = 1024, C_SV = 1280, C_AQ = 1536, C_AK = 2048, C_AV = 2176;
constexpr int NPOS = 66;
constexpr int PEER_N = 16384, NSEL = 128;
constexpr float LN_EPS = 1e-5f;
constexpr float ALPHA = 1.681792830507429f;
constexpr int NT = 512;
constexpr int NW = 8;
constexpr int LDS_BYTES = 147456;
constexpr int MISC_OFF = 131072 + 320;

typedef unsigned short bf16;
#define LAS __attribute__((address_space(3)))

struct Params {
    const float *x, *c, *ctx, *c_ctx, *w_mod, *b_mod, *w_in, *w_out, *rdf, *rdb, *sgu_w, *sgu_b, *sink, *lnm_g, *lnm_b, *wq, *k1, *k2, *pu, *pv, *lnf_g, *lnf_b;
    float* out;
    unsigned* ctl;
    float *modp, *mod, *rope, *KV, *ST, *Q, *GATE, *V1, *ACT;
    bf16 *X, *X1, *Y;
    bf16 *WtIn, *WtOut, *WtQ, *H, *P, *MIX, *Qb, *ST16;
    unsigned char *U8, *V8, *XQ;
    float *SU, *SV, *SX;
    int *EIDX, *I1;
};

__device__ __forceinline__ unsigned f2bf(float f) { unsigned u = __builtin_bit_cast(unsigned, f); return (u + 0x7fffu + ((u >> 16) & 1u)) >> 16; }
__device__ __forceinline__ unsigned pk2(float lo, float hi) { return f2bf(lo) | (f2bf(hi) << 16); }
__device__ __forceinline__ float bf2f(bf16 v) { return __builtin_bit_cast(float, (unsigned)v << 16); }
__device__ __forceinline__ float bflo(unsigned w) { return __builtin_bit_cast(float, w << 16); }
__device__ __forceinline__ float bfhi(unsigned w) { return __builtin_bit_cast(float, w & 0xffff0000u); }

__device__ __forceinline__ float gelu_tanh(float x) {
    const float u2 = x * (1.5957691216057308f + 0.07135481627f * x * x);
    return x * __builtin_amdgcn_rcpf(1.0f + __builtin_amdgcn_exp2f(-1.4426950408889634f * u2));
}
__device__ __forceinline__ float silu_f(float x) { return x / (1.0f + expf(-x)); }
__device__ __forceinline__ int chunk_row0(int b, int pos) { return pos < 2 ? TL + b * LC + pos * 128 : b * SEQ + (pos - 2) * 128; }
__device__ __forceinline__ int mod_idx(int r) { return r < TL ? r / SEQ : 2; }
__device__ __forceinline__ float log_sigmoid_f(float x) { return -log1pf(expf(-x)); }
typedef const __attribute__((address_space(4))) Params* KP;
__device__ __forceinline__ KP kparams() { KP k = (KP)__builtin_amdgcn_kernarg_segment_ptr(); asm volatile("" : "+s"(k)); return k; }
__device__ __forceinline__ float shx(float v, int m, int lane) { return __builtin_bit_cast(float, __builtin_amdgcn_ds_bpermute((lane ^ m) << 2, __builtin_bit_cast(int, v))); }
__device__ __forceinline__ int shx(int v, int m, int lane) { return __builtin_amdgcn_ds_bpermute((lane ^ m) << 2, v); }
__device__ __forceinline__ float shf(float v, int src) { return __builtin_bit_cast(float, __builtin_amdgcn_ds_bpermute(src << 2, __builtin_bit_cast(int, v))); }
__device__ __forceinline__ int shf(int v, int src) { return __builtin_amdgcn_ds_bpermute(src << 2, v); }
__device__ __forceinline__ float wave_sum(float v, int lane) {
#pragma unroll
    for (int o = 32; o >= 1; o >>= 1) v += shx(v, o, lane);
    return v;
}
__device__ __forceinline__ int lane_opaque() { unsigned m = ~0u; asm volatile("" : "+s"(m)); return (int)__builtin_amdgcn_mbcnt_hi(m, __builtin_amdgcn_mbcnt_lo(m, 0u)); }
__device__ __forceinline__ int tid_opaque(int wv) { return wv * 64 + lane_opaque(); }

namespace pg8 {
#define PG8_LAS __attribute__((address_space(3)))
typedef unsigned short bf16_t;
typedef short bf16x8 __attribute__((ext_vector_type(8)));
typedef float f32x4 __attribute__((ext_vector_type(4)));
typedef unsigned u32x4 __attribute__((ext_vector_type(4)));
constexpr int BM = 256, BK = 64, HALF = 128, HTB = HALF * BK * 2  , STAGE_BYTES = 8 * HTB, NXCD = 8, WGM = 8;

__host__ __device__ __forceinline__ int lds_byte(int r, int c) { const int st = (r >> 4) * 2 + (c >> 5), rr = r & 15, cc = c & 31, ob = rr * 64 + cc * 2; return st * 1024 + (ob ^ (((ob >> 9) & 1) << 5)); }
__host__ __device__ __forceinline__ void stage_rc(int b, int& R, int& C) { const int st = b / 1024, sb = b % 1024, swz = sb ^ (((sb >> 9) & 1) << 5); R = (st >> 1) * 16 + swz / 64; C = (st & 1) * 32 + (swz % 64) / 2; }
__host__ __device__ __forceinline__ int perm32(int rho) { const int n = rho >> 4, i = rho & 15; return 8 * (i >> 2) + 4 * n + (i & 3); }

struct Unit { int pm, pn; };
struct Gemm { const bf16_t* A; const bf16_t* Bt; int M, N, K; };

struct StaticOrder {
    int nM, nN, nwg, G, c;
    __host__ __device__ void init(int M, int N, int G_, int c_) { nM = M / BM; nN = N / BM; nwg = nM * nN; G = G_; c = c_; }
    __host__ __device__ bool next(int i, Unit& u) const {
        const long L = (long)i * G + c; if (L >= nwg) return false;
        int wgid = (int)L; { const int q = nwg / NXCD, r = nwg % NXCD, xcd = wgid % NXCD, off = wgid / NXCD; wgid = (xcd < r ? xcd * (q + 1) : r * (q + 1) + (xcd - r) * q) + off; }
        const int nig = WGM * nN, gid = wgid / nig, fm = gid * WGM, gsz = (nM - fm) < WGM ? (nM - fm) : WGM;
        u.pm = fm + ((wgid % nig) % gsz); u.pn = (wgid % nig) / gsz; return true;
    }
    __device__ __forceinline__ void a_ready(const Unit&) const {}
    __device__ __forceinline__ void done(const Unit&) const {}
};

__device__ __forceinline__ unsigned cvt_pk_bf16(float lo, float hi) { unsigned r; asm volatile("v_cvt_pk_bf16_f32 %0, %1, %2" : "=v"(r) : "v"(lo), "v"(hi)); return r; }
struct EpiInProj {
    static constexpr bool PERM = true, AFTER_DRAIN = false;
    bf16_t* P; const float* rope;
    __device__ __forceinline__ void operator()(const f32x4 (&acc)[2][2][4][2], const Unit& u, int wr, int wc, int fr, int fq) const {
        const int pn = u.pn; const bool lat = u.pm < 64; const int lane = fq * 16 + fr;
        const float sc = (pn == 1 || pn == 6 || pn == 7) ? 0.125f : 1.0f;
        const float sgn = fq < 2 ? -1.0f : 1.0f;
#pragma unroll
        for (int bj = 0; bj < 2; ++bj) {
            const bool roped = lat && (pn == 0 || pn == 1 || pn == 6 || pn == 7 || (pn == 8 && bj == 0));
#pragma unroll
            for (int ai = 0; ai < 2; ++ai)
#pragma unroll
                for (int m = 0; m < 4; ++m) {
                    const int row = u.pm * BM + ai * HALF + wr * 64 + m * 16 + fr;
                    f32x4 v0 = acc[ai][bj][m][0], v1 = acc[ai][bj][m][1];
                    if (roped) {
                        const int pos = row & 8191, idx = (wc & 1) ? 128 + (pos & 63) : (pos >> 6);
                        const float2* tb = (const float2*)rope + idx * 16 + 8 * (fq & 1);
#pragma unroll
                        for (int e = 0; e < 4; ++e) {
                            const float p0 = shx(v0[e], 32, lane), p1 = shx(v1[e], 32, lane);
                            const float2 c0 = tb[e], c1 = tb[4 + e];
                            v0[e] = v0[e] * c0.x + sgn * p0 * c0.y;
                            v1[e] = v1[e] * c1.x + sgn * p1 * c1.y;
                        }
                    }
                    v0 = v0 * sc; v1 = v1 * sc;
                    u32x4 w; w.x = cvt_pk_bf16(v0[0], v0[1]); w.y = cvt_pk_bf16(v0[2], v0[3]); w.z = cvt_pk_bf16(v1[0], v1[1]); w.w = cvt_pk_bf16(v1[2], v1[3]);
                    *(u32x4*)(P + (size_t)row * 2304 + pn * BM + bj * HALF + wc * 32 + fq * 8) = w;
                    __builtin_amdgcn_sched_barrier(0);
                }
        }
    }
};
struct EpiF32 {
    static constexpr bool PERM = false, AFTER_DRAIN = false;
    float* O; int ldc;
    __device__ __forceinline__ void operator()(const f32x4 (&acc)[2][2][4][2], const Unit& u, int wr, int wc, int fr, int fq) const {
#pragma unroll
        for (int ai = 0; ai < 2; ++ai)
#pragma unroll
            for (int m = 0; m < 4; ++m) {
                float* rowp = O + (size_t)(u.pm * BM + ai * HALF + wr * 64 + m * 16 + fr) * ldc + u.pn * BM + wc * 32 + fq * 4;
#pragma unroll
                for (int bj = 0; bj < 2; ++bj)
#pragma unroll
                    for (int n = 0; n < 2; ++n) *(f32x4*)(rowp + bj * HALF + n * 16) = acc[ai][bj][m][n];
            }
    }
};


struct EpiBf16Plain {
    static constexpr bool PERM = true, AFTER_DRAIN = false;
    bf16_t* O; int ldc;
    __device__ __forceinline__ void operator()(const f32x4 (&acc)[2][2][4][2], const Unit& u, int wr, int wc, int fr, int fq) const {
#pragma unroll
        for (int ai = 0; ai < 2; ++ai)
#pragma unroll
            for (int m = 0; m < 4; ++m) {
                bf16_t* rowp = O + (size_t)(u.pm * BM + ai * HALF + wr * 64 + m * 16 + fr) * ldc + u.pn * BM + wc * 32 + fq * 8;
#pragma unroll
                for (int bj = 0; bj < 2; ++bj) {
                    const f32x4 v0 = acc[ai][bj][m][0], v1 = acc[ai][bj][m][1];
                    u32x4 w; w.x = cvt_pk_bf16(v0[0], v0[1]); w.y = cvt_pk_bf16(v0[2], v0[3]); w.z = cvt_pk_bf16(v1[0], v1[1]); w.w = cvt_pk_bf16(v1[2], v1[3]);
                    *(u32x4*)(rowp + bj * HALF) = w;
                }
            }
    }
};
template <class Epi, class Sched, bool ALIGN_EPI = false, bool SP2 = false>
__device__ __forceinline__ void gemm_phase(PG8_LAS unsigned char* lds, const Gemm g, const Sched& S, const Epi& E, int wv) {
    int tid_ = wv * 64; { unsigned m_ = ~0u; asm volatile("" : "+s"(m_)); tid_ += (int)__builtin_amdgcn_mbcnt_hi(m_, __builtin_amdgcn_mbcnt_lo(m_, 0u)); }
    const int tid = tid_, wid = __builtin_amdgcn_readfirstlane(tid >> 6), lane = tid & 63, wr = wid >> 2, wc = wid & 3, fr = lane & 15, fq = lane >> 4;
    const int K = g.K, nt = K / BK;
    unsigned voffA[2], voffB[2];
#pragma unroll
    for (int i = 0; i < 2; ++i) { int R, C; stage_rc(tid * 16 + i * 8192, R, C); const int Rb = Epi::PERM ? ((R & ~31) + perm32(R & 31)) : R;
        voffA[i] = (unsigned)(R * K + C) * 2u; voffB[i] = (unsigned)(Rb * K + C) * 2u; }
    const size_t kstep = (size_t)(BK * 2);
    const size_t hstep = (size_t)HALF * K * 2;
    const size_t tstep = 2 * hstep;
    const unsigned ldsw = (unsigned)wid * 1024u;
    const int aoff = lds_byte(wr * 64 + fr, fq * 8), boff = lds_byte(wc * 32 + fr, fq * 8);
#define PG8_SA(b, h) (((b) * 2 + (h)) * HTB)
#define PG8_SB(b, h) ((4 + (b) * 2 + (h)) * HTB)
#define PG8_STAGE(bufoff, gbase, voff) do { _Pragma("unroll") for (int _i = 0; _i < 2; ++_i) \
        __builtin_amdgcn_global_load_lds((const unsigned*)((const char*)(gbase) + (voff)[_i]), (PG8_LAS unsigned*)(lds + (bufoff) + ldsw + _i * 8192), 16, 0, 0); } while (0)
#define PG8_LDA(dst, b, h) do { _Pragma("unroll") for (int m = 0; m < 4; ++m) _Pragma("unroll") for (int k = 0; k < 2; ++k) dst[m][k] = *(const PG8_LAS bf16x8*)(lds + PG8_SA(b, h) + aoff + m * 2048 + k * 1024); } while (0)
#define PG8_LDB(dst, b, h) do { _Pragma("unroll") for (int n = 0; n < 2; ++n) _Pragma("unroll") for (int k = 0; k < 2; ++k) dst[n][k] = *(const PG8_LAS bf16x8*)(lds + PG8_SB(b, h) + boff + n * 2048 + k * 1024); } while (0)
#define PG8_MMA(ai, bj, At, Bt) do { __builtin_amdgcn_s_setprio(1); _Pragma("unroll") for (int m = 0; m < 4; ++m) _Pragma("unroll") for (int n = 0; n < 2; ++n) _Pragma("unroll") for (int k = 0; k < 2; ++k) \
        acc[ai][bj][m][n] = __builtin_amdgcn_mfma_f32_16x16x32_bf16(Bt[n][k], At[m][k], acc[ai][bj][m][n], 0, 0, 0); __builtin_amdgcn_s_setprio(0); } while (0)
#define PG8_WAIT_V(n) asm volatile("s_waitcnt vmcnt(" #n ")" ::: "memory")
#define PG8_WAIT_L(n) asm volatile("s_waitcnt lgkmcnt(" #n ")" ::: "memory")
#define PG8_BAR __builtin_amdgcn_s_barrier()
#define PG8_SCHED __builtin_amdgcn_sched_barrier(0)
    Unit cur, nxt; int ui = 0;
    if (!S.next(0, cur)) return;
    f32x4 acc[2][2][4][2];
#pragma unroll
    for (int a = 0; a < 2; ++a)
#pragma unroll
        for (int b = 0; b < 2; ++b)
#pragma unroll
            for (int m = 0; m < 4; ++m)
#pragma unroll
                for (int n = 0; n < 2; ++n) acc[a][b][m][n] = (f32x4){0.f, 0.f, 0.f, 0.f};
    bf16x8 At[4][2], B0[2][2], B1[2][2];
    const char* cA = (const char*)g.A + (size_t)cur.pm * tstep; const char* cB = (const char*)g.Bt + (size_t)cur.pn * tstep;
    S.a_ready(cur);
    if constexpr (SP2) {
        PG8_STAGE(PG8_SB(0, 0), cB, voffB); PG8_STAGE(PG8_SB(0, 1), cB + hstep, voffB); PG8_STAGE(PG8_SA(0, 0), cA, voffA); PG8_STAGE(PG8_SA(0, 1), cA + hstep, voffA);
        if (wr == 1) PG8_BAR;
        PG8_WAIT_V(2); PG8_BAR;
        PG8_STAGE(PG8_SB(1, 0), cB + kstep, voffB); PG8_STAGE(PG8_SA(1, 0), cA + kstep, voffA); PG8_STAGE(PG8_SB(1, 1), cB + hstep + kstep, voffB);
        PG8_WAIT_V(6); PG8_BAR;
    } else {
        PG8_STAGE(PG8_SB(0, 0), cB, voffB); PG8_STAGE(PG8_SA(0, 0), cA, voffA); PG8_STAGE(PG8_SB(0, 1), cB + hstep, voffB); PG8_STAGE(PG8_SA(0, 1), cA + hstep, voffA);
        if (wr == 1) PG8_BAR;
        PG8_WAIT_V(4); PG8_BAR;
        PG8_STAGE(PG8_SB(1, 0), cB + kstep, voffB); PG8_STAGE(PG8_SA(1, 0), cA + kstep, voffA); PG8_STAGE(PG8_SB(1, 1), cB + hstep + kstep, voffB);
        PG8_WAIT_V(6); PG8_BAR;
    }
    for (;;) {
        const bool has_next = S.next(ui + 1, nxt);
        const char* nA = has_next ? (const char*)g.A + (size_t)nxt.pm * tstep : cA; const char* nB = has_next ? (const char*)g.Bt + (size_t)nxt.pn * tstep : cB;
        for (int t = 0; t < nt; t += 2) {
            const bool last = (t == nt - 2);
            const char* a1 = cA + (size_t)(t + 1) * kstep;
            const char* a2 = last ? nA : cA + (size_t)(t + 2) * kstep; const char* b2 = last ? nB : cB + (size_t)(t + 2) * kstep;
            const char* a3 = a2 + kstep; const char* b3 = b2 + kstep;
            if (last && has_next) S.a_ready(nxt);
            if constexpr (SP2) {
            PG8_LDB(B0, 0, 0); PG8_LDB(B1, 0, 1); PG8_SCHED; PG8_LDA(At, 0, 0); PG8_STAGE(PG8_SA(1, 1), a1 + hstep, voffA);
            PG8_WAIT_V(8); PG8_WAIT_L(0); PG8_BAR; PG8_MMA(0, 0, At, B0); PG8_MMA(0, 1, At, B1); PG8_BAR; PG8_SCHED;
            PG8_LDA(At, 0, 1); PG8_STAGE(PG8_SB(0, 0), b2, voffB); PG8_STAGE(PG8_SB(0, 1), b2 + hstep, voffB); PG8_STAGE(PG8_SA(0, 0), a2, voffA);
            PG8_WAIT_V(8); PG8_WAIT_L(0); PG8_BAR; PG8_MMA(1, 0, At, B0); PG8_MMA(1, 1, At, B1); PG8_BAR; PG8_SCHED;
            PG8_LDB(B0, 1, 0); PG8_LDB(B1, 1, 1); PG8_SCHED; PG8_LDA(At, 1, 0); PG8_STAGE(PG8_SA(0, 1), a2 + hstep, voffA);
            PG8_WAIT_V(8); PG8_WAIT_L(0); PG8_BAR; PG8_MMA(0, 0, At, B0); PG8_MMA(0, 1, At, B1); PG8_BAR; PG8_SCHED;
            PG8_LDA(At, 1, 1); PG8_STAGE(PG8_SB(1, 0), b3, voffB); PG8_STAGE(PG8_SB(1, 1), b3 + hstep, voffB); PG8_STAGE(PG8_SA(1, 0), a3, voffA);
            PG8_WAIT_V(8); PG8_WAIT_L(0); PG8_BAR; PG8_MMA(1, 0, At, B0); PG8_MMA(1, 1, At, B1); PG8_BAR; PG8_SCHED;
            } else {
            PG8_LDB(B0, 0, 0); PG8_SCHED; PG8_LDA(At, 0, 0); PG8_STAGE(PG8_SA(1, 1), a1 + hstep, voffA);
            PG8_WAIT_L(8); PG8_BAR; PG8_WAIT_L(0); PG8_MMA(0, 0, At, B0); PG8_BAR; PG8_SCHED;
            PG8_LDB(B1, 0, 1); PG8_STAGE(PG8_SB(0, 0), b2, voffB);
            PG8_BAR; PG8_WAIT_L(0); PG8_MMA(0, 1, At, B1); PG8_BAR;
            PG8_LDA(At, 0, 1); PG8_STAGE(PG8_SA(0, 0), a2, voffA);
            PG8_BAR; PG8_WAIT_L(0); PG8_MMA(1, 0, At, B0); PG8_BAR; PG8_SCHED;
            PG8_STAGE(PG8_SB(0, 1), b2 + hstep, voffB);
            PG8_WAIT_V(6); PG8_BAR; PG8_MMA(1, 1, At, B1); PG8_BAR;
            PG8_LDB(B0, 1, 0); PG8_SCHED; PG8_LDA(At, 1, 0); PG8_STAGE(PG8_SA(0, 1), a2 + hstep, voffA);
            PG8_WAIT_L(8); PG8_BAR; PG8_WAIT_L(0); PG8_MMA(0, 0, At, B0); PG8_BAR; PG8_SCHED;
            PG8_LDB(B1, 1, 1); PG8_STAGE(PG8_SB(1, 0), b3, voffB);
            PG8_BAR; PG8_WAIT_L(0); PG8_MMA(0, 1, At, B1); PG8_BAR;
            PG8_LDA(At, 1, 1); PG8_STAGE(PG8_SA(1, 0), a3, voffA);
            PG8_BAR; PG8_WAIT_L(0); PG8_MMA(1, 0, At, B0); PG8_BAR; PG8_SCHED;
            PG8_STAGE(PG8_SB(1, 1), b3 + hstep, voffB);
            PG8_WAIT_V(6); PG8_BAR; PG8_MMA(1, 1, At, B1); PG8_BAR;
            }
        }
        if constexpr (ALIGN_EPI) { if (wr == 0) PG8_BAR; }
        if constexpr (!Epi::AFTER_DRAIN) { E(acc, cur, wr, wc, fr, fq); S.done(cur); }
        if (!has_next) break;
#pragma unroll
        for (int a = 0; a < 2; ++a)
#pragma unroll
            for (int b = 0; b < 2; ++b)
#pragma unroll
                for (int m = 0; m < 4; ++m)
#pragma unroll
                    for (int n = 0; n < 2; ++n) acc[a][b][m][n] = (f32x4){0.f, 0.f, 0.f, 0.f};
        cur = nxt; cA = nA; cB = nB; ++ui;
        if constexpr (ALIGN_EPI) { if (wr == 1) PG8_BAR; }
    }
    PG8_WAIT_V(0);
    if constexpr (!ALIGN_EPI) { if (wr == 0) PG8_BAR; }
    PG8_BAR;
    if constexpr (Epi::AFTER_DRAIN) { E.fused(acc, cur, wr, wc, fr, fq, lds, wid, lane); S.done(cur); }
#undef PG8_SA
#undef PG8_SB
#undef PG8_STAGE
#undef PG8_LDA
#undef PG8_LDB
#undef PG8_MMA
#undef PG8_WAIT_V
#undef PG8_WAIT_L
#undef PG8_BAR
#undef PG8_SCHED
}
}
constexpr int CW_BAR = 4096;
constexpr size_t CTL_BYTES = 65536;
#define XB_TMO      128
#define XB_XCNT(j)  (256  + 64 * (j))
#define XB_XSUB(j)  (1280 + 64 * (j))
#define XB_XGEN(j)  (2304 + 64 * (j))
#define XB_TOP      3328
#define XB_TOPGEN   3392
#define XCD_BAR_WORDS 3456
#define XB_SPIN_CAP (1u << 18)

__device__ __forceinline__ unsigned xb_ld(unsigned* p)              { return __hip_atomic_load(p, __ATOMIC_RELAXED, __HIP_MEMORY_SCOPE_AGENT); }
__device__ __forceinline__ unsigned xb_add(unsigned* p, unsigned v) { return __hip_atomic_fetch_add(p, v, __ATOMIC_RELAXED, __HIP_MEMORY_SCOPE_AGENT); }
__device__ __forceinline__ unsigned xb_xcc_id() { return (unsigned)__builtin_amdgcn_s_getreg((3 << 11) | 20) & 0xFu; }
#define XB_SPIN(cond, bar) do { unsigned _sp = 0; while (cond) { __builtin_amdgcn_s_sleep(1); \
    if ((++_sp & 255u) == 0u) { if (xb_ld(&(bar)[XB_TMO])) break; if (_sp > XB_SPIN_CAP) { atomicAdd(&(bar)[XB_TMO], 1u); break; } } } } while (0)

struct XcdBarrier {
    unsigned* bar; unsigned x; bool lead;
    volatile LAS unsigned* st;
};

__device__ __forceinline__ XcdBarrier xcd_barrier_post(unsigned* bar, volatile LAS unsigned* st, bool lead) {
    XcdBarrier b; b.bar = bar; b.x = xb_xcc_id(); b.st = st; b.lead = lead;
    if (b.lead) (void)xb_add(&bar[XB_XCNT(b.x)], 1u);
    return b;
}
__device__ __forceinline__ void xcd_barrier_complete(unsigned* bar, unsigned x, unsigned& nloc, unsigned& nx) {
    const unsigned G = gridDim.x * gridDim.y * gridDim.z;
    unsigned sum, cnt, mine, sp = 0u;
    for (;;) {
        sum = 0u; cnt = 0u; mine = 0u;
#pragma unroll
        for (unsigned j = 0; j < 16; ++j) { const unsigned c = xb_ld(&bar[XB_XCNT(j)]); sum += c; cnt += (c > 0u) ? 1u : 0u; mine = (j == x) ? c : mine; }
        if (sum == G) break;
        __builtin_amdgcn_s_sleep(1);
        if ((++sp & 255u) == 0u) { if (xb_ld(&bar[XB_TMO])) break; if (sp > XB_SPIN_CAP) { atomicAdd(&bar[XB_TMO], 1u); break; } }
    }
    nloc = mine > 0u ? mine : 1u; nx = cnt > 0u ? cnt : 1u;
}

__device__ __forceinline__ void xcd_barrier(const XcdBarrier& b) {
    asm volatile("s_waitcnt vmcnt(0)" ::: "memory");
    __syncthreads();
    if (b.lead) {
        unsigned* bar = b.bar;
        __builtin_amdgcn_s_waitcnt(0);
        unsigned nloc = b.st[0], nx = b.st[1];
        if (nloc == 0u) { xcd_barrier_complete(bar, b.x, nloc, nx); b.st[0] = nloc; b.st[1] = nx; }
        const unsigned old = xb_add(&bar[XB_XSUB(b.x)], 1u);
        const unsigned gen = old / nloc;
        if (old + 1u == (gen + 1u) * nloc) {
            __builtin_amdgcn_fence(__ATOMIC_RELEASE, "agent");
            asm volatile("s_waitcnt vmcnt(0)" ::: "memory");
            const unsigned og = xb_add(&bar[XB_TOP], 1u);
            const unsigned tg = og / nx;
            if (og + 1u == (tg + 1u) * nx) xb_add(&bar[XB_TOPGEN], 1u);
            else XB_SPIN(xb_ld(&bar[XB_TOPGEN]) == tg, bar);
            __builtin_amdgcn_fence(__ATOMIC_ACQUIRE, "agent");
            xb_add(&bar[XB_XGEN(b.x)], 1u);
            asm volatile("s_waitcnt vmcnt(0)" ::: "memory");
        } else {
            XB_SPIN(xb_ld(&bar[XB_XGEN(b.x)]) == gen, bar);
            __builtin_amdgcn_fence(__ATOMIC_ACQUIRE, "agent");
            asm volatile("s_waitcnt vmcnt(0)" ::: "memory");
        }
    }
    __syncthreads();
}


__device__ __forceinline__ void phase_mod1(KP p, int wv, int bid, int nb, float* lds) {
    float (*red)[8][64] = (float (*)[8][64])lds;
    const int t = tid_opaque(wv), cn = t & 63, kg = t >> 6;
    for (int u = bid; u < DEPTH * 96 * 16; u += nb) {
        const int ks = u & 15, nblk = (u >> 4) % 96, l = u / (16 * 96);
        const int n = nblk * 64 + cn;
        float a0 = 0.f, a1 = 0.f, a2 = 0.f;
#pragma unroll
        for (int kk = 0; kk < 8; ++kk) {
            const int k = ks * 64 + kg * 8 + kk;
            const float w = p->w_mod[((size_t)l * D + k) * 6144 + n];
            a0 += silu_f(p->c[k]) * w; a1 += silu_f(p->c[D + k]) * w; a2 += silu_f(p->c_ctx[k]) * w;
        }
        __syncthreads();
        red[0][kg][cn] = a0; red[1][kg][cn] = a1; red[2][kg][cn] = a2;
        __syncthreads();
        if (t < 192) {
            const int v = t >> 6;
            float s = 0.f;
#pragma unroll
            for (int g = 0; g < 8; ++g) s += red[v][g][cn];
            p->modp[(((size_t)ks * DEPTH + l) * 3 + v) * 6144 + n] = s;
        }
    }
    __syncthreads();
}
__device__ __forceinline__ void phase_mod2(KP p, int wv, int bid, int nb) {
    for (int i = bid * NT + tid_opaque(wv); i < DEPTH * 3 * 6144; i += nb * NT) {
        const int n = i % 6144, l = i / (3 * 6144);
        float s = p->b_mod[l * 6144 + n];
        for (int ks = 0; ks < 16; ++ks) s += p->modp[(size_t)ks * DEPTH * 3 * 6144 + i];
        p->mod[i] = s;
    }
}
__device__ __forceinline__ void transpose_item(const float* W, int K, int N, bf16* WT, float* scr, int item, int lane) {
    const int nblk = N / 32, kb = item / nblk, nbk = item % nblk, k0 = 64 * kb, n0 = 32 * nbk;
#pragma unroll 8
    for (int i = 0; i < 32; ++i) { const int kk = 2 * i + (lane >> 5); scr[kk * 33 + (lane & 31)] = W[(size_t)(k0 + kk) * N + n0 + (lane & 31)]; }
    __builtin_amdgcn_wave_barrier();
    const int c = lane & 7;
#pragma unroll
    for (int j = 0; j < 4; ++j) { const int n = (lane >> 3) + 8 * j; const float* s = scr + (8 * c) * 33 + n;
        uint4 o; o.x = pk2(s[0 * 33], s[1 * 33]); o.y = pk2(s[2 * 33], s[3 * 33]); o.z = pk2(s[4 * 33], s[5 * 33]); o.w = pk2(s[6 * 33], s[7 * 33]);
        *(uint4*)(WT + (size_t)(n0 + n) * K + k0 + 8 * c) = o; }
    __builtin_amdgcn_wave_barrier();
}
__device__ __forceinline__ void phase_weights(KP p, int wv, int bid, int nb, float* lds) {
    const int lane = tid_opaque(wv) & 63, w = tid_opaque(wv) >> 6;
    float* scr = lds + 2048 + w * (64 * 33 + 16);
    constexpr int I_IN = 16 * 72, I_OUT = 16 * 32, I_Q = 16 * 64;
    constexpr int NITEMS = DEPTH * (I_IN + I_OUT + I_Q);
    for (int it = bid * NW + w; it < NITEMS; it += nb * NW) {
        int r = it;
        if (r < DEPTH * I_IN) { const int l = r / I_IN; transpose_item(p->w_in + (size_t)l * D * DIN, D, DIN, p->WtIn + (size_t)l * DIN * D, scr, r % I_IN, lane); continue; } r -= DEPTH * I_IN;
        if (r < DEPTH * I_OUT) { const int l = r / I_OUT; transpose_item(p->w_out + (size_t)l * D * D, D, D, p->WtOut + (size_t)l * D * D, scr, r % I_OUT, lane); continue; } r -= DEPTH * I_OUT;
        { const int l = r / I_Q; transpose_item(p->wq + (size_t)l * D * 2048, D, 2048, p->WtQ + (size_t)l * 2048 * D, scr, r % I_Q, lane); }
    }
    {
        const int lane_ = tid_opaque(wv) & 63, w_ = tid_opaque(wv) >> 6;
        for (int row0 = (bid * NW + w_) * 4; row0 < 2 * DEPTH * PEER_N; row0 += nb * NW * 4) {
            float v[4][16];
#pragma unroll
            for (int q = 0; q < 4; ++q) {
                const int row = row0 + q; const bool isv = row >= DEPTH * PEER_N; const int rr = isv ? row - DEPTH * PEER_N : row;
                const float* src_ = (isv ? p->pv : p->pu) + (size_t)rr * D;
#pragma unroll
                for (int i = 0; i < 4; ++i) { typedef float f4v_ __attribute__((ext_vector_type(4))); const f4v_ q4 = __builtin_nontemporal_load((const f4v_*)(src_ + i * 256 + lane_ * 4)); v[q][i * 4 + 0] = q4[0]; v[q][i * 4 + 1] = q4[1]; v[q][i * 4 + 2] = q4[2]; v[q][i * 4 + 3] = q4[3]; }
            }
#pragma unroll
            for (int q = 0; q < 4; ++q) {
                const int row = row0 + q; const bool isv = row >= DEPTH * PEER_N; const int rr = isv ? row - DEPTH * PEER_N : row;
                float m = 0.f;
#pragma unroll
                for (int i = 0; i < 16; ++i) m = fmaxf(m, fabsf(v[q][i]));
#pragma unroll
                for (int o = 32; o >= 1; o >>= 1) m = fmaxf(m, shx(m, o, lane_));
                unsigned* dst = (unsigned*)((isv ? p->V8 : p->U8) + (size_t)rr * D);
                if (!isv) {
                    const float inv = m > 0.f ? 127.0f / m : 0.f;
#pragma unroll
                    for (int i = 0; i < 4; ++i) {
                        const int q0 = (int)rintf(v[q][i * 4 + 0] * inv), q1 = (int)rintf(v[q][i * 4 + 1] * inv), q2 = (int)rintf(v[q][i * 4 + 2] * inv), q3 = (int)rintf(v[q][i * 4 + 3] * inv);
                        dst[i * 64 + lane_] = (unsigned)(q0 & 0xff) | ((unsigned)(q1 & 0xff) << 8) | ((unsigned)(q2 & 0xff) << 16) | ((unsigned)(q3 & 0xff) << 24);
                    }
                    if (lane_ == 0) p->SU[rr] = m * (1.0f / 127.0f);
                } else {
                    const float inv = m > 0.f ? 240.0f / m : 0.f;
#pragma unroll
                    for (int i = 0; i < 4; ++i) {
                        int pk = __builtin_amdgcn_cvt_pk_fp8_f32(v[q][i * 4 + 0] * inv, v[q][i * 4 + 1] * inv, 0, false);
                        pk = __builtin_amdgcn_cvt_pk_fp8_f32(v[q][i * 4 + 2] * inv, v[q][i * 4 + 3] * inv, pk, true);
                        dst[i * 64 + lane_] = (unsigned)pk;
                    }
                    if (lane_ == 0) p->SV[rr] = m * (1.0f / 240.0f);
                }
            }
        }
    }
    for (int i = bid * NT + tid_opaque(wv); i < 192 * 16; i += nb * NT) {
        const int idx = i >> 4, f = i & 15;
        const float inv = powf(10000.0f, -(float)f / 16.0f);
        const float ang = (float)(idx < 128 ? idx : idx - 128) * inv;
        p->rope[2 * i] = cosf(ang); p->rope[2 * i + 1] = sinf(ang);
    }
}

__device__ __forceinline__ void row_load(const float* src, float (&v)[16], int lane) {
#pragma unroll
    for (int i = 0; i < 4; ++i) { const float4 q = *(const float4*)(src + i * 256 + lane * 4); v[i * 4 + 0] = q.x; v[i * 4 + 1] = q.y; v[i * 4 + 2] = q.z; v[i * 4 + 3] = q.w; }
}
__device__ __forceinline__ void row_store(float* dst, const float (&v)[16], int lane) {
#pragma unroll
    for (int i = 0; i < 4; ++i) *(float4*)(dst + i * 256 + lane * 4) = make_float4(v[i * 4 + 0], v[i * 4 + 1], v[i * 4 + 2], v[i * 4 + 3]);
}
__device__ __forceinline__ void row_store_bf(bf16* dst, const float (&v)[16], int lane) {
#pragma unroll
    for (int i = 0; i < 4; ++i) *(uint2*)(dst + i * 256 + lane * 4) = make_uint2(pk2(v[i * 4 + 0], v[i * 4 + 1]), pk2(v[i * 4 + 2], v[i * 4 + 3]));
}
__device__ __forceinline__ void row_load_bf(const bf16* src, float (&v)[16], int lane) {
#pragma unroll
    for (int i = 0; i < 4; ++i) { const uint2 q = *(const uint2*)(src + i * 256 + lane * 4); v[i * 4 + 0] = bflo(q.x); v[i * 4 + 1] = bfhi(q.x); v[i * 4 + 2] = bflo(q.y); v[i * 4 + 3] = bfhi(q.y); }
}
__device__ __forceinline__ void row_ln(float (&v)[16], int lane) {
    float s = 0.f;
#pragma unroll
    for (int i = 0; i < 16; ++i) s += v[i];
    const float mu = wave_sum(s, lane) * (1.0f / D);
    float q = 0.f;
#pragma unroll
    for (int i = 0; i < 16; ++i) { v[i] -= mu; q += v[i] * v[i]; }
    const float rstd = rsqrtf(wave_sum(q, lane) * (1.0f / D) + LN_EPS);
#pragma unroll
    for (int i = 0; i < 16; ++i) v[i] *= rstd;
}
__device__ __forceinline__ const float* x_row(KP p, int l, int r) {
    if (l == 0) return r < TL ? p->x + (size_t)r * D : p->ctx + (size_t)(r - TL) * D;
    return nullptr;
}

__device__ __forceinline__ void phase_lnmod(KP p, int wv, int l, int bid, int nb) {
    const int lane = tid_opaque(wv) & 63, w = tid_opaque(wv) >> 6;
    for (int r = bid * NW + w; r < T; r += nb * NW) {
        float v[16], sh[16], sc[16];
        row_load(x_row(p, l, r), v, lane);
        const float* m = p->mod + ((size_t)l * 3 + mod_idx(r)) * 6144;
        row_load(m, sh, lane); row_load(m + 1024, sc, lane);
        row_ln(v, lane);
#pragma unroll
        for (int i = 0; i < 16; ++i) v[i] = v[i] * (1.0f + sc[i]) + sh[i];
        row_store_bf(p->H + (size_t)r * D, v, lane);
    }
}

typedef short bf16x8_t __attribute__((ext_vector_type(8)));
typedef short bf16x4_t __attribute__((ext_vector_type(4)));
typedef float f32x4_t __attribute__((ext_vector_type(4)));
#define MFMA16(a, b, c) __builtin_amdgcn_mfma_f32_16x16x32_bf16((a), (b), (c), 0, 0, 0)
constexpr int KROW = 72;
constexpr int TROW = 136;
__device__ __forceinline__ bf16x8_t lds_frag16(const bf16* p) { return *(const bf16x8_t*)p; }
__device__ __forceinline__ bf16x8_t lds_frag8x2(const bf16* p0, const bf16* p1) {
    const bf16x4_t a = *(const bf16x4_t*)p0, b = *(const bf16x4_t*)p1;
    bf16x8_t o; o[0] = a[0]; o[1] = a[1]; o[2] = a[2]; o[3] = a[3]; o[4] = b[0]; o[5] = b[1]; o[6] = b[2]; o[7] = b[3]; return o;
}
__device__ __forceinline__ bf16x8_t pack_p(const f32x4_t& x, const f32x4_t& y) {
    uint4 w; w.x = pk2(x[0], x[1]); w.y = pk2(x[2], x[3]); w.z = pk2(y[0], y[1]); w.w = pk2(y[2], y[3]);
    return __builtin_bit_cast(bf16x8_t, w);
}
__device__ __forceinline__ void st_tr8(bf16* dst_col0, int stride, const uint4& v) {
    dst_col0[0 * stride] = (bf16)(v.x & 0xffffu); dst_col0[1 * stride] = (bf16)(v.x >> 16);
    dst_col0[2 * stride] = (bf16)(v.y & 0xffffu); dst_col0[3 * stride] = (bf16)(v.y >> 16);
    dst_col0[4 * stride] = (bf16)(v.z & 0xffffu); dst_col0[5 * stride] = (bf16)(v.z >> 16);
    dst_col0[6 * stride] = (bf16)(v.w & 0xffffu); dst_col0[7 * stride] = (bf16)(v.w >> 16);
}

constexpr int ATT_BUF = 128 * KROW + 64 * TROW;
__device__ __forceinline__ void att_unit(KP p, int wv, int l, int u, bf16* lds) {
    const int t = tid_opaque(wv), lane = t & 63, w = t >> 6, r = lane & 15, g = lane >> 4;
    const bool lat = u < 256;
    int b, n, hkv;
    if (lat) { hkv = u & 1; n = (u >> 1) & 63; b = u >> 7; } else { const int v = u - 256; hkv = v & 1; n = (v >> 1) & 1; b = v >> 2; }
    const int hq = hkv * 4 + (w >> 1), qh = w & 1;
    const int qrow0 = (lat ? b * SEQ + n * 128 : TL + b * LC + n * 128) + qh * 64;
    int kb_lo = 0, kb_hi = -1;
    if (lat) { kb_lo = n > 0 ? n - 1 : 0; kb_hi = n < 63 ? n + 1 : 63; }
    const int nloc = kb_hi - kb_lo + 1, nblk = nloc + 2;
    const bf16* P = p->P;
    bf16x8_t qf[4][2];
#pragma unroll
    for (int qt = 0; qt < 4; ++qt)
#pragma unroll
        for (int ks = 0; ks < 2; ++ks) qf[qt][ks] = *(const bf16x8_t*)(P + (size_t)(qrow0 + qt * 16 + r) * DIN + C_AQ + hq * 64 + ks * 32 + g * 8);
    const float LOG2E = 1.4426950408889634f;
    const float sink2 = p->sink[l * 8 + hq] * LOG2E;
    float m[4], lsum[4];
    f32x4_t ot[4][4];
#pragma unroll
    for (int qt = 0; qt < 4; ++qt) { m[qt] = sink2; lsum[qt] = g == 0 ? 1.0f : 0.0f; }
#pragma unroll
    for (int dt = 0; dt < 4; ++dt)
#pragma unroll
        for (int qt = 0; qt < 4; ++qt) ot[dt][qt] = (f32x4_t){0.f, 0.f, 0.f, 0.f};
    uint4 kreg0, kreg1, vreg0, vreg1;
#define ATT_ROW0(bi) ((bi) < nloc ? b * SEQ + (kb_lo + (bi)) * 128 : TL + b * LC + ((bi) - nloc) * 128)
    const int key0 = t >> 3, key1 = key0 + 64, c8 = t & 7;
#define ATT_ISSUE(bi) do { const bf16* src_ = P + (size_t)(ATT_ROW0(bi) + key0) * DIN + hkv * 64 + c8 * 8; \
        kreg0 = *(const uint4*)(src_ + C_AK); vreg0 = *(const uint4*)(src_ + C_AV); \
        kreg1 = *(const uint4*)(src_ + 64 * DIN + C_AK); vreg1 = *(const uint4*)(src_ + 64 * DIN + C_AV); } while (0)
#define ATT_STAGE(buf) do { \
        *(uint4*)((buf) + key0 * KROW + c8 * 8) = kreg0; *(uint4*)((buf) + key1 * KROW + c8 * 8) = kreg1; \
        st_tr8((buf) + 128 * KROW + (c8 * 8) * TROW + key0, TROW, vreg0); st_tr8((buf) + 128 * KROW + (c8 * 8) * TROW + key1, TROW, vreg1); } while (0)
    __syncthreads();
    ATT_ISSUE(0);
    for (int bi = 0; bi < nblk; ++bi) {
        bf16* buf = lds + (bi & 1) * ATT_BUF;
        ATT_STAGE(buf);
        __syncthreads();
        if (bi + 1 < nblk) ATT_ISSUE(bi + 1);
        const bf16* Ks = buf; const bf16* Vt = buf + 128 * KROW;
        const int band = (bi < nloc) ? (kb_lo + bi) - n : 0;
#pragma unroll 1
        for (int sub = 0; sub < 2; ++sub) {
            f32x4_t st[4][4];
#pragma unroll
            for (int kt = 0; kt < 4; ++kt) {
#pragma unroll
                for (int qt = 0; qt < 4; ++qt) st[kt][qt] = (f32x4_t){0.f, 0.f, 0.f, 0.f};
#pragma unroll
                for (int ks = 0; ks < 2; ++ks) {
                    const bf16x8_t a = lds_frag16(Ks + (sub * 64 + kt * 16 + r) * KROW + ks * 32 + g * 8);
#pragma unroll
                    for (int qt = 0; qt < 4; ++qt) st[kt][qt] = MFMA16(a, qf[qt][ks], st[kt][qt]);
                }
            }
#pragma unroll
            for (int qt = 0; qt < 4; ++qt) {
                const int il = qh * 64 + qt * 16 + r;
                float mloc = -INFINITY;
#pragma unroll
                for (int kt = 0; kt < 4; ++kt)
#pragma unroll
                    for (int i = 0; i < 4; ++i) {
                        const int jl = sub * 64 + kt * 16 + g * 4 + i;
                        float s = st[kt][qt][i] * LOG2E;
                        if (band < 0) { if (jl < il) s = -INFINITY; } else if (band > 0) { if (jl > il) s = -INFINITY; }
                        st[kt][qt][i] = s; mloc = fmaxf(mloc, s);
                    }
                mloc = fmaxf(mloc, shx(mloc, 16, lane)); mloc = fmaxf(mloc, shx(mloc, 32, lane));
                const float mnew = fmaxf(m[qt], mloc);
                const float alpha = __builtin_amdgcn_exp2f(m[qt] - mnew);
                m[qt] = mnew;
                float ps = 0.f;
#pragma unroll
                for (int kt = 0; kt < 4; ++kt)
#pragma unroll
                    for (int i = 0; i < 4; ++i) { const float e = __builtin_amdgcn_exp2f(st[kt][qt][i] - mnew); st[kt][qt][i] = e; ps += e; }
                lsum[qt] = lsum[qt] * alpha + ps;
#pragma unroll
                for (int dt = 0; dt < 4; ++dt) ot[dt][qt] = ot[dt][qt] * alpha;
            }
#pragma unroll
            for (int kp = 0; kp < 2; ++kp) {
                bf16x8_t pf[4];
#pragma unroll
                for (int qt = 0; qt < 4; ++qt) pf[qt] = pack_p(st[2 * kp][qt], st[2 * kp + 1][qt]);
#pragma unroll
                for (int dt = 0; dt < 4; ++dt) {
                    const bf16* vrow = Vt + (dt * 16 + r) * TROW + sub * 64 + g * 4;
                    const bf16x8_t a = lds_frag8x2(vrow + (2 * kp) * 16, vrow + (2 * kp + 1) * 16);
#pragma unroll
                    for (int qt = 0; qt < 4; ++qt) ot[dt][qt] = MFMA16(a, pf[qt], ot[dt][qt]);
                }
            }
        }
    }
#pragma unroll
    for (int qt = 0; qt < 4; ++qt) {
        float ls = lsum[qt]; ls += shx(ls, 16, lane); ls += shx(ls, 32, lane);
        const float inv = 1.0f / ls;
        bf16* orow = p->MIX + (size_t)(qrow0 + qt * 16 + r) * D + 512 + hq * 64 + g * 4;
#pragma unroll
        for (int dt = 0; dt < 4; ++dt) {
            const f32x4_t o = ot[dt][qt] * inv;
            *(uint2*)(orow + dt * 16) = make_uint2(pk2(o[0], o[1]), pk2(o[2], o[3]));
        }
    }
}

__device__ __forceinline__ size_t kv_off(int dir, int b, int pos, int h) { return ((((size_t)dir * NB + b) * NPOS + pos) * 4 + h) * 4096; }
__device__ __forceinline__ void ret_kv_unit(KP p, int wv, int l, int u, bf16* lds) {
    const int h = u & 3, pos = (u >> 2) % NPOS, b = u / (4 * NPOS);
    const int t = tid_opaque(wv), lane = t & 63, w = t >> 6, r = lane & 15, g = lane >> 4;
    bf16* Ktf = lds; bf16* Ktb = lds + 64 * TROW; bf16* Vt = lds + 2 * 64 * TROW;
    const float lgf = log_sigmoid_f(p->rdf[l * 4 + h]), lgb = log_sigmoid_f(p->rdb[l * 4 + h]);
    const int r0 = chunk_row0(b, pos);
    const bf16* P = p->P;
    __syncthreads();
#pragma unroll
    for (int q = 0; q < 2; ++q) {
        const int pc = t + q * NT, j = pc >> 3, c8 = pc & 7;
        const bf16* src = P + (size_t)(r0 + j) * DIN + h * 64 + c8 * 8;
        const uint4 kv = *(const uint4*)(src + C_RK), vv = *(const uint4*)(src + C_RV);
        const float wf = expf(lgf * (float)(127 - j)), wb = expf(lgb * (float)j);
        uint4 kf, kb;
        kf.x = pk2(bflo(kv.x) * wf, bfhi(kv.x) * wf); kf.y = pk2(bflo(kv.y) * wf, bfhi(kv.y) * wf); kf.z = pk2(bflo(kv.z) * wf, bfhi(kv.z) * wf); kf.w = pk2(bflo(kv.w) * wf, bfhi(kv.w) * wf);
        kb.x = pk2(bflo(kv.x) * wb, bfhi(kv.x) * wb); kb.y = pk2(bflo(kv.y) * wb, bfhi(kv.y) * wb); kb.z = pk2(bflo(kv.z) * wb, bfhi(kv.z) * wb); kb.w = pk2(bflo(kv.w) * wb, bfhi(kv.w) * wb);
        st_tr8(Ktf + (c8 * 8) * TROW + j, TROW, kf);
        st_tr8(Ktb + (c8 * 8) * TROW + j, TROW, kb);
        st_tr8(Vt + (c8 * 8) * TROW + j, TROW, vv);
    }
    __syncthreads();
    const int dir = w >> 2, dvt = w & 3;
    const bf16* Kt = dir ? Ktb : Ktf;
    f32x4_t acc[4];
#pragma unroll
    for (int dkt = 0; dkt < 4; ++dkt) acc[dkt] = (f32x4_t){0.f, 0.f, 0.f, 0.f};
#pragma unroll
    for (int ks = 0; ks < 4; ++ks) {
        const bf16x8_t a = lds_frag16(Vt + (dvt * 16 + r) * TROW + ks * 32 + g * 8);
#pragma unroll
        for (int dkt = 0; dkt < 4; ++dkt) acc[dkt] = MFMA16(a, lds_frag16(Kt + (dkt * 16 + r) * TROW + ks * 32 + g * 8), acc[dkt]);
    }
    float* o = p->KV + kv_off(dir, b, pos, h);
#pragma unroll
    for (int dkt = 0; dkt < 4; ++dkt)
#pragma unroll
        for (int i = 0; i < 4; ++i) o[(dvt * 16 + g * 4 + i) * 64 + dkt * 16 + r] = acc[dkt][i];
}

__device__ __forceinline__ void phase_ret_scan(KP p, int wv, int l, int bid, int nb) {
    for (int i = bid * NT + tid_opaque(wv); i < 2 * NB * 4 * 4096; i += nb * NT) {
        const int e = i & 4095, h = (i >> 12) & 3, b = (i >> 14) & 1, dir = i >> 15;
        const float lg = log_sigmoid_f(dir ? p->rdb[l * 4 + h] : p->rdf[l * 4 + h]);
        const float cdec = expf(128.0f * lg);
        const float* kv = p->KV; bf16* st = p->ST16;
        float v[NPOS];
#pragma unroll
        for (int step = 0; step < NPOS; ++step) {
            const int pos = dir == 0 ? step : (step == 0 ? 1 : (step == 1 ? 0 : 67 - step));
            v[step] = kv[kv_off(dir, b, pos, h) + e];
        }
        float s = 0.f;
#pragma unroll
        for (int step = 0; step < NPOS; ++step) {
            const int pos = dir == 0 ? step : (step == 0 ? 1 : (step == 1 ? 0 : 67 - step));
            st[kv_off(dir, b, pos, h) + e] = (bf16)f2bf(s);
            s = s * cdec + v[step];
        }
    }
}

constexpr int RO_HEAD = 128 * KROW + 64 * TROW + 2 * 64 * KROW;
constexpr int RO_TAB = 2 * RO_HEAD;
__device__ __forceinline__ void ret_out_unit(KP p, int wv, int l, int u, bf16* lds) {
    const int hp = u & 1, pos = (u >> 1) % NPOS, b = u / (2 * NPOS);
    if (l == DEPTH - 1 && pos < 2) return;
    const int t = tid_opaque(wv), lane = t & 63, w = t >> 6, r = lane & 15, g = lane >> 4;
    const int r0 = chunk_row0(b, pos);
    const bf16* P = p->P;
    float* tabs = (float*)(lds + RO_TAB);
    __syncthreads();
#pragma unroll
    for (int q = 0; q < 4; ++q) {
        const int pc = t + q * NT, hh = pc >> 10, j = (pc >> 3) & 127, c8 = pc & 7, h = hp * 2 + hh;
        bf16* base = lds + hh * RO_HEAD;
        const bf16* src = P + (size_t)(r0 + j) * DIN + h * 64 + c8 * 8;
        *(uint4*)(base + j * KROW + c8 * 8) = *(const uint4*)(src + C_RK);
        const uint4 vv = *(const uint4*)(src + C_RV);
        st_tr8(base + 128 * KROW + (c8 * 8) * TROW + j, TROW, vv);
    }
#pragma unroll
    for (int q = 0; q < 4; ++q) {
        const int pc = t + q * NT, hh = pc >> 10, dir = (pc >> 9) & 1, dv = (pc >> 3) & 63, c8 = pc & 7, h = hp * 2 + hh;
        const uint4 sv = *(const uint4*)(p->ST16 + kv_off(dir, b, pos, h) + dv * 64 + c8 * 8);
        *(uint4*)(lds + hh * RO_HEAD + 128 * KROW + 64 * TROW + dir * 64 * KROW + dv * KROW + c8 * 8) = sv;
    }
    if (t < 4 * 132) {
        const int hh = t / 264, dir = (t / 132) & 1, k = t % 132, h = hp * 2 + hh;
        const float lg = log_sigmoid_f(dir ? p->rdb[l * 4 + h] : p->rdf[l * 4 + h]);
        tabs[(hh * 2 + dir) * 132 + k] = expf(lg * (float)k);
    }
    __syncthreads();
    const int hh = w >> 2, h = hp * 2 + hh, qw = w & 3;
    const bf16* Ks = lds + hh * RO_HEAD; const bf16* Vt = Ks + 128 * KROW; const bf16* Sft = Vt + 64 * TROW; const bf16* Sbt = Sft + 64 * KROW;
    const float* pf = tabs + (hh * 2) * 132; const float* pb = pf + 132;
    bf16x8_t qf[2][2];
#pragma unroll
    for (int qt = 0; qt < 2; ++qt)
#pragma unroll
        for (int ks = 0; ks < 2; ++ks) qf[qt][ks] = *(const bf16x8_t*)(P + (size_t)(r0 + qw * 32 + qt * 16 + r) * DIN + C_RQ + h * 64 + ks * 32 + g * 8);
    f32x4_t accI[4][2], accF[4][2], accB[4][2];
#pragma unroll
    for (int dt = 0; dt < 4; ++dt)
#pragma unroll
        for (int qt = 0; qt < 2; ++qt) { accI[dt][qt] = (f32x4_t){0.f, 0.f, 0.f, 0.f}; accF[dt][qt] = accI[dt][qt]; accB[dt][qt] = accI[dt][qt]; }
#pragma unroll
    for (int dt = 0; dt < 4; ++dt)
#pragma unroll
        for (int ks = 0; ks < 2; ++ks) {
            const bf16x8_t af = lds_frag16(Sft + (dt * 16 + r) * KROW + ks * 32 + g * 8), ab = lds_frag16(Sbt + (dt * 16 + r) * KROW + ks * 32 + g * 8);
#pragma unroll
            for (int qt = 0; qt < 2; ++qt) { accF[dt][qt] = MFMA16(af, qf[qt][ks], accF[dt][qt]); accB[dt][qt] = MFMA16(ab, qf[qt][ks], accB[dt][qt]); }
        }
#pragma unroll 1
    for (int sub = 0; sub < 2; ++sub) {
        f32x4_t st[4][2];
#pragma unroll
        for (int kt = 0; kt < 4; ++kt) {
#pragma unroll
            for (int qt = 0; qt < 2; ++qt) st[kt][qt] = (f32x4_t){0.f, 0.f, 0.f, 0.f};
#pragma unroll
            for (int ks = 0; ks < 2; ++ks) {
                const bf16x8_t a = lds_frag16(Ks + (sub * 64 + kt * 16 + r) * KROW + ks * 32 + g * 8);
#pragma unroll
                for (int qt = 0; qt < 2; ++qt) st[kt][qt] = MFMA16(a, qf[qt][ks], st[kt][qt]);
            }
        }
#pragma unroll
        for (int qt = 0; qt < 2; ++qt) {
            const int il = qw * 32 + qt * 16 + r;
#pragma unroll
            for (int kt = 0; kt < 4; ++kt)
#pragma unroll
                for (int i = 0; i < 4; ++i) {
                    const int rel = il - (sub * 64 + kt * 16 + g * 4 + i);
                    const float wgt = rel > 0 ? pf[rel] : (rel < 0 ? pb[-rel] : 2.0f);
                    st[kt][qt][i] *= wgt;
                }
        }
#pragma unroll
        for (int kp = 0; kp < 2; ++kp) {
            bf16x8_t pfr[2];
#pragma unroll
            for (int qt = 0; qt < 2; ++qt) pfr[qt] = pack_p(st[2 * kp][qt], st[2 * kp + 1][qt]);
#pragma unroll
            for (int dt = 0; dt < 4; ++dt) {
                const bf16* vrow = Vt + (dt * 16 + r) * TROW + sub * 64 + g * 4;
                const bf16x8_t a = lds_frag8x2(vrow + (2 * kp) * 16, vrow + (2 * kp + 1) * 16);
#pragma unroll
                for (int qt = 0; qt < 2; ++qt) accI[dt][qt] = MFMA16(a, pfr[qt], accI[dt][qt]);
            }
        }
    }
#pragma unroll
    for (int qt = 0; qt < 2; ++qt) {
        const int il = qw * 32 + qt * 16 + r;
        const float qfd = pf[il + 1], qbd = pb[128 - il];
        float s = 0.f;
#pragma unroll
        for (int dt = 0; dt < 4; ++dt) { accI[dt][qt] = accI[dt][qt] + accF[dt][qt] * qfd + accB[dt][qt] * qbd; s += (accI[dt][qt][0] + accI[dt][qt][1]) + (accI[dt][qt][2] + accI[dt][qt][3]); }
        s += shx(s, 16, lane); s += shx(s, 32, lane);
        const float mu = s * (1.0f / 64.0f);
        float qq = 0.f;
#pragma unroll
        for (int dt = 0; dt < 4; ++dt) { accI[dt][qt] = accI[dt][qt] - mu; qq += (accI[dt][qt][0] * accI[dt][qt][0] + accI[dt][qt][1] * accI[dt][qt][1]) + (accI[dt][qt][2] * accI[dt][qt][2] + accI[dt][qt][3] * accI[dt][qt][3]); }
        qq += shx(qq, 16, lane); qq += shx(qq, 32, lane);
        const float rstd = rsqrtf(qq * (1.0f / 64.0f) + LN_EPS);
        const size_t row = (size_t)(r0 + il);
#pragma unroll
        for (int dt = 0; dt < 4; ++dt) {
            const uint2 gw = *(const uint2*)(P + row * DIN + C_RG + h * 64 + dt * 16 + g * 4);
            const f32x4_t o = accI[dt][qt] * rstd;
            const float o0 = o[0] * silu_f(bflo(gw.x)), o1 = o[1] * silu_f(bfhi(gw.x)), o2 = o[2] * silu_f(bflo(gw.y)), o3 = o[3] * silu_f(bfhi(gw.y));
            *(uint2*)(p->MIX + row * D + h * 64 + dt * 16 + g * 4) = make_uint2(pk2(o0, o1), pk2(o2, o3));
        }
    }
}

__device__ __forceinline__ void sgu_unit(KP p, int wv, int l, int u, bf16* lds) {
    const int grp = u & 3, pos = (u >> 2) % NPOS, b = u / (4 * NPOS);
    if (l == DEPTH - 1 && pos < 2) return;
    const int t = tid_opaque(wv), lane = t & 63, w = t >> 6, r = lane & 15, g = lane >> 4;
    const int r0 = chunk_row0(b, pos);
    const bf16* P = p->P;
    bf16* vnT = lds;
    __syncthreads();
    {
        const int j = t >> 2, qd = t & 3;
        const uint4* src = (const uint4*)(P + (size_t)(r0 + j) * DIN + C_SV + grp * 64 + qd * 16);
        const uint4 a = src[0], c = src[1];
        float v[16] = {bflo(a.x), bfhi(a.x), bflo(a.y), bfhi(a.y), bflo(a.z), bfhi(a.z), bflo(a.w), bfhi(a.w), bflo(c.x), bfhi(c.x), bflo(c.y), bfhi(c.y), bflo(c.z), bfhi(c.z), bflo(c.w), bfhi(c.w)};
        float s = 0.f;
#pragma unroll
        for (int d = 0; d < 16; ++d) { v[d] = gelu_tanh(v[d]); s += v[d]; }
        s += shx(s, 1, lane); s += shx(s, 2, lane);
        const float mu = s * (1.0f / 64.0f);
        float qq = 0.f;
#pragma unroll
        for (int d = 0; d < 16; ++d) { v[d] -= mu; qq += v[d] * v[d]; }
        qq += shx(qq, 1, lane); qq += shx(qq, 2, lane);
        const float rstd = rsqrtf(qq * (1.0f / 64.0f) + LN_EPS);
#pragma unroll
        for (int d = 0; d < 16; ++d) vnT[(qd * 16 + d) * TROW + j] = (bf16)f2bf(v[d] * rstd);
    }
    bf16x8_t wf[4];
    {
        const float* wrow = p->sgu_w + (((size_t)l * 4 + grp) * 128 + w * 16 + r) * 128 + g * 8;
#pragma unroll
        for (int ks = 0; ks < 4; ++ks) {
            const float4 a = *(const float4*)(wrow + ks * 32), c = *(const float4*)(wrow + ks * 32 + 4);
            uint4 o; o.x = pk2(a.x, a.y); o.y = pk2(a.z, a.w); o.z = pk2(c.x, c.y); o.w = pk2(c.z, c.w);
            wf[ks] = __builtin_bit_cast(bf16x8_t, o);
        }
    }
    __syncthreads();
    const int i = w * 16 + r;
    const float bs = p->sgu_b[((size_t)l * 4 + grp) * 128 + i];
#pragma unroll
    for (int dt = 0; dt < 4; ++dt) {
        f32x4_t acc = {0.f, 0.f, 0.f, 0.f};
#pragma unroll
        for (int ks = 0; ks < 4; ++ks) acc = MFMA16(lds_frag16(vnT + (dt * 16 + r) * TROW + ks * 32 + g * 8), wf[ks], acc);
        const uint2 uw = *(const uint2*)(P + (size_t)(r0 + i) * DIN + C_SU + grp * 64 + dt * 16 + g * 4);
        const float o0 = gelu_tanh(bflo(uw.x)) * (acc[0] + bs), o1 = gelu_tanh(bfhi(uw.x)) * (acc[1] + bs), o2 = gelu_tanh(bflo(uw.y)) * (acc[2] + bs), o3 = gelu_tanh(bfhi(uw.y)) * (acc[3] + bs);
        *(uint2*)(p->MIX + (size_t)(r0 + i) * D + 256 + grp * 64 + dt * 16 + g * 4) = make_uint2(pk2(o0, o1), pk2(o2, o3));
    }
}

__device__ __forceinline__ void phase_mix_a(KP p, int wv, int l, int bid, int nb, float* ldsf) {
    bf16* lds = (bf16*)ldsf;
    const int n_att = (l == DEPTH - 1) ? 256 : 264, n_kv = NB * NPOS * 4, n_sgu = NB * NPOS * 4;
    for (int u = bid; u < n_att + n_kv + n_sgu; u += nb) {
        if (u < n_att) att_unit(p, wv, l, u, lds);
        else if (u < n_att + n_kv) ret_kv_unit(p, wv, l, u - n_att, lds);
        else sgu_unit(p, wv, l, u - n_att - n_kv, lds);
    }
    __syncthreads();
}
__device__ __forceinline__ void phase_ret_out(KP p, int wv, int l, int bid, int nb, float* ldsf) {
    bf16* lds = (bf16*)ldsf;
    for (int u = bid; u < NB * NPOS * 2; u += nb) ret_out_unit(p, wv, l, u, lds);
    __syncthreads();
}

__device__ __forceinline__ void phase_ln1(KP p, int wv, int l, int bid, int nb) {
    const int lane = tid_opaque(wv) & 63, w = tid_opaque(wv) >> 6;
    const int Tn = (l == DEPTH - 1) ? TL : T;
    for (int r = bid * NW + w; r < Tn; r += nb * NW) {
        float v[16], a[16], c[16];
        if (l == 0) row_load(x_row(p, 0, r), v, lane); else row_load_bf(p->X + (size_t)r * D, v, lane);
        row_load_bf(p->Y + (size_t)r * D, a, lane);
        const float* m = p->mod + ((size_t)l * 3 + mod_idx(r)) * 6144;
        row_load(m + 2048, c, lane);
#pragma unroll
        for (int i = 0; i < 16; ++i) v[i] = ALPHA * v[i] + c[i] * a[i];
        row_ln(v, lane);
        row_load(p->lnm_g + l * D, a, lane); row_load(p->lnm_b + l * D, c, lane);
#pragma unroll
        for (int i = 0; i < 16; ++i) v[i] = v[i] * a[i] + c[i];
        row_store_bf(p->X1 + (size_t)r * D, v, lane);
        row_ln(v, lane);
        row_load(m + 3072, a, lane); row_load(m + 4096, c, lane);
#pragma unroll
        for (int i = 0; i < 16; ++i) v[i] = v[i] * (1.0f + c[i]) + a[i];
        row_store_bf(p->H + (size_t)r * D, v, lane);
        float mx = 0.f;
#pragma unroll
        for (int i = 0; i < 16; ++i) mx = fmaxf(mx, fabsf(v[i]));
#pragma unroll
        for (int o = 32; o >= 1; o >>= 1) mx = fmaxf(mx, shx(mx, o, lane));
        const float xinv = mx > 0.f ? 127.0f / mx : 0.f;
        unsigned* xq = (unsigned*)(p->XQ + (size_t)r * D);
#pragma unroll
        for (int i = 0; i < 4; ++i) {
            const int q0 = (int)rintf(v[i * 4 + 0] * xinv), q1 = (int)rintf(v[i * 4 + 1] * xinv), q2 = (int)rintf(v[i * 4 + 2] * xinv), q3 = (int)rintf(v[i * 4 + 3] * xinv);
            xq[i * 64 + lane] = (unsigned)(q0 & 0xff) | ((unsigned)(q1 & 0xff) << 8) | ((unsigned)(q2 & 0xff) << 16) | ((unsigned)(q3 & 0xff) << 24);
        }
        if (lane == 0) p->SX[r] = mx * (1.0f / 127.0f);
    }
}

template <int NV, class IdFn>
__device__ __forceinline__ void select_top16(const float (&v)[NV], IdFn idf, float* lv, int* li, int lane) {
    float mx = v[0], mn = v[0];
#pragma unroll
    for (int e = 1; e < NV; ++e) { mx = fmaxf(mx, v[e]); mn = fminf(mn, v[e]); }
    mx = fmaxf(mx, shx(mx, 16, lane)); mx = fmaxf(mx, shx(mx, 32, lane));
    mn = fminf(mn, shx(mn, 16, lane)); mn = fminf(mn, shx(mn, 32, lane));
    float lo = mn - 1.0f, hi = mx, tau = lo;
    bool done = false;
    for (int iter = 0; iter < 48; ++iter) {
        const float mid = 0.5f * (lo + hi);
        int cnt = 0;
#pragma unroll
        for (int e = 0; e < NV; ++e) cnt += (v[e] > mid) ? 1 : 0;
        cnt += shx(cnt, 16, lane); cnt += shx(cnt, 32, lane);
        if (!done) {
            if (cnt == 16) { tau = mid; done = true; }
            else if (cnt > 16) { lo = mid; tau = mid; } else hi = mid;
            if (!(mid > lo || mid < hi)) done = true;
        }
        if (__all(done)) break;
    }
    int c = 0;
#pragma unroll
    for (int e = 0; e < NV; ++e) c += (v[e] > tau) ? 1 : 0;
    const int base = lane & 15, g = lane >> 4;
    const int c0 = shf(c, base), c1 = shf(c, base + 16), c2 = shf(c, base + 32);
    int pos = (g > 0 ? c0 : 0) + (g > 1 ? c1 : 0) + (g > 2 ? c2 : 0);
#pragma unroll
    for (int e = 0; e < NV; ++e) {
        if (v[e] > tau && pos < 16) { lv[base * 16 + pos] = v[e]; li[base * 16 + pos] = idf(e); ++pos; }
    }
}
constexpr int KS_STRIDE = 136;
__device__ __forceinline__ void phase_topk(KP p, int wv, int l, int bid, int nb, float* lds) {
    bf16* k1s = (bf16*)lds;
    bf16* k2s = k1s + 128 * KS_STRIDE;
    const int t = tid_opaque(wv), lane = t & 63, w = t >> 6;
    float* lists = lds + (2 * 128 * KS_STRIDE * 2) / 4 + w * 1536;
    float* v1 = lists; int* i1 = (int*)(lists + 256); float* v2 = lists + 512; int* i2 = (int*)(lists + 768); float* v3 = lists + 1024; int* c3 = (int*)(lists + 1280);
    __syncthreads();
    for (int e = t; e < 2 * 128 * 16; e += NT) {
        const int tab = e >> 11, r = (e >> 4) & 127, c8 = e & 15;
        const float* src = (tab ? p->k2 : p->k1) + (size_t)l * 128 * 128 + r * 128 + c8 * 8;
        const float4 a = *(const float4*)src, b = *(const float4*)(src + 4);
        uint4 o; o.x = pk2(a.x, a.y); o.y = pk2(a.z, a.w); o.z = pk2(b.x, b.y); o.w = pk2(b.z, b.w);
        *(uint4*)((tab ? k2s : k1s) + r * KS_STRIDE + c8 * 8) = o;
    }
    __syncthreads();
    const int fr = lane & 15, fq = lane >> 4;
    const int ntask = ((l == DEPTH - 1) ? TL : T) * 8 / 16;
    for (int task = bid * NW + w; task < ntask; task += nb * NW) {
        const int it0 = task * 16;
        const bf16* qrow = p->Qb + (size_t)(it0 + fr) * 256 + fq * 8;
        bf16x8_t bq[8];
#pragma unroll
        for (int ks = 0; ks < 8; ++ks) bq[ks] = *(const bf16x8_t*)(qrow + ks * 32);
        float s[32];
#pragma unroll
        for (int kt = 0; kt < 8; ++kt) {
            f32x4_t acc = {0.f, 0.f, 0.f, 0.f};
#pragma unroll
            for (int ks = 0; ks < 4; ++ks) {
                const bf16x8_t a = *(const bf16x8_t*)(k1s + (kt * 16 + fr) * KS_STRIDE + ks * 32 + fq * 8);
                acc = __builtin_amdgcn_mfma_f32_16x16x32_bf16(a, bq[ks], acc, 0, 0, 0);
            }
            s[kt * 4 + 0] = acc[0]; s[kt * 4 + 1] = acc[1]; s[kt * 4 + 2] = acc[2]; s[kt * 4 + 3] = acc[3];
        }
        select_top16<32>(s, [fq](int e) { return (e >> 2) * 16 + fq * 4 + (e & 3); }, v1, i1, lane);
#pragma unroll
        for (int kt = 0; kt < 8; ++kt) {
            f32x4_t acc = {0.f, 0.f, 0.f, 0.f};
#pragma unroll
            for (int ks = 0; ks < 4; ++ks) {
                const bf16x8_t a = *(const bf16x8_t*)(k2s + (kt * 16 + fr) * KS_STRIDE + ks * 32 + fq * 8);
                acc = __builtin_amdgcn_mfma_f32_16x16x32_bf16(a, bq[4 + ks], acc, 0, 0, 0);
            }
            s[kt * 4 + 0] = acc[0]; s[kt * 4 + 1] = acc[1]; s[kt * 4 + 2] = acc[2]; s[kt * 4 + 3] = acc[3];
        }
        select_top16<32>(s, [fq](int e) { return (e >> 2) * 16 + fq * 4 + (e & 3); }, v2, i2, lane);
        __builtin_amdgcn_wave_barrier();
        float cv[64];
#pragma unroll
        for (int a = 0; a < 4; ++a) {
            const float va = v1[fr * 16 + fq * 4 + a];
#pragma unroll
            for (int b = 0; b < 16; ++b) cv[a * 16 + b] = va + v2[fr * 16 + b];
        }
        select_top16<64>(cv, [fq](int e) { return (fq * 4 + (e >> 4)) * 16 + (e & 15); }, v3, c3, lane);
        __builtin_amdgcn_wave_barrier();
        float tv[4]; int tc[4];
#pragma unroll
        for (int k = 0; k < 4; ++k) { tv[k] = v3[fr * 16 + fq * 4 + k]; tc[k] = c3[fr * 16 + fq * 4 + k]; }
        float mx = fmaxf(fmaxf(tv[0], tv[1]), fmaxf(tv[2], tv[3]));
        mx = fmaxf(mx, shx(mx, 16, lane)); mx = fmaxf(mx, shx(mx, 32, lane));
        float ex[4], den = 0.f;
#pragma unroll
        for (int k = 0; k < 4; ++k) { ex[k] = expf(tv[k] - mx); den += ex[k]; }
        den += shx(den, 16, lane); den += shx(den, 32, lane);
        const float inv = 1.0f / den;
        int4 eo; float4 go;
        eo.x = i1[fr * 16 + (tc[0] >> 4)] * 128 + i2[fr * 16 + (tc[0] & 15)];
        eo.y = i1[fr * 16 + (tc[1] >> 4)] * 128 + i2[fr * 16 + (tc[1] & 15)];
        eo.z = i1[fr * 16 + (tc[2] >> 4)] * 128 + i2[fr * 16 + (tc[2] & 15)];
        eo.w = i1[fr * 16 + (tc[3] >> 4)] * 128 + i2[fr * 16 + (tc[3] & 15)];
        go = make_float4(ex[0] * inv, ex[1] * inv, ex[2] * inv, ex[3] * inv);
        *(int4*)(p->EIDX + (size_t)(it0 + fr) * 16 + fq * 4) = eo;
        *(float4*)(p->GATE + (size_t)(it0 + fr) * 16 + fq * 4) = go;
        __builtin_amdgcn_wave_barrier();
    }
    __syncthreads();
}

typedef unsigned u32x4_t __attribute__((ext_vector_type(4)));
using bf16x2_t = __attribute__((ext_vector_type(2))) __bf16;
__device__ __forceinline__ float dot2bf(unsigned a, unsigned b, float acc) { return __builtin_amdgcn_fdot2_f32_bf16(__builtin_bit_cast(bf16x2_t, a), __builtin_bit_cast(bf16x2_t, b), acc, false); }
struct RowBf { u32x4_t a, b; };
__device__ __forceinline__ RowBf ld_row(const bf16* tab, int e, int lane) {
    const u32x4_t* r = (const u32x4_t*)(tab + (size_t)e * D) + lane;
    RowBf x; x.a = r[0]; x.b = r[64]; return x;
}
__device__ __forceinline__ float row_dot(const RowBf& x, const RowBf& u) {
    float d = 0.f;
#pragma unroll
    for (int k = 0; k < 4; ++k) { d = dot2bf(x.a[k], u.a[k], d); d = dot2bf(x.b[k], u.b[k], d); }
    return d;
}
__device__ __forceinline__ void row_axpy(float (&acc)[16], float a, const RowBf& v) {
#pragma unroll
    for (int k = 0; k < 4; ++k) {
        acc[2 * k] += a * bflo(v.a[k]); acc[2 * k + 1] += a * bfhi(v.a[k]);
        acc[8 + 2 * k] += a * bflo(v.b[k]); acc[8 + 2 * k + 1] += a * bfhi(v.b[k]);
    }
}
__device__ __forceinline__ float transpose_reduce16(float (&part)[16], int lane) {
#pragma unroll
    for (int st = 32, n = 8; n >= 1; st >>= 1, n >>= 1) {
        const bool up = (lane & st) != 0;
#pragma unroll
        for (int s = 0; s < n; ++s) {
            const float lo = part[s], hi = part[s + n];
            const float recv = shx(up ? lo : hi, st, lane);
            part[s] = (up ? hi : lo) + recv;
        }
    }
    float v = part[0];
    v += shx(v, 2, lane); v += shx(v, 1, lane);
    return v;
}
typedef float f32x2_t __attribute__((ext_vector_type(2)));
__device__ __forceinline__ float transpose_reduce8(float (&part)[8], int lane) {
#pragma unroll
    for (int st = 32, n = 4; n >= 1; st >>= 1, n >>= 1) {
        const bool up = (lane & st) != 0;
#pragma unroll
        for (int s = 0; s < n; ++s) {
            const float lo = part[s], hi = part[s + n];
            const float recv = shx(up ? lo : hi, st, lane);
            part[s] = (up ? hi : lo) + recv;
        }
    }
    float v = part[0];
    v += shx(v, 4, lane); v += shx(v, 2, lane); v += shx(v, 1, lane);
    return v;
}
typedef int v4i_t __attribute__((ext_vector_type(4)));
typedef unsigned u32x4v __attribute__((ext_vector_type(4)));
constexpr int EXU_CAP = 992, EXU_TROW = 1056;
__device__ __forceinline__ void phase_expert_u(KP p, int wv, int l, int bid, int nb, float* lds) {
    const int lane = tid_opaque(wv) & 63, w = __builtin_amdgcn_readfirstlane(tid_opaque(wv) >> 6);
    const int G8 = nb >> 3;
    if (bid >= G8 * 8) return;
    const int rng = bid & 7, r = lane & 15, g = lane >> 4;
    const unsigned char* U = p->U8 + (size_t)l * PEER_N * D;
    const float* SU = p->SU + (size_t)l * PEER_N; const float* SV = p->SV + (size_t)l * PEER_N;
    unsigned char* wl = (unsigned char*)lds + w * 16384;
    unsigned* lpk = (unsigned*)wl; float* lgt = (float*)(wl + 4 * EXU_CAP); unsigned char* tile = wl + 8 * EXU_CAP;
    const unsigned long long ltmask = (1ull << lane) - 1ull;
    const int tstride = G8 * NW, Tn = (l == DEPTH - 1) ? TL : T, t0 = (bid >> 3) * NW + w;
    if (t0 >= Tn) return;
    const int nitem = (Tn - t0 + tstride - 1) / tstride;
    int i0 = 0;
    while (i0 < nitem) {
        const int nt = nitem - i0 < 16 ? nitem - i0 : 16;
        v4i_t afr[16];
        {
            const unsigned char* xa = p->XQ + (size_t)(t0 + (i0 + (r < nt ? r : nt - 1)) * tstride) * D + g * 16;
#pragma unroll
            for (int ks = 0; ks < 16; ++ks) afr[ks] = *(const v4i_t*)(xa + ks * 64);
        }
        const float sxv = p->SX[t0 + (i0 + (lane < nt ? lane : nt - 1)) * tstride];
        int e0[16], e1[16]; float g0[16], g1[16];
#pragma unroll
        for (int j = 0; j < 16; ++j) {
            const size_t tb = (size_t)(t0 + (i0 + (j < nt ? j : nt - 1)) * tstride) * NSEL;
            e0[j] = p->EIDX[tb + lane]; e1[j] = p->EIDX[tb + 64 + lane]; g0[j] = p->GATE[tb + lane]; g1[j] = p->GATE[tb + 64 + lane];
        }
        int cnt = 0, ndone = 0; bool open = true;
#pragma unroll
        for (int j = 0; j < 16; ++j) {
            const bool in0 = (e0[j] >> 11) == rng, in1 = (e1[j] >> 11) == rng;
            const unsigned long long m0 = __ballot(in0), m1 = __ballot(in1);
            const int c0 = __popcll(m0), c = c0 + __popcll(m1);
            open = open && j < nt && cnt + c <= EXU_CAP;
            if (open) {
                if (in0) { const int pos = cnt + __popcll(m0 & ltmask); lpk[pos] = (unsigned)e0[j] | ((unsigned)j << 14) | ((unsigned)lane << 18); lgt[pos] = g0[j]; }
                if (in1) { const int pos = cnt + c0 + __popcll(m1 & ltmask); lpk[pos] = (unsigned)e1[j] | ((unsigned)j << 14) | ((unsigned)(lane + 64) << 18); lgt[pos] = g1[j]; }
                cnt += c; ndone = j + 1;
            }
        }
        __builtin_amdgcn_wave_barrier();
        const int ntile = (cnt + 7) >> 3;
        u32x4v rw[8]; unsigned pkv = 0u; float gtv = 0.f, suv = 0.f, svv = 0.f;
#define EXU_ISSUE(q) do { const int idx_ = 8 * (q) + (lane & 7) < cnt ? 8 * (q) + (lane & 7) : cnt - 1; \
            pkv = lpk[idx_]; gtv = lgt[idx_]; const unsigned e_ = pkv & 0x3fffu; \
            _Pragma("unroll") for (int k = 0; k < 8; ++k) rw[k] = *(const u32x4v*)(U + ((size_t)(__builtin_amdgcn_readlane((int)pkv, k) & 0x3fff) << 10) + lane * 16); \
            suv = SU[e_]; svv = SV[e_]; } while (0)
        if (ntile > 0) EXU_ISSUE(0);
#pragma unroll 1
        for (int q = 0; q < ntile; ++q) {
#pragma unroll
            for (int k = 0; k < 8; ++k) *(u32x4v*)(tile + k * EXU_TROW + lane * 16) = rw[k];
            const unsigned pk = pkv; const float gt = gtv, su = suv, sv = svv;
            __builtin_amdgcn_wave_barrier();
            if (q + 1 < ntile) EXU_ISSUE(q + 1);
            v4i_t acc = {0, 0, 0, 0};
#pragma unroll
            for (int ks = 0; ks < 16; ++ks) {
                const v4i_t b = *(const v4i_t*)(tile + (r & 7) * EXU_TROW + ks * 64 + g * 16);
                acc = __builtin_amdgcn_mfma_i32_16x16x64_i8(afr[ks], b, acc, 0, 0, 0);
            }
            const int j = (int)((pk >> 14) & 15u), slot = (int)(pk >> 18);
            const int d = (j & 2) ? ((j & 1) ? acc[3] : acc[2]) : ((j & 1) ? acc[1] : acc[0]);
            const float sx = shf(sxv, j);
            if (r < 8 && g == (j >> 2) && 8 * q + r < cnt) lgt[8 * q + r] = (float)d * su * sx;
            __builtin_amdgcn_wave_barrier();
        }
#undef EXU_ISSUE
        for (int idx = lane; idx < cnt; idx += 64) {
            const unsigned pk = lpk[idx]; const int e = (int)(pk & 0x3fffu), j = (int)((pk >> 14) & 15u), slot = (int)(pk >> 18);
            const size_t ao = (size_t)(t0 + (i0 + j) * tstride) * NSEL + slot;
            p->ACT[ao] = gelu_tanh(lgt[idx]) * p->GATE[ao] * SV[e];
        }
        __builtin_amdgcn_wave_barrier();
        i0 += ndone > 0 ? ndone : 1;
    }
}
__device__ __forceinline__ void phase_expert_v(KP p, int wv, int l, int bid, int nb) {
    const int lane = tid_opaque(wv) & 63, w = __builtin_amdgcn_readfirstlane(tid_opaque(wv) >> 6);
    const int G8 = nb >> 3;
    if (bid >= G8 * 8) return;
    const int sl = bid & 7, q = lane >> 3, c = lane & 7;
    const __amdgpu_buffer_rsrc_t rsV = __builtin_amdgcn_make_buffer_rsrc((void*)(p->V8 + (size_t)l * PEER_N * D), 0, PEER_N * D, 0x00020000);
    const int coff = sl * 128 + c * 16;
    const int tstride = G8 * NW, Tn = (l == DEPTH - 1) ? TL : T, t0 = (bid >> 3) * NW + w;
    const int nitem = t0 < Tn ? (Tn - t0 + tstride - 1) / tstride : 0;
    for (int j0 = 0; j0 < nitem; j0 += 8) {
        const bool valid = j0 + q < nitem;
        const int t = t0 + (valid ? j0 + q : nitem - 1) * tstride;
        int e[16]; float a[16];
        {
            const int4* ep = (const int4*)(p->EIDX + (size_t)t * NSEL + c * 16); const float4* ap = (const float4*)(p->ACT + (size_t)t * NSEL + c * 16);
#pragma unroll
            for (int k = 0; k < 4; ++k) { const int4 ev = ep[k]; const float4 av = ap[k];
                e[k * 4 + 0] = ev.x << 10; e[k * 4 + 1] = ev.y << 10; e[k * 4 + 2] = ev.z << 10; e[k * 4 + 3] = ev.w << 10;
                a[k * 4 + 0] = av.x; a[k * 4 + 1] = av.y; a[k * 4 + 2] = av.z; a[k * 4 + 3] = av.w; }
        }
        f32x2_t acc[8];
#pragma unroll
        for (int k = 0; k < 8; ++k) acc[k] = (f32x2_t){0.f, 0.f};
#pragma unroll 1
        for (int cc = 0; cc < 8; ++cc) {
            const int baddr = ((lane & 56) | cc) << 2;
#pragma unroll
            for (int hb = 0; hb < 2; ++hb) {
                u32x4v rv[8]; float av[8];
#pragma unroll
                for (int k = 0; k < 8; ++k) {
                    const int j = hb * 8 + k;
                    const int eo = __builtin_amdgcn_ds_bpermute(baddr, e[j]);
                    av[k] = __builtin_bit_cast(float, __builtin_amdgcn_ds_bpermute(baddr, __builtin_bit_cast(int, a[j])));
                    rv[k] = __builtin_amdgcn_raw_buffer_load_b128(rsV, eo + coff, 0, 0);
                }
#pragma unroll
                for (int k = 0; k < 8; ++k) {
                    const f32x2_t a2 = {av[k], av[k]};
                    acc[0] += a2 * __builtin_amdgcn_cvt_pk_f32_fp8((int)rv[k][0], false); acc[1] += a2 * __builtin_amdgcn_cvt_pk_f32_fp8((int)rv[k][0], true);
                    acc[2] += a2 * __builtin_amdgcn_cvt_pk_f32_fp8((int)rv[k][1], false); acc[3] += a2 * __builtin_amdgcn_cvt_pk_f32_fp8((int)rv[k][1], true);
                    acc[4] += a2 * __builtin_amdgcn_cvt_pk_f32_fp8((int)rv[k][2], false); acc[5] += a2 * __builtin_amdgcn_cvt_pk_f32_fp8((int)rv[k][2], true);
                    acc[6] += a2 * __builtin_amdgcn_cvt_pk_f32_fp8((int)rv[k][3], false); acc[7] += a2 * __builtin_amdgcn_cvt_pk_f32_fp8((int)rv[k][3], true);
                    __builtin_amdgcn_sched_barrier(0);
                }
            }
        }
        if (valid) {
            bf16* yr = p->Y + (size_t)t * D + coff;
            *(uint4*)yr = make_uint4(pk2(acc[0].x, acc[0].y), pk2(acc[1].x, acc[1].y), pk2(acc[2].x, acc[2].y), pk2(acc[3].x, acc[3].y));
            *(uint4*)(yr + 8) = make_uint4(pk2(acc[4].x, acc[4].y), pk2(acc[5].x, acc[5].y), pk2(acc[6].x, acc[6].y), pk2(acc[7].x, acc[7].y));
        }
    }
}

__device__ __forceinline__ void phase_ln2(KP p, int wv, int l, int bid, int nb) {
    const int lane = tid_opaque(wv) & 63, w = tid_opaque(wv) >> 6;
    const int Tn = (l == DEPTH - 1) ? TL : T;
    for (int r = bid * NW + w; r < Tn; r += nb * NW) {
        float v[16], a[16], c[16];
        row_load_bf(p->X1 + (size_t)r * D, v, lane);
        row_load_bf(p->Y + (size_t)r * D, a, lane);
        const float* m = p->mod + ((size_t)l * 3 + mod_idx(r)) * 6144;
        row_load(m + 5120, c, lane);
#pragma unroll
        for (int i = 0; i < 16; ++i) v[i] = ALPHA * v[i] + c[i] * a[i];
        row_ln(v, lane);
        row_load(p->lnf_g + l * D, a, lane); row_load(p->lnf_b + l * D, c, lane);
#pragma unroll
        for (int i = 0; i < 16; ++i) v[i] = v[i] * a[i] + c[i];
        if (l == DEPTH - 1) { if (r < TL) row_store(p->out + (size_t)r * D, v, lane); continue; }
        row_store_bf(p->X + (size_t)r * D, v, lane);
        const float* m2 = p->mod + ((size_t)(l + 1) * 3 + mod_idx(r)) * 6144;
        row_ln(v, lane);
        row_load(m2, a, lane); row_load(m2 + 1024, c, lane);
#pragma unroll
        for (int i = 0; i < 16; ++i) v[i] = v[i] * (1.0f + c[i]) + a[i];
        row_store_bf(p->H + (size_t)r * D, v, lane);
    }
}

constexpr int REP_MIXA = 1, REP_TOPK = 1, REP_EXPU = 1, REP_EXPV = 1, REP_RETOUT = 1, REP_GEMM = 1, REP_PRO = 1;
__global__ void __launch_bounds__(NT, 2) mega(Params p_unused) {
    extern __shared__ __attribute__((aligned(16))) unsigned char lds_raw[];
    cg::grid_group grid = cg::this_grid();
    const int bid = blockIdx.x, nb = gridDim.x;
    const int wv = __builtin_amdgcn_readfirstlane(threadIdx.x >> 6);
    float* lds = (float*)lds_raw;
    LAS unsigned char* ldsl = (LAS unsigned char*)lds_raw;
    volatile LAS unsigned* MISC = (volatile LAS unsigned*)(ldsl + MISC_OFF);
    for (int u = threadIdx.x; u < (LDS_BYTES - 131072) / 4; u += NT) ((LAS unsigned*)(ldsl + 131072))[u] = 0u;
    __syncthreads();
#define IS_LEAD() (wv == 0 && lane_opaque() == 0)
    (void)xcd_barrier_post(kparams()->ctl + CW_BAR, MISC + 8, IS_LEAD());
#define GRID_BAR() do { XcdBarrier b_; b_.bar = kparams()->ctl + CW_BAR; b_.x = xb_xcc_id(); b_.st = MISC + 8; b_.lead = IS_LEAD(); xcd_barrier(b_); } while (0)

    phase_mod1(kparams(), wv, bid, nb, lds);
    for (int rep = 0; rep < REP_PRO; ++rep) phase_weights(kparams(), wv, bid, nb, lds);
    grid.sync();
    phase_mod2(kparams(), wv, bid, nb);
    GRID_BAR();
    phase_lnmod(kparams(), wv, 0, bid, nb);
    GRID_BAR();
#define LAYER_BODY(l) do { \
        { KP p = kparams(); \
            pg8::Gemm g{p->H, p->WtIn + (size_t)l * DIN * D, T, DIN, D}; pg8::StaticOrder S; S.init(T, DIN, nb, bid); \
            pg8::EpiInProj E{p->P, p->rope}; \
            for (int rep = 0; rep < REP_GEMM; ++rep) pg8::gemm_phase<pg8::EpiInProj, pg8::StaticOrder, true, true>(ldsl, g, S, E, wv); \
        } \
        GRID_BAR(); \
        for (int rep = 0; rep < REP_MIXA; ++rep) phase_mix_a(kparams(), wv, l, bid, nb, lds); \
        GRID_BAR(); \
        phase_ret_scan(kparams(), wv, l, bid, nb); \
        GRID_BAR(); \
        for (int rep = 0; rep < REP_RETOUT; ++rep) phase_ret_out(kparams(), wv, l, bid, nb, lds); \
        GRID_BAR(); \
        { KP p = kparams(); \
            const int Mr = (l == DEPTH - 1) ? TL : T; pg8::Gemm g{p->MIX, p->WtOut + (size_t)l * D * D, Mr, D, D}; pg8::StaticOrder S; S.init(Mr, D, nb, bid); \
            pg8::EpiBf16Plain E{p->Y, D}; \
            for (int rep = 0; rep < REP_GEMM; ++rep) pg8::gemm_phase<pg8::EpiBf16Plain, pg8::StaticOrder, true, true>(ldsl, g, S, E, wv); \
        } \
        GRID_BAR(); \
        phase_ln1(kparams(), wv, l, bid, nb); \
        GRID_BAR(); \
        { KP p = kparams(); \
            const int Mr = (l == DEPTH - 1) ? TL : T; pg8::Gemm g{p->H, p->WtQ + (size_t)l * 2048 * D, Mr, 2048, D}; pg8::StaticOrder S; S.init(Mr, 2048, nb, bid); \
            pg8::EpiBf16Plain E{p->Qb, 2048}; \
            for (int rep = 0; rep < REP_GEMM; ++rep) pg8::gemm_phase<pg8::EpiBf16Plain, pg8::StaticOrder, true, true>(ldsl, g, S, E, wv); \
        } \
        GRID_BAR(); \
        for (int rep = 0; rep < REP_TOPK; ++rep) phase_topk(kparams(), wv, l, bid, nb, lds); \
        GRID_BAR(); \
        for (int rep = 0; rep < REP_EXPU; ++rep) phase_expert_u(kparams(), wv, l, bid, nb, lds); \
        GRID_BAR(); \
        for (int rep = 0; rep < REP_EXPV; ++rep) phase_expert_v(kparams(), wv, l, bid, nb); \
        GRID_BAR(); \
        phase_ln2(kparams(), wv, l, bid, nb); \
        if (l + 1 < DEPTH) GRID_BAR(); \
    } while (0)
    LAYER_BODY(0); LAYER_BODY(1); LAYER_BODY(2); LAYER_BODY(3);
#undef LAYER_BODY
}

extern "C" void kernel_launch(void* const* d_in, const int* in_sizes, int n_in, void* d_out, int out_size, void* d_ws, size_t ws_size, hipStream_t stream) {
    static int grid_blocks = 0;
    if (!grid_blocks) {
        int dev = 0, cus = 0, per_cu = 0;
        (void)hipGetDevice(&dev);
        (void)hipDeviceGetAttribute(&cus, hipDeviceAttributeMultiprocessorCount, dev);
        (void)hipFuncSetAttribute((const void*)mega, hipFuncAttributeMaxDynamicSharedMemorySize, LDS_BYTES);
        (void)hipOccupancyMaxActiveBlocksPerMultiprocessor(&per_cu, mega, NT, LDS_BYTES);
        if (per_cu < 1) { fprintf(stderr, "occupancy query says %d blocks per CU\n", per_cu); per_cu = 1; }
        grid_blocks = cus;
    }
    Params p{};
    const float** ins = (const float**)&p;
    for (int i = 0; i < 22; ++i) ins[i] = (const float*)d_in[i];
    p.out = (float*)d_out;
    char* ws = (char*)d_ws;
    size_t off = 0;
    auto carve = [&](size_t bytes) { void* r = ws + off; off += (bytes + 255) & ~(size_t)255; return r; };
    p.ctl = (unsigned*)carve(CTL_BYTES);
    p.modp = (float*)carve((size_t)16 * DEPTH * 3 * 6144 * 4);
    p.mod = (float*)carve((size_t)DEPTH * 3 * 6144 * 4);
    p.rope = (float*)carve((size_t)192 * 16 * 2 * 4);
    p.WtIn = (bf16*)carve((size_t)DEPTH * DIN * D * 2);
    p.WtOut = (bf16*)carve((size_t)DEPTH * D * D * 2);
    p.WtQ = (bf16*)carve((size_t)DEPTH * 2048 * D * 2);
    p.X = (bf16*)carve((size_t)T * D * 2);
    p.H = (bf16*)carve((size_t)T * D * 2);
    p.P = (bf16*)carve((size_t)T * DIN * 2);
    p.KV = (float*)carve((size_t)2 * NB * NPOS * 4 * 4096 * 4);
    p.ST = (float*)carve((size_t)2 * NB * NPOS * 4 * 4096 * 4);
    p.MIX = (bf16*)carve((size_t)T * D * 2);
    p.ST16 = (bf16*)carve((size_t)2 * NB * NPOS * 4 * 4096 * 2);
    p.Qb = (bf16*)carve((size_t)T * 2048 * 2);
    p.U8 = (unsigned char*)carve((size_t)DEPTH * PEER_N * D);
    p.V8 = (unsigned char*)carve((size_t)DEPTH * PEER_N * D);
    p.XQ = (unsigned char*)carve((size_t)T * D);
    p.SX = (float*)carve((size_t)T * 4);
    p.SU = (float*)carve((size_t)DEPTH * PEER_N * 4);
    p.SV = (float*)carve((size_t)DEPTH * PEER_N * 4);
    p.Y = (bf16*)carve((size_t)T * D * 2);
    p.X1 = (bf16*)carve((size_t)T * D * 2);
    p.Q = (float*)carve((size_t)T * 2048 * 4);
    p.GATE = (float*)carve((size_t)T * NSEL * 4);
    p.ACT = (float*)carve((size_t)T * NSEL * 4);
    p.V1 = (float*)carve((size_t)T * 8 * 16 * 4);
    p.EIDX = (int*)carve((size_t)T * NSEL * 4);
    p.I1 = (int*)carve((size_t)T * 8 * 16 * 4);
    if (off > ws_size) { fprintf(stderr, "workspace too small: need %zu have %zu\n", off, ws_size); return; }
    (void)hipMemsetAsync(p.ctl, 0, CTL_BYTES, stream);
    void* args[] = {&p};
    hipError_t e = hipLaunchCooperativeKernel((void*)mega, dim3(grid_blocks), dim3(NT), args, LDS_BYTES, stream);
    if (e != hipSuccess) fprintf(stderr, "cooperative launch failed: %s (grid %d)\n", hipGetErrorString(e), grid_blocks);
}
```

```cpp
#include <hip/hip_runtime.h>
#include <hip/hip_cooperative_groups.h>
#include <cstdio>
#include <cstdint>
namespace cg = cooperative_groups;

constexpr int D = 1024, NB = 2, SEQ = 8192, DEPTH = 4, LC = 256, HD = 64;
constexpr int TL = NB * SEQ, TC = NB * LC, T = TL + TC;
constexpr int DIN = 2304;
constexpr int C_RQ = 0, C_RK = 256, C_RV = 512, C_RG = 768, C_SU = 1024, C_SV = 1280, C_AQ = 1536, C_AK = 2048, C_AV = 2176;
constexpr int NPOS = 66;
constexpr int PEER_N = 16384, NSEL = 128;
constexpr float LN_EPS = 1e-5f;
constexpr float ALPHA = 1.681792830507429f;
constexpr int NT = 512;
constexpr int NW = 8;
constexpr int LDS_BYTES = 163840;
constexpr int MISC_OFF = LDS_BYTES - 256;

typedef unsigned short bf16;
#define LAS __attribute__((address_space(3)))

struct Params {
    const float *x, *c, *ctx, *c_ctx, *w_mod, *b_mod, *w_in, *w_out, *rdf, *rdb, *sgu_w, *sgu_b, *sink, *lnm_g, *lnm_b, *wq, *k1, *k2, *pu, *pv, *lnf_g, *lnf_b;
    float* out;
    unsigned* ctl;
    float *modp, *mod, *rope, *KV, *ST, *Q, *GATE, *V1, *ACT;
    bf16 *X, *X1, *Y;
    bf16 *WtIn, *WtOut, *WtQ, *H, *P, *MIX, *Qb, *ST16;
    unsigned char *U8, *V8, *XQ;
    float *SU, *SV, *SX;
    int *EIDX, *I1;
};

__device__ __forceinline__ unsigned f2bf(float f) { unsigned u = __builtin_bit_cast(unsigned, f); return (u + 0x7fffu + ((u >> 16) & 1u)) >> 16; }
__device__ __forceinline__ unsigned pk2(float lo, float hi) { return f2bf(lo) | (f2bf(hi) << 16); }
__device__ __forceinline__ float bf2f(bf16 v) { return __builtin_bit_cast(float, (unsigned)v << 16); }
__device__ __forceinline__ float bflo(unsigned w) { return __builtin_bit_cast(float, w << 16); }
__device__ __forceinline__ float bfhi(unsigned w) { return __builtin_bit_cast(float, w & 0xffff0000u); }

__device__ __forceinline__ float gelu_tanh(float x) {
    const float u2 = x * (1.5957691216057308f + 0.07135481627f * x * x);
    return x * __builtin_amdgcn_rcpf(1.0f + __builtin_amdgcn_exp2f(-1.4426950408889634f * u2));
}
__device__ __forceinline__ float silu_f(float x) { return x / (1.0f + expf(-x)); }
__device__ __forceinline__ int chunk_row0(int b, int pos) { return pos < 2 ? TL + b * LC + pos * 128 : b * SEQ + (pos - 2) * 128; }
__device__ __forceinline__ int mod_idx(int r) { return r < TL ? r / SEQ : 2; }
__device__ __forceinline__ float log_sigmoid_f(float x) { return -log1pf(expf(-x)); }
typedef const __attribute__((address_space(4))) Params* KP;
__device__ __forceinline__ KP kparams() { KP k = (KP)__builtin_amdgcn_kernarg_segment_ptr(); asm volatile("" : "+s"(k)); return k; }
__device__ __forceinline__ float shx(float v, int m, int lane) { return __builtin_bit_cast(float, __builtin_amdgcn_ds_bpermute((lane ^ m) << 2, __builtin_bit_cast(int, v))); }
__device__ __forceinline__ int shx(int v, int m, int lane) { return __builtin_amdgcn_ds_bpermute((lane ^ m) << 2, v); }
__device__ __forceinline__ float shf(float v, int src) { return __builtin_bit_cast(float, __builtin_amdgcn_ds_bpermute(src << 2, __builtin_bit_cast(int, v))); }
__device__ __forceinline__ int shf(int v, int src) { return __builtin_amdgcn_ds_bpermute(src << 2, v); }
__device__ __forceinline__ float wave_sum(float v, int lane) {
#pragma unroll
    for (int o = 32; o >= 1; o >>= 1) v += shx(v, o, lane);
    return v;
}
__device__ __forceinline__ int lane_opaque() { unsigned m = ~0u; asm volatile("" : "+s"(m)); return (int)__builtin_amdgcn_mbcnt_hi(m, __builtin_amdgcn_mbcnt_lo(m, 0u)); }
__device__ __forceinline__ int tid_opaque(int wv) { return wv * 64 + lane_opaque(); }

namespace pg8 {
#define PG8_LAS __attribute__((address_space(3)))
typedef unsigned short bf16_t;
typedef short bf16x8 __attribute__((ext_vector_type(8)));
typedef float f32x4 __attribute__((ext_vector_type(4)));
typedef unsigned u32x4 __attribute__((ext_vector_type(4)));
constexpr int BM = 256, BK = 64, HALF = 128, HTB = HALF * BK * 2  , STAGE_BYTES = 8 * HTB, NXCD = 8, WGM = 8;

__host__ __device__ __forceinline__ int lds_byte(int r, int c) { const int st = (r >> 4) * 2 + (c >> 5), rr = r & 15, cc = c & 31, ob = rr * 64 + cc * 2; return st * 1024 + (ob ^ (((ob >> 9) & 1) << 5)); }
__host__ __device__ __forceinline__ void stage_rc(int b, int& R, int& C) { const int st = b / 1024, sb = b % 1024, swz = sb ^ (((sb >> 9) & 1) << 5); R = (st >> 1) * 16 + swz / 64; C = (st & 1) * 32 + (swz % 64) / 2; }
__host__ __device__ __forceinline__ int perm32(int rho) { const int n = rho >> 4, i = rho & 15; return 8 * (i >> 2) + 4 * n + (i & 3); }

struct Unit { int pm, pn; };
struct Gemm { const bf16_t* A; const bf16_t* Bt; int M, N, K; };

struct StaticOrder {
    int nM, nN, nwg, G, c;
    __host__ __device__ void init(int M, int N, int G_, int c_) { nM = M / BM; nN = N / BM; nwg = nM * nN; G = G_; c = c_; }
    __host__ __device__ bool next(int i, Unit& u) const {
        const long L = (long)i * G + c; if (L >= nwg) return false;
        int wgid = (int)L; { const int q = nwg / NXCD, r = nwg % NXCD, xcd = wgid % NXCD, off = wgid / NXCD; wgid = (xcd < r ? xcd * (q + 1) : r * (q + 1) + (xcd - r) * q) + off; }
        const int nig = WGM * nN, gid = wgid / nig, fm = gid * WGM, gsz = (nM - fm) < WGM ? (nM - fm) : WGM;
        u.pm = fm + ((wgid % nig) % gsz); u.pn = (wgid % nig) / gsz; return true;
    }
    __device__ __forceinline__ void a_ready(const Unit&) const {}
    __device__ __forceinline__ void done(const Unit&) const {}
};

__device__ __forceinline__ unsigned cvt_pk_bf16(float lo, float hi) { unsigned r; asm volatile("v_cvt_pk_bf16_f32 %0, %1, %2" : "=v"(r) : "v"(lo), "v"(hi)); return r; }
struct EpiInProj {
    static constexpr bool PERM = true, AFTER_DRAIN = false;
    bf16_t* P; const float* rope;
    __device__ __forceinline__ void operator()(const f32x4 (&acc)[2][2][4][2], const Unit& u, int wr, int wc, int fr, int fq) const {
        const int pn = u.pn; const bool lat = u.pm < 64; const int lane = fq * 16 + fr;
        const float sc = (pn == 1 || pn == 6 || pn == 7) ? 0.125f : 1.0f;
        const float sgn = fq < 2 ? -1.0f : 1.0f;
#pragma unroll
        for (int bj = 0; bj < 2; ++bj) {
            const bool roped = lat && (pn == 0 || pn == 1 || pn == 6 || pn == 7 || (pn == 8 && bj == 0));
#pragma unroll
            for (int ai = 0; ai < 2; ++ai)
#pragma unroll
                for (int m = 0; m < 4; ++m) {
                    const int row = u.pm * BM + ai * HALF + wr * 64 + m * 16 + fr;
                    f32x4 v0 = acc[ai][bj][m][0], v1 = acc[ai][bj][m][1];
                    if (roped) {
                        const int pos = row & 8191, idx = (wc & 1) ? 128 + (pos & 63) : (pos >> 6);
                        const float2* tb = (const float2*)rope + idx * 16 + 8 * (fq & 1);
#pragma unroll
                        for (int e = 0; e < 4; ++e) {
                            const float p0 = shx(v0[e], 32, lane), p1 = shx(v1[e], 32, lane);
                            const float2 c0 = tb[e], c1 = tb[4 + e];
                            v0[e] = v0[e] * c0.x + sgn * p0 * c0.y;
                            v1[e] = v1[e] * c1.x + sgn * p1 * c1.y;
                        }
                    }
                    v0 = v0 * sc; v1 = v1 * sc;
                    u32x4 w; w.x = cvt_pk_bf16(v0[0], v0[1]); w.y = cvt_pk_bf16(v0[2], v0[3]); w.z = cvt_pk_bf16(v1[0], v1[1]); w.w = cvt_pk_bf16(v1[2], v1[3]);
                    *(u32x4*)(P + (size_t)row * 2304 + pn * BM + bj * HALF + wc * 32 + fq * 8) = w;
                    __builtin_amdgcn_sched_barrier(0);
                }
        }
    }
};
struct EpiF32 {
    static constexpr bool PERM = false, AFTER_DRAIN = false;
    float* O; int ldc;
    __device__ __forceinline__ void operator()(const f32x4 (&acc)[2][2][4][2], const Unit& u, int wr, int wc, int fr, int fq) const {
#pragma unroll
        for (int ai = 0; ai < 2; ++ai)
#pragma unroll
            for (int m = 0; m < 4; ++m) {
                float* rowp = O + (size_t)(u.pm * BM + ai * HALF + wr * 64 + m * 16 + fr) * ldc + u.pn * BM + wc * 32 + fq * 4;
#pragma unroll
                for (int bj = 0; bj < 2; ++bj)
#pragma unroll
                    for (int n = 0; n < 2; ++n) *(f32x4*)(rowp + bj * HALF + n * 16) = acc[ai][bj][m][n];
            }
    }
};


struct EpiBf16Plain {
    static constexpr bool PERM = true, AFTER_DRAIN = false;
    bf16_t* O; int ldc;
    __device__ __forceinline__ void operator()(const f32x4 (&acc)[2][2][4][2], const Unit& u, int wr, int wc, int fr, int fq) const {
#pragma unroll
        for (int ai = 0; ai < 2; ++ai)
#pragma unroll
            for (int m = 0; m < 4; ++m) {
                bf16_t* rowp = O + (size_t)(u.pm * BM + ai * HALF + wr * 64 + m * 16 + fr) * ldc + u.pn * BM + wc * 32 + fq * 8;
#pragma unroll
                for (int bj = 0; bj < 2; ++bj) {
                    const f32x4 v0 = acc[ai][bj][m][0], v1 = acc[ai][bj][m][1];
                    u32x4 w; w.x = cvt_pk_bf16(v0[0], v0[1]); w.y = cvt_pk_bf16(v0[2], v0[3]); w.z = cvt_pk_bf16(v1[0], v1[1]); w.w = cvt_pk_bf16(v1[2], v1[3]);
                    *(u32x4*)(rowp + bj * HALF) = w;
                }
            }
    }
};
template <class Epi, class Sched, bool ALIGN_EPI = false, bool SP2 = false>
__device__ __forceinline__ void gemm_phase(PG8_LAS unsigned char* lds, const Gemm g, const Sched& S, const Epi& E, int wv) {
    int tid_ = wv * 64; { unsigned m_ = ~0u; asm volatile("" : "+s"(m_)); tid_ += (int)__builtin_amdgcn_mbcnt_hi(m_, __builtin_amdgcn_mbcnt_lo(m_, 0u)); }
    const int tid = tid_, wid = __builtin_amdgcn_readfirstlane(tid >> 6), lane = tid & 63, wr = wid >> 2, wc = wid & 3, fr = lane & 15, fq = lane >> 4;
    const int K = g.K, nt = K / BK;
    unsigned voffA[2], voffB[2];
#pragma unroll
    for (int i = 0; i < 2; ++i) { int R, C; stage_rc(tid * 16 + i * 8192, R, C); const int Rb = Epi::PERM ? ((R & ~31) + perm32(R & 31)) : R;
        voffA[i] = (unsigned)(R * K + C) * 2u; voffB[i] = (unsigned)(Rb * K + C) * 2u; }
    const size_t kstep = (size_t)(BK * 2);
    const size_t hstep = (size_t)HALF * K * 2;
    const size_t tstep = 2 * hstep;
    const unsigned ldsw = (unsigned)wid * 1024u;
    const int aoff = lds_byte(wr * 64 + fr, fq * 8), boff = lds_byte(wc * 32 + fr, fq * 8);
#define PG8_SA(b, h) (((b) * 2 + (h)) * HTB)
#define PG8_SB(b, h) ((4 + (b) * 2 + (h)) * HTB)
#define PG8_STAGE(bufoff, gbase, voff) do { _Pragma("unroll") for (int _i = 0; _i < 2; ++_i) \
        __builtin_amdgcn_global_load_lds((const unsigned*)((const char*)(gbase) + (voff)[_i]), (PG8_LAS unsigned*)(lds + (bufoff) + ldsw + _i * 8192), 16, 0, 0); } while (0)
#define PG8_LDA(dst, b, h) do { _Pragma("unroll") for (int m = 0; m < 4; ++m) _Pragma("unroll") for (int k = 0; k < 2; ++k) dst[m][k] = *(const PG8_LAS bf16x8*)(lds + PG8_SA(b, h) + aoff + m * 2048 + k * 1024); } while (0)
#define PG8_LDB(dst, b, h) do { _Pragma("unroll") for (int n = 0; n < 2; ++n) _Pragma("unroll") for (int k = 0; k < 2; ++k) dst[n][k] = *(const PG8_LAS bf16x8*)(lds + PG8_SB(b, h) + boff + n * 2048 + k * 1024); } while (0)
#define PG8_MMA(ai, bj, At, Bt) do { __builtin_amdgcn_s_setprio(1); _Pragma("unroll") for (int m = 0; m < 4; ++m) _Pragma("unroll") for (int n = 0; n < 2; ++n) _Pragma("unroll") for (int k = 0; k < 2; ++k) \
        acc[ai][bj][m][n] = __builtin_amdgcn_mfma_f32_16x16x32_bf16(Bt[n][k], At[m][k], acc[ai][bj][m][n], 0, 0, 0); __builtin_amdgcn_s_setprio(0); } while (0)
#define PG8_WAIT_V(n) asm volatile("s_waitcnt vmcnt(" #n ")" ::: "memory")
#define PG8_WAIT_L(n) asm volatile("s_waitcnt lgkmcnt(" #n ")" ::: "memory")
#define PG8_BAR __builtin_amdgcn_s_barrier()
#define PG8_SCHED __builtin_amdgcn_sched_barrier(0)
    Unit cur, nxt; int ui = 0;
    if (!S.next(0, cur)) return;
    f32x4 acc[2][2][4][2];
#pragma unroll
    for (int a = 0; a < 2; ++a)
#pragma unroll
        for (int b = 0; b < 2; ++b)
#pragma unroll
            for (int m = 0; m < 4; ++m)
#pragma unroll
                for (int n = 0; n < 2; ++n) acc[a][b][m][n] = (f32x4){0.f, 0.f, 0.f, 0.f};
    bf16x8 At[4][2], B0[2][2], B1[2][2];
    const char* cA = (const char*)g.A + (size_t)cur.pm * tstep; const char* cB = (const char*)g.Bt + (size_t)cur.pn * tstep;
    S.a_ready(cur);
    if constexpr (SP2) {
        PG8_STAGE(PG8_SB(0, 0), cB, voffB); PG8_STAGE(PG8_SB(0, 1), cB + hstep, voffB); PG8_STAGE(PG8_SA(0, 0), cA, voffA); PG8_STAGE(PG8_SA(0, 1), cA + hstep, voffA);
        if (wr == 1) PG8_BAR;
        PG8_WAIT_V(2); PG8_BAR;
        PG8_STAGE(PG8_SB(1, 0), cB + kstep, voffB); PG8_STAGE(PG8_SA(1, 0), cA + kstep, voffA); PG8_STAGE(PG8_SB(1, 1), cB + hstep + kstep, voffB);
        PG8_WAIT_V(6); PG8_BAR;
    } else {
        PG8_STAGE(PG8_SB(0, 0), cB, voffB); PG8_STAGE(PG8_SA(0, 0), cA, voffA); PG8_STAGE(PG8_SB(0, 1), cB + hstep, voffB); PG8_STAGE(PG8_SA(0, 1), cA + hstep, voffA);
        if (wr == 1) PG8_BAR;
        PG8_WAIT_V(4); PG8_BAR;
        PG8_STAGE(PG8_SB(1, 0), cB + kstep, voffB); PG8_STAGE(PG8_SA(1, 0), cA + kstep, voffA); PG8_STAGE(PG8_SB(1, 1), cB + hstep + kstep, voffB);
        PG8_WAIT_V(6); PG8_BAR;
    }
    for (;;) {
        const bool has_next = S.next(ui + 1, nxt);
        const char* nA = has_next ? (const char*)g.A + (size_t)nxt.pm * tstep : cA; const char* nB = has_next ? (const char*)g.Bt + (size_t)nxt.pn * tstep : cB;
        for (int t = 0; t < nt; t += 2) {
            const bool last = (t == nt - 2);
            const char* a1 = cA + (size_t)(t + 1) * kstep;
            const char* a2 = last ? nA : cA + (size_t)(t + 2) * kstep; const char* b2 = last ? nB : cB + (size_t)(t + 2) * kstep;
            const char* a3 = a2 + kstep; const char* b3 = b2 + kstep;
            if (last && has_next) S.a_ready(nxt);
            if constexpr (SP2) {
            PG8_LDB(B0, 0, 0); PG8_LDB(B1, 0, 1); PG8_SCHED; PG8_LDA(At, 0, 0); PG8_STAGE(PG8_SA(1, 1), a1 + hstep, voffA);
            PG8_WAIT_V(8); PG8_WAIT_L(0); PG8_BAR; PG8_MMA(0, 0, At, B0); PG8_MMA(0, 1, At, B1); PG8_BAR; PG8_SCHED;
            PG8_LDA(At, 0, 1); PG8_STAGE(PG8_SB(0, 0), b2, voffB); PG8_STAGE(PG8_SB(0, 1), b2 + hstep, voffB); PG8_STAGE(PG8_SA(0, 0), a2, voffA);
            PG8_WAIT_V(8); PG8_WAIT_L(0); PG8_BAR; PG8_MMA(1, 0, At, B0); PG8_MMA(1, 1, At, B1); PG8_BAR; PG8_SCHED;
            PG8_LDB(B0, 1, 0); PG8_LDB(B1, 1, 1); PG8_SCHED; PG8_LDA(At, 1, 0); PG8_STAGE(PG8_SA(0, 1), a2 + hstep, voffA);
            PG8_WAIT_V(8); PG8_WAIT_L(0); PG8_BAR; PG8_MMA(0, 0, At, B0); PG8_MMA(0, 1, At, B1); PG8_BAR; PG8_SCHED;
            PG8_LDA(At, 1, 1); PG8_STAGE(PG8_SB(1, 0), b3, voffB); PG8_STAGE(PG8_SB(1, 1), b3 + hstep, voffB); PG8_STAGE(PG8_SA(1, 0), a3, voffA);
            PG8_WAIT_V(8); PG8_WAIT_L(0); PG8_BAR; PG8_MMA(1, 0, At, B0); PG8_MMA(1, 1, At, B1); PG8_BAR; PG8_SCHED;
            } else {
            PG8_LDB(B0, 0, 0); PG8_SCHED; PG8_LDA(At, 0, 0); PG8_STAGE(PG8_SA(1, 1), a1 + hstep, voffA);
            PG8_WAIT_L(8); PG8_BAR; PG8_WAIT_L(0); PG8_MMA(0, 0, At, B0); PG8_BAR; PG8_SCHED;
            PG8_LDB(B1, 0, 1); PG8_STAGE(PG8_SB(0, 0), b2, voffB);
            PG8_BAR; PG8_WAIT_L(0); PG8_MMA(0, 1, At, B1); PG8_BAR;
            PG8_LDA(At, 0, 1); PG8_STAGE(PG8_SA(0, 0), a2, voffA);
            PG8_BAR; PG8_WAIT_L(0); PG8_MMA(1, 0, At, B0); PG8_BAR; PG8_SCHED;
            PG8_STAGE(PG8_SB(0, 1), b2 + hstep, voffB);
            PG8_WAIT_V(6); PG8_BAR; PG8_MMA(1, 1, At, B1); PG8_BAR;
            PG8_LDB(B0, 1, 0); PG8_SCHED; PG8_LDA(At, 1, 0); PG8_STAGE(PG8_SA(0, 1), a2 + hstep, voffA);
            PG8_WAIT_L(8); PG8_BAR; PG8_WAIT_L(0); PG8_MMA(0, 0, At, B0); PG8_BAR; PG8_SCHED;
            PG8_LDB(B1, 1, 1); PG8_STAGE(PG8_SB(1, 0), b3, voffB);
            PG8_BAR; PG8_WAIT_L(0); PG8_MMA(0, 1, At, B1); PG8_BAR;
            PG8_LDA(At, 1, 1); PG8_STAGE(PG8_SA(1, 0), a3, voffA);
            PG8_BAR; PG8_WAIT_L(0); PG8_MMA(1, 0, At, B0); PG8_BAR; PG8_SCHED;
            PG8_STAGE(PG8_SB(1, 1), b3 + hstep, voffB);
            PG8_WAIT_V(6); PG8_BAR; PG8_MMA(1, 1, At, B1); PG8_BAR;
            }
        }
        if constexpr (ALIGN_EPI) { if (wr == 0) PG8_BAR; }
        if constexpr (!Epi::AFTER_DRAIN) { E(acc, cur, wr, wc, fr, fq); S.done(cur); }
        if (!has_next) break;
#pragma unroll
        for (int a = 0; a < 2; ++a)
#pragma unroll
            for (int b = 0; b < 2; ++b)
#pragma unroll
                for (int m = 0; m < 4; ++m)
#pragma unroll
                    for (int n = 0; n < 2; ++n) acc[a][b][m][n] = (f32x4){0.f, 0.f, 0.f, 0.f};
        cur = nxt; cA = nA; cB = nB; ++ui;
        if constexpr (ALIGN_EPI) { if (wr == 1) PG8_BAR; }
    }
    PG8_WAIT_V(0);
    if constexpr (!ALIGN_EPI) { if (wr == 0) PG8_BAR; }
    PG8_BAR;
    if constexpr (Epi::AFTER_DRAIN) { E.fused(acc, cur, wr, wc, fr, fq, lds, wid, lane); S.done(cur); }
#undef PG8_SA
#undef PG8_SB
#undef PG8_STAGE
#undef PG8_LDA
#undef PG8_LDB
#undef PG8_MMA
#undef PG8_WAIT_V
#undef PG8_WAIT_L
#undef PG8_BAR
#undef PG8_SCHED
}
}
constexpr int CW_BAR = 4096;
constexpr size_t CTL_BYTES = 65536;
#define XB_TMO      128
#define XB_XCNT(j)  (256  + 64 * (j))
#define XB_XSUB(j)  (1280 + 64 * (j))
#define XB_XGEN(j)  (2304 + 64 * (j))
#define XB_TOP      3328
#define XB_TOPGEN   3392
#define XCD_BAR_WORDS 3456
#define XB_SPIN_CAP (1u << 18)

__device__ __forceinline__ unsigned xb_ld(unsigned* p)              { return __hip_atomic_load(p, __ATOMIC_RELAXED, __HIP_MEMORY_SCOPE_AGENT); }
__device__ __forceinline__ unsigned xb_add(unsigned* p, unsigned v) { return __hip_atomic_fetch_add(p, v, __ATOMIC_RELAXED, __HIP_MEMORY_SCOPE_AGENT); }
__device__ __forceinline__ unsigned xb_xcc_id() { return (unsigned)__builtin_amdgcn_s_getreg((3 << 11) | 20) & 0xFu; }
#define XB_SPIN(cond, bar) do { unsigned _sp = 0; while (cond) { __builtin_amdgcn_s_sleep(1); \
    if ((++_sp & 255u) == 0u) { if (xb_ld(&(bar)[XB_TMO])) break; if (_sp > XB_SPIN_CAP) { atomicAdd(&(bar)[XB_TMO], 1u); break; } } } } while (0)

struct XcdBarrier {
    unsigned* bar; unsigned x; bool lead;
    volatile LAS unsigned* st;
};

__device__ __forceinline__ XcdBarrier xcd_barrier_post(unsigned* bar, volatile LAS unsigned* st, bool lead) {
    XcdBarrier b; b.bar = bar; b.x = xb_xcc_id(); b.st = st; b.lead = lead;
    if (b.lead) (void)xb_add(&bar[XB_XCNT(b.x)], 1u);
    return b;
}
__device__ __forceinline__ void xcd_barrier_complete(unsigned* bar, unsigned x, unsigned& nloc, unsigned& nx) {
    const unsigned G = gridDim.x * gridDim.y * gridDim.z;
    unsigned sum, cnt, mine, sp = 0u;
    for (;;) {
        sum = 0u; cnt = 0u; mine = 0u;
#pragma unroll
        for (unsigned j = 0; j < 16; ++j) { const unsigned c = xb_ld(&bar[XB_XCNT(j)]); sum += c; cnt += (c > 0u) ? 1u : 0u; mine = (j == x) ? c : mine; }
        if (sum == G) break;
        __builtin_amdgcn_s_sleep(1);
        if ((++sp & 255u) == 0u) { if (xb_ld(&bar[XB_TMO])) break; if (sp > XB_SPIN_CAP) { atomicAdd(&bar[XB_TMO], 1u); break; } }
    }
    nloc = mine > 0u ? mine : 1u; nx = cnt > 0u ? cnt : 1u;
}

__device__ __forceinline__ void xcd_barrier(const XcdBarrier& b) {
    asm volatile("s_waitcnt vmcnt(0)" ::: "memory");
    __syncthreads();
    if (b.lead) {
        unsigned* bar = b.bar;
        __builtin_amdgcn_s_waitcnt(0);
        unsigned nloc = b.st[0], nx = b.st[1];
        if (nloc == 0u) { xcd_barrier_complete(bar, b.x, nloc, nx); b.st[0] = nloc; b.st[1] = nx; }
        const unsigned old = xb_add(&bar[XB_XSUB(b.x)], 1u);
        const unsigned gen = old / nloc;
        if (old + 1u == (gen + 1u) * nloc) {
            __builtin_amdgcn_fence(__ATOMIC_RELEASE, "agent");
            asm volatile("s_waitcnt vmcnt(0)" ::: "memory");
            const unsigned og = xb_add(&bar[XB_TOP], 1u);
            const unsigned tg = og / nx;
            if (og + 1u == (tg + 1u) * nx) xb_add(&bar[XB_TOPGEN], 1u);
            else XB_SPIN(xb_ld(&bar[XB_TOPGEN]) == tg, bar);
            __builtin_amdgcn_fence(__ATOMIC_ACQUIRE, "agent");
            xb_add(&bar[XB_XGEN(b.x)], 1u);
            asm volatile("s_waitcnt vmcnt(0)" ::: "memory");
        } else {
            XB_SPIN(xb_ld(&bar[XB_XGEN(b.x)]) == gen, bar);
            __builtin_amdgcn_fence(__ATOMIC_ACQUIRE, "agent");
            asm volatile("s_waitcnt vmcnt(0)" ::: "memory");
        }
    }
    __syncthreads();
}


__device__ __forceinline__ void phase_mod1(KP p, int wv, int bid, int nb, float* lds) {
    float (*red)[8][64] = (float (*)[8][64])lds;
    const int t = tid_opaque(wv), cn = t & 63, kg = t >> 6;
    for (int u = bid; u < DEPTH * 96 * 16; u += nb) {
        const int ks = u & 15, nblk = (u >> 4) % 96, l = u / (16 * 96);
        const int n = nblk * 64 + cn;
        float a0 = 0.f, a1 = 0.f, a2 = 0.f;
#pragma unroll
        for (int kk = 0; kk < 8; ++kk) {
            const int k = ks * 64 + kg * 8 + kk;
            const float w = p->w_mod[((size_t)l * D + k) * 6144 + n];
            a0 += silu_f(p->c[k]) * w; a1 += silu_f(p->c[D + k]) * w; a2 += silu_f(p->c_ctx[k]) * w;
        }
        __syncthreads();
        red[0][kg][cn] = a0; red[1][kg][cn] = a1; red[2][kg][cn] = a2;
        __syncthreads();
        if (t < 192) {
            const int v = t >> 6;
            float s = 0.f;
#pragma unroll
            for (int g = 0; g < 8; ++g) s += red[v][g][cn];
            p->modp[(((size_t)ks * DEPTH + l) * 3 + v) * 6144 + n] = s;
        }
    }
    __syncthreads();
}
__device__ __forceinline__ void phase_mod2(KP p, int wv, int bid, int nb) {
    for (int i = bid * NT + tid_opaque(wv); i < DEPTH * 3 * 6144; i += nb * NT) {
        const int n = i % 6144, l = i / (3 * 6144);
        float s = p->b_mod[l * 6144 + n];
        for (int ks = 0; ks < 16; ++ks) s += p->modp[(size_t)ks * DEPTH * 3 * 6144 + i];
        p->mod[i] = s;
    }
}
__device__ __forceinline__ void transpose_item(const float* W, int K, int N, bf16* WT, float* scr, int item, int lane) {
    const int nblk = N / 32, kb = item / nblk, nbk = item % nblk, k0 = 64 * kb, n0 = 32 * nbk;
#pragma unroll 8
    for (int i = 0; i < 32; ++i) { const int kk = 2 * i + (lane >> 5); scr[kk * 33 + (lane & 31)] = W[(size_t)(k0 + kk) * N + n0 + (lane & 31)]; }
    __builtin_amdgcn_wave_barrier();
    const int c = lane & 7;
#pragma unroll
    for (int j = 0; j < 4; ++j) { const int n = (lane >> 3) + 8 * j; const float* s = scr + (8 * c) * 33 + n;
        uint4 o; o.x = pk2(s[0 * 33], s[1 * 33]); o.y = pk2(s[2 * 33], s[3 * 33]); o.z = pk2(s[4 * 33], s[5 * 33]); o.w = pk2(s[6 * 33], s[7 * 33]);
        *(uint4*)(WT + (size_t)(n0 + n) * K + k0 + 8 * c) = o; }
    __builtin_amdgcn_wave_barrier();
}
__device__ __forceinline__ void phase_weights(KP p, int wv, int bid, int nb, float* lds) {
    const int lane = tid_opaque(wv) & 63, w = tid_opaque(wv) >> 6;
    float* scr = lds + 2048 + w * (64 * 33 + 16);
    constexpr int I_IN = 16 * 72, I_OUT = 16 * 32, I_Q = 16 * 64;
    constexpr int NITEMS = DEPTH * (I_IN + I_OUT + I_Q);
    for (int it = bid * NW + w; it < NITEMS; it += nb * NW) {
        int r = it;
        if (r < DEPTH * I_IN) { const int l = r / I_IN; transpose_item(p->w_in + (size_t)l * D * DIN, D, DIN, p->WtIn + (size_t)l * DIN * D, scr, r % I_IN, lane); continue; } r -= DEPTH * I_IN;
        if (r < DEPTH * I_OUT) { const int l = r / I_OUT; transpose_item(p->w_out + (size_t)l * D * D, D, D, p->WtOut + (size_t)l * D * D, scr, r % I_OUT, lane); continue; } r -= DEPTH * I_OUT;
        { const int l = r / I_Q; transpose_item(p->wq + (size_t)l * D * 2048, D, 2048, p->WtQ + (size_t)l * 2048 * D, scr, r % I_Q, lane); }
    }
    {
        const int lane_ = tid_opaque(wv) & 63, w_ = tid_opaque(wv) >> 6;
        for (int row0 = (bid * NW + w_) * 4; row0 < 2 * DEPTH * PEER_N; row0 += nb * NW * 4) {
            float v[4][16];
#pragma unroll
            for (int q = 0; q < 4; ++q) {
                const int row = row0 + q; const bool isv = row >= DEPTH * PEER_N; const int rr = isv ? row - DEPTH * PEER_N : row;
                const float* src_ = (isv ? p->pv : p->pu) + (size_t)rr * D;
#pragma unroll
                for (int i = 0; i < 4; ++i) { typedef float f4v_ __attribute__((ext_vector_type(4))); const f4v_ q4 = __builtin_nontemporal_load((const f4v_*)(src_ + i * 256 + lane_ * 4)); v[q][i * 4 + 0] = q4[0]; v[q][i * 4 + 1] = q4[1]; v[q][i * 4 + 2] = q4[2]; v[q][i * 4 + 3] = q4[3]; }
            }
#pragma unroll
            for (int q = 0; q < 4; ++q) {
                const int row = row0 + q; const bool isv = row >= DEPTH * PEER_N; const int rr = isv ? row - DEPTH * PEER_N : row;
                float m = 0.f;
#pragma unroll
                for (int i = 0; i < 16; ++i) m = fmaxf(m, fabsf(v[q][i]));
#pragma unroll
                for (int o = 32; o >= 1; o >>= 1) m = fmaxf(m, shx(m, o, lane_));
                unsigned* dst = (unsigned*)((isv ? p->V8 : p->U8) + (size_t)rr * D);
                if (!isv) {
                    const float inv = m > 0.f ? 127.0f / m : 0.f;
#pragma unroll
                    for (int i = 0; i < 4; ++i) {
                        const int q0 = (int)rintf(v[q][i * 4 + 0] * inv), q1 = (int)rintf(v[q][i * 4 + 1] * inv), q2 = (int)rintf(v[q][i * 4 + 2] * inv), q3 = (int)rintf(v[q][i * 4 + 3] * inv);
                        dst[i * 64 + lane_] = (unsigned)(q0 & 0xff) | ((unsigned)(q1 & 0xff) << 8) | ((unsigned)(q2 & 0xff) << 16) | ((unsigned)(q3 & 0xff) << 24);
                    }
                    if (lane_ == 0) p->SU[rr] = m * (1.0f / 127.0f);
                } else {
                    const float inv = m > 0.f ? 240.0f / m : 0.f;
#pragma unroll
                    for (int i = 0; i < 4; ++i) {
                        int pk = __builtin_amdgcn_cvt_pk_fp8_f32(v[q][i * 4 + 0] * inv, v[q][i * 4 + 1] * inv, 0, false);
                        pk = __builtin_amdgcn_cvt_pk_fp8_f32(v[q][i * 4 + 2] * inv, v[q][i * 4 + 3] * inv, pk, true);
                        dst[i * 64 + lane_] = (unsigned)pk;
                    }
                    if (lane_ == 0) p->SV[rr] = m * (1.0f / 240.0f);
                }
            }
        }
    }
    for (int i = bid * NT + tid_opaque(wv); i < 192 * 16; i += nb * NT) {
        const int idx = i >> 4, f = i & 15;
        const float inv = powf(10000.0f, -(float)f / 16.0f);
        const float ang = (float)(idx < 128 ? idx : idx - 128) * inv;
        p->rope[2 * i] = cosf(ang); p->rope[2 * i + 1] = sinf(ang);
    }
}

__device__ __forceinline__ void row_load(const float* src, float (&v)[16], int lane) {
#pragma unroll
    for (int i = 0; i < 4; ++i) { const float4 q = *(const float4*)(src + i * 256 + lane * 4); v[i * 4 + 0] = q.x; v[i * 4 + 1] = q.y; v[i * 4 + 2] = q.z; v[i * 4 + 3] = q.w; }
}
__device__ __forceinline__ void row_store(float* dst, const float (&v)[16], int lane) {
#pragma unroll
    for (int i = 0; i < 4; ++i) *(float4*)(dst + i * 256 + lane * 4) = make_float4(v[i * 4 + 0], v[i * 4 + 1], v[i * 4 + 2], v[i * 4 + 3]);
}
__device__ __forceinline__ void row_store_bf(bf16* dst, const float (&v)[16], int lane) {
#pragma unroll
    for (int i = 0; i < 4; ++i) *(uint2*)(dst + i * 256 + lane * 4) = make_uint2(pk2(v[i * 4 + 0], v[i * 4 + 1]), pk2(v[i * 4 + 2], v[i * 4 + 3]));
}
__device__ __forceinline__ void row_load_bf(const bf16* src, float (&v)[16], int lane) {
#pragma unroll
    for (int i = 0; i < 4; ++i) { const uint2 q = *(const uint2*)(src + i * 256 + lane * 4); v[i * 4 + 0] = bflo(q.x); v[i * 4 + 1] = bfhi(q.x); v[i * 4 + 2] = bflo(q.y); v[i * 4 + 3] = bfhi(q.y); }
}
__device__ __forceinline__ void row_ln(float (&v)[16], int lane) {
    float s = 0.f;
#pragma unroll
    for (int i = 0; i < 16; ++i) s += v[i];
    const float mu = wave_sum(s, lane) * (1.0f / D);
    float q = 0.f;
#pragma unroll
    for (int i = 0; i < 16; ++i) { v[i] -= mu; q += v[i] * v[i]; }
    const float rstd = rsqrtf(wave_sum(q, lane) * (1.0f / D) + LN_EPS);
#pragma unroll
    for (int i = 0; i < 16; ++i) v[i] *= rstd;
}
__device__ __forceinline__ const float* x_row(KP p, int l, int r) {
    if (l == 0) return r < TL ? p->x + (size_t)r * D : p->ctx + (size_t)(r - TL) * D;
    return nullptr;
}

__device__ __forceinline__ void phase_lnmod(KP p, int wv, int l, int bid, int nb) {
    const int lane = tid_opaque(wv) & 63, w = tid_opaque(wv) >> 6;
    for (int r = bid * NW + w; r < T; r += nb * NW) {
        float v[16], sh[16], sc[16];
        row_load(x_row(p, l, r), v, lane);
        const float* m = p->mod + ((size_t)l * 3 + mod_idx(r)) * 6144;
        row_load(m, sh, lane); row_load(m + 1024, sc, lane);
        row_ln(v, lane);
#pragma unroll
        for (int i = 0; i < 16; ++i) v[i] = v[i] * (1.0f + sc[i]) + sh[i];
        row_store_bf(p->H + (size_t)r * D, v, lane);
    }
}

typedef short bf16x8_t __attribute__((ext_vector_type(8)));
typedef short bf16x4_t __attribute__((ext_vector_type(4)));
typedef float f32x4_t __attribute__((ext_vector_type(4)));
#define MFMA16(a, b, c) __builtin_amdgcn_mfma_f32_16x16x32_bf16((a), (b), (c), 0, 0, 0)
constexpr int KROW = 72;
constexpr int TROW = 136;
__device__ __forceinline__ bf16x8_t lds_frag16(const bf16* p) { return *(const bf16x8_t*)p; }
__device__ __forceinline__ bf16x8_t lds_frag8x2(const bf16* p0, const bf16* p1) {
    const bf16x4_t a = *(const bf16x4_t*)p0, b = *(const bf16x4_t*)p1;
    bf16x8_t o; o[0] = a[0]; o[1] = a[1]; o[2] = a[2]; o[3] = a[3]; o[4] = b[0]; o[5] = b[1]; o[6] = b[2]; o[7] = b[3]; return o;
}
__device__ __forceinline__ bf16x8_t pack_p(const f32x4_t& x, const f32x4_t& y) {
    uint4 w; w.x = pk2(x[0], x[1]); w.y = pk2(x[2], x[3]); w.z = pk2(y[0], y[1]); w.w = pk2(y[2], y[3]);
    return __builtin_bit_cast(bf16x8_t, w);
}
__device__ __forceinline__ void st_tr8(bf16* dst_col0, int stride, const uint4& v) {
    dst_col0[0 * stride] = (bf16)(v.x & 0xffffu); dst_col0[1 * stride] = (bf16)(v.x >> 16);
    dst_col0[2 * stride] = (bf16)(v.y & 0xffffu); dst_col0[3 * stride] = (bf16)(v.y >> 16);
    dst_col0[4 * stride] = (bf16)(v.z & 0xffffu); dst_col0[5 * stride] = (bf16)(v.z >> 16);
    dst_col0[6 * stride] = (bf16)(v.w & 0xffffu); dst_col0[7 * stride] = (bf16)(v.w >> 16);
}

constexpr int ATT_BUF = 128 * KROW + 64 * TROW;
__device__ __forceinline__ void att_unit(KP p, int wv, int l, int u, bf16* lds) {
    const int t = tid_opaque(wv), lane = t & 63, w = t >> 6, r = lane & 15, g = lane >> 4;
    const bool lat = u < 256;
    int b, n, hkv;
    if (lat) { hkv = u & 1; n = (u >> 1) & 63; b = u >> 7; } else { const int v = u - 256; hkv = v & 1; n = (v >> 1) & 1; b = v >> 2; }
    const int hq = hkv * 4 + (w >> 1), qh = w & 1;
    const int qrow0 = (lat ? b * SEQ + n * 128 : TL + b * LC + n * 128) + qh * 64;
    int kb_lo = 0, kb_hi = -1;
    if (lat) { kb_lo = n > 0 ? n - 1 : 0; kb_hi = n < 63 ? n + 1 : 63; }
    const int nloc = kb_hi - kb_lo + 1, nblk = nloc + 2;
    const bf16* P = p->P;
    bf16x8_t qf[4][2];
#pragma unroll
    for (int qt = 0; qt < 4; ++qt)
#pragma unroll
        for (int ks = 0; ks < 2; ++ks) qf[qt][ks] = *(const bf16x8_t*)(P + (size_t)(qrow0 + qt * 16 + r) * DIN + C_AQ + hq * 64 + ks * 32 + g * 8);
    const float LOG2E = 1.4426950408889634f;
    const float sink2 = p->sink[l * 8 + hq] * LOG2E;
    float m[4], lsum[4];
    f32x4_t ot[4][4];
#pragma unroll
    for (int qt = 0; qt < 4; ++qt) { m[qt] = sink2; lsum[qt] = g == 0 ? 1.0f : 0.0f; }
#pragma unroll
    for (int dt = 0; dt < 4; ++dt)
#pragma unroll
        for (int qt = 0; qt < 4; ++qt) ot[dt][qt] = (f32x4_t){0.f, 0.f, 0.f, 0.f};
    uint4 kreg0, kreg1, vreg0, vreg1;
#define ATT_ROW0(bi) ((bi) < nloc ? b * SEQ + (kb_lo + (bi)) * 128 : TL + b * LC + ((bi) - nloc) * 128)
    const int key0 = t >> 3, key1 = key0 + 64, c8 = t & 7;
#define ATT_ISSUE(bi) do { const bf16* src_ = P + (size_t)(ATT_ROW0(bi) + key0) * DIN + hkv * 64 + c8 * 8; \
        kreg0 = *(const uint4*)(src_ + C_AK); vreg0 = *(const uint4*)(src_ + C_AV); \
        kreg1 = *(const uint4*)(src_ + 64 * DIN + C_AK); vreg1 = *(const uint4*)(src_ + 64 * DIN + C_AV); } while (0)
#define ATT_STAGE(buf) do { \
        *(uint4*)((buf) + key0 * KROW + c8 * 8) = kreg0; *(uint4*)((buf) + key1 * KROW + c8 * 8) = kreg1; \
        st_tr8((buf) + 128 * KROW + (c8 * 8) * TROW + key0, TROW, vreg0); st_tr8((buf) + 128 * KROW + (c8 * 8) * TROW + key1, TROW, vreg1); } while (0)
    __syncthreads();
    ATT_ISSUE(0);
    for (int bi = 0; bi < nblk; ++bi) {
        bf16* buf = lds + (bi & 1) * ATT_BUF;
        ATT_STAGE(buf);
        __syncthreads();
        if (bi + 1 < nblk) ATT_ISSUE(bi + 1);
        const bf16* Ks = buf; const bf16* Vt = buf + 128 * KROW;
        const int band = (bi < nloc) ? (kb_lo + bi) - n : 0;
#pragma unroll 1
        for (int sub = 0; sub < 2; ++sub) {
            f32x4_t st[4][4];
#pragma unroll
            for (int kt = 0; kt < 4; ++kt) {
#pragma unroll
                for (int qt = 0; qt < 4; ++qt) st[kt][qt] = (f32x4_t){0.f, 0.f, 0.f, 0.f};
#pragma unroll
                for (int ks = 0; ks < 2; ++ks) {
                    const bf16x8_t a = lds_frag16(Ks + (sub * 64 + kt * 16 + r) * KROW + ks * 32 + g * 8);
#pragma unroll
                    for (int qt = 0; qt < 4; ++qt) st[kt][qt] = MFMA16(a, qf[qt][ks], st[kt][qt]);
                }
            }
#pragma unroll
            for (int qt = 0; qt < 4; ++qt) {
                const int il = qh * 64 + qt * 16 + r;
                float mloc = -INFINITY;
#pragma unroll
                for (int kt = 0; kt < 4; ++kt)
#pragma unroll
                    for (int i = 0; i < 4; ++i) {
                        const int jl = sub * 64 + kt * 16 + g * 4 + i;
                        float s = st[kt][qt][i] * LOG2E;
                        if (band < 0) { if (jl < il) s = -INFINITY; } else if (band > 0) { if (jl > il) s = -INFINITY; }
                        st[kt][qt][i] = s; mloc = fmaxf(mloc, s);
                    }
                mloc = fmaxf(mloc, shx(mloc, 16, lane)); mloc = fmaxf(mloc, shx(mloc, 32, lane));
                const float mnew = fmaxf(m[qt], mloc);
                const float alpha = __builtin_amdgcn_exp2f(m[qt] - mnew);
                m[qt] = mnew;
                float ps = 0.f;
#pragma unroll
                for (int kt = 0; kt < 4; ++kt)
#pragma unroll
                    for (int i = 0; i < 4; ++i) { const float e = __builtin_amdgcn_exp2f(st[kt][qt][i] - mnew); st[kt][qt][i] = e; ps += e; }
                lsum[qt] = lsum[qt] * alpha + ps;
#pragma unroll
                for (int dt = 0; dt < 4; ++dt) ot[dt][qt] = ot[dt][qt] * alpha;
            }
#pragma unroll
            for (int kp = 0; kp < 2; ++kp) {
                bf16x8_t pf[4];
#pragma unroll
                for (int qt = 0; qt < 4; ++qt) pf[qt] = pack_p(st[2 * kp][qt], st[2 * kp + 1][qt]);
#pragma unroll
                for (int dt = 0; dt < 4; ++dt) {
                    const bf16* vrow = Vt + (dt * 16 + r) * TROW + sub * 64 + g * 4;
                    const bf16x8_t a = lds_frag8x2(vrow + (2 * kp) * 16, vrow + (2 * kp + 1) * 16);
#pragma unroll
                    for (int qt = 0; qt < 4; ++qt) ot[dt][qt] = MFMA16(a, pf[qt], ot[dt][qt]);
                }
            }
        }
    }
#pragma unroll
    for (int qt = 0; qt < 4; ++qt) {
        float ls = lsum[qt]; ls += shx(ls, 16, lane); ls += shx(ls, 32, lane);
        const float inv = 1.0f / ls;
        bf16* orow = p->MIX + (size_t)(qrow0 + qt * 16 + r) * D + 512 + hq * 64 + g * 4;
#pragma unroll
        for (int dt = 0; dt < 4; ++dt) {
            const f32x4_t o = ot[dt][qt] * inv;
            *(uint2*)(orow + dt * 16) = make_uint2(pk2(o[0], o[1]), pk2(o[2], o[3]));
        }
    }
}

__device__ __forceinline__ size_t kv_off(int dir, int b, int pos, int h) { return ((((size_t)dir * NB + b) * NPOS + pos) * 4 + h) * 4096; }
__device__ __forceinline__ void ret_kv_unit(KP p, int wv, int l, int u, bf16* lds) {
    const int h = u & 3, pos = (u >> 2) % NPOS, b = u / (4 * NPOS);
    const int t = tid_opaque(wv), lane = t & 63, w = t >> 6, r = lane & 15, g = lane >> 4;
    bf16* Ktf = lds; bf16* Ktb = lds + 64 * TROW; bf16* Vt = lds + 2 * 64 * TROW;
    const float lgf = log_sigmoid_f(p->rdf[l * 4 + h]), lgb = log_sigmoid_f(p->rdb[l * 4 + h]);
    const int r0 = chunk_row0(b, pos);
    const bf16* P = p->P;
    __syncthreads();
#pragma unroll
    for (int q = 0; q < 2; ++q) {
        const int pc = t + q * NT, j = pc >> 3, c8 = pc & 7;
        const bf16* src = P + (size_t)(r0 + j) * DIN + h * 64 + c8 * 8;
        const uint4 kv = *(const uint4*)(src + C_RK), vv = *(const uint4*)(src + C_RV);
        const float wf = expf(lgf * (float)(127 - j)), wb = expf(lgb * (float)j);
        uint4 kf, kb;
        kf.x = pk2(bflo(kv.x) * wf, bfhi(kv.x) * wf); kf.y = pk2(bflo(kv.y) * wf, bfhi(kv.y) * wf); kf.z = pk2(bflo(kv.z) * wf, bfhi(kv.z) * wf); kf.w = pk2(bflo(kv.w) * wf, bfhi(kv.w) * wf);
        kb.x = pk2(bflo(kv.x) * wb, bfhi(kv.x) * wb); kb.y = pk2(bflo(kv.y) * wb, bfhi(kv.y) * wb); kb.z = pk2(bflo(kv.z) * wb, bfhi(kv.z) * wb); kb.w = pk2(bflo(kv.w) * wb, bfhi(kv.w) * wb);
        st_tr8(Ktf + (c8 * 8) * TROW + j, TROW, kf);
        st_tr8(Ktb + (c8 * 8) * TROW + j, TROW, kb);
        st_tr8(Vt + (c8 * 8) * TROW + j, TROW, vv);
    }
    __syncthreads();
    const int dir = w >> 2, dvt = w & 3;
    const bf16* Kt = dir ? Ktb : Ktf;
    f32x4_t acc[4];
#pragma unroll
    for (int dkt = 0; dkt < 4; ++dkt) acc[dkt] = (f32x4_t){0.f, 0.f, 0.f, 0.f};
#pragma unroll
    for (int ks = 0; ks < 4; ++ks) {
        const bf16x8_t a = lds_frag16(Vt + (dvt * 16 + r) * TROW + ks * 32 + g * 8);
#pragma unroll
        for (int dkt = 0; dkt < 4; ++dkt) acc[dkt] = MFMA16(a, lds_frag16(Kt + (dkt * 16 + r) * TROW + ks * 32 + g * 8), acc[dkt]);
    }
    float* o = p->KV + kv_off(dir, b, pos, h);
#pragma unroll
    for (int dkt = 0; dkt < 4; ++dkt)
#pragma unroll
        for (int i = 0; i < 4; ++i) o[(dvt * 16 + g * 4 + i) * 64 + dkt * 16 + r] = acc[dkt][i];
}

__device__ __forceinline__ void phase_ret_scan(KP p, int wv, int l, int bid, int nb) {
    for (int i = bid * NT + tid_opaque(wv); i < 2 * NB * 4 * 4096; i += nb * NT) {
        const int e = i & 4095, h = (i >> 12) & 3, b = (i >> 14) & 1, dir = i >> 15;
        const float lg = log_sigmoid_f(dir ? p->rdb[l * 4 + h] : p->rdf[l * 4 + h]);
        const float cdec = expf(128.0f * lg);
        const float* kv = p->KV; bf16* st = p->ST16;
        float v[NPOS];
#pragma unroll
        for (int step = 0; step < NPOS; ++step) {
            const int pos = dir == 0 ? step : (step == 0 ? 1 : (step == 1 ? 0 : 67 - step));
            v[step] = kv[kv_off(dir, b, pos, h) + e];
        }
        float s = 0.f;
#pragma unroll
        for (int step = 0; step < NPOS; ++step) {
            const int pos = dir == 0 ? step : (step == 0 ? 1 : (step == 1 ? 0 : 67 - step));
            st[kv_off(dir, b, pos, h) + e] = (bf16)f2bf(s);
            s = s * cdec + v[step];
        }
    }
}

constexpr int RO_HEAD = 128 * KROW + 64 * TROW + 2 * 64 * KROW;
constexpr int RO_TAB = 2 * RO_HEAD;
__device__ __forceinline__ void ret_out_unit(KP p, int wv, int l, int u, bf16* lds) {
    const int hp = u & 1, pos = (u >> 1) % NPOS, b = u / (2 * NPOS);
    if (l == DEPTH - 1 && pos < 2) return;
    const int t = tid_opaque(wv), lane = t & 63, w = t >> 6, r = lane & 15, g = lane >> 4;
    const int r0 = chunk_row0(b, pos);
    const bf16* P = p->P;
    float* tabs = (float*)(lds + RO_TAB);
    __syncthreads();
#pragma unroll
    for (int q = 0; q < 4; ++q) {
        const int pc = t + q * NT, hh = pc >> 10, j = (pc >> 3) & 127, c8 = pc & 7, h = hp * 2 + hh;
        bf16* base = lds + hh * RO_HEAD;
        const bf16* src = P + (size_t)(r0 + j) * DIN + h * 64 + c8 * 8;
        *(uint4*)(base + j * KROW + c8 * 8) = *(const uint4*)(src + C_RK);
        const uint4 vv = *(const uint4*)(src + C_RV);
        st_tr8(base + 128 * KROW + (c8 * 8) * TROW + j, TROW, vv);
    }
#pragma unroll
    for (int q = 0; q < 4; ++q) {
        const int pc = t + q * NT, hh = pc >> 10, dir = (pc >> 9) & 1, dv = (pc >> 3) & 63, c8 = pc & 7, h = hp * 2 + hh;
        const uint4 sv = *(const uint4*)(p->ST16 + kv_off(dir, b, pos, h) + dv * 64 + c8 * 8);
        *(uint4*)(lds + hh * RO_HEAD + 128 * KROW + 64 * TROW + dir * 64 * KROW + dv * KROW + c8 * 8) = sv;
    }
    if (t < 4 * 132) {
        const int hh = t / 264, dir = (t / 132) & 1, k = t % 132, h = hp * 2 + hh;
        const float lg = log_sigmoid_f(dir ? p->rdb[l * 4 + h] : p->rdf[l * 4 + h]);
        tabs[(hh * 2 + dir) * 132 + k] = expf(lg * (float)k);
    }
    __syncthreads();
    const int hh = w >> 2, h = hp * 2 + hh, qw = w & 3;
    const bf16* Ks = lds + hh * RO_HEAD; const bf16* Vt = Ks + 128 * KROW; const bf16* Sft = Vt + 64 * TROW; const bf16* Sbt = Sft + 64 * KROW;
    const float* pf = tabs + (hh * 2) * 132; const float* pb = pf + 132;
    bf16x8_t qf[2][2];
#pragma unroll
    for (int qt = 0; qt < 2; ++qt)
#pragma unroll
        for (int ks = 0; ks < 2; ++ks) qf[qt][ks] = *(const bf16x8_t*)(P + (size_t)(r0 + qw * 32 + qt * 16 + r) * DIN + C_RQ + h * 64 + ks * 32 + g * 8);
    f32x4_t accI[4][2], accF[4][2], accB[4][2];
#pragma unroll
    for (int dt = 0; dt < 4; ++dt)
#pragma unroll
        for (int qt = 0; qt < 2; ++qt) { accI[dt][qt] = (f32x4_t){0.f, 0.f, 0.f, 0.f}; accF[dt][qt] = accI[dt][qt]; accB[dt][qt] = accI[dt][qt]; }
#pragma unroll
    for (int dt = 0; dt < 4; ++dt)
#pragma unroll
        for (int ks = 0; ks < 2; ++ks) {
            const bf16x8_t af = lds_frag16(Sft + (dt * 16 + r) * KROW + ks * 32 + g * 8), ab = lds_frag16(Sbt + (dt * 16 + r) * KROW + ks * 32 + g * 8);
#pragma unroll
            for (int qt = 0; qt < 2; ++qt) { accF[dt][qt] = MFMA16(af, qf[qt][ks], accF[dt][qt]); accB[dt][qt] = MFMA16(ab, qf[qt][ks], accB[dt][qt]); }
        }
#pragma unroll 1
    for (int sub = 0; sub < 2; ++sub) {
        f32x4_t st[4][2];
#pragma unroll
        for (int kt = 0; kt < 4; ++kt) {
#pragma unroll
            for (int qt = 0; qt < 2; ++qt) st[kt][qt] = (f32x4_t){0.f, 0.f, 0.f, 0.f};
#pragma unroll
            for (int ks = 0; ks < 2; ++ks) {
                const bf16x8_t a = lds_frag16(Ks + (sub * 64 + kt * 16 + r) * KROW + ks * 32 + g * 8);
#pragma unroll
                for (int qt = 0; qt < 2; ++qt) st[kt][qt] = MFMA16(a, qf[qt][ks], st[kt][qt]);
            }
        }
#pragma unroll
        for (int qt = 0; qt < 2; ++qt) {
            const int il = qw * 32 + qt * 16 + r;
#pragma unroll
            for (int kt = 0; kt < 4; ++kt)
#pragma unroll
                for (int i = 0; i < 4; ++i) {
                    const int rel = il - (sub * 64 + kt * 16 + g * 4 + i);
                    const float wgt = rel > 0 ? pf[rel] : (rel < 0 ? pb[-rel] : 2.0f);
                    st[kt][qt][i] *= wgt;
                }
        }
#pragma unroll
        for (int kp = 0; kp < 2; ++kp) {
            bf16x8_t pfr[2];
#pragma unroll
            for (int qt = 0; qt < 2; ++qt) pfr[qt] = pack_p(st[2 * kp][qt], st[2 * kp + 1][qt]);
#pragma unroll
            for (int dt = 0; dt < 4; ++dt) {
                const bf16* vrow = Vt + (dt * 16 + r) * TROW + sub * 64 + g * 4;
                const bf16x8_t a = lds_frag8x2(vrow + (2 * kp) * 16, vrow + (2 * kp + 1) * 16);
#pragma unroll
                for (int qt = 0; qt < 2; ++qt) accI[dt][qt] = MFMA16(a, pfr[qt], accI[dt][qt]);
            }
        }
    }
#pragma unroll
    for (int qt = 0; qt < 2; ++qt) {
        const int il = qw * 32 + qt * 16 + r;
        const float qfd = pf[il + 1], qbd = pb[128 - il];
        float s = 0.f;
#pragma unroll
        for (int dt = 0; dt < 4; ++dt) { accI[dt][qt] = accI[dt][qt] + accF[dt][qt] * qfd + accB[dt][qt] * qbd; s += (accI[dt][qt][0] + accI[dt][qt][1]) + (accI[dt][qt][2] + accI[dt][qt][3]); }
        s += shx(s, 16, lane); s += shx(s, 32, lane);
        const float mu = s * (1.0f / 64.0f);
        float qq = 0.f;
#pragma unroll
        for (int dt = 0; dt < 4; ++dt) { accI[dt][qt] = accI[dt][qt] - mu; qq += (accI[dt][qt][0] * accI[dt][qt][0] + accI[dt][qt][1] * accI[dt][qt][1]) + (accI[dt][qt][2] * accI[dt][qt][2] + accI[dt][qt][3] * accI[dt][qt][3]); }
        qq += shx(qq, 16, lane); qq += shx(qq, 32, lane);
        const float rstd = rsqrtf(qq * (1.0f / 64.0f) + LN_EPS);
        const size_t row = (size_t)(r0 + il);
#pragma unroll
        for (int dt = 0; dt < 4; ++dt) {
            const uint2 gw = *(const uint2*)(P + row * DIN + C_RG + h * 64 + dt * 16 + g * 4);
            const f32x4_t o = accI[dt][qt] * rstd;
            const float o0 = o[0] * silu_f(bflo(gw.x)), o1 = o[1] * silu_f(bfhi(gw.x)), o2 = o[2] * silu_f(bflo(gw.y)), o3 = o[3] * silu_f(bfhi(gw.y));
            *(uint2*)(p->MIX + row * D + h * 64 + dt * 16 + g * 4) = make_uint2(pk2(o0, o1), pk2(o2, o3));
        }
    }
}

__device__ __forceinline__ void sgu_unit(KP p, int wv, int l, int u, bf16* lds) {
    const int grp = u & 3, pos = (u >> 2) % NPOS, b = u / (4 * NPOS);
    if (l == DEPTH - 1 && pos < 2) return;
    const int t = tid_opaque(wv), lane = t & 63, w = t >> 6, r = lane & 15, g = lane >> 4;
    const int r0 = chunk_row0(b, pos);
    const bf16* P = p->P;
    bf16* vnT = lds;
    __syncthreads();
    {
        const int j = t >> 2, qd = t & 3;
        const uint4* src = (const uint4*)(P + (size_t)(r0 + j) * DIN + C_SV + grp * 64 + qd * 16);
        const uint4 a = src[0], c = src[1];
        float v[16] = {bflo(a.x), bfhi(a.x), bflo(a.y), bfhi(a.y), bflo(a.z), bfhi(a.z), bflo(a.w), bfhi(a.w), bflo(c.x), bfhi(c.x), bflo(c.y), bfhi(c.y), bflo(c.z), bfhi(c.z), bflo(c.w), bfhi(c.w)};
        float s = 0.f;
#pragma unroll
        for (int d = 0; d < 16; ++d) { v[d] = gelu_tanh(v[d]); s += v[d]; }
        s += shx(s, 1, lane); s += shx(s, 2, lane);
        const float mu = s * (1.0f / 64.0f);
        float qq = 0.f;
#pragma unroll
        for (int d = 0; d < 16; ++d) { v[d] -= mu; qq += v[d] * v[d]; }
        qq += shx(qq, 1, lane); qq += shx(qq, 2, lane);
        const float rstd = rsqrtf(qq * (1.0f / 64.0f) + LN_EPS);
#pragma unroll
        for (int d = 0; d < 16; ++d) vnT[(qd * 16 + d) * TROW + j] = (bf16)f2bf(v[d] * rstd);
    }
    bf16x8_t wf[4];
    {
        const float* wrow = p->sgu_w + (((size_t)l * 4 + grp) * 128 + w * 16 + r) * 128 + g * 8;
#pragma unroll
        for (int ks = 0; ks < 4; ++ks) {
            const float4 a = *(const float4*)(wrow + ks * 32), c = *(const float4*)(wrow + ks * 32 + 4);
            uint4 o; o.x = pk2(a.x, a.y); o.y = pk2(a.z, a.w); o.z = pk2(c.x, c.y); o.w = pk2(c.z, c.w);
            wf[ks] = __builtin_bit_cast(bf16x8_t, o);
        }
    }
    __syncthreads();
    const int i = w * 16 + r;
    const float bs = p->sgu_b[((size_t)l * 4 + grp) * 128 + i];
#pragma unroll
    for (int dt = 0; dt < 4; ++dt) {
        f32x4_t acc = {0.f, 0.f, 0.f, 0.f};
#pragma unroll
        for (int ks = 0; ks < 4; ++ks) acc = MFMA16(lds_frag16(vnT + (dt * 16 + r) * TROW + ks * 32 + g * 8), wf[ks], acc);
        const uint2 uw = *(const uint2*)(P + (size_t)(r0 + i) * DIN + C_SU + grp * 64 + dt * 16 + g * 4);
        const float o0 = gelu_tanh(bflo(uw.x)) * (acc[0] + bs), o1 = gelu_tanh(bfhi(uw.x)) * (acc[1] + bs), o2 = gelu_tanh(bflo(uw.y)) * (acc[2] + bs), o3 = gelu_tanh(bfhi(uw.y)) * (acc[3] + bs);
        *(uint2*)(p->MIX + (size_t)(r0 + i) * D + 256 + grp * 64 + dt * 16 + g * 4) = make_uint2(pk2(o0, o1), pk2(o2, o3));
    }
}

__device__ __forceinline__ void phase_mix_a(KP p, int wv, int l, int bid, int nb, float* ldsf) {
    bf16* lds = (bf16*)ldsf;
    const int n_att = (l == DEPTH - 1) ? 256 : 264, n_kv = NB * NPOS * 4, n_sgu = NB * NPOS * 4;
    for (int u = bid; u < n_att + n_kv + n_sgu; u += nb) {
        if (u < n_att) att_unit(p, wv, l, u, lds);
        else if (u < n_att + n_kv) ret_kv_unit(p, wv, l, u - n_att, lds);
        else sgu_unit(p, wv, l, u - n_att - n_kv, lds);
    }
    __syncthreads();
}
__device__ __forceinline__ void phase_ret_out(KP p, int wv, int l, int bid, int nb, float* ldsf) {
    bf16* lds = (bf16*)ldsf;
    for (int u = bid; u < NB * NPOS * 2; u += nb) ret_out_unit(p, wv, l, u, lds);
    __syncthreads();
}

__device__ __forceinline__ void phase_ln1(KP p, int wv, int l, int bid, int nb) {
    const int lane = tid_opaque(wv) & 63, w = tid_opaque(wv) >> 6;
    const int Tn = (l == DEPTH - 1) ? TL : T;
    for (int r = bid * NW + w; r < Tn; r += nb * NW) {
        float v[16], a[16], c[16];
        if (l == 0) row_load(x_row(p, 0, r), v, lane); else row_load_bf(p->X + (size_t)r * D, v, lane);
        row_load_bf(p->Y + (size_t)r * D, a, lane);
        const float* m = p->mod + ((size_t)l * 3 + mod_idx(r)) * 6144;
        row_load(m + 2048, c, lane);
#pragma unroll
        for (int i = 0; i < 16; ++i) v[i] = ALPHA * v[i] + c[i] * a[i];
        row_ln(v, lane);
        row_load(p->lnm_g + l * D, a, lane); row_load(p->lnm_b + l * D, c, lane);
#pragma unroll
        for (int i = 0; i < 16; ++i) v[i] = v[i] * a[i] + c[i];
        row_store_bf(p->X1 + (size_t)r * D, v, lane);
        row_ln(v, lane);
        row_load(m + 3072, a, lane); row_load(m + 4096, c, lane);
#pragma unroll
        for (int i = 0; i < 16; ++i) v[i] = v[i] * (1.0f + c[i]) + a[i];
        row_store_bf(p->H + (size_t)r * D, v, lane);
        float mx = 0.f;
#pragma unroll
        for (int i = 0; i < 16; ++i) mx = fmaxf(mx, fabsf(v[i]));
#pragma unroll
        for (int o = 32; o >= 1; o >>= 1) mx = fmaxf(mx, shx(mx, o, lane));
        const float xinv = mx > 0.f ? 127.0f / mx : 0.f;
        unsigned* xq = (unsigned*)(p->XQ + (size_t)r * D);
#pragma unroll
        for (int i = 0; i < 4; ++i) {
            const int q0 = (int)rintf(v[i * 4 + 0] * xinv), q1 = (int)rintf(v[i * 4 + 1] * xinv), q2 = (int)rintf(v[i * 4 + 2] * xinv), q3 = (int)rintf(v[i * 4 + 3] * xinv);
            xq[i * 64 + lane] = (unsigned)(q0 & 0xff) | ((unsigned)(q1 & 0xff) << 8) | ((unsigned)(q2 & 0xff) << 16) | ((unsigned)(q3 & 0xff) << 24);
        }
        if (lane == 0) p->SX[r] = mx * (1.0f / 127.0f);
    }
}

template <int NV, class IdFn>
__device__ __forceinline__ void select_top16(const float (&v)[NV], IdFn idf, float* lv, int* li, int lane) {
    float mx = v[0], mn = v[0];
#pragma unroll
    for (int e = 1; e < NV; ++e) { mx = fmaxf(mx, v[e]); mn = fminf(mn, v[e]); }
    mx = fmaxf(mx, shx(mx, 16, lane)); mx = fmaxf(mx, shx(mx, 32, lane));
    mn = fminf(mn, shx(mn, 16, lane)); mn = fminf(mn, shx(mn, 32, lane));
    float lo = mn - 1.0f, hi = mx, tau = lo;
    bool done = false;
    for (int iter = 0; iter < 48; ++iter) {
        const float mid = 0.5f * (lo + hi);
        int cnt = 0;
#pragma unroll
        for (int e = 0; e < NV; ++e) cnt += (v[e] > mid) ? 1 : 0;
        cnt += shx(cnt, 16, lane); cnt += shx(cnt, 32, lane);
        if (!done) {
            if (cnt == 16) { tau = mid; done = true; }
            else if (cnt > 16) { lo = mid; tau = mid; } else hi = mid;
            if (!(mid > lo || mid < hi)) done = true;
        }
        if (__all(done)) break;
    }
    int c = 0;
#pragma unroll
    for (int e = 0; e < NV; ++e) c += (v[e] > tau) ? 1 : 0;
    const int base = lane & 15, g = lane >> 4;
    const int c0 = shf(c, base), c1 = shf(c, base + 16), c2 = shf(c, base + 32);
    int pos = (g > 0 ? c0 : 0) + (g > 1 ? c1 : 0) + (g > 2 ? c2 : 0);
#pragma unroll
    for (int e = 0; e < NV; ++e) {
        if (v[e] > tau && pos < 16) { lv[base * 16 + pos] = v[e]; li[base * 16 + pos] = idf(e); ++pos; }
    }
}
constexpr int KS_STRIDE = 136;
__device__ __forceinline__ void phase_topk(KP p, int wv, int l, int bid, int nb, float* lds) {
    bf16* k1s = (bf16*)lds;
    bf16* k2s = k1s + 128 * KS_STRIDE;
    const int t = tid_opaque(wv), lane = t & 63, w = t >> 6;
    float* lists = lds + (2 * 128 * KS_STRIDE * 2) / 4 + w * 1536;
    float* v1 = lists; int* i1 = (int*)(lists + 256); float* v2 = lists + 512; int* i2 = (int*)(lists + 768); float* v3 = lists + 1024; int* c3 = (int*)(lists + 1280);
    unsigned char* ctab = (unsigned char*)(lds + (2 * 128 * KS_STRIDE * 2) / 4 + NW * 1536);
    __syncthreads();
    if (t < 64) {
        const int gq = t >> 4, k = t & 15; int ab = 0xff;
        if (gq == 0) { if (k < 13) ab = k; }
        else if (gq == 1) { if (k < 3) ab = 13 + k; else if (k < 11) ab = 0x10 | (k - 3); else if (k < 13) ab = 0x20 | (k - 11); }
        else if (gq == 2) { if (k < 3) ab = 0x20 | (k + 2); else if (k < 7) ab = 0x30 | (k - 3); else if (k < 10) ab = 0x40 | (k - 7); else if (k < 12) ab = 0x50 | (k - 10); else if (k < 13) ab = 0x60; }
        else { if (k == 0) ab = 0x61; else if (k < 3) ab = 0x70 | (k - 1); else if (k < 11) ab = (k + 5) << 4; }
        ctab[t] = (unsigned char)ab;
    }
    for (int e = t; e < 2 * 128 * 16; e += NT) {
        const int tab = e >> 11, r = (e >> 4) & 127, c8 = e & 15;
        const float* src = (tab ? p->k2 : p->k1) + (size_t)l * 128 * 128 + r * 128 + c8 * 8;
        const float4 a = *(const float4*)src, b = *(const float4*)(src + 4);
        uint4 o; o.x = pk2(a.x, a.y); o.y = pk2(a.z, a.w); o.z = pk2(b.x, b.y); o.w = pk2(b.z, b.w);
        *(uint4*)((tab ? k2s : k1s) + r * KS_STRIDE + c8 * 8) = o;
    }
    __syncthreads();
    const int fr = lane & 15, fq = lane >> 4;
    const int ntask = ((l == DEPTH - 1) ? TL : T) * 8 / 16;
    for (int task = bid * NW + w; task < ntask; task += nb * NW) {
        const int it0 = task * 16;
        const bf16* qrow = p->Qb + (size_t)(it0 + fr) * 256 + fq * 8;
        bf16x8_t bq[8];
#pragma unroll
        for (int ks = 0; ks < 8; ++ks) bq[ks] = *(const bf16x8_t*)(qrow + ks * 32);
        float s[32];
#pragma unroll
        for (int kt = 0; kt < 8; ++kt) {
            f32x4_t acc = {0.f, 0.f, 0.f, 0.f};
#pragma unroll
            for (int ks = 0; ks < 4; ++ks) {
                const bf16x8_t a = *(const bf16x8_t*)(k1s + (kt * 16 + fr) * KS_STRIDE + ks * 32 + fq * 8);
                acc = __builtin_amdgcn_mfma_f32_16x16x32_bf16(a, bq[ks], acc, 0, 0, 0);
            }
            s[kt * 4 + 0] = acc[0]; s[kt * 4 + 1] = acc[1]; s[kt * 4 + 2] = acc[2]; s[kt * 4 + 3] = acc[3];
        }
        select_top16<32>(s, [fq](int e) { return (e >> 2) * 16 + fq * 4 + (e & 3); }, v1, i1, lane);
#pragma unroll
        for (int kt = 0; kt < 8; ++kt) {
            f32x4_t acc = {0.f, 0.f, 0.f, 0.f};
#pragma unroll
            for (int ks = 0; ks < 4; ++ks) {
                const bf16x8_t a = *(const bf16x8_t*)(k2s + (kt * 16 + fr) * KS_STRIDE + ks * 32 + fq * 8);
                acc = __builtin_amdgcn_mfma_f32_16x16x32_bf16(a, bq[4 + ks], acc, 0, 0, 0);
            }
            s[kt * 4 + 0] = acc[0]; s[kt * 4 + 1] = acc[1]; s[kt * 4 + 2] = acc[2]; s[kt * 4 + 3] = acc[3];
        }
        select_top16<32>(s, [fq](int e) { return (e >> 2) * 16 + fq * 4 + (e & 3); }, v2, i2, lane);
        __builtin_amdgcn_wave_barrier();
        {
            const int L = lane >> 1, h = lane & 1;
            float* lst = ((L & 1) ? v2 : v1) + (L >> 1) * 16 + h * 8;
            float key[8];
#pragma unroll
            for (int k = 0; k < 8; ++k) key[k] = __builtin_bit_cast(float, (__builtin_bit_cast(unsigned, lst[k]) & ~15u) | (unsigned)(h * 8 + k));
#define CE_DESC(a, b) do { const float mx_ = fmaxf(key[a], key[b]), mn_ = fminf(key[a], key[b]); key[a] = mx_; key[b] = mn_; } while (0)
#define CE_ASC(a, b) do { const float mx_ = fmaxf(key[a], key[b]), mn_ = fminf(key[a], key[b]); key[a] = mn_; key[b] = mx_; } while (0)
#define CE_DIR(a, b, d) do { const float mx_ = fmaxf(key[a], key[b]), mn_ = fminf(key[a], key[b]); key[a] = (d) ? mx_ : mn_; key[b] = (d) ? mn_ : mx_; } while (0)
            CE_DESC(0, 1); CE_ASC(2, 3); CE_DESC(4, 5); CE_ASC(6, 7);
            CE_DESC(0, 2); CE_DESC(1, 3); CE_ASC(4, 6); CE_ASC(5, 7);
            CE_DESC(0, 1); CE_DESC(2, 3); CE_ASC(4, 5); CE_ASC(6, 7);
            { const bool d = h == 0;
              CE_DIR(0, 4, d); CE_DIR(1, 5, d); CE_DIR(2, 6, d); CE_DIR(3, 7, d);
              CE_DIR(0, 2, d); CE_DIR(1, 3, d); CE_DIR(4, 6, d); CE_DIR(5, 7, d);
              CE_DIR(0, 1, d); CE_DIR(2, 3, d); CE_DIR(4, 5, d); CE_DIR(6, 7, d); }
#pragma unroll
            for (int k = 0; k < 8; ++k) { const float pk_ = shx(key[k], 1, lane); key[k] = h ? fminf(key[k], pk_) : fmaxf(key[k], pk_); }
            CE_DESC(0, 4); CE_DESC(1, 5); CE_DESC(2, 6); CE_DESC(3, 7);
            CE_DESC(0, 2); CE_DESC(1, 3); CE_DESC(4, 6); CE_DESC(5, 7);
            CE_DESC(0, 1); CE_DESC(2, 3); CE_DESC(4, 5); CE_DESC(6, 7);
#undef CE_DESC
#undef CE_ASC
#undef CE_DIR
            __builtin_amdgcn_wave_barrier();
#pragma unroll
            for (int k = 0; k < 8; ++k) lst[k] = key[k];
        }
        __builtin_amdgcn_wave_barrier();
        const uint4 tw = *(const uint4*)(ctab + fq * 16);
        const unsigned twd[4] = {tw.x, tw.y, tw.z, tw.w};
        float cv[13];
        const float padv = __builtin_bit_cast(float, __builtin_bit_cast(unsigned, v1[fr * 16 + 15]) & ~15u) + __builtin_bit_cast(float, __builtin_bit_cast(unsigned, v2[fr * 16 + 15]) & ~15u) - 1.0f;
#pragma unroll
        for (int k = 0; k < 13; ++k) {
            const unsigned ab = (twd[k >> 2] >> (8 * (k & 3))) & 0xffu;
            const float ka = __builtin_bit_cast(float, __builtin_bit_cast(unsigned, v1[fr * 16 + ((ab >> 4) & 15u)]) & ~15u);
            const float kb = __builtin_bit_cast(float, __builtin_bit_cast(unsigned, v2[fr * 16 + (ab & 15u)]) & ~15u);
            cv[k] = ab == 0xffu ? padv : ka + kb;
        }
        select_top16<13>(cv, [&twd](int e) { return (int)((twd[e >> 2] >> (8 * (e & 3))) & 0xffu); }, v3, c3, lane);
        __builtin_amdgcn_wave_barrier();
        float tv[4]; int tc[4];
#pragma unroll
        for (int k = 0; k < 4; ++k) { tv[k] = v3[fr * 16 + fq * 4 + k]; tc[k] = c3[fr * 16 + fq * 4 + k]; }
        float mx = fmaxf(fmaxf(tv[0], tv[1]), fmaxf(tv[2], tv[3]));
        mx = fmaxf(mx, shx(mx, 16, lane)); mx = fmaxf(mx, shx(mx, 32, lane));
        float ex[4], den = 0.f;
#pragma unroll
        for (int k = 0; k < 4; ++k) { ex[k] = expf(tv[k] - mx); den += ex[k]; }
        den += shx(den, 16, lane); den += shx(den, 32, lane);
        const float inv = 1.0f / den;
        int4 eo; float4 go;
#define TK_EID(c) (i1[fr * 16 + (int)(__builtin_bit_cast(unsigned, v1[fr * 16 + ((c) >> 4)]) & 15u)] * 128 + i2[fr * 16 + (int)(__builtin_bit_cast(unsigned, v2[fr * 16 + ((c) & 15)]) & 15u)])
        eo.x = TK_EID(tc[0]); eo.y = TK_EID(tc[1]); eo.z = TK_EID(tc[2]); eo.w = TK_EID(tc[3]);
#undef TK_EID
        go = make_float4(ex[0] * inv, ex[1] * inv, ex[2] * inv, ex[3] * inv);
        *(int4*)(p->EIDX + (size_t)(it0 + fr) * 16 + fq * 4) = eo;
        *(float4*)(p->GATE + (size_t)(it0 + fr) * 16 + fq * 4) = go;
        __builtin_amdgcn_wave_barrier();
    }
    __syncthreads();
}

typedef unsigned u32x4_t __attribute__((ext_vector_type(4)));
using bf16x2_t = __attribute__((ext_vector_type(2))) __bf16;
__device__ __forceinline__ float dot2bf(unsigned a, unsigned b, float acc) { return __builtin_amdgcn_fdot2_f32_bf16(__builtin_bit_cast(bf16x2_t, a), __builtin_bit_cast(bf16x2_t, b), acc, false); }
struct RowBf { u32x4_t a, b; };
__device__ __forceinline__ RowBf ld_row(const bf16* tab, int e, int lane) {
    const u32x4_t* r = (const u32x4_t*)(tab + (size_t)e * D) + lane;
    RowBf x; x.a = r[0]; x.b = r[64]; return x;
}
__device__ __forceinline__ float row_dot(const RowBf& x, const RowBf& u) {
    float d = 0.f;
#pragma unroll
    for (int k = 0; k < 4; ++k) { d = dot2bf(x.a[k], u.a[k], d); d = dot2bf(x.b[k], u.b[k], d); }
    return d;
}
__device__ __forceinline__ void row_axpy(float (&acc)[16], float a, const RowBf& v) {
#pragma unroll
    for (int k = 0; k < 4; ++k) {
        acc[2 * k] += a * bflo(v.a[k]); acc[2 * k + 1] += a * bfhi(v.a[k]);
        acc[8 + 2 * k] += a * bflo(v.b[k]); acc[8 + 2 * k + 1] += a * bfhi(v.b[k]);
    }
}
__device__ __forceinline__ float transpose_reduce16(float (&part)[16], int lane) {
#pragma unroll
    for (int st = 32, n = 8; n >= 1; st >>= 1, n >>= 1) {
        const bool up = (lane & st) != 0;
#pragma unroll
        for (int s = 0; s < n; ++s) {
            const float lo = part[s], hi = part[s + n];
            const float recv = shx(up ? lo : hi, st, lane);
            part[s] = (up ? hi : lo) + recv;
        }
    }
    float v = part[0];
    v += shx(v, 2, lane); v += shx(v, 1, lane);
    return v;
}
typedef float f32x2_t __attribute__((ext_vector_type(2)));
__device__ __forceinline__ float transpose_reduce8(float (&part)[8], int lane) {
#pragma unroll
    for (int st = 32, n = 4; n >= 1; st >>= 1, n >>= 1) {
        const bool up = (lane & st) != 0;
#pragma unroll
        for (int s = 0; s < n; ++s) {
            const float lo = part[s], hi = part[s + n];
            const float recv = shx(up ? lo : hi, st, lane);
            part[s] = (up ? hi : lo) + recv;
        }
    }
    float v = part[0];
    v += shx(v, 4, lane); v += shx(v, 2, lane); v += shx(v, 1, lane);
    return v;
}
typedef int v4i_t __attribute__((ext_vector_type(4)));
typedef unsigned u32x4v __attribute__((ext_vector_type(4)));
constexpr int EXU_CAP = 440, EXU_TROW = 1056, EXU_WAVE = 8 * EXU_CAP + 16 * EXU_TROW;
__device__ __forceinline__ void phase_expert_u(KP p, int wv, int l, int bid, int nb, float* lds) {
    const int lane = tid_opaque(wv) & 63, w = __builtin_amdgcn_readfirstlane(tid_opaque(wv) >> 6);
    const int G8 = nb >> 3;
    if (bid >= G8 * 8) return;
    const int rng = bid & 7, r = lane & 15, g = lane >> 4;
    const unsigned char* U = p->U8 + (size_t)l * PEER_N * D;
    const float* SU = p->SU + (size_t)l * PEER_N; const float* SV = p->SV + (size_t)l * PEER_N;
    unsigned char* wl = (unsigned char*)lds + w * EXU_WAVE;
    unsigned* lpk = (unsigned*)wl; float* lgt = (float*)(wl + 4 * EXU_CAP); unsigned char* tile = wl + 8 * EXU_CAP;
    const unsigned long long ltmask = (1ull << lane) - 1ull;
    const int tstride = G8 * NW, Tn = (l == DEPTH - 1) ? TL : T, t0 = (bid >> 3) * NW + w;
    if (t0 >= Tn) return;
    const int nitem = (Tn - t0 + tstride - 1) / tstride;
    int i0 = 0;
    while (i0 < nitem) {
        const int nt = nitem - i0 < 16 ? nitem - i0 : 16;
        v4i_t afr[16];
        {
            const unsigned char* xa = p->XQ + (size_t)(t0 + (i0 + (r < nt ? r : nt - 1)) * tstride) * D + g * 16;
#pragma unroll
            for (int ks = 0; ks < 16; ++ks) afr[ks] = *(const v4i_t*)(xa + ks * 64);
        }
        const float sxv = p->SX[t0 + (i0 + (lane < nt ? lane : nt - 1)) * tstride];
        int e0[16], e1[16];
#pragma unroll
        for (int j = 0; j < 16; ++j) {
            const size_t tb = (size_t)(t0 + (i0 + (j < nt ? j : nt - 1)) * tstride) * NSEL;
            e0[j] = p->EIDX[tb + lane]; e1[j] = p->EIDX[tb + 64 + lane];
        }
        int cnt = 0, ndone = 0; bool open = true;
#pragma unroll
        for (int j = 0; j < 16; ++j) {
            const bool in0 = (e0[j] >> 11) == rng, in1 = (e1[j] >> 11) == rng;
            const unsigned long long m0 = __ballot(in0), m1 = __ballot(in1);
            const int c0 = __popcll(m0), c = c0 + __popcll(m1);
            open = open && j < nt && cnt + c <= EXU_CAP;
            if (open) {
                if (in0) { const int pos = cnt + __popcll(m0 & ltmask); lpk[pos] = (unsigned)e0[j] | ((unsigned)j << 14) | ((unsigned)lane << 18); }
                if (in1) { const int pos = cnt + c0 + __popcll(m1 & ltmask); lpk[pos] = (unsigned)e1[j] | ((unsigned)j << 14) | ((unsigned)(lane + 64) << 18); }
                cnt += c; ndone = j + 1;
            }
        }
        __builtin_amdgcn_wave_barrier();
        const int ntile = (cnt + 15) >> 4;
        u32x4v rw[16]; unsigned pkv = 0u; float suv = 0.f;
#define EXU_ISSUE(q) do { const int idx_ = 16 * (q) + r < cnt ? 16 * (q) + r : cnt - 1; \
            pkv = lpk[idx_]; const unsigned e_ = pkv & 0x3fffu; \
            _Pragma("unroll") for (int k = 0; k < 16; ++k) rw[k] = *(const u32x4v*)(U + ((size_t)(__builtin_amdgcn_readlane((int)pkv, k) & 0x3fff) << 10) + lane * 16); \
            suv = SU[e_]; } while (0)
        if (ntile > 0) EXU_ISSUE(0);
#pragma unroll 1
        for (int q = 0; q < ntile; ++q) {
#pragma unroll
            for (int k = 0; k < 16; ++k) *(u32x4v*)(tile + k * EXU_TROW + lane * 16) = rw[k];
            const unsigned pk = pkv; const float su = suv;
            __builtin_amdgcn_wave_barrier();
            if (q + 1 < ntile) EXU_ISSUE(q + 1);
            v4i_t acc = {0, 0, 0, 0};
#pragma unroll
            for (int ks = 0; ks < 16; ++ks) {
                const v4i_t b = *(const v4i_t*)(tile + r * EXU_TROW + ks * 64 + g * 16);
                acc = __builtin_amdgcn_mfma_i32_16x16x64_i8(afr[ks], b, acc, 0, 0, 0);
            }
            const int j = (int)((pk >> 14) & 15u);
            const int d = (j & 2) ? ((j & 1) ? acc[3] : acc[2]) : ((j & 1) ? acc[1] : acc[0]);
            const float sx = shf(sxv, j);
            if (g == (j >> 2) && 16 * q + r < cnt) lgt[16 * q + r] = (float)d * su * sx;
            __builtin_amdgcn_wave_barrier();
        }
#undef EXU_ISSUE
        for (int idx = lane; idx < cnt; idx += 64) {
            const unsigned pk = lpk[idx]; const int e = (int)(pk & 0x3fffu), j = (int)((pk >> 14) & 15u), slot = (int)(pk >> 18);
            const size_t ao = (size_t)(t0 + (i0 + j) * tstride) * NSEL + slot;
            p->ACT[ao] = gelu_tanh(lgt[idx]) * p->GATE[ao] * SV[e];
        }
        __builtin_amdgcn_wave_barrier();
        i0 += ndone > 0 ? ndone : 1;
    }
}
__device__ __forceinline__ void phase_expert_v(KP p, int wv, int l, int bid, int nb) {
    const int lane = tid_opaque(wv) & 63, w = __builtin_amdgcn_readfirstlane(tid_opaque(wv) >> 6);
    const int G8 = nb >> 3;
    if (bid >= G8 * 8) return;
    const int sl = bid & 7, q = lane >> 3, c = lane & 7;
    const __amdgpu_buffer_rsrc_t rsV = __builtin_amdgcn_make_buffer_rsrc((void*)(p->V8 + (size_t)l * PEER_N * D), 0, PEER_N * D, 0x00020000);
    const int coff = sl * 128 + c * 16;
    const int tstride = G8 * NW, Tn = (l == DEPTH - 1) ? TL : T, t0 = (bid >> 3) * NW + w;
    const int nitem = t0 < Tn ? (Tn - t0 + tstride - 1) / tstride : 0;
    for (int j0 = 0; j0 < nitem; j0 += 8) {
        const bool valid = j0 + q < nitem;
        const int t = t0 + (valid ? j0 + q : nitem - 1) * tstride;
        int e[16]; float a[16];
        {
            const int4* ep = (const int4*)(p->EIDX + (size_t)t * NSEL + c * 16); const float4* ap = (const float4*)(p->ACT + (size_t)t * NSEL + c * 16);
#pragma unroll
            for (int k = 0; k < 4; ++k) { const int4 ev = ep[k]; const float4 av = ap[k];
                e[k * 4 + 0] = ev.x << 10; e[k * 4 + 1] = ev.y << 10; e[k * 4 + 2] = ev.z << 10; e[k * 4 + 3] = ev.w << 10;
                a[k * 4 + 0] = av.x; a[k * 4 + 1] = av.y; a[k * 4 + 2] = av.z; a[k * 4 + 3] = av.w; }
        }
        f32x2_t acc[8];
#pragma unroll
        for (int k = 0; k < 8; ++k) acc[k] = (f32x2_t){0.f, 0.f};
#pragma unroll 1
        for (int cc = 0; cc < 8; ++cc) {
            const int baddr = ((lane & 56) | cc) << 2;
#pragma unroll
            for (int hb = 0; hb < 2; ++hb) {
                u32x4v rv[8]; float av[8];
#pragma unroll
                for (int k = 0; k < 8; ++k) {
                    const int j = hb * 8 + k;
                    const int eo = __builtin_amdgcn_ds_bpermute(baddr, e[j]);
                    av[k] = __builtin_bit_cast(float, __builtin_amdgcn_ds_bpermute(baddr, __builtin_bit_cast(int, a[j])));
                    rv[k] = __builtin_amdgcn_raw_buffer_load_b128(rsV, eo + coff, 0, 0);
                }
#pragma unroll
                for (int k = 0; k < 8; ++k) {
                    const f32x2_t a2 = {av[k], av[k]};
                    acc[0] += a2 * __builtin_amdgcn_cvt_pk_f32_fp8((int)rv[k][0], false); acc[1] += a2 * __builtin_amdgcn_cvt_pk_f32_fp8((int)rv[k][0], true);
                    acc[2] += a2 * __builtin_amdgcn_cvt_pk_f32_fp8((int)rv[k][1], false); acc[3] += a2 * __builtin_amdgcn_cvt_pk_f32_fp8((int)rv[k][1], true);
                    acc[4] += a2 * __builtin_amdgcn_cvt_pk_f32_fp8((int)rv[k][2], false); acc[5] += a2 * __builtin_amdgcn_cvt_pk_f32_fp8((int)rv[k][2], true);
                    acc[6] += a2 * __builtin_amdgcn_cvt_pk_f32_fp8((int)rv[k][3], false); acc[7] += a2 * __builtin_amdgcn_cvt_pk_f32_fp8((int)rv[k][3], true);
                    __builtin_amdgcn_sched_barrier(0);
                }
            }
        }
        if (valid) {
            bf16* yr = p->Y + (size_t)t * D + coff;
            *(uint4*)yr = make_uint4(pk2(acc[0].x, acc[0].y), pk2(acc[1].x, acc[1].y), pk2(acc[2].x, acc[2].y), pk2(acc[3].x, acc[3].y));
            *(uint4*)(yr + 8) = make_uint4(pk2(acc[4].x, acc[4].y), pk2(acc[5].x, acc[5].y), pk2(acc[6].x, acc[6].y), pk2(acc[7].x, acc[7].y));
        }
    }
}

__device__ __forceinline__ void phase_ln2(KP p, int wv, int l, int bid, int nb) {
    const int lane = tid_opaque(wv) & 63, w = tid_opaque(wv) >> 6;
    const int Tn = (l == DEPTH - 1) ? TL : T;
    for (int r = bid * NW + w; r < Tn; r += nb * NW) {
        float v[16], a[16], c[16];
        row_load_bf(p->X1 + (size_t)r * D, v, lane);
        row_load_bf(p->Y + (size_t)r * D, a, lane);
        const float* m = p->mod + ((size_t)l * 3 + mod_idx(r)) * 6144;
        row_load(m + 5120, c, lane);
#pragma unroll
        for (int i = 0; i < 16; ++i) v[i] = ALPHA * v[i] + c[i] * a[i];
        row_ln(v, lane);
        row_load(p->lnf_g + l * D, a, lane); row_load(p->lnf_b + l * D, c, lane);
#pragma unroll
        for (int i = 0; i < 16; ++i) v[i] = v[i] * a[i] + c[i];
        if (l == DEPTH - 1) { if (r < TL) row_store(p->out + (size_t)r * D, v, lane); continue; }
        row_store_bf(p->X + (size_t)r * D, v, lane);
        const float* m2 = p->mod + ((size_t)(l + 1) * 3 + mod_idx(r)) * 6144;
        row_ln(v, lane);
        row_load(m2, a, lane); row_load(m2 + 1024, c, lane);
#pragma unroll
        for (int i = 0; i < 16; ++i) v[i] = v[i] * (1.0f + c[i]) + a[i];
        row_store_bf(p->H + (size_t)r * D, v, lane);
    }
}

constexpr int REP_MIXA = 1, REP_TOPK = 1, REP_EXPU = 1, REP_EXPV = 1, REP_RETOUT = 1, REP_GEMM = 1, REP_PRO = 1;
__global__ void __launch_bounds__(NT, 2) mega(Params p_unused) {
    extern __shared__ __attribute__((aligned(16))) unsigned char lds_raw[];
    cg::grid_group grid = cg::this_grid();
    const int bid = blockIdx.x, nb = gridDim.x;
    const int wv = __builtin_amdgcn_readfirstlane(threadIdx.x >> 6);
    float* lds = (float*)lds_raw;
    LAS unsigned char* ldsl = (LAS unsigned char*)lds_raw;
    volatile LAS unsigned* MISC = (volatile LAS unsigned*)(ldsl + MISC_OFF);
    for (int u = threadIdx.x; u < 64; u += NT) ((LAS unsigned*)(ldsl + MISC_OFF))[u] = 0u;
    __syncthreads();
#define IS_LEAD() (wv == 0 && lane_opaque() == 0)
    (void)xcd_barrier_post(kparams()->ctl + CW_BAR, MISC + 8, IS_LEAD());
#define GRID_BAR() do { XcdBarrier b_; b_.bar = kparams()->ctl + CW_BAR; b_.x = xb_xcc_id(); b_.st = MISC + 8; b_.lead = IS_LEAD(); xcd_barrier(b_); } while (0)

    phase_mod1(kparams(), wv, bid, nb, lds);
    for (int rep = 0; rep < REP_PRO; ++rep) phase_weights(kparams(), wv, bid, nb, lds);
    grid.sync();
    phase_mod2(kparams(), wv, bid, nb);
    GRID_BAR();
    phase_lnmod(kparams(), wv, 0, bid, nb);
    GRID_BAR();
#define LAYER_BODY(l) do { \
        { KP p = kparams(); \
            pg8::Gemm g{p->H, p->WtIn + (size_t)l * DIN * D, T, DIN, D}; pg8::StaticOrder S; S.init(T, DIN, nb, bid); \
            pg8::EpiInProj E{p->P, p->rope}; \
            for (int rep = 0; rep < REP_GEMM; ++rep) pg8::gemm_phase<pg8::EpiInProj, pg8::StaticOrder, true, true>(ldsl, g, S, E, wv); \
        } \
        GRID_BAR(); \
        for (int rep = 0; rep < REP_MIXA; ++rep) phase_mix_a(kparams(), wv, l, bid, nb, lds); \
        GRID_BAR(); \
        phase_ret_scan(kparams(), wv, l, bid, nb); \
        GRID_BAR(); \
        for (int rep = 0; rep < REP_RETOUT; ++rep) phase_ret_out(kparams(), wv, l, bid, nb, lds); \
        GRID_BAR(); \
        { KP p = kparams(); \
            const int Mr = (l == DEPTH - 1) ? TL : T; pg8::Gemm g{p->MIX, p->WtOut + (size_t)l * D * D, Mr, D, D}; pg8::StaticOrder S; S.init(Mr, D, nb, bid); \
            pg8::EpiBf16Plain E{p->Y, D}; \
            for (int rep = 0; rep < REP_GEMM; ++rep) pg8::gemm_phase<pg8::EpiBf16Plain, pg8::StaticOrder, true, true>(ldsl, g, S, E, wv); \
        } \
        GRID_BAR(); \
        phase_ln1(kparams(), wv, l, bid, nb); \
        GRID_BAR(); \
        { KP p = kparams(); \
            const int Mr = (l == DEPTH - 1) ? TL : T; pg8::Gemm g{p->H, p->WtQ + (size_t)l * 2048 * D, Mr, 2048, D}; pg8::StaticOrder S; S.init(Mr, 2048, nb, bid); \
            pg8::EpiBf16Plain E{p->Qb, 2048}; \
            for (int rep = 0; rep < REP_GEMM; ++rep) pg8::gemm_phase<pg8::EpiBf16Plain, pg8::StaticOrder, true, true>(ldsl, g, S, E, wv); \
        } \
        GRID_BAR(); \
        for (int rep = 0; rep < REP_TOPK; ++rep) phase_topk(kparams(), wv, l, bid, nb, lds); \
        GRID_BAR(); \
        for (int rep = 0; rep < REP_EXPU; ++rep) phase_expert_u(kparams(), wv, l, bid, nb, lds); \
        GRID_BAR(); \
        for (int rep = 0; rep < REP_EXPV; ++rep) phase_expert_v(kparams(), wv, l, bid, nb); \
        GRID_BAR(); \
        phase_ln2(kparams(), wv, l, bid, nb); \
        if (l + 1 < DEPTH) GRID_BAR(); \
    } while (0)
    LAYER_BODY(0); LAYER_BODY(1); LAYER_BODY(2); LAYER_BODY(3);
#undef LAYER_BODY
}

extern "C" void kernel_launch(void* const* d_in, const int* in_sizes, int n_in, void* d_out, int out_size, void* d_ws, size_t ws_size, hipStream_t stream) {
    static int grid_blocks = 0;
    if (!grid_blocks) {
        int dev = 0, cus = 0, per_cu = 0;
        (void)hipGetDevice(&dev);
        (void)hipDeviceGetAttribute(&cus, hipDeviceAttributeMultiprocessorCount, dev);
        (void)hipFuncSetAttribute((const void*)mega, hipFuncAttributeMaxDynamicSharedMemorySize, LDS_BYTES);
        (void)hipOccupancyMaxActiveBlocksPerMultiprocessor(&per_cu, mega, NT, LDS_BYTES);
        if (per_cu < 1) { fprintf(stderr, "occupancy query says %d blocks per CU\n", per_cu); per_cu = 1; }
        grid_blocks = cus;
    }
    Params p{};
    const float** ins = (const float**)&p;
    for (int i = 0; i < 22; ++i) ins[i] = (const float*)d_in[i];
    p.out = (float*)d_out;
    char* ws = (char*)d_ws;
    size_t off = 0;
    auto carve = [&](size_t bytes) { void* r = ws + off; off += (bytes + 255) & ~(size_t)255; return r; };
    p.ctl = (unsigned*)carve(CTL_BYTES);
    p.modp = (float*)carve((size_t)16 * DEPTH * 3 * 6144 * 4);
    p.mod = (float*)carve((size_t)DEPTH * 3 * 6144 * 4);
    p.rope = (float*)carve((size_t)192 * 16 * 2 * 4);
    p.WtIn = (bf16*)carve((size_t)DEPTH * DIN * D * 2);
    p.WtOut = (bf16*)carve((size_t)DEPTH * D * D * 2);
    p.WtQ = (bf16*)carve((size_t)DEPTH * 2048 * D * 2);
    p.X = (bf16*)carve((size_t)T * D * 2);
    p.H = (bf16*)carve((size_t)T * D * 2);
    p.P = (bf16*)carve((size_t)T * DIN * 2);
    p.KV = (float*)carve((size_t)2 * NB * NPOS * 4 * 4096 * 4);
    p.ST = (float*)carve((size_t)2 * NB * NPOS * 4 * 4096 * 4);
    p.MIX = (bf16*)carve((size_t)T * D * 2);
    p.ST16 = (bf16*)carve((size_t)2 * NB * NPOS * 4 * 4096 * 2);
    p.Qb = (bf16*)carve((size_t)T * 2048 * 2);
    p.U8 = (unsigned char*)carve((size_t)DEPTH * PEER_N * D);
    p.V8 = (unsigned char*)carve((size_t)DEPTH * PEER_N * D);
    p.XQ = (unsigned char*)carve((size_t)T * D);
    p.SX = (float*)carve((size_t)T * 4);
    p.SU = (float*)carve((size_t)DEPTH * PEER_N * 4);
    p.SV = (float*)carve((size_t)DEPTH * PEER_N * 4);
    p.Y = (bf16*)carve((size_t)T * D * 2);
    p.X1 = (bf16*)carve((size_t)T * D * 2);
    p.Q = (float*)carve((size_t)T * 2048 * 4);
    p.GATE = (float*)carve((size_t)T * NSEL * 4);
    p.ACT = (float*)carve((size_t)T * NSEL * 4);
    p.V1 = (float*)carve((size_t)T * 8 * 16 * 4);
    p.EIDX = (int*)carve((size_t)T * NSEL * 4);
    p.I1 = (int*)carve((size_t)T * 8 * 16 * 4);
    if (off > ws_size) { fprintf(stderr, "workspace too small: need %zu have %zu\n", off, ws_size); return; }
    (void)hipMemsetAsync(p.ctl, 0, CTL_BYTES, stream);
    void* args[] = {&p};
    hipError_t e = hipLaunchCooperativeKernel((void*)mega, dim3(grid_blocks), dim3(NT), args, LDS_BYTES, stream);
    if (e != hipSuccess) fprintf(stderr, "cooperative launch failed: %s (grid %d)\n", hipGetErrorString(e), grid_blocks);
}
```

```cpp
#include <hip/hip_runtime.h>
#include <hip/hip_cooperative_groups.h>
#include <cstdio>
#include <cstdint>
namespace cg = cooperative_groups;

constexpr int D = 1024, NB = 2, SEQ = 8192, DEPTH = 4, LC = 256, HD = 64;
constexpr int TL = NB * SEQ, TC = NB * LC, T = TL + TC;
constexpr int DIN = 2304;
constexpr int C_RQ = 0, C_RK = 256, C_RV = 512, C_RG = 768, C_SU = 1024, C_SV = 1280, C_AQ = 1536, C_AK = 2048, C_AV = 2176;
constexpr int NPOS = 66;
constexpr int PEER_N = 16384, NSEL = 128;
constexpr float LN_EPS = 1e-5f;
constexpr float ALPHA = 1.681792830507429f;
constexpr int NT = 512;
constexpr int NW = 8;
constexpr int LDS_BYTES = 163840;
constexpr int MISC_OFF = LDS_BYTES - 256;

typedef unsigned short bf16;
#define LAS __attribute__((address_space(3)))

struct Params {
    const float *x, *c, *ctx, *c_ctx, *w_mod, *b_mod, *w_in, *w_out, *rdf, *rdb, *sgu_w, *sgu_b, *sink, *lnm_g, *lnm_b, *wq, *k1, *k2, *pu, *pv, *lnf_g, *lnf_b;
    float* out;
    unsigned* ctl;
    float *modp, *mod, *rope, *KV, *GATE, *ACT;
    bf16 *X, *X1, *Y;
    bf16 *WtIn, *WtOut, *WtQ, *H, *P, *MIX, *Qb, *ST16;
    unsigned char *U8, *V8, *XQ;
    float *SU, *SV, *SX;
    int *EIDX;
};

__device__ __forceinline__ unsigned f2bf(float f) { return (unsigned)__builtin_bit_cast(unsigned short, (__bf16)f); }
typedef float f32x2_pk __attribute__((ext_vector_type(2))); typedef __bf16 bf16x2_pk __attribute__((ext_vector_type(2)));
__device__ __forceinline__ unsigned pk2(float lo, float hi) { const f32x2_pk v = {lo, hi}; return __builtin_bit_cast(unsigned, __builtin_convertvector(v, bf16x2_pk)); }
__device__ __forceinline__ float bf2f(bf16 v) { return __builtin_bit_cast(float, (unsigned)v << 16); }
__device__ __forceinline__ float bflo(unsigned w) { return __builtin_bit_cast(float, w << 16); }
__device__ __forceinline__ float bfhi(unsigned w) { return __builtin_bit_cast(float, w & 0xffff0000u); }

__device__ __forceinline__ float gelu_tanh(float x) {
    const float u2 = x * (1.5957691216057308f + 0.07135481627f * x * x);
    return x * __builtin_amdgcn_rcpf(1.0f + __builtin_amdgcn_exp2f(-1.4426950408889634f * u2));
}
__device__ __forceinline__ float silu_f(float x) { return x * __builtin_amdgcn_rcpf(1.0f + __builtin_amdgcn_exp2f(-1.4426950408889634f * x)); }
__device__ __forceinline__ int chunk_row0(int b, int pos) { return pos < 2 ? TL + b * LC + pos * 128 : b * SEQ + (pos - 2) * 128; }
__device__ __forceinline__ int mod_idx(int r) { return r < TL ? r / SEQ : 2; }
__device__ __forceinline__ float log_sigmoid_f(float x) { return -log1pf(expf(-x)); }
typedef const __attribute__((address_space(4))) Params* KP;
__device__ __forceinline__ KP kparams() { KP k = (KP)__builtin_amdgcn_kernarg_segment_ptr(); asm volatile("" : "+s"(k)); return k; }
__device__ __forceinline__ float shx(float v, int m, int lane) { return __builtin_bit_cast(float, __builtin_amdgcn_ds_bpermute((lane ^ m) << 2, __builtin_bit_cast(int, v))); }
__device__ __forceinline__ int shx(int v, int m, int lane) { return __builtin_amdgcn_ds_bpermute((lane ^ m) << 2, v); }
__device__ __forceinline__ float shf(float v, int src) { return __builtin_bit_cast(float, __builtin_amdgcn_ds_bpermute(src << 2, __builtin_bit_cast(int, v))); }
__device__ __forceinline__ int shf(int v, int src) { return __builtin_amdgcn_ds_bpermute(src << 2, v); }
__device__ __forceinline__ float wave_sum(float v, int lane) {
#pragma unroll
    for (int o = 32; o >= 1; o >>= 1) v += shx(v, o, lane);
    return v;
}
__device__ __forceinline__ int lane_opaque() { unsigned m = ~0u; asm volatile("" : "+s"(m)); return (int)__builtin_amdgcn_mbcnt_hi(m, __builtin_amdgcn_mbcnt_lo(m, 0u)); }
__device__ __forceinline__ int tid_opaque(int wv) { return wv * 64 + lane_opaque(); }

namespace pg8 {
#define PG8_LAS __attribute__((address_space(3)))
typedef unsigned short bf16_t;
typedef short bf16x8 __attribute__((ext_vector_type(8)));
typedef float f32x4 __attribute__((ext_vector_type(4)));
typedef unsigned u32x4 __attribute__((ext_vector_type(4)));
constexpr int BM = 256, BK = 64, HALF = 128, HTB = HALF * BK * 2  , STAGE_BYTES = 8 * HTB, NXCD = 8, WGM = 8;

__host__ __device__ __forceinline__ int lds_byte(int r, int c) { const int st = (r >> 4) * 2 + (c >> 5), rr = r & 15, cc = c & 31, ob = rr * 64 + cc * 2; return st * 1024 + (ob ^ (((ob >> 9) & 1) << 5)); }
__host__ __device__ __forceinline__ void stage_rc(int b, int& R, int& C) { const int st = b / 1024, sb = b % 1024, swz = sb ^ (((sb >> 9) & 1) << 5); R = (st >> 1) * 16 + swz / 64; C = (st & 1) * 32 + (swz % 64) / 2; }
__host__ __device__ __forceinline__ int perm32(int rho) { const int n = rho >> 4, i = rho & 15; return 8 * (i >> 2) + 4 * n + (i & 3); }

struct Unit { int pm, pn; };
struct Gemm { const bf16_t* A; const bf16_t* Bt; int M, N, K; };

struct StaticOrder {
    int nM, nN, nwg, G, c;
    __host__ __device__ void init(int M, int N, int G_, int c_) { nM = M / BM; nN = N / BM; nwg = nM * nN; G = G_; c = c_; }
    __host__ __device__ bool next(int i, Unit& u) const {
        const long L = (long)i * G + c; if (L >= nwg) return false;
        int wgid = (int)L; { const int q = nwg / NXCD, r = nwg % NXCD, xcd = wgid % NXCD, off = wgid / NXCD; wgid = (xcd < r ? xcd * (q + 1) : r * (q + 1) + (xcd - r) * q) + off; }
        const int nig = WGM * nN, gid = wgid / nig, fm = gid * WGM, gsz = (nM - fm) < WGM ? (nM - fm) : WGM;
        u.pm = fm + ((wgid % nig) % gsz); u.pn = (wgid % nig) / gsz; return true;
    }
    __device__ __forceinline__ void a_ready(const Unit&) const {}
    __device__ __forceinline__ void done(const Unit&) const {}
};

__device__ __forceinline__ unsigned cvt_pk_bf16(float lo, float hi) { unsigned r; asm volatile("v_cvt_pk_bf16_f32 %0, %1, %2" : "=v"(r) : "v"(lo), "v"(hi)); return r; }
struct EpiInProj {
    static constexpr bool PERM = true, AFTER_DRAIN = false;
    bf16_t* P; const float* rope;
    __device__ __forceinline__ void operator()(const f32x4 (&acc)[2][2][4][2], const Unit& u, int wr, int wc, int fr, int fq) const {
        const int pn = u.pn; const bool lat = u.pm < 64; const int lane = fq * 16 + fr;
        const float sc = pn == 1 ? 0.125f : ((pn == 6 || pn == 7) ? 0.125f * 1.4426950408889634f : 1.0f);
        const float sgn = fq < 2 ? -1.0f : 1.0f;
#pragma unroll
        for (int bj = 0; bj < 2; ++bj) {
            const bool roped = lat && (pn == 0 || pn == 1 || pn == 6 || pn == 7 || (pn == 8 && bj == 0));
#pragma unroll
            for (int ai = 0; ai < 2; ++ai)
#pragma unroll
                for (int m = 0; m < 4; ++m) {
                    const int row = u.pm * BM + ai * HALF + wr * 64 + m * 16 + fr;
                    f32x4 v0 = acc[ai][bj][m][0], v1 = acc[ai][bj][m][1];
                    if (roped) {
                        const int pos = row & 8191, idx = (wc & 1) ? 128 + (pos & 63) : (pos >> 6);
                        const float2* tb = (const float2*)rope + idx * 16 + 8 * (fq & 1);
#pragma unroll
                        for (int e = 0; e < 4; ++e) {
                            const float p0 = shx(v0[e], 32, lane), p1 = shx(v1[e], 32, lane);
                            const float2 c0 = tb[e], c1 = tb[4 + e];
                            v0[e] = v0[e] * c0.x + sgn * p0 * c0.y;
                            v1[e] = v1[e] * c1.x + sgn * p1 * c1.y;
                        }
                    }
                    v0 = v0 * sc; v1 = v1 * sc;
                    u32x4 w; w.x = cvt_pk_bf16(v0[0], v0[1]); w.y = cvt_pk_bf16(v0[2], v0[3]); w.z = cvt_pk_bf16(v1[0], v1[1]); w.w = cvt_pk_bf16(v1[2], v1[3]);
                    *(u32x4*)(P + (size_t)row * 2304 + pn * BM + bj * HALF + wc * 32 + fq * 8) = w;
                    __builtin_amdgcn_sched_barrier(0);
                }
        }
    }
};
struct EpiF32 {
    static constexpr bool PERM = false, AFTER_DRAIN = false;
    float* O; int ldc;
    __device__ __forceinline__ void operator()(const f32x4 (&acc)[2][2][4][2], const Unit& u, int wr, int wc, int fr, int fq) const {
#pragma unroll
        for (int ai = 0; ai < 2; ++ai)
#pragma unroll
            for (int m = 0; m < 4; ++m) {
                float* rowp = O + (size_t)(u.pm * BM + ai * HALF + wr * 64 + m * 16 + fr) * ldc + u.pn * BM + wc * 32 + fq * 4;
#pragma unroll
                for (int bj = 0; bj < 2; ++bj)
#pragma unroll
                    for (int n = 0; n < 2; ++n) *(f32x4*)(rowp + bj * HALF + n * 16) = acc[ai][bj][m][n];
            }
    }
};


struct EpiBf16Plain {
    static constexpr bool PERM = true, AFTER_DRAIN = false;
    bf16_t* O; int ldc;
    __device__ __forceinline__ void operator()(const f32x4 (&acc)[2][2][4][2], const Unit& u, int wr, int wc, int fr, int fq) const {
#pragma unroll
        for (int ai = 0; ai < 2; ++ai)
#pragma unroll
            for (int m = 0; m < 4; ++m) {
                bf16_t* rowp = O + (size_t)(u.pm * BM + ai * HALF + wr * 64 + m * 16 + fr) * ldc + u.pn * BM + wc * 32 + fq * 8;
#pragma unroll
                for (int bj = 0; bj < 2; ++bj) {
                    const f32x4 v0 = acc[ai][bj][m][0], v1 = acc[ai][bj][m][1];
                    u32x4 w; w.x = cvt_pk_bf16(v0[0], v0[1]); w.y = cvt_pk_bf16(v0[2], v0[3]); w.z = cvt_pk_bf16(v1[0], v1[1]); w.w = cvt_pk_bf16(v1[2], v1[3]);
                    *(u32x4*)(rowp + bj * HALF) = w;
                }
            }
    }
};
template <class Epi, class Sched, bool ALIGN_EPI = false, bool SP2 = false>
__device__ __forceinline__ void gemm_phase(PG8_LAS unsigned char* lds, const Gemm g, const Sched& S, const Epi& E, int wv) {
    int tid_ = wv * 64; { unsigned m_ = ~0u; asm volatile("" : "+s"(m_)); tid_ += (int)__builtin_amdgcn_mbcnt_hi(m_, __builtin_amdgcn_mbcnt_lo(m_, 0u)); }
    const int tid = tid_, wid = __builtin_amdgcn_readfirstlane(tid >> 6), lane = tid & 63, wr = wid >> 2, wc = wid & 3, fr = lane & 15, fq = lane >> 4;
    const int K = g.K, nt = K / BK;
    unsigned voffA[2], voffB[2];
#pragma unroll
    for (int i = 0; i < 2; ++i) { int R, C; stage_rc(tid * 16 + i * 8192, R, C); const int Rb = Epi::PERM ? ((R & ~31) + perm32(R & 31)) : R;
        voffA[i] = (unsigned)(R * K + C) * 2u; voffB[i] = (unsigned)(Rb * K + C) * 2u; }
    const size_t kstep = (size_t)(BK * 2);
    const size_t hstep = (size_t)HALF * K * 2;
    const size_t tstep = 2 * hstep;
    const unsigned ldsw = (unsigned)wid * 1024u;
    const int aoff = lds_byte(wr * 64 + fr, fq * 8), boff = lds_byte(wc * 32 + fr, fq * 8);
#define PG8_SA(b, h) (((b) * 2 + (h)) * HTB)
#define PG8_SB(b, h) ((4 + (b) * 2 + (h)) * HTB)
#define PG8_STAGE(bufoff, gbase, voff) do { _Pragma("unroll") for (int _i = 0; _i < 2; ++_i) \
        __builtin_amdgcn_global_load_lds((const unsigned*)((const char*)(gbase) + (voff)[_i]), (PG8_LAS unsigned*)(lds + (bufoff) + ldsw + _i * 8192), 16, 0, 0); } while (0)
#define PG8_LDA(dst, b, h) do { _Pragma("unroll") for (int m = 0; m < 4; ++m) _Pragma("unroll") for (int k = 0; k < 2; ++k) dst[m][k] = *(const PG8_LAS bf16x8*)(lds + PG8_SA(b, h) + aoff + m * 2048 + k * 1024); } while (0)
#define PG8_LDB(dst, b, h) do { _Pragma("unroll") for (int n = 0; n < 2; ++n) _Pragma("unroll") for (int k = 0; k < 2; ++k) dst[n][k] = *(const PG8_LAS bf16x8*)(lds + PG8_SB(b, h) + boff + n * 2048 + k * 1024); } while (0)
#define PG8_MMA(ai, bj, At, Bt) do { __builtin_amdgcn_s_setprio(1); _Pragma("unroll") for (int m = 0; m < 4; ++m) _Pragma("unroll") for (int n = 0; n < 2; ++n) _Pragma("unroll") for (int k = 0; k < 2; ++k) \
        acc[ai][bj][m][n] = __builtin_amdgcn_mfma_f32_16x16x32_bf16(Bt[n][k], At[m][k], acc[ai][bj][m][n], 0, 0, 0); __builtin_amdgcn_s_setprio(0); } while (0)
#define PG8_WAIT_V(n) asm volatile("s_waitcnt vmcnt(" #n ")" ::: "memory")
#define PG8_WAIT_L(n) asm volatile("s_waitcnt lgkmcnt(" #n ")" ::: "memory")
#define PG8_BAR __builtin_amdgcn_s_barrier()
#define PG8_SCHED __builtin_amdgcn_sched_barrier(0)
    Unit cur, nxt; int ui = 0;
    if (!S.next(0, cur)) return;
    f32x4 acc[2][2][4][2];
#pragma unroll
    for (int a = 0; a < 2; ++a)
#pragma unroll
        for (int b = 0; b < 2; ++b)
#pragma unroll
            for (int m = 0; m < 4; ++m)
#pragma unroll
                for (int n = 0; n < 2; ++n) acc[a][b][m][n] = (f32x4){0.f, 0.f, 0.f, 0.f};
    bf16x8 At[4][2], B0[2][2], B1[2][2];
    const char* cA = (const char*)g.A + (size_t)cur.pm * tstep; const char* cB = (const char*)g.Bt + (size_t)cur.pn * tstep;
    S.a_ready(cur);
    if constexpr (SP2) {
        PG8_STAGE(PG8_SB(0, 0), cB, voffB); PG8_STAGE(PG8_SB(0, 1), cB + hstep, voffB); PG8_STAGE(PG8_SA(0, 0), cA, voffA); PG8_STAGE(PG8_SA(0, 1), cA + hstep, voffA);
        if (wr == 1) PG8_BAR;
        PG8_WAIT_V(2); PG8_BAR;
        PG8_STAGE(PG8_SB(1, 0), cB + kstep, voffB); PG8_STAGE(PG8_SA(1, 0), cA + kstep, voffA); PG8_STAGE(PG8_SB(1, 1), cB + hstep + kstep, voffB);
        PG8_WAIT_V(6); PG8_BAR;
    } else {
        PG8_STAGE(PG8_SB(0, 0), cB, voffB); PG8_STAGE(PG8_SA(0, 0), cA, voffA); PG8_STAGE(PG8_SB(0, 1), cB + hstep, voffB); PG8_STAGE(PG8_SA(0, 1), cA + hstep, voffA);
        if (wr == 1) PG8_BAR;
        PG8_WAIT_V(4); PG8_BAR;
        PG8_STAGE(PG8_SB(1, 0), cB + kstep, voffB); PG8_STAGE(PG8_SA(1, 0), cA + kstep, voffA); PG8_STAGE(PG8_SB(1, 1), cB + hstep + kstep, voffB);
        PG8_WAIT_V(6); PG8_BAR;
    }
    for (;;) {
        const bool has_next = S.next(ui + 1, nxt);
        const char* nA = has_next ? (const char*)g.A + (size_t)nxt.pm * tstep : cA; const char* nB = has_next ? (const char*)g.Bt + (size_t)nxt.pn * tstep : cB;
        for (int t = 0; t < nt; t += 2) {
            const bool last = (t == nt - 2);
            const char* a1 = cA + (size_t)(t + 1) * kstep;
            const char* a2 = last ? nA : cA + (size_t)(t + 2) * kstep; const char* b2 = last ? nB : cB + (size_t)(t + 2) * kstep;
            const char* a3 = a2 + kstep; const char* b3 = b2 + kstep;
            if (last && has_next) S.a_ready(nxt);
            if constexpr (SP2) {
            PG8_LDB(B0, 0, 0); PG8_LDB(B1, 0, 1); PG8_SCHED; PG8_LDA(At, 0, 0); PG8_STAGE(PG8_SA(1, 1), a1 + hstep, voffA);
            PG8_WAIT_V(8); PG8_WAIT_L(0); PG8_BAR; PG8_MMA(0, 0, At, B0); PG8_MMA(0, 1, At, B1); PG8_BAR; PG8_SCHED;
            PG8_LDA(At, 0, 1); PG8_STAGE(PG8_SB(0, 0), b2, voffB); PG8_STAGE(PG8_SB(0, 1), b2 + hstep, voffB); PG8_STAGE(PG8_SA(0, 0), a2, voffA);
            PG8_WAIT_V(8); PG8_WAIT_L(0); PG8_BAR; PG8_MMA(1, 0, At, B0); PG8_MMA(1, 1, At, B1); PG8_BAR; PG8_SCHED;
            PG8_LDB(B0, 1, 0); PG8_LDB(B1, 1, 1); PG8_SCHED; PG8_LDA(At, 1, 0); PG8_STAGE(PG8_SA(0, 1), a2 + hstep, voffA);
            PG8_WAIT_V(8); PG8_WAIT_L(0); PG8_BAR; PG8_MMA(0, 0, At, B0); PG8_MMA(0, 1, At, B1); PG8_BAR; PG8_SCHED;
            PG8_LDA(At, 1, 1); PG8_STAGE(PG8_SB(1, 0), b3, voffB); PG8_STAGE(PG8_SB(1, 1), b3 + hstep, voffB); PG8_STAGE(PG8_SA(1, 0), a3, voffA);
            PG8_WAIT_V(8); PG8_WAIT_L(0); PG8_BAR; PG8_MMA(1, 0, At, B0); PG8_MMA(1, 1, At, B1); PG8_BAR; PG8_SCHED;
            } else {
            PG8_LDB(B0, 0, 0); PG8_SCHED; PG8_LDA(At, 0, 0); PG8_STAGE(PG8_SA(1, 1), a1 + hstep, voffA);
            PG8_WAIT_L(8); PG8_BAR; PG8_WAIT_L(0); PG8_MMA(0, 0, At, B0); PG8_BAR; PG8_SCHED;
            PG8_LDB(B1, 0, 1); PG8_STAGE(PG8_SB(0, 0), b2, voffB);
            PG8_BAR; PG8_WAIT_L(0); PG8_MMA(0, 1, At, B1); PG8_BAR;
            PG8_LDA(At, 0, 1); PG8_STAGE(PG8_SA(0, 0), a2, voffA);
            PG8_BAR; PG8_WAIT_L(0); PG8_MMA(1, 0, At, B0); PG8_BAR; PG8_SCHED;
            PG8_STAGE(PG8_SB(0, 1), b2 + hstep, voffB);
            PG8_WAIT_V(6); PG8_BAR; PG8_MMA(1, 1, At, B1); PG8_BAR;
            PG8_LDB(B0, 1, 0); PG8_SCHED; PG8_LDA(At, 1, 0); PG8_STAGE(PG8_SA(0, 1), a2 + hstep, voffA);
            PG8_WAIT_L(8); PG8_BAR; PG8_WAIT_L(0); PG8_MMA(0, 0, At, B0); PG8_BAR; PG8_SCHED;
            PG8_LDB(B1, 1, 1); PG8_STAGE(PG8_SB(1, 0), b3, voffB);
            PG8_BAR; PG8_WAIT_L(0); PG8_MMA(0, 1, At, B1); PG8_BAR;
            PG8_LDA(At, 1, 1); PG8_STAGE(PG8_SA(1, 0), a3, voffA);
            PG8_BAR; PG8_WAIT_L(0); PG8_MMA(1, 0, At, B0); PG8_BAR; PG8_SCHED;
            PG8_STAGE(PG8_SB(1, 1), b3 + hstep, voffB);
            PG8_WAIT_V(6); PG8_BAR; PG8_MMA(1, 1, At, B1); PG8_BAR;
            }
        }
        if constexpr (ALIGN_EPI) { if (wr == 0) PG8_BAR; }
        if constexpr (!Epi::AFTER_DRAIN) { E(acc, cur, wr, wc, fr, fq); S.done(cur); }
        if (!has_next) break;
#pragma unroll
        for (int a = 0; a < 2; ++a)
#pragma unroll
            for (int b = 0; b < 2; ++b)
#pragma unroll
                for (int m = 0; m < 4; ++m)
#pragma unroll
                    for (int n = 0; n < 2; ++n) acc[a][b][m][n] = (f32x4){0.f, 0.f, 0.f, 0.f};
        cur = nxt; cA = nA; cB = nB; ++ui;
        if constexpr (ALIGN_EPI) { if (wr == 1) PG8_BAR; }
    }
    PG8_WAIT_V(0);
    if constexpr (!ALIGN_EPI) { if (wr == 0) PG8_BAR; }
    PG8_BAR;
    if constexpr (Epi::AFTER_DRAIN) { E.fused(acc, cur, wr, wc, fr, fq, lds, wid, lane); S.done(cur); }
#undef PG8_SA
#undef PG8_SB
#undef PG8_STAGE
#undef PG8_LDA
#undef PG8_LDB
#undef PG8_MMA
#undef PG8_WAIT_V
#undef PG8_WAIT_L
#undef PG8_BAR
#undef PG8_SCHED
}
}
constexpr int CW_BAR = 4096;
constexpr size_t CTL_BYTES = 65536;
#define XB_TMO      128
#define XB_XCNT(j)  (256  + 64 * (j))
#define XB_XSUB(j)  (1280 + 64 * (j))
#define XB_XGEN(j)  (2304 + 64 * (j))
#define XB_TOP      3328
#define XB_TOPGEN   3392
#define XCD_BAR_WORDS 3456
#define XB_SPIN_CAP (1u << 18)

__device__ __forceinline__ unsigned xb_ld(unsigned* p)              { return __hip_atomic_load(p, __ATOMIC_RELAXED, __HIP_MEMORY_SCOPE_AGENT); }
__device__ __forceinline__ unsigned xb_add(unsigned* p, unsigned v) { return __hip_atomic_fetch_add(p, v, __ATOMIC_RELAXED, __HIP_MEMORY_SCOPE_AGENT); }
__device__ __forceinline__ unsigned xb_xcc_id() { return (unsigned)__builtin_amdgcn_s_getreg((3 << 11) | 20) & 0xFu; }
#define XB_SPIN(cond, bar) do { unsigned _sp = 0; while (cond) { __builtin_amdgcn_s_sleep(1); \
    if ((++_sp & 255u) == 0u) { if (xb_ld(&(bar)[XB_TMO])) break; if (_sp > XB_SPIN_CAP) { atomicAdd(&(bar)[XB_TMO], 1u); break; } } } } while (0)

struct XcdBarrier {
    unsigned* bar; unsigned x; bool lead;
    volatile LAS unsigned* st;
};

__device__ __forceinline__ XcdBarrier xcd_barrier_post(unsigned* bar, volatile LAS unsigned* st, bool lead) {
    XcdBarrier b; b.bar = bar; b.x = xb_xcc_id(); b.st = st; b.lead = lead;
    if (b.lead) (void)xb_add(&bar[XB_XCNT(b.x)], 1u);
    return b;
}
__device__ __forceinline__ void xcd_barrier_complete(unsigned* bar, unsigned x, unsigned& nloc, unsigned& nx) {
    const unsigned G = gridDim.x * gridDim.y * gridDim.z;
    unsigned sum, cnt, mine, sp = 0u;
    for (;;) {
        sum = 0u; cnt = 0u; mine = 0u;
#pragma unroll
        for (unsigned j = 0; j < 16; ++j) { const unsigned c = xb_ld(&bar[XB_XCNT(j)]); sum += c; cnt += (c > 0u) ? 1u : 0u; mine = (j == x) ? c : mine; }
        if (sum == G) break;
        __builtin_amdgcn_s_sleep(1);
        if ((++sp & 255u) == 0u) { if (xb_ld(&bar[XB_TMO])) break; if (sp > XB_SPIN_CAP) { atomicAdd(&bar[XB_TMO], 1u); break; } }
    }
    nloc = mine > 0u ? mine : 1u; nx = cnt > 0u ? cnt : 1u;
}

__device__ __forceinline__ void xcd_barrier(const XcdBarrier& b) {
    asm volatile("s_waitcnt vmcnt(0)" ::: "memory");
    __syncthreads();
    if (b.lead) {
        unsigned* bar = b.bar;
        __builtin_amdgcn_s_waitcnt(0);
        unsigned nloc = b.st[0], nx = b.st[1];
        if (nloc == 0u) { xcd_barrier_complete(bar, b.x, nloc, nx); b.st[0] = nloc; b.st[1] = nx; }
        const unsigned old = xb_add(&bar[XB_XSUB(b.x)], 1u);
        const unsigned gen = old / nloc;
        if (old + 1u == (gen + 1u) * nloc) {
            __builtin_amdgcn_fence(__ATOMIC_RELEASE, "agent");
            asm volatile("s_waitcnt vmcnt(0)" ::: "memory");
            const unsigned og = xb_add(&bar[XB_TOP], 1u);
            const unsigned tg = og / nx;
            if (og + 1u == (tg + 1u) * nx) xb_add(&bar[XB_TOPGEN], 1u);
            else XB_SPIN(xb_ld(&bar[XB_TOPGEN]) == tg, bar);
            __builtin_amdgcn_fence(__ATOMIC_ACQUIRE, "agent");
            xb_add(&bar[XB_XGEN(b.x)], 1u);
            asm volatile("s_waitcnt vmcnt(0)" ::: "memory");
        } else {
            XB_SPIN(xb_ld(&bar[XB_XGEN(b.x)]) == gen, bar);
            __builtin_amdgcn_fence(__ATOMIC_ACQUIRE, "agent");
            asm volatile("s_waitcnt vmcnt(0)" ::: "memory");
        }
    }
    __syncthreads();
}


__device__ __forceinline__ void phase_mod1(KP p, int wv, int bid, int nb, float* lds) {
    float (*red)[8][64] = (float (*)[8][64])lds;
    const int t = tid_opaque(wv), cn = t & 63, kg = t >> 6;
    for (int u = bid; u < DEPTH * 96 * 16; u += nb) {
        const int ks = u & 15, nblk = (u >> 4) % 96, l = u / (16 * 96);
        const int n = nblk * 64 + cn;
        float a0 = 0.f, a1 = 0.f, a2 = 0.f;
#pragma unroll
        for (int kk = 0; kk < 8; ++kk) {
            const int k = ks * 64 + kg * 8 + kk;
            const float w = p->w_mod[((size_t)l * D + k) * 6144 + n];
            a0 += silu_f(p->c[k]) * w; a1 += silu_f(p->c[D + k]) * w; a2 += silu_f(p->c_ctx[k]) * w;
        }
        __syncthreads();
        red[0][kg][cn] = a0; red[1][kg][cn] = a1; red[2][kg][cn] = a2;
        __syncthreads();
        if (t < 192) {
            const int v = t >> 6;
            float s = 0.f;
#pragma unroll
            for (int g = 0; g < 8; ++g) s += red[v][g][cn];
            p->modp[(((size_t)ks * DEPTH + l) * 3 + v) * 6144 + n] = s;
        }
    }
    __syncthreads();
}
__device__ __forceinline__ void phase_mod2(KP p, int wv, int bid, int nb) {
    for (int i = bid * NT + tid_opaque(wv); i < DEPTH * 3 * 6144; i += nb * NT) {
        const int n = i % 6144, l = i / (3 * 6144);
        float s = p->b_mod[l * 6144 + n];
        for (int ks = 0; ks < 16; ++ks) s += p->modp[(size_t)ks * DEPTH * 3 * 6144 + i];
        p->mod[i] = s;
    }
}
__device__ __forceinline__ void transpose_item(const float* W, int K, int N, bf16* WT, float* scr, int item, int lane) {
    const int nblk = N / 32, kb = item / nblk, nbk = item % nblk, k0 = 64 * kb, n0 = 32 * nbk;
#pragma unroll 8
    for (int i = 0; i < 32; ++i) { const int kk = 2 * i + (lane >> 5); scr[kk * 33 + (lane & 31)] = W[(size_t)(k0 + kk) * N + n0 + (lane & 31)]; }
    __builtin_amdgcn_wave_barrier();
    const int c = lane & 7;
#pragma unroll
    for (int j = 0; j < 4; ++j) { const int n = (lane >> 3) + 8 * j; const float* s = scr + (8 * c) * 33 + n;
        uint4 o; o.x = pk2(s[0 * 33], s[1 * 33]); o.y = pk2(s[2 * 33], s[3 * 33]); o.z = pk2(s[4 * 33], s[5 * 33]); o.w = pk2(s[6 * 33], s[7 * 33]);
        *(uint4*)(WT + (size_t)(n0 + n) * K + k0 + 8 * c) = o; }
    __builtin_amdgcn_wave_barrier();
}
__device__ __forceinline__ void phase_tables(KP p, int wv, int l, int vb, int nvb) {
    {
        const int lane_ = tid_opaque(wv) & 63, w_ = tid_opaque(wv) >> 6;
        for (int row0 = (vb * NW + w_) * 4; row0 < 2 * PEER_N; row0 += nvb * NW * 4) {
            float v[4][16];
#pragma unroll
            for (int q = 0; q < 4; ++q) {
                const int row = row0 + q; const bool isv = row >= PEER_N; const int rr = l * PEER_N + (isv ? row - PEER_N : row);
                const float* src_ = (isv ? p->pv : p->pu) + (size_t)rr * D;
#pragma unroll
                for (int i = 0; i < 4; ++i) { typedef float f4v_ __attribute__((ext_vector_type(4))); const f4v_ q4 = __builtin_nontemporal_load((const f4v_*)(src_ + i * 256 + lane_ * 4)); v[q][i * 4 + 0] = q4[0]; v[q][i * 4 + 1] = q4[1]; v[q][i * 4 + 2] = q4[2]; v[q][i * 4 + 3] = q4[3]; }
            }
#pragma unroll
            for (int q = 0; q < 4; ++q) {
                const int row = row0 + q; const bool isv = row >= PEER_N; const int rr = l * PEER_N + (isv ? row - PEER_N : row);
                float m = 0.f;
#pragma unroll
                for (int i = 0; i < 16; ++i) m = fmaxf(m, fabsf(v[q][i]));
#pragma unroll
                for (int o = 32; o >= 1; o >>= 1) m = fmaxf(m, shx(m, o, lane_));
                unsigned* dst = (unsigned*)((isv ? p->V8 : p->U8) + (size_t)rr * D);
                if (!isv) {
                    const float inv = m > 0.f ? 127.0f / m : 0.f;
#pragma unroll
                    for (int i = 0; i < 4; ++i) {
                        const int q0 = (int)rintf(v[q][i * 4 + 0] * inv), q1 = (int)rintf(v[q][i * 4 + 1] * inv), q2 = (int)rintf(v[q][i * 4 + 2] * inv), q3 = (int)rintf(v[q][i * 4 + 3] * inv);
                        dst[i * 64 + lane_] = (unsigned)(q0 & 0xff) | ((unsigned)(q1 & 0xff) << 8) | ((unsigned)(q2 & 0xff) << 16) | ((unsigned)(q3 & 0xff) << 24);
                    }
                    if (lane_ == 0) p->SU[rr] = m * (1.0f / 127.0f);
                } else {
                    const float inv = m > 0.f ? 240.0f / m : 0.f;
#pragma unroll
                    for (int i = 0; i < 4; ++i) {
                        int pk = __builtin_amdgcn_cvt_pk_fp8_f32(v[q][i * 4 + 0] * inv, v[q][i * 4 + 1] * inv, 0, false);
                        pk = __builtin_amdgcn_cvt_pk_fp8_f32(v[q][i * 4 + 2] * inv, v[q][i * 4 + 3] * inv, pk, true);
                        dst[i * 64 + lane_] = (unsigned)pk;
                    }
                    if (lane_ == 0) p->SV[rr] = m * (1.0f / 240.0f);
                }
            }
        }
    }
}

__device__ __forceinline__ void phase_weights(KP p, int wv, int bid, int nb, float* lds) {
    const int lane = tid_opaque(wv) & 63, w = tid_opaque(wv) >> 6;
    float* scr = lds + 2048 + w * (64 * 33 + 16);
    constexpr int I_IN = 16 * 72, I_OUT = 16 * 32, I_Q = 16 * 64;
    constexpr int NITEMS = DEPTH * (I_IN + I_OUT + I_Q);
    for (int it = bid * NW + w; it < NITEMS; it += nb * NW) {
        int r = it;
        if (r < DEPTH * I_IN) { const int l = r / I_IN; transpose_item(p->w_in + (size_t)l * D * DIN, D, DIN, p->WtIn + (size_t)l * DIN * D, scr, r % I_IN, lane); continue; } r -= DEPTH * I_IN;
        if (r < DEPTH * I_OUT) { const int l = r / I_OUT; transpose_item(p->w_out + (size_t)l * D * D, D, D, p->WtOut + (size_t)l * D * D, scr, r % I_OUT, lane); continue; } r -= DEPTH * I_OUT;
        { const int l = r / I_Q; transpose_item(p->wq + (size_t)l * D * 2048, D, 2048, p->WtQ + (size_t)l * 2048 * D, scr, r % I_Q, lane); }
    }
    for (int i = bid * NT + tid_opaque(wv); i < 192 * 16; i += nb * NT) {
        const int idx = i >> 4, f = i & 15;
        const float inv = powf(10000.0f, -(float)f / 16.0f);
        const float ang = (float)(idx < 128 ? idx : idx - 128) * inv;
        p->rope[2 * i] = cosf(ang); p->rope[2 * i + 1] = sinf(ang);
    }
}

__device__ __forceinline__ void row_load(const float* src, float (&v)[16], int lane) {
#pragma unroll
    for (int i = 0; i < 4; ++i) { const float4 q = *(const float4*)(src + i * 256 + lane * 4); v[i * 4 + 0] = q.x; v[i * 4 + 1] = q.y; v[i * 4 + 2] = q.z; v[i * 4 + 3] = q.w; }
}
__device__ __forceinline__ void row_store(float* dst, const float (&v)[16], int lane) {
#pragma unroll
    for (int i = 0; i < 4; ++i) *(float4*)(dst + i * 256 + lane * 4) = make_float4(v[i * 4 + 0], v[i * 4 + 1], v[i * 4 + 2], v[i * 4 + 3]);
}
__device__ __forceinline__ void row_store_bf(bf16* dst, const float (&v)[16], int lane) {
#pragma unroll
    for (int i = 0; i < 4; ++i) *(uint2*)(dst + i * 256 + lane * 4) = make_uint2(pk2(v[i * 4 + 0], v[i * 4 + 1]), pk2(v[i * 4 + 2], v[i * 4 + 3]));
}
__device__ __forceinline__ void row_load_bf(const bf16* src, float (&v)[16], int lane) {
#pragma unroll
    for (int i = 0; i < 4; ++i) { const uint2 q = *(const uint2*)(src + i * 256 + lane * 4); v[i * 4 + 0] = bflo(q.x); v[i * 4 + 1] = bfhi(q.x); v[i * 4 + 2] = bflo(q.y); v[i * 4 + 3] = bfhi(q.y); }
}
__device__ __forceinline__ void row_ln(float (&v)[16], int lane) {
    float s = 0.f;
#pragma unroll
    for (int i = 0; i < 16; ++i) s += v[i];
    const float mu = wave_sum(s, lane) * (1.0f / D);
    float q = 0.f;
#pragma unroll
    for (int i = 0; i < 16; ++i) { v[i] -= mu; q += v[i] * v[i]; }
    const float rstd = rsqrtf(wave_sum(q, lane) * (1.0f / D) + LN_EPS);
#pragma unroll
    for (int i = 0; i < 16; ++i) v[i] *= rstd;
}
__device__ __forceinline__ const float* x_row(KP p, int l, int r) {
    if (l == 0) return r < TL ? p->x + (size_t)r * D : p->ctx + (size_t)(r - TL) * D;
    return nullptr;
}

__device__ __forceinline__ void phase_lnmod(KP p, int wv, int l, int bid, int nb) {
    const int lane = tid_opaque(wv) & 63, w = tid_opaque(wv) >> 6;
    for (int r = bid * NW + w; r < T; r += nb * NW) {
        float v[16], sh[16], sc[16];
        row_load(x_row(p, l, r), v, lane);
        const float* m = p->mod + ((size_t)l * 3 + mod_idx(r)) * 6144;
        row_load(m, sh, lane); row_load(m + 1024, sc, lane);
        row_ln(v, lane);
#pragma unroll
        for (int i = 0; i < 16; ++i) v[i] = v[i] * (1.0f + sc[i]) + sh[i];
        row_store_bf(p->H + (size_t)r * D, v, lane);
    }
}

typedef short bf16x8_t __attribute__((ext_vector_type(8)));
typedef short bf16x4_t __attribute__((ext_vector_type(4)));
typedef float f32x4_t __attribute__((ext_vector_type(4)));
#define MFMA16(a, b, c) __builtin_amdgcn_mfma_f32_16x16x32_bf16((a), (b), (c), 0, 0, 0)
constexpr int KROW = 72;
constexpr int TROW = 136;
__device__ __forceinline__ bf16x8_t lds_frag16(const bf16* p) { return *(const bf16x8_t*)p; }
__device__ __forceinline__ bf16x8_t lds_frag8x2(const bf16* p0, const bf16* p1) {
    const bf16x4_t a = *(const bf16x4_t*)p0, b = *(const bf16x4_t*)p1;
    bf16x8_t o; o[0] = a[0]; o[1] = a[1]; o[2] = a[2]; o[3] = a[3]; o[4] = b[0]; o[5] = b[1]; o[6] = b[2]; o[7] = b[3]; return o;
}
__device__ __forceinline__ bf16x8_t pack_p(const f32x4_t& x, const f32x4_t& y) {
    uint4 w; w.x = pk2(x[0], x[1]); w.y = pk2(x[2], x[3]); w.z = pk2(y[0], y[1]); w.w = pk2(y[2], y[3]);
    return __builtin_bit_cast(bf16x8_t, w);
}
__device__ __forceinline__ void st_tr8(bf16* dst_col0, int stride, const uint4& v) {
    dst_col0[0 * stride] = (bf16)(v.x & 0xffffu); dst_col0[1 * stride] = (bf16)(v.x >> 16);
    dst_col0[2 * stride] = (bf16)(v.y & 0xffffu); dst_col0[3 * stride] = (bf16)(v.y >> 16);
    dst_col0[4 * stride] = (bf16)(v.z & 0xffffu); dst_col0[5 * stride] = (bf16)(v.z >> 16);
    dst_col0[6 * stride] = (bf16)(v.w & 0xffffu); dst_col0[7 * stride] = (bf16)(v.w >> 16);
}

constexpr int ATT_BUF = 128 * KROW + 64 * TROW;
__device__ __forceinline__ void att_unit(KP p, int wv, int l, int u, bf16* lds) {
    const int t = tid_opaque(wv), lane = t & 63, w = t >> 6, r = lane & 15, g = lane >> 4;
    const bool lat = u < 256;
    int b, n, hkv;
    if (lat) { hkv = u & 1; n = (u >> 1) & 63; b = u >> 7; } else { const int v = u - 256; hkv = v & 1; n = (v >> 1) & 1; b = v >> 2; }
    const int hq = hkv * 4 + (w >> 1), qh = w & 1;
    const int qrow0 = (lat ? b * SEQ + n * 128 : TL + b * LC + n * 128) + qh * 64;
    int kb_lo = 0, kb_hi = -1;
    if (lat) { kb_lo = n > 0 ? n - 1 : 0; kb_hi = n < 63 ? n + 1 : 63; }
    const int nloc = kb_hi - kb_lo + 1, nblk = nloc + 2;
    const bf16* P = p->P;
    bf16x8_t qf[4][2];
#pragma unroll
    for (int qt = 0; qt < 4; ++qt)
#pragma unroll
        for (int ks = 0; ks < 2; ++ks) qf[qt][ks] = *(const bf16x8_t*)(P + (size_t)(qrow0 + qt * 16 + r) * DIN + C_AQ + hq * 64 + ks * 32 + g * 8);
    const float LOG2E = 1.4426950408889634f;
    const float sink2 = p->sink[l * 8 + hq] * LOG2E;
    float m[4], lsum[4];
    f32x4_t ot[4][4];
#pragma unroll
    for (int qt = 0; qt < 4; ++qt) { m[qt] = sink2; lsum[qt] = g == 0 ? 1.0f : 0.0f; }
#pragma unroll
    for (int dt = 0; dt < 4; ++dt)
#pragma unroll
        for (int qt = 0; qt < 4; ++qt) ot[dt][qt] = (f32x4_t){0.f, 0.f, 0.f, 0.f};
    uint4 kreg0, kreg1, vreg0, vreg1;
#define ATT_ROW0(bi) ((bi) < nloc ? b * SEQ + (kb_lo + (bi)) * 128 : TL + b * LC + ((bi) - nloc) * 128)
    const int key0 = t >> 3, key1 = key0 + 64, c8 = t & 7;
#define ATT_ISSUE(bi) do { const bf16* src_ = P + (size_t)(ATT_ROW0(bi) + key0) * DIN + hkv * 64 + c8 * 8; \
        kreg0 = *(const uint4*)(src_ + C_AK); vreg0 = *(const uint4*)(src_ + C_AV); \
        kreg1 = *(const uint4*)(src_ + 64 * DIN + C_AK); vreg1 = *(const uint4*)(src_ + 64 * DIN + C_AV); } while (0)
#define ATT_STAGE(buf) do { \
        *(uint4*)((buf) + key0 * KROW + c8 * 8) = kreg0; *(uint4*)((buf) + key1 * KROW + c8 * 8) = kreg1; \
        st_tr8((buf) + 128 * KROW + (c8 * 8) * TROW + key0, TROW, vreg0); st_tr8((buf) + 128 * KROW + (c8 * 8) * TROW + key1, TROW, vreg1); } while (0)
    __syncthreads();
    ATT_ISSUE(0);
    for (int bi = 0; bi < nblk; ++bi) {
        bf16* buf = lds + (bi & 1) * ATT_BUF;
        ATT_STAGE(buf);
        __syncthreads();
        if (bi + 1 < nblk) ATT_ISSUE(bi + 1);
        const bf16* Ks = buf; const bf16* Vt = buf + 128 * KROW;
        const int band = (bi < nloc) ? (kb_lo + bi) - n : 0;
#pragma unroll 1
        for (int sub = 0; sub < 2; ++sub) {
            f32x4_t st[4][4];
#pragma unroll
            for (int kt = 0; kt < 4; ++kt) {
#pragma unroll
                for (int qt = 0; qt < 4; ++qt) st[kt][qt] = (f32x4_t){0.f, 0.f, 0.f, 0.f};
#pragma unroll
                for (int ks = 0; ks < 2; ++ks) {
                    const bf16x8_t a = lds_frag16(Ks + (sub * 64 + kt * 16 + r) * KROW + ks * 32 + g * 8);
#pragma unroll
                    for (int qt = 0; qt < 4; ++qt) st[kt][qt] = MFMA16(a, qf[qt][ks], st[kt][qt]);
                }
            }
            if (band != 0) {
#pragma unroll
                for (int qt = 0; qt < 4; ++qt) {
                    const int il = qh * 64 + qt * 16 + r;
#pragma unroll
                    for (int kt = 0; kt < 4; ++kt)
#pragma unroll
                        for (int i = 0; i < 4; ++i) {
                            const int jl = sub * 64 + kt * 16 + g * 4 + i;
                            if (band < 0 ? jl < il : jl > il) st[kt][qt][i] = -INFINITY;
                        }
                }
            }
            float mnew[4]; bool grow = false;
#pragma unroll
            for (int qt = 0; qt < 4; ++qt) {
                float mloc = fmaxf(fmaxf(fmaxf(st[0][qt][0], st[0][qt][1]), fmaxf(st[0][qt][2], st[0][qt][3])), fmaxf(fmaxf(st[1][qt][0], st[1][qt][1]), fmaxf(st[1][qt][2], st[1][qt][3])));
                mloc = fmaxf(mloc, fmaxf(fmaxf(fmaxf(st[2][qt][0], st[2][qt][1]), fmaxf(st[2][qt][2], st[2][qt][3])), fmaxf(fmaxf(st[3][qt][0], st[3][qt][1]), fmaxf(st[3][qt][2], st[3][qt][3]))));
                mloc = fmaxf(mloc, shx(mloc, 16, lane)); mloc = fmaxf(mloc, shx(mloc, 32, lane));
                mnew[qt] = fmaxf(m[qt], mloc);
                grow = grow || (mnew[qt] > m[qt]);
            }
            if (__any(grow)) {
#pragma unroll
                for (int qt = 0; qt < 4; ++qt) {
                    const float alpha = __builtin_amdgcn_exp2f(m[qt] - mnew[qt]);
                    m[qt] = mnew[qt]; lsum[qt] *= alpha;
#pragma unroll
                    for (int dt = 0; dt < 4; ++dt) ot[dt][qt] = ot[dt][qt] * alpha;
                }
            }
#pragma unroll
            for (int qt = 0; qt < 4; ++qt) {
                float ps = 0.f;
#pragma unroll
                for (int kt = 0; kt < 4; ++kt)
#pragma unroll
                    for (int i = 0; i < 4; ++i) { const float e = __builtin_amdgcn_exp2f(st[kt][qt][i] - m[qt]); st[kt][qt][i] = e; ps += e; }
                lsum[qt] += ps;
            }
#pragma unroll
            for (int kp = 0; kp < 2; ++kp) {
                bf16x8_t pf[4];
#pragma unroll
                for (int qt = 0; qt < 4; ++qt) pf[qt] = pack_p(st[2 * kp][qt], st[2 * kp + 1][qt]);
#pragma unroll
                for (int dt = 0; dt < 4; ++dt) {
                    const bf16* vrow = Vt + (dt * 16 + r) * TROW + sub * 64 + g * 4;
                    const bf16x8_t a = lds_frag8x2(vrow + (2 * kp) * 16, vrow + (2 * kp + 1) * 16);
#pragma unroll
                    for (int qt = 0; qt < 4; ++qt) ot[dt][qt] = MFMA16(a, pf[qt], ot[dt][qt]);
                }
            }
        }
    }
#pragma unroll
    for (int qt = 0; qt < 4; ++qt) {
        float ls = lsum[qt]; ls += shx(ls, 16, lane); ls += shx(ls, 32, lane);
        const float inv = 1.0f / ls;
        bf16* orow = p->MIX + (size_t)(qrow0 + qt * 16 + r) * D + 512 + hq * 64 + g * 4;
#pragma unroll
        for (int dt = 0; dt < 4; ++dt) {
            const f32x4_t o = ot[dt][qt] * inv;
            *(uint2*)(orow + dt * 16) = make_uint2(pk2(o[0], o[1]), pk2(o[2], o[3]));
        }
    }
}

__device__ __forceinline__ size_t kv_off(int dir, int b, int pos, int h) { return ((((size_t)dir * NB + b) * NPOS + pos) * 4 + h) * 4096; }
__device__ __forceinline__ void ret_kv_unit(KP p, int wv, int l, int u, bf16* lds) {
    const int h = u & 3, pos = (u >> 2) % NPOS, b = u / (4 * NPOS);
    const int t = tid_opaque(wv), lane = t & 63, w = t >> 6, r = lane & 15, g = lane >> 4;
    bf16* Ktf = lds; bf16* Ktb = lds + 64 * TROW; bf16* Vt = lds + 2 * 64 * TROW;
    const float lgf = log_sigmoid_f(p->rdf[l * 4 + h]), lgb = log_sigmoid_f(p->rdb[l * 4 + h]);
    const int r0 = chunk_row0(b, pos);
    const bf16* P = p->P;
    __syncthreads();
#pragma unroll
    for (int q = 0; q < 2; ++q) {
        const int pc = t + q * NT, j = pc >> 3, c8 = pc & 7;
        const bf16* src = P + (size_t)(r0 + j) * DIN + h * 64 + c8 * 8;
        const uint4 kv = *(const uint4*)(src + C_RK), vv = *(const uint4*)(src + C_RV);
        const float wf = expf(lgf * (float)(127 - j)), wb = expf(lgb * (float)j);
        uint4 kf, kb;
        kf.x = pk2(bflo(kv.x) * wf, bfhi(kv.x) * wf); kf.y = pk2(bflo(kv.y) * wf, bfhi(kv.y) * wf); kf.z = pk2(bflo(kv.z) * wf, bfhi(kv.z) * wf); kf.w = pk2(bflo(kv.w) * wf, bfhi(kv.w) * wf);
        kb.x = pk2(bflo(kv.x) * wb, bfhi(kv.x) * wb); kb.y = pk2(bflo(kv.y) * wb, bfhi(kv.y) * wb); kb.z = pk2(bflo(kv.z) * wb, bfhi(kv.z) * wb); kb.w = pk2(bflo(kv.w) * wb, bfhi(kv.w) * wb);
        st_tr8(Ktf + (c8 * 8) * TROW + j, TROW, kf);
        st_tr8(Ktb + (c8 * 8) * TROW + j, TROW, kb);
        st_tr8(Vt + (c8 * 8) * TROW + j, TROW, vv);
    }
    __syncthreads();
    const int dir = w >> 2, dvt = w & 3;
    const bf16* Kt = dir ? Ktb : Ktf;
    f32x4_t acc[4];
#pragma unroll
    for (int dkt = 0; dkt < 4; ++dkt) acc[dkt] = (f32x4_t){0.f, 0.f, 0.f, 0.f};
#pragma unroll
    for (int ks = 0; ks < 4; ++ks) {
        const bf16x8_t a = lds_frag16(Vt + (dvt * 16 + r) * TROW + ks * 32 + g * 8);
#pragma unroll
        for (int dkt = 0; dkt < 4; ++dkt) acc[dkt] = MFMA16(a, lds_frag16(Kt + (dkt * 16 + r) * TROW + ks * 32 + g * 8), acc[dkt]);
    }
    float* o = p->KV + kv_off(dir, b, pos, h);
#pragma unroll
    for (int dkt = 0; dkt < 4; ++dkt)
#pragma unroll
        for (int i = 0; i < 4; ++i) o[(dvt * 16 + g * 4 + i) * 64 + dkt * 16 + r] = acc[dkt][i];
}

__device__ __forceinline__ void phase_ret_scan(KP p, int wv, int l, int bid, int nb) {
    for (int i = bid * NT + tid_opaque(wv); i < 2 * NB * 4 * 4096; i += nb * NT) {
        const int e = i & 4095, h = (i >> 12) & 3, b = (i >> 14) & 1, dir = i >> 15;
        const float lg = log_sigmoid_f(dir ? p->rdb[l * 4 + h] : p->rdf[l * 4 + h]);
        const float cdec = expf(128.0f * lg);
        const float* kv = p->KV; bf16* st = p->ST16;
        float v[NPOS];
#pragma unroll
        for (int step = 0; step < NPOS; ++step) {
            const int pos = dir == 0 ? step : (step == 0 ? 1 : (step == 1 ? 0 : 67 - step));
            v[step] = kv[kv_off(dir, b, pos, h) + e];
        }
        float s = 0.f;
#pragma unroll
        for (int step = 0; step < NPOS; ++step) {
            const int pos = dir == 0 ? step : (step == 0 ? 1 : (step == 1 ? 0 : 67 - step));
            st[kv_off(dir, b, pos, h) + e] = (bf16)f2bf(s);
            s = s * cdec + v[step];
        }
    }
}

constexpr int RO_HEAD = 128 * KROW + 64 * TROW + 2 * 64 * KROW;
constexpr int RO_TAB = 2 * RO_HEAD;
__device__ __forceinline__ void ret_out_unit(KP p, int wv, int l, int u, bf16* lds) {
    const int hp = u & 1, pos = (u >> 1) % NPOS, b = u / (2 * NPOS);
    if (l == DEPTH - 1 && pos < 2) return;
    const int t = tid_opaque(wv), lane = t & 63, w = t >> 6, r = lane & 15, g = lane >> 4;
    const int r0 = chunk_row0(b, pos);
    const bf16* P = p->P;
    float* tabs = (float*)(lds + RO_TAB);
    __syncthreads();
#pragma unroll
    for (int q = 0; q < 4; ++q) {
        const int pc = t + q * NT, hh = pc >> 10, j = (pc >> 3) & 127, c8 = pc & 7, h = hp * 2 + hh;
        bf16* base = lds + hh * RO_HEAD;
        const bf16* src = P + (size_t)(r0 + j) * DIN + h * 64 + c8 * 8;
        *(uint4*)(base + j * KROW + c8 * 8) = *(const uint4*)(src + C_RK);
        const uint4 vv = *(const uint4*)(src + C_RV);
        st_tr8(base + 128 * KROW + (c8 * 8) * TROW + j, TROW, vv);
    }
#pragma unroll
    for (int q = 0; q < 4; ++q) {
        const int pc = t + q * NT, hh = pc >> 10, dir = (pc >> 9) & 1, dv = (pc >> 3) & 63, c8 = pc & 7, h = hp * 2 + hh;
        const uint4 sv = *(const uint4*)(p->ST16 + kv_off(dir, b, pos, h) + dv * 64 + c8 * 8);
        *(uint4*)(lds + hh * RO_HEAD + 128 * KROW + 64 * TROW + dir * 64 * KROW + dv * KROW + c8 * 8) = sv;
    }
    if (t < 4 * 132) {
        const int hh = t / 264, dir = (t / 132) & 1, k = t % 132, h = hp * 2 + hh;
        const float lg = log_sigmoid_f(dir ? p->rdb[l * 4 + h] : p->rdf[l * 4 + h]);
        tabs[(hh * 2 + dir) * 132 + k] = expf(lg * (float)k);
    }
    __syncthreads();
    const int hh = w >> 2, h = hp * 2 + hh, qw = w & 3;
    const bf16* Ks = lds + hh * RO_HEAD; const bf16* Vt = Ks + 128 * KROW; const bf16* Sft = Vt + 64 * TROW; const bf16* Sbt = Sft + 64 * KROW;
    const float* pf = tabs + (hh * 2) * 132; const float* pb = pf + 132;
    bf16x8_t qf[2][2];
#pragma unroll
    for (int qt = 0; qt < 2; ++qt)
#pragma unroll
        for (int ks = 0; ks < 2; ++ks) qf[qt][ks] = *(const bf16x8_t*)(P + (size_t)(r0 + qw * 32 + qt * 16 + r) * DIN + C_RQ + h * 64 + ks * 32 + g * 8);
    f32x4_t accI[4][2], accF[4][2], accB[4][2];
#pragma unroll
    for (int dt = 0; dt < 4; ++dt)
#pragma unroll
        for (int qt = 0; qt < 2; ++qt) { accI[dt][qt] = (f32x4_t){0.f, 0.f, 0.f, 0.f}; accF[dt][qt] = accI[dt][qt]; accB[dt][qt] = accI[dt][qt]; }
#pragma unroll
    for (int dt = 0; dt < 4; ++dt)
#pragma unroll
        for (int ks = 0; ks < 2; ++ks) {
            const bf16x8_t af = lds_frag16(Sft + (dt * 16 + r) * KROW + ks * 32 + g * 8), ab = lds_frag16(Sbt + (dt * 16 + r) * KROW + ks * 32 + g * 8);
#pragma unroll
            for (int qt = 0; qt < 2; ++qt) { accF[dt][qt] = MFMA16(af, qf[qt][ks], accF[dt][qt]); accB[dt][qt] = MFMA16(ab, qf[qt][ks], accB[dt][qt]); }
        }
#pragma unroll 1
    for (int sub = 0; sub < 2; ++sub) {
        f32x4_t st[4][2];
#pragma unroll
        for (int kt = 0; kt < 4; ++kt) {
#pragma unroll
            for (int qt = 0; qt < 2; ++qt) st[kt][qt] = (f32x4_t){0.f, 0.f, 0.f, 0.f};
#pragma unroll
            for (int ks = 0; ks < 2; ++ks) {
                const bf16x8_t a = lds_frag16(Ks + (sub * 64 + kt * 16 + r) * KROW + ks * 32 + g * 8);
#pragma unroll
                for (int qt = 0; qt < 2; ++qt) st[kt][qt] = MFMA16(a, qf[qt][ks], st[kt][qt]);
            }
        }
#pragma unroll
        for (int qt = 0; qt < 2; ++qt) {
            const int il = qw * 32 + qt * 16 + r;
#pragma unroll
            for (int kt = 0; kt < 4; ++kt)
#pragma unroll
                for (int i = 0; i < 4; ++i) {
                    const int rel = il - (sub * 64 + kt * 16 + g * 4 + i);
                    const float wgt = rel > 0 ? pf[rel] : (rel < 0 ? pb[-rel] : 2.0f);
                    st[kt][qt][i] *= wgt;
                }
        }
#pragma unroll
        for (int kp = 0; kp < 2; ++kp) {
            bf16x8_t pfr[2];
#pragma unroll
            for (int qt = 0; qt < 2; ++qt) pfr[qt] = pack_p(st[2 * kp][qt], st[2 * kp + 1][qt]);
#pragma unroll
            for (int dt = 0; dt < 4; ++dt) {
                const bf16* vrow = Vt + (dt * 16 + r) * TROW + sub * 64 + g * 4;
                const bf16x8_t a = lds_frag8x2(vrow + (2 * kp) * 16, vrow + (2 * kp + 1) * 16);
#pragma unroll
                for (int qt = 0; qt < 2; ++qt) accI[dt][qt] = MFMA16(a, pfr[qt], accI[dt][qt]);
            }
        }
    }
#pragma unroll
    for (int qt = 0; qt < 2; ++qt) {
        const int il = qw * 32 + qt * 16 + r;
        const float qfd = pf[il + 1], qbd = pb[128 - il];
        float s = 0.f;
#pragma unroll
        for (int dt = 0; dt < 4; ++dt) { accI[dt][qt] = accI[dt][qt] + accF[dt][qt] * qfd + accB[dt][qt] * qbd; s += (accI[dt][qt][0] + accI[dt][qt][1]) + (accI[dt][qt][2] + accI[dt][qt][3]); }
        s += shx(s, 16, lane); s += shx(s, 32, lane);
        const float mu = s * (1.0f / 64.0f);
        float qq = 0.f;
#pragma unroll
        for (int dt = 0; dt < 4; ++dt) { accI[dt][qt] = accI[dt][qt] - mu; qq += (accI[dt][qt][0] * accI[dt][qt][0] + accI[dt][qt][1] * accI[dt][qt][1]) + (accI[dt][qt][2] * accI[dt][qt][2] + accI[dt][qt][3] * accI[dt][qt][3]); }
        qq += shx(qq, 16, lane); qq += shx(qq, 32, lane);
        const float rstd = rsqrtf(qq * (1.0f / 64.0f) + LN_EPS);
        const size_t row = (size_t)(r0 + il);
#pragma unroll
        for (int dt = 0; dt < 4; ++dt) {
            const uint2 gw = *(const uint2*)(P + row * DIN + C_RG + h * 64 + dt * 16 + g * 4);
            const f32x4_t o = accI[dt][qt] * rstd;
            const float o0 = o[0] * silu_f(bflo(gw.x)), o1 = o[1] * silu_f(bfhi(gw.x)), o2 = o[2] * silu_f(bflo(gw.y)), o3 = o[3] * silu_f(bfhi(gw.y));
            *(uint2*)(p->MIX + row * D + h * 64 + dt * 16 + g * 4) = make_uint2(pk2(o0, o1), pk2(o2, o3));
        }
    }
}

__device__ __forceinline__ void sgu_unit(KP p, int wv, int l, int u, bf16* lds) {
    const int grp = u & 3, pos = (u >> 2) % NPOS, b = u / (4 * NPOS);
    if (l == DEPTH - 1 && pos < 2) return;
    const int t = tid_opaque(wv), lane = t & 63, w = t >> 6, r = lane & 15, g = lane >> 4;
    const int r0 = chunk_row0(b, pos);
    const bf16* P = p->P;
    bf16* vnT = lds;
    __syncthreads();
    {
        const int j = t >> 2, qd = t & 3;
        const uint4* src = (const uint4*)(P + (size_t)(r0 + j) * DIN + C_SV + grp * 64 + qd * 16);
        const uint4 a = src[0], c = src[1];
        float v[16] = {bflo(a.x), bfhi(a.x), bflo(a.y), bfhi(a.y), bflo(a.z), bfhi(a.z), bflo(a.w), bfhi(a.w), bflo(c.x), bfhi(c.x), bflo(c.y), bfhi(c.y), bflo(c.z), bfhi(c.z), bflo(c.w), bfhi(c.w)};
        float s = 0.f;
#pragma unroll
        for (int d = 0; d < 16; ++d) { v[d] = gelu_tanh(v[d]); s += v[d]; }
        s += shx(s, 1, lane); s += shx(s, 2, lane);
        const float mu = s * (1.0f / 64.0f);
        float qq = 0.f;
#pragma unroll
        for (int d = 0; d < 16; ++d) { v[d] -= mu; qq += v[d] * v[d]; }
        qq += shx(qq, 1, lane); qq += shx(qq, 2, lane);
        const float rstd = rsqrtf(qq * (1.0f / 64.0f) + LN_EPS);
#pragma unroll
        for (int d = 0; d < 16; ++d) vnT[(qd * 16 + d) * TROW + j] = (bf16)f2bf(v[d] * rstd);
    }
    bf16x8_t wf[4];
    {
        const float* wrow = p->sgu_w + (((size_t)l * 4 + grp) * 128 + w * 16 + r) * 128 + g * 8;
#pragma unroll
        for (int ks = 0; ks < 4; ++ks) {
            const float4 a = *(const float4*)(wrow + ks * 32), c = *(const float4*)(wrow + ks * 32 + 4);
            uint4 o; o.x = pk2(a.x, a.y); o.y = pk2(a.z, a.w); o.z = pk2(c.x, c.y); o.w = pk2(c.z, c.w);
            wf[ks] = __builtin_bit_cast(bf16x8_t, o);
        }
    }
    __syncthreads();
    const int i = w * 16 + r;
    const float bs = p->sgu_b[((size_t)l * 4 + grp) * 128 + i];
#pragma unroll
    for (int dt = 0; dt < 4; ++dt) {
        f32x4_t acc = {0.f, 0.f, 0.f, 0.f};
#pragma unroll
        for (int ks = 0; ks < 4; ++ks) acc = MFMA16(lds_frag16(vnT + (dt * 16 + r) * TROW + ks * 32 + g * 8), wf[ks], acc);
        const uint2 uw = *(const uint2*)(P + (size_t)(r0 + i) * DIN + C_SU + grp * 64 + dt * 16 + g * 4);
        const float o0 = gelu_tanh(bflo(uw.x)) * (acc[0] + bs), o1 = gelu_tanh(bfhi(uw.x)) * (acc[1] + bs), o2 = gelu_tanh(bflo(uw.y)) * (acc[2] + bs), o3 = gelu_tanh(bfhi(uw.y)) * (acc[3] + bs);
        *(uint2*)(p->MIX + (size_t)(r0 + i) * D + 256 + grp * 64 + dt * 16 + g * 4) = make_uint2(pk2(o0, o1), pk2(o2, o3));
    }
}

__device__ __forceinline__ void phase_mix_a(KP p, int wv, int l, int bid, int nb, float* ldsf) {
    bf16* lds = (bf16*)ldsf;
    const int n_att = (l == DEPTH - 1) ? 256 : 264, n_kv = NB * NPOS * 4, n_sgu = NB * NPOS * 4;
    for (int u = bid; u < n_att + n_kv + n_sgu; u += nb) {
        if (u < n_att) att_unit(p, wv, l, u, lds);
        else if (u < n_att + n_kv) ret_kv_unit(p, wv, l, u - n_att, lds);
        else sgu_unit(p, wv, l, u - n_att - n_kv, lds);
    }
    __syncthreads();
}
__device__ __forceinline__ void phase_ret_out(KP p, int wv, int l, int bid, int nb, float* ldsf) {
    bf16* lds = (bf16*)ldsf;
    for (int u = bid; u < NB * NPOS * 2; u += nb) ret_out_unit(p, wv, l, u, lds);
    __syncthreads();
}

__device__ __forceinline__ void phase_ln1(KP p, int wv, int l, int bid, int nb) {
    const int lane = tid_opaque(wv) & 63, w = tid_opaque(wv) >> 6;
    const int Tn = (l == DEPTH - 1) ? TL : T;
    for (int r = bid * NW + w; r < Tn; r += nb * NW) {
        float v[16], a[16], c[16];
        if (l == 0) row_load(x_row(p, 0, r), v, lane); else row_load_bf(p->X + (size_t)r * D, v, lane);
        row_load_bf(p->Y + (size_t)r * D, a, lane);
        const float* m = p->mod + ((size_t)l * 3 + mod_idx(r)) * 6144;
        row_load(m + 2048, c, lane);
#pragma unroll
        for (int i = 0; i < 16; ++i) v[i] = ALPHA * v[i] + c[i] * a[i];
        row_ln(v, lane);
        row_load(p->lnm_g + l * D, a, lane); row_load(p->lnm_b + l * D, c, lane);
#pragma unroll
        for (int i = 0; i < 16; ++i) v[i] = v[i] * a[i] + c[i];
        row_store_bf(p->X1 + (size_t)r * D, v, lane);
        row_ln(v, lane);
        row_load(m + 3072, a, lane); row_load(m + 4096, c, lane);
#pragma unroll
        for (int i = 0; i < 16; ++i) v[i] = v[i] * (1.0f + c[i]) + a[i];
        row_store_bf(p->H + (size_t)r * D, v, lane);
        float mx = 0.f;
#pragma unroll
        for (int i = 0; i < 16; ++i) mx = fmaxf(mx, fabsf(v[i]));
#pragma unroll
        for (int o = 32; o >= 1; o >>= 1) mx = fmaxf(mx, shx(mx, o, lane));
        const float xinv = mx > 0.f ? 127.0f / mx : 0.f;
        unsigned* xq = (unsigned*)(p->XQ + (size_t)r * D);
#pragma unroll
        for (int i = 0; i < 4; ++i) {
            const int q0 = (int)rintf(v[i * 4 + 0] * xinv), q1 = (int)rintf(v[i * 4 + 1] * xinv), q2 = (int)rintf(v[i * 4 + 2] * xinv), q3 = (int)rintf(v[i * 4 + 3] * xinv);
            xq[i * 64 + lane] = (unsigned)(q0 & 0xff) | ((unsigned)(q1 & 0xff) << 8) | ((unsigned)(q2 & 0xff) << 16) | ((unsigned)(q3 & 0xff) << 24);
        }
        if (lane == 0) p->SX[r] = mx * (1.0f / 127.0f);
    }
}

template <int N> __device__ __forceinline__ void bitonic_sort_desc(float (&x)[N]) {
#pragma unroll
    for (int sz = 2; sz <= N; sz <<= 1)
#pragma unroll
        for (int t = sz >> 1; t > 0; t >>= 1)
#pragma unroll
            for (int i = 0; i < N; ++i)
                if ((i & t) == 0) {
                    const int j = i | t; const bool desc = (i & sz) == 0;
                    const float mx_ = fmaxf(x[i], x[j]), mn_ = fminf(x[i], x[j]);
                    x[i] = desc ? mx_ : mn_; x[j] = desc ? mn_ : mx_;
                }
}
__device__ __forceinline__ void bitonic_merge16_desc(float (&x)[16]) {
#pragma unroll
    for (int t = 8; t > 0; t >>= 1)
#pragma unroll
        for (int i = 0; i < 16; ++i)
            if ((i & t) == 0) { const int j = i | t; const float mx_ = fmaxf(x[i], x[j]), mn_ = fminf(x[i], x[j]); x[i] = mx_; x[j] = mn_; }
}
__device__ __forceinline__ void xmerge16_desc(float (&c)[16], int lane) {
#pragma unroll
    for (int o = 16; o <= 32; o <<= 1) {
        float pr[16];
#pragma unroll
        for (int i = 0; i < 16; ++i) pr[i] = shx(c[i], o, lane);
#pragma unroll
        for (int i = 0; i < 16; ++i) c[i] = fmaxf(c[i], pr[15 - i]);
        bitonic_merge16_desc(c);
    }
}
__device__ __forceinline__ void top16_keys(const float (&sc)[32], int fq, int lane, float (&c)[16]) {
    float a[16], b[16];
#pragma unroll
    for (int e = 0; e < 16; ++e) {
        a[e] = __builtin_bit_cast(float, (__builtin_bit_cast(unsigned, sc[e]) & ~127u) | (unsigned)((e >> 2) * 16 + (e & 3)) | ((unsigned)fq << 2));
        b[e] = __builtin_bit_cast(float, (__builtin_bit_cast(unsigned, sc[16 + e]) & ~127u) | (unsigned)(((16 + e) >> 2) * 16 + (e & 3)) | ((unsigned)fq << 2));
    }
    bitonic_sort_desc<16>(a); bitonic_sort_desc<16>(b);
#pragma unroll
    for (int i = 0; i < 16; ++i) c[i] = fmaxf(a[i], b[15 - i]);
    bitonic_merge16_desc(c);
    xmerge16_desc(c, lane);
}
constexpr int KS_STRIDE = 136;
__device__ __forceinline__ void phase_topk(KP p, int wv, int l, int bid, int nb, float* lds) {
    bf16* k1s = (bf16*)lds;
    bf16* k2s = k1s + 128 * KS_STRIDE;
    const int t = tid_opaque(wv), lane = t & 63, w = t >> 6;
    float* lists = lds + (2 * 128 * KS_STRIDE * 2) / 4 + w * 1536;
    float* v1 = lists; int* i1 = (int*)(lists + 256); float* v2 = lists + 512; int* i2 = (int*)(lists + 768); float* v3 = lists + 1024; int* c3 = (int*)(lists + 1280);
    unsigned char* ctab = (unsigned char*)(lds + (2 * 128 * KS_STRIDE * 2) / 4 + NW * 1536);
    __syncthreads();
    if (t < 64) {
        const int gq = t >> 4, k = t & 15; int ab = 0xff;
        if (gq == 0) { if (k < 13) ab = k; }
        else if (gq == 1) { if (k < 3) ab = 13 + k; else if (k < 11) ab = 0x10 | (k - 3); else if (k < 13) ab = 0x20 | (k - 11); }
        else if (gq == 2) { if (k < 3) ab = 0x20 | (k + 2); else if (k < 7) ab = 0x30 | (k - 3); else if (k < 10) ab = 0x40 | (k - 7); else if (k < 12) ab = 0x50 | (k - 10); else if (k < 13) ab = 0x60; }
        else { if (k == 0) ab = 0x61; else if (k < 3) ab = 0x70 | (k - 1); else if (k < 11) ab = (k + 5) << 4; }
        ctab[t] = (unsigned char)ab;
    }
    for (int e = t; e < 2 * 128 * 16; e += NT) {
        const int tab = e >> 11, r = (e >> 4) & 127, c8 = e & 15;
        const float* src = (tab ? p->k2 : p->k1) + (size_t)l * 128 * 128 + r * 128 + c8 * 8;
        const float4 a = *(const float4*)src, b = *(const float4*)(src + 4);
        uint4 o; o.x = pk2(a.x, a.y); o.y = pk2(a.z, a.w); o.z = pk2(b.x, b.y); o.w = pk2(b.z, b.w);
        *(uint4*)((tab ? k2s : k1s) + r * KS_STRIDE + c8 * 8) = o;
    }
    __syncthreads();
    const int fr = lane & 15, fq = lane >> 4;
    const int ntask = ((l == DEPTH - 1) ? TL : T) * 8 / 16;
    for (int task = bid * NW + w; task < ntask; task += nb * NW) {
        const int it0 = task * 16;
        const bf16* qrow = p->Qb + (size_t)(it0 + fr) * 256 + fq * 8;
        bf16x8_t bq[8];
#pragma unroll
        for (int ks = 0; ks < 8; ++ks) bq[ks] = *(const bf16x8_t*)(qrow + ks * 32);
        float s[32];
#pragma unroll
        for (int kt = 0; kt < 8; ++kt) {
            f32x4_t acc = {0.f, 0.f, 0.f, 0.f};
#pragma unroll
            for (int ks = 0; ks < 4; ++ks) {
                const bf16x8_t a = *(const bf16x8_t*)(k1s + (kt * 16 + fr) * KS_STRIDE + ks * 32 + fq * 8);
                acc = __builtin_amdgcn_mfma_f32_16x16x32_bf16(a, bq[ks], acc, 0, 0, 0);
            }
            s[kt * 4 + 0] = acc[0]; s[kt * 4 + 1] = acc[1]; s[kt * 4 + 2] = acc[2]; s[kt * 4 + 3] = acc[3];
        }
        { float ck[16]; top16_keys(s, fq, lane, ck);
          if (fq == 0) {
#pragma unroll
              for (int i = 0; i < 16; ++i) v1[fr * 16 + i] = ck[i]; } }
#pragma unroll
        for (int kt = 0; kt < 8; ++kt) {
            f32x4_t acc = {0.f, 0.f, 0.f, 0.f};
#pragma unroll
            for (int ks = 0; ks < 4; ++ks) {
                const bf16x8_t a = *(const bf16x8_t*)(k2s + (kt * 16 + fr) * KS_STRIDE + ks * 32 + fq * 8);
                acc = __builtin_amdgcn_mfma_f32_16x16x32_bf16(a, bq[4 + ks], acc, 0, 0, 0);
            }
            s[kt * 4 + 0] = acc[0]; s[kt * 4 + 1] = acc[1]; s[kt * 4 + 2] = acc[2]; s[kt * 4 + 3] = acc[3];
        }
        { float ck[16]; top16_keys(s, fq, lane, ck);
          if (fq == 0) {
#pragma unroll
              for (int i = 0; i < 16; ++i) v2[fr * 16 + i] = ck[i]; } }
        __builtin_amdgcn_wave_barrier();
        const uint4 tw = *(const uint4*)(ctab + fq * 16);
        const unsigned twd[4] = {tw.x, tw.y, tw.z, tw.w};
        float ck3[16];
        const float padv = __builtin_bit_cast(float, __builtin_bit_cast(unsigned, v1[fr * 16 + 15]) & ~127u) + __builtin_bit_cast(float, __builtin_bit_cast(unsigned, v2[fr * 16 + 15]) & ~127u) - 1.0f;
#pragma unroll
        for (int k = 0; k < 16; ++k) {
            const unsigned ab = k < 13 ? (twd[k >> 2] >> (8 * (k & 3))) & 0xffu : 0xffu;
            const float ka = __builtin_bit_cast(float, __builtin_bit_cast(unsigned, v1[fr * 16 + ((ab >> 4) & 15u)]) & ~127u);
            const float kb = __builtin_bit_cast(float, __builtin_bit_cast(unsigned, v2[fr * 16 + (ab & 15u)]) & ~127u);
            const float cvv = ab == 0xffu ? padv : ka + kb;
            ck3[k] = __builtin_bit_cast(float, (__builtin_bit_cast(unsigned, cvv) & ~255u) | ab);
        }
        bitonic_sort_desc<16>(ck3);
        xmerge16_desc(ck3, lane);
        float tv[4]; int tc[4];
#pragma unroll
        for (int k = 0; k < 4; ++k) {
            const float kk = fq == 0 ? ck3[k] : (fq == 1 ? ck3[4 + k] : (fq == 2 ? ck3[8 + k] : ck3[12 + k]));
            tv[k] = __builtin_bit_cast(float, __builtin_bit_cast(unsigned, kk) & ~255u); tc[k] = (int)(__builtin_bit_cast(unsigned, kk) & 255u);
        }
        float mx = fmaxf(fmaxf(tv[0], tv[1]), fmaxf(tv[2], tv[3]));
        mx = fmaxf(mx, shx(mx, 16, lane)); mx = fmaxf(mx, shx(mx, 32, lane));
        float ex[4], den = 0.f;
#pragma unroll
        for (int k = 0; k < 4; ++k) { ex[k] = expf(tv[k] - mx); den += ex[k]; }
        den += shx(den, 16, lane); den += shx(den, 32, lane);
        const float inv = 1.0f / den;
        int4 eo; float4 go;
#define TK_EID(c) ((int)(__builtin_bit_cast(unsigned, v1[fr * 16 + ((c) >> 4)]) & 127u) * 128 + (int)(__builtin_bit_cast(unsigned, v2[fr * 16 + ((c) & 15)]) & 127u))
        eo.x = TK_EID(tc[0]); eo.y = TK_EID(tc[1]); eo.z = TK_EID(tc[2]); eo.w = TK_EID(tc[3]);
#undef TK_EID
        go = make_float4(ex[0] * inv, ex[1] * inv, ex[2] * inv, ex[3] * inv);
        *(int4*)(p->EIDX + (size_t)(it0 + fr) * 16 + fq * 4) = eo;
        *(float4*)(p->GATE + (size_t)(it0 + fr) * 16 + fq * 4) = go;
        __builtin_amdgcn_wave_barrier();
    }
    __syncthreads();
}

typedef unsigned u32x4_t __attribute__((ext_vector_type(4)));
using bf16x2_t = __attribute__((ext_vector_type(2))) __bf16;
__device__ __forceinline__ float dot2bf(unsigned a, unsigned b, float acc) { return __builtin_amdgcn_fdot2_f32_bf16(__builtin_bit_cast(bf16x2_t, a), __builtin_bit_cast(bf16x2_t, b), acc, false); }
struct RowBf { u32x4_t a, b; };
__device__ __forceinline__ RowBf ld_row(const bf16* tab, int e, int lane) {
    const u32x4_t* r = (const u32x4_t*)(tab + (size_t)e * D) + lane;
    RowBf x; x.a = r[0]; x.b = r[64]; return x;
}
__device__ __forceinline__ float row_dot(const RowBf& x, const RowBf& u) {
    float d = 0.f;
#pragma unroll
    for (int k = 0; k < 4; ++k) { d = dot2bf(x.a[k], u.a[k], d); d = dot2bf(x.b[k], u.b[k], d); }
    return d;
}
__device__ __forceinline__ void row_axpy(float (&acc)[16], float a, const RowBf& v) {
#pragma unroll
    for (int k = 0; k < 4; ++k) {
        acc[2 * k] += a * bflo(v.a[k]); acc[2 * k + 1] += a * bfhi(v.a[k]);
        acc[8 + 2 * k] += a * bflo(v.b[k]); acc[8 + 2 * k + 1] += a * bfhi(v.b[k]);
    }
}
__device__ __forceinline__ float transpose_reduce16(float (&part)[16], int lane) {
#pragma unroll
    for (int st = 32, n = 8; n >= 1; st >>= 1, n >>= 1) {
        const bool up = (lane & st) != 0;
#pragma unroll
        for (int s = 0; s < n; ++s) {
            const float lo = part[s], hi = part[s + n];
            const float recv = shx(up ? lo : hi, st, lane);
            part[s] = (up ? hi : lo) + recv;
        }
    }
    float v = part[0];
    v += shx(v, 2, lane); v += shx(v, 1, lane);
    return v;
}
typedef float f32x2_t __attribute__((ext_vector_type(2)));
__device__ __forceinline__ float transpose_reduce8(float (&part)[8], int lane) {
#pragma unroll
    for (int st = 32, n = 4; n >= 1; st >>= 1, n >>= 1) {
        const bool up = (lane & st) != 0;
#pragma unroll
        for (int s = 0; s < n; ++s) {
            const float lo = part[s], hi = part[s + n];
            const float recv = shx(up ? lo : hi, st, lane);
            part[s] = (up ? hi : lo) + recv;
        }
    }
    float v = part[0];
    v += shx(v, 4, lane); v += shx(v, 2, lane); v += shx(v, 1, lane);
    return v;
}
typedef int v4i_t __attribute__((ext_vector_type(4)));
typedef unsigned u32x4v __attribute__((ext_vector_type(4)));
constexpr int EXU_CAP = 440, EXU_TROW = 1056, EXU_WAVE = 8 * EXU_CAP + 16 * EXU_TROW;
__device__ __forceinline__ void phase_expert_u(KP p, int wv, int l, int bid, int nb, float* lds) {
    const int lane = tid_opaque(wv) & 63, w = __builtin_amdgcn_readfirstlane(tid_opaque(wv) >> 6);
    const int G8 = nb >> 3;
    if (bid >= G8 * 8) return;
    const int rng = bid & 7, r = lane & 15, g = lane >> 4;
    const unsigned char* U = p->U8 + (size_t)l * PEER_N * D;
    const float* SU = p->SU + (size_t)l * PEER_N; const float* SV = p->SV + (size_t)l * PEER_N;
    unsigned char* wl = (unsigned char*)lds + w * EXU_WAVE;
    unsigned* lpk = (unsigned*)wl; float* lgt = (float*)(wl + 4 * EXU_CAP); unsigned char* tile = wl + 8 * EXU_CAP;
    const unsigned long long ltmask = (1ull << lane) - 1ull;
    const int tstride = G8 * NW, Tn = (l == DEPTH - 1) ? TL : T, t0 = (bid >> 3) * NW + w;
    if (t0 >= Tn) return;
    const int nitem = (Tn - t0 + tstride - 1) / tstride;
    int i0 = 0;
    while (i0 < nitem) {
        const int nt = nitem - i0 < 16 ? nitem - i0 : 16;
        v4i_t afr[16];
        {
            const unsigned char* xa = p->XQ + (size_t)(t0 + (i0 + (r < nt ? r : nt - 1)) * tstride) * D + g * 16;
#pragma unroll
            for (int ks = 0; ks < 16; ++ks) afr[ks] = *(const v4i_t*)(xa + ks * 64);
        }
        const float sxv = p->SX[t0 + (i0 + (lane < nt ? lane : nt - 1)) * tstride];
        int e0[16], e1[16];
#pragma unroll
        for (int j = 0; j < 16; ++j) {
            const size_t tb = (size_t)(t0 + (i0 + (j < nt ? j : nt - 1)) * tstride) * NSEL;
            e0[j] = p->EIDX[tb + lane]; e1[j] = p->EIDX[tb + 64 + lane];
        }
        int cnt = 0, ndone = 0; bool open = true;
#pragma unroll
        for (int j = 0; j < 16; ++j) {
            const bool in0 = (e0[j] >> 11) == rng, in1 = (e1[j] >> 11) == rng;
            const unsigned long long m0 = __ballot(in0), m1 = __ballot(in1);
            const int c0 = __popcll(m0), c = c0 + __popcll(m1);
            open = open && j < nt && cnt + c <= EXU_CAP;
            if (open) {
                if (in0) { const int pos = cnt + __popcll(m0 & ltmask); lpk[pos] = (unsigned)e0[j] | ((unsigned)j << 14) | ((unsigned)lane << 18); }
                if (in1) { const int pos = cnt + c0 + __popcll(m1 & ltmask); lpk[pos] = (unsigned)e1[j] | ((unsigned)j << 14) | ((unsigned)(lane + 64) << 18); }
                cnt += c; ndone = j + 1;
            }
        }
        __builtin_amdgcn_wave_barrier();
        const int ntile = (cnt + 15) >> 4;
        u32x4v rw[16]; unsigned pkv = 0u; float suv = 0.f;
#define EXU_ISSUE(q) do { const int idx_ = 16 * (q) + r < cnt ? 16 * (q) + r : cnt - 1; \
            pkv = lpk[idx_]; const unsigned e_ = pkv & 0x3fffu; \
            _Pragma("unroll") for (int k = 0; k < 16; ++k) rw[k] = *(const u32x4v*)(U + ((size_t)(__builtin_amdgcn_readlane((int)pkv, k) & 0x3fff) << 10) + lane * 16); \
            suv = SU[e_]; } while (0)
        if (ntile > 0) EXU_ISSUE(0);
#pragma unroll 1
        for (int q = 0; q < ntile; ++q) {
#pragma unroll
            for (int k = 0; k < 16; ++k) *(u32x4v*)(tile + k * EXU_TROW + lane * 16) = rw[k];
            const unsigned pk = pkv; const float su = suv;
            __builtin_amdgcn_wave_barrier();
            if (q + 1 < ntile) EXU_ISSUE(q + 1);
            v4i_t acc = {0, 0, 0, 0};
#pragma unroll
            for (int ks = 0; ks < 16; ++ks) {
                const v4i_t b = *(const v4i_t*)(tile + r * EXU_TROW + ks * 64 + g * 16);
                acc = __builtin_amdgcn_mfma_i32_16x16x64_i8(afr[ks], b, acc, 0, 0, 0);
            }
            const int j = (int)((pk >> 14) & 15u);
            const int d = (j & 2) ? ((j & 1) ? acc[3] : acc[2]) : ((j & 1) ? acc[1] : acc[0]);
            const float sx = shf(sxv, j);
            if (g == (j >> 2) && 16 * q + r < cnt) lgt[16 * q + r] = (float)d * su * sx;
            __builtin_amdgcn_wave_barrier();
        }
#undef EXU_ISSUE
        for (int idx = lane; idx < cnt; idx += 64) {
            const unsigned pk = lpk[idx]; const int e = (int)(pk & 0x3fffu), j = (int)((pk >> 14) & 15u), slot = (int)(pk >> 18);
            const size_t ao = (size_t)(t0 + (i0 + j) * tstride) * NSEL + slot;
            p->ACT[ao] = gelu_tanh(lgt[idx]) * p->GATE[ao] * SV[e];
        }
        __builtin_amdgcn_wave_barrier();
        i0 += ndone > 0 ? ndone : 1;
    }
}
__device__ __forceinline__ void phase_expert_v(KP p, int wv, int l, int bid, int nb) {
    const int lane = tid_opaque(wv) & 63, w = __builtin_amdgcn_readfirstlane(tid_opaque(wv) >> 6);
    const int G8 = nb >> 3;
    if (bid >= G8 * 8) return;
    const int sl = bid & 7, q = lane >> 3, c = lane & 7;
    const __amdgpu_buffer_rsrc_t rsV = __builtin_amdgcn_make_buffer_rsrc((void*)(p->V8 + (size_t)l * PEER_N * D), 0, PEER_N * D, 0x00020000);
    const int coff = sl * 128 + c * 16;
    const int tstride = G8 * NW, Tn = (l == DEPTH - 1) ? TL : T, t0 = (bid >> 3) * NW + w;
    const int nitem = t0 < Tn ? (Tn - t0 + tstride - 1) / tstride : 0;
    for (int j0 = 0; j0 < nitem; j0 += 8) {
        const bool valid = j0 + q < nitem;
        const int t = t0 + (valid ? j0 + q : nitem - 1) * tstride;
        int e[16]; float a[16];
        {
            const int4* ep = (const int4*)(p->EIDX + (size_t)t * NSEL + c * 16); const float4* ap = (const float4*)(p->ACT + (size_t)t * NSEL + c * 16);
#pragma unroll
            for (int k = 0; k < 4; ++k) { const int4 ev = ep[k]; const float4 av = ap[k];
                e[k * 4 + 0] = ev.x << 10; e[k * 4 + 1] = ev.y << 10; e[k * 4 + 2] = ev.z << 10; e[k * 4 + 3] = ev.w << 10;
                a[k * 4 + 0] = av.x; a[k * 4 + 1] = av.y; a[k * 4 + 2] = av.z; a[k * 4 + 3] = av.w; }
        }
        f32x2_t acc[8];
#pragma unroll
        for (int k = 0; k < 8; ++k) acc[k] = (f32x2_t){0.f, 0.f};
#pragma unroll 1
        for (int cc = 0; cc < 8; ++cc) {
            const int baddr = ((lane & 56) | cc) << 2;
#pragma unroll
            for (int hb = 0; hb < 2; ++hb) {
                u32x4v rv[8]; float av[8];
#pragma unroll
                for (int k = 0; k < 8; ++k) {
                    const int j = hb * 8 + k;
                    const int eo = __builtin_amdgcn_ds_bpermute(baddr, e[j]);
                    av[k] = __builtin_bit_cast(float, __builtin_amdgcn_ds_bpermute(baddr, __builtin_bit_cast(int, a[j])));
                    rv[k] = __builtin_amdgcn_raw_buffer_load_b128(rsV, eo + coff, 0, 0);
                }
#pragma unroll
                for (int k = 0; k < 8; ++k) {
                    const f32x2_t a2 = {av[k], av[k]};
                    acc[0] += a2 * __builtin_amdgcn_cvt_pk_f32_fp8((int)rv[k][0], false); acc[1] += a2 * __builtin_amdgcn_cvt_pk_f32_fp8((int)rv[k][0], true);
                    acc[2] += a2 * __builtin_amdgcn_cvt_pk_f32_fp8((int)rv[k][1], false); acc[3] += a2 * __builtin_amdgcn_cvt_pk_f32_fp8((int)rv[k][1], true);
                    acc[4] += a2 * __builtin_amdgcn_cvt_pk_f32_fp8((int)rv[k][2], false); acc[5] += a2 * __builtin_amdgcn_cvt_pk_f32_fp8((int)rv[k][2], true);
                    acc[6] += a2 * __builtin_amdgcn_cvt_pk_f32_fp8((int)rv[k][3], false); acc[7] += a2 * __builtin_amdgcn_cvt_pk_f32_fp8((int)rv[k][3], true);
                    __builtin_amdgcn_sched_barrier(0);
                }
            }
        }
        if (valid) {
            bf16* yr = p->Y + (size_t)t * D + coff;
            *(uint4*)yr = make_uint4(pk2(acc[0].x, acc[0].y), pk2(acc[1].x, acc[1].y), pk2(acc[2].x, acc[2].y), pk2(acc[3].x, acc[3].y));
            *(uint4*)(yr + 8) = make_uint4(pk2(acc[4].x, acc[4].y), pk2(acc[5].x, acc[5].y), pk2(acc[6].x, acc[6].y), pk2(acc[7].x, acc[7].y));
        }
    }
}

__device__ __forceinline__ void phase_ln2(KP p, int wv, int l, int bid, int nb) {
    const int lane = tid_opaque(wv) & 63, w = tid_opaque(wv) >> 6;
    const int Tn = (l == DEPTH - 1) ? TL : T;
    for (int r = bid * NW + w; r < Tn; r += nb * NW) {
        float v[16], a[16], c[16];
        row_load_bf(p->X1 + (size_t)r * D, v, lane);
        row_load_bf(p->Y + (size_t)r * D, a, lane);
        const float* m = p->mod + ((size_t)l * 3 + mod_idx(r)) * 6144;
        row_load(m + 5120, c, lane);
#pragma unroll
        for (int i = 0; i < 16; ++i) v[i] = ALPHA * v[i] + c[i] * a[i];
        row_ln(v, lane);
        row_load(p->lnf_g + l * D, a, lane); row_load(p->lnf_b + l * D, c, lane);
#pragma unroll
        for (int i = 0; i < 16; ++i) v[i] = v[i] * a[i] + c[i];
        if (l == DEPTH - 1) { if (r < TL) row_store(p->out + (size_t)r * D, v, lane); continue; }
        row_store_bf(p->X + (size_t)r * D, v, lane);
        const float* m2 = p->mod + ((size_t)(l + 1) * 3 + mod_idx(r)) * 6144;
        row_ln(v, lane);
        row_load(m2, a, lane); row_load(m2 + 1024, c, lane);
#pragma unroll
        for (int i = 0; i < 16; ++i) v[i] = v[i] * (1.0f + c[i]) + a[i];
        row_store_bf(p->H + (size_t)r * D, v, lane);
    }
}

__global__ void __launch_bounds__(NT, 2) mega(Params p_unused) {
    extern __shared__ __attribute__((aligned(16))) unsigned char lds_raw[];
    cg::grid_group grid = cg::this_grid();
    const int bid = blockIdx.x, nb = gridDim.x;
    const int wv = __builtin_amdgcn_readfirstlane(threadIdx.x >> 6);
    float* lds = (float*)lds_raw;
    LAS unsigned char* ldsl = (LAS unsigned char*)lds_raw;
    volatile LAS unsigned* MISC = (volatile LAS unsigned*)(ldsl + MISC_OFF);
    for (int u = threadIdx.x; u < 64; u += NT) ((LAS unsigned*)(ldsl + MISC_OFF))[u] = 0u;
    __syncthreads();
#define IS_LEAD() (wv == 0 && lane_opaque() == 0)
    (void)xcd_barrier_post(kparams()->ctl + CW_BAR, MISC + 8, IS_LEAD());
#define GRID_BAR() do { XcdBarrier b_; b_.bar = kparams()->ctl + CW_BAR; b_.x = xb_xcc_id(); b_.st = MISC + 8; b_.lead = IS_LEAD(); xcd_barrier(b_); } while (0)

    phase_mod1(kparams(), wv, bid, nb, lds);
    phase_weights(kparams(), wv, bid, nb, lds);
    grid.sync();
    phase_mod2(kparams(), wv, bid, nb);
    GRID_BAR();
    phase_lnmod(kparams(), wv, 0, bid, nb);
    GRID_BAR();
#define LAYER_BODY(l) do { \
        { KP p = kparams(); \
            pg8::Gemm g{p->H, p->WtIn + (size_t)l * DIN * D, T, DIN, D}; pg8::StaticOrder S; S.init(T, DIN, nb, bid); \
            pg8::EpiInProj E{p->P, p->rope}; \
            pg8::gemm_phase<pg8::EpiInProj, pg8::StaticOrder, true, true>(ldsl, g, S, E, wv); \
            { const int busy3 = 66 * 9 - 2 * nb;                       \
              if (busy3 > 0 && busy3 < nb) { if (bid >= busy3) phase_tables(p, wv, l, bid - busy3, nb - busy3); } else phase_tables(p, wv, l, bid, nb); } \
        } \
        GRID_BAR(); \
        phase_mix_a(kparams(), wv, l, bid, nb, lds); \
        GRID_BAR(); \
        phase_ret_scan(kparams(), wv, l, bid, nb); \
        GRID_BAR(); \
        phase_ret_out(kparams(), wv, l, bid, nb, lds); \
        GRID_BAR(); \
        { KP p = kparams(); \
            const int Mr = (l == DEPTH - 1) ? TL : T; pg8::Gemm g{p->MIX, p->WtOut + (size_t)l * D * D, Mr, D, D}; pg8::StaticOrder S; S.init(Mr, D, nb, bid); \
            pg8::EpiBf16Plain E{p->Y, D}; \
            pg8::gemm_phase<pg8::EpiBf16Plain, pg8::StaticOrder, true, true>(ldsl, g, S, E, wv); \
        } \
        GRID_BAR(); \
        phase_ln1(kparams(), wv, l, bid, nb); \
        GRID_BAR(); \
        { KP p = kparams(); \
            const int Mr = (l == DEPTH - 1) ? TL : T; pg8::Gemm g{p->H, p->WtQ + (size_t)l * 2048 * D, Mr, 2048, D}; pg8::StaticOrder S; S.init(Mr, 2048, nb, bid); \
            pg8::EpiBf16Plain E{p->Qb, 2048}; \
            pg8::gemm_phase<pg8::EpiBf16Plain, pg8::StaticOrder, true, true>(ldsl, g, S, E, wv); \
        } \
        GRID_BAR(); \
        phase_topk(kparams(), wv, l, bid, nb, lds); \
        GRID_BAR(); \
        phase_expert_u(kparams(), wv, l, bid, nb, lds); \
        GRID_BAR(); \
        phase_expert_v(kparams(), wv, l, bid, nb); \
        GRID_BAR(); \
        phase_ln2(kparams(), wv, l, bid, nb); \
        if (l + 1 < DEPTH) GRID_BAR(); \
    } while (0)
    LAYER_BODY(0); LAYER_BODY(1); LAYER_BODY(2); LAYER_BODY(3);
#undef LAYER_BODY
}

extern "C" void kernel_launch(void* const* d_in, const int* in_sizes, int n_in, void* d_out, int out_size, void* d_ws, size_t ws_size, hipStream_t stream) {
    static int grid_blocks = 0;
    if (!grid_blocks) {
        int dev = 0, cus = 0, per_cu = 0;
        (void)hipGetDevice(&dev);
        (void)hipDeviceGetAttribute(&cus, hipDeviceAttributeMultiprocessorCount, dev);
        (void)hipFuncSetAttribute((const void*)mega, hipFuncAttributeMaxDynamicSharedMemorySize, LDS_BYTES);
        (void)hipOccupancyMaxActiveBlocksPerMultiprocessor(&per_cu, mega, NT, LDS_BYTES);
        if (per_cu < 1) { fprintf(stderr, "occupancy query says %d blocks per CU\n", per_cu); per_cu = 1; }
        grid_blocks = cus;
    }
    Params p{};
    const float** ins = (const float**)&p;
    for (int i = 0; i < 22; ++i) ins[i] = (const float*)d_in[i];
    p.out = (float*)d_out;
    char* ws = (char*)d_ws;
    size_t off = 0;
    auto carve = [&](size_t bytes) { void* r = ws + off; off += (bytes + 255) & ~(size_t)255; return r; };
    p.ctl = (unsigned*)carve(CTL_BYTES);
    p.modp = (float*)carve((size_t)16 * DEPTH * 3 * 6144 * 4);
    p.mod = (float*)carve((size_t)DEPTH * 3 * 6144 * 4);
    p.rope = (float*)carve((size_t)192 * 16 * 2 * 4);
    p.WtIn = (bf16*)carve((size_t)DEPTH * DIN * D * 2);
    p.WtOut = (bf16*)carve((size_t)DEPTH * D * D * 2);
    p.WtQ = (bf16*)carve((size_t)DEPTH * 2048 * D * 2);
    p.X = (bf16*)carve((size_t)T * D * 2);
    p.H = (bf16*)carve((size_t)T * D * 2);
    p.P = (bf16*)carve((size_t)T * DIN * 2);
    p.KV = (float*)carve((size_t)2 * NB * NPOS * 4 * 4096 * 4);
    p.MIX = (bf16*)carve((size_t)T * D * 2);
    p.ST16 = (bf16*)carve((size_t)2 * NB * NPOS * 4 * 4096 * 2);
    p.Qb = (bf16*)carve((size_t)T * 2048 * 2);
    p.U8 = (unsigned char*)carve((size_t)DEPTH * PEER_N * D);
    p.V8 = (unsigned char*)carve((size_t)DEPTH * PEER_N * D);
    p.XQ = (unsigned char*)carve((size_t)T * D);
    p.SX = (float*)carve((size_t)T * 4);
    p.SU = (float*)carve((size_t)DEPTH * PEER_N * 4);
    p.SV = (float*)carve((size_t)DEPTH * PEER_N * 4);
    p.Y = (bf16*)carve((size_t)T * D * 2);
    p.X1 = (bf16*)carve((size_t)T * D * 2);
    p.GATE = (float*)carve((size_t)T * NSEL * 4);
    p.ACT = (float*)carve((size_t)T * NSEL * 4);
    p.EIDX = (int*)carve((size_t)T * NSEL * 4);
    if (off > ws_size) { fprintf(stderr, "workspace too small: need %zu have %zu\n", off, ws_size); return; }
    (void)hipMemsetAsync(p.ctl, 0, CTL_BYTES, stream);
    void* args[] = {&p};
    hipError_t e = hipLaunchCooperativeKernel((void*)mega, dim3(grid_blocks), dim3(NT), args, LDS_BYTES, stream);
    if (e != hipSuccess) fprintf(stderr, "cooperative launch failed: %s (grid %d)\n", hipGetErrorString(e), grid_blocks);
}
```

```cpp
#include <hip/hip_runtime.h>
#include <hip/hip_cooperative_groups.h>
#include <cstdio>
#include <cstdint>
namespace cg = cooperative_groups;

constexpr int D = 1024, NB = 2, SEQ = 8192, DEPTH = 4, LC = 256, HD = 64;
constexpr int TL = NB * SEQ, TC = NB * LC, T = TL + TC;
constexpr int DIN = 2304;
constexpr int C_RQ = 0, C_RK = 256, C_RV = 512, C_RG = 768, C_SU = 1024, C_SV = 1280, C_AQ = 1536, C_AK = 2048, C_AV = 2176;
constexpr int NPOS = 66;
constexpr int PEER_N = 16384, NSEL = 128;
constexpr float LN_EPS = 1e-5f;
constexpr float ALPHA = 1.681792830507429f;
constexpr int NT = 512;
constexpr int NW = 8;
constexpr int LDS_BYTES = 163840;
constexpr int MISC_OFF = LDS_BYTES - 256;

typedef unsigned short bf16;
#define LAS __attribute__((address_space(3)))

struct Params {
    const float *x, *c, *ctx, *c_ctx, *w_mod, *b_mod, *w_in, *w_out, *rdf, *rdb, *sgu_w, *sgu_b, *sink, *lnm_g, *lnm_b, *wq, *k1, *k2, *pu, *pv, *lnf_g, *lnf_b;
    float* out;
    unsigned* ctl;
    float *modp, *mod, *rope, *KV, *GATE, *ACT;
    bf16 *X, *X1, *Y;
    bf16 *WtIn, *WtOut, *WtQ, *H, *P, *MIX, *Qb, *ST16;
    unsigned char *U8, *V8, *XQ;
    float *SU, *SV, *SX;
    int *EIDX;
};

__device__ __forceinline__ unsigned f2bf(float f) { return (unsigned)__builtin_bit_cast(unsigned short, (__bf16)f); }
typedef float f32x2_pk __attribute__((ext_vector_type(2))); typedef __bf16 bf16x2_pk __attribute__((ext_vector_type(2)));
__device__ __forceinline__ unsigned pk2(float lo, float hi) { const f32x2_pk v = {lo, hi}; return __builtin_bit_cast(unsigned, __builtin_convertvector(v, bf16x2_pk)); }
__device__ __forceinline__ float bf2f(bf16 v) { return __builtin_bit_cast(float, (unsigned)v << 16); }
__device__ __forceinline__ float bflo(unsigned w) { return __builtin_bit_cast(float, w << 16); }
__device__ __forceinline__ float bfhi(unsigned w) { return __builtin_bit_cast(float, w & 0xffff0000u); }

__device__ __forceinline__ float gelu_tanh(float x) {
    const float u2 = x * (1.5957691216057308f + 0.07135481627f * x * x);
    return x * __builtin_amdgcn_rcpf(1.0f + __builtin_amdgcn_exp2f(-1.4426950408889634f * u2));
}
__device__ __forceinline__ float silu_f(float x) { return x * __builtin_amdgcn_rcpf(1.0f + __builtin_amdgcn_exp2f(-1.4426950408889634f * x)); }
__device__ __forceinline__ int chunk_row0(int b, int pos) { return pos < 2 ? TL + b * LC + pos * 128 : b * SEQ + (pos - 2) * 128; }
__device__ __forceinline__ int mod_idx(int r) { return r < TL ? r / SEQ : 2; }
__device__ __forceinline__ float log_sigmoid_f(float x) { return -log1pf(expf(-x)); }
typedef const __attribute__((address_space(4))) Params* KP;
__device__ __forceinline__ KP kparams() { KP k = (KP)__builtin_amdgcn_kernarg_segment_ptr(); asm volatile("" : "+s"(k)); return k; }
__device__ __forceinline__ float shx(float v, int m, int lane) { return __builtin_bit_cast(float, __builtin_amdgcn_ds_bpermute((lane ^ m) << 2, __builtin_bit_cast(int, v))); }
__device__ __forceinline__ int shx(int v, int m, int lane) { return __builtin_amdgcn_ds_bpermute((lane ^ m) << 2, v); }
__device__ __forceinline__ float shf(float v, int src) { return __builtin_bit_cast(float, __builtin_amdgcn_ds_bpermute(src << 2, __builtin_bit_cast(int, v))); }
__device__ __forceinline__ int shf(int v, int src) { return __builtin_amdgcn_ds_bpermute(src << 2, v); }
__device__ __forceinline__ float wave_sum(float v, int lane) {
#pragma unroll
    for (int o = 32; o >= 1; o >>= 1) v += shx(v, o, lane);
    return v;
}
__device__ __forceinline__ int lane_opaque() { unsigned m = ~0u; asm volatile("" : "+s"(m)); return (int)__builtin_amdgcn_mbcnt_hi(m, __builtin_amdgcn_mbcnt_lo(m, 0u)); }
__device__ __forceinline__ int tid_opaque(int wv) { return wv * 64 + lane_opaque(); }

namespace pg8 {
#define PG8_LAS __attribute__((address_space(3)))
typedef unsigned short bf16_t;
typedef short bf16x8 __attribute__((ext_vector_type(8)));
typedef float f32x4 __attribute__((ext_vector_type(4)));
typedef unsigned u32x4 __attribute__((ext_vector_type(4)));
constexpr int BM = 256, BK = 64, HALF = 128, HTB = HALF * BK * 2  , STAGE_BYTES = 8 * HTB, NXCD = 8, WGM = 8;

__host__ __device__ __forceinline__ int lds_byte(int r, int c) { const int st = (r >> 4) * 2 + (c >> 5), rr = r & 15, cc = c & 31, ob = rr * 64 + cc * 2; return st * 1024 + (ob ^ (((ob >> 9) & 1) << 5)); }
__host__ __device__ __forceinline__ void stage_rc(int b, int& R, int& C) { const int st = b / 1024, sb = b % 1024, swz = sb ^ (((sb >> 9) & 1) << 5); R = (st >> 1) * 16 + swz / 64; C = (st & 1) * 32 + (swz % 64) / 2; }
__host__ __device__ __forceinline__ int perm32(int rho) { const int n = rho >> 4, i = rho & 15; return 8 * (i >> 2) + 4 * n + (i & 3); }

struct Unit { int pm, pn; };
struct Gemm { const bf16_t* A; const bf16_t* Bt; int M, N, K; };

struct StaticOrder {
    int nM, nN, nwg, G, c;
    __host__ __device__ void init(int M, int N, int G_, int c_) { nM = M / BM; nN = N / BM; nwg = nM * nN; G = G_; c = c_; }
    __host__ __device__ bool next(int i, Unit& u) const {
        const long L = (long)i * G + c; if (L >= nwg) return false;
        int wgid = (int)L; { const int q = nwg / NXCD, r = nwg % NXCD, xcd = wgid % NXCD, off = wgid / NXCD; wgid = (xcd < r ? xcd * (q + 1) : r * (q + 1) + (xcd - r) * q) + off; }
        const int nig = WGM * nN, gid = wgid / nig, fm = gid * WGM, gsz = (nM - fm) < WGM ? (nM - fm) : WGM;
        u.pm = fm + ((wgid % nig) % gsz); u.pn = (wgid % nig) / gsz; return true;
    }
    __device__ __forceinline__ void a_ready(const Unit&) const {}
    __device__ __forceinline__ void done(const Unit&) const {}
};

__device__ __forceinline__ unsigned cvt_pk_bf16(float lo, float hi) { unsigned r; asm volatile("v_cvt_pk_bf16_f32 %0, %1, %2" : "=v"(r) : "v"(lo), "v"(hi)); return r; }
struct EpiInProj {
    static constexpr bool PERM = true, AFTER_DRAIN = false;
    bf16_t* P; const float* rope;
    __device__ __forceinline__ void operator()(const f32x4 (&acc)[2][2][4][2], const Unit& u, int wr, int wc, int fr, int fq) const {
        const int pn = u.pn; const bool lat = u.pm < 64; const int lane = fq * 16 + fr;
        const float sc = pn == 1 ? 0.125f : ((pn == 6 || pn == 7) ? 0.125f * 1.4426950408889634f : 1.0f);
        const float sgn = fq < 2 ? -1.0f : 1.0f;
#pragma unroll
        for (int bj = 0; bj < 2; ++bj) {
            const bool roped = lat && (pn == 0 || pn == 1 || pn == 6 || pn == 7 || (pn == 8 && bj == 0));
#pragma unroll
            for (int ai = 0; ai < 2; ++ai)
#pragma unroll
                for (int m = 0; m < 4; ++m) {
                    const int row = u.pm * BM + ai * HALF + wr * 64 + m * 16 + fr;
                    f32x4 v0 = acc[ai][bj][m][0], v1 = acc[ai][bj][m][1];
                    if (roped) {
                        const int pos = row & 8191, idx = (wc & 1) ? 128 + (pos & 63) : (pos >> 6);
                        const float2* tb = (const float2*)rope + idx * 16 + 8 * (fq & 1);
#pragma unroll
                        for (int e = 0; e < 4; ++e) {
                            const float p0 = shx(v0[e], 32, lane), p1 = shx(v1[e], 32, lane);
                            const float2 c0 = tb[e], c1 = tb[4 + e];
                            v0[e] = v0[e] * c0.x + sgn * p0 * c0.y;
                            v1[e] = v1[e] * c1.x + sgn * p1 * c1.y;
                        }
                    }
                    v0 = v0 * sc; v1 = v1 * sc;
                    u32x4 w; w.x = cvt_pk_bf16(v0[0], v0[1]); w.y = cvt_pk_bf16(v0[2], v0[3]); w.z = cvt_pk_bf16(v1[0], v1[1]); w.w = cvt_pk_bf16(v1[2], v1[3]);
                    *(u32x4*)(P + (size_t)row * 2304 + pn * BM + bj * HALF + wc * 32 + fq * 8) = w;
                    __builtin_amdgcn_sched_barrier(0);
                }
        }
    }
};
struct EpiF32 {
    static constexpr bool PERM = false, AFTER_DRAIN = false;
    float* O; int ldc;
    __device__ __forceinline__ void operator()(const f32x4 (&acc)[2][2][4][2], const Unit& u, int wr, int wc, int fr, int fq) const {
#pragma unroll
        for (int ai = 0; ai < 2; ++ai)
#pragma unroll
            for (int m = 0; m < 4; ++m) {
                float* rowp = O + (size_t)(u.pm * BM + ai * HALF + wr * 64 + m * 16 + fr) * ldc + u.pn * BM + wc * 32 + fq * 4;
#pragma unroll
                for (int bj = 0; bj < 2; ++bj)
#pragma unroll
                    for (int n = 0; n < 2; ++n) *(f32x4*)(rowp + bj * HALF + n * 16) = acc[ai][bj][m][n];
            }
    }
};


struct EpiBf16Plain {
    static constexpr bool PERM = true, AFTER_DRAIN = false;
    bf16_t* O; int ldc;
    __device__ __forceinline__ void operator()(const f32x4 (&acc)[2][2][4][2], const Unit& u, int wr, int wc, int fr, int fq) const {
#pragma unroll
        for (int ai = 0; ai < 2; ++ai)
#pragma unroll
            for (int m = 0; m < 4; ++m) {
                bf16_t* rowp = O + (size_t)(u.pm * BM + ai * HALF + wr * 64 + m * 16 + fr) * ldc + u.pn * BM + wc * 32 + fq * 8;
#pragma unroll
                for (int bj = 0; bj < 2; ++bj) {
                    const f32x4 v0 = acc[ai][bj][m][0], v1 = acc[ai][bj][m][1];
                    u32x4 w; w.x = cvt_pk_bf16(v0[0], v0[1]); w.y = cvt_pk_bf16(v0[2], v0[3]); w.z = cvt_pk_bf16(v1[0], v1[1]); w.w = cvt_pk_bf16(v1[2], v1[3]);
                    *(u32x4*)(rowp + bj * HALF) = w;
                }
            }
    }
};
template <class Epi, class Sched, bool ALIGN_EPI = false, bool SP2 = false>
__device__ __forceinline__ void gemm_phase(PG8_LAS unsigned char* lds, const Gemm g, const Sched& S, const Epi& E, int wv) {
    int tid_ = wv * 64; { unsigned m_ = ~0u; asm volatile("" : "+s"(m_)); tid_ += (int)__builtin_amdgcn_mbcnt_hi(m_, __builtin_amdgcn_mbcnt_lo(m_, 0u)); }
    const int tid = tid_, wid = __builtin_amdgcn_readfirstlane(tid >> 6), lane = tid & 63, wr = wid >> 2, wc = wid & 3, fr = lane & 15, fq = lane >> 4;
    const int K = g.K, nt = K / BK;
    unsigned voffA[2], voffB[2];
#pragma unroll
    for (int i = 0; i < 2; ++i) { int R, C; stage_rc(tid * 16 + i * 8192, R, C); const int Rb = Epi::PERM ? ((R & ~31) + perm32(R & 31)) : R;
        voffA[i] = (unsigned)(R * K + C) * 2u; voffB[i] = (unsigned)(Rb * K + C) * 2u; }
    const size_t kstep = (size_t)(BK * 2);
    const size_t hstep = (size_t)HALF * K * 2;
    const size_t tstep = 2 * hstep;
    const unsigned ldsw = (unsigned)wid * 1024u;
    const int aoff = lds_byte(wr * 64 + fr, fq * 8), boff = lds_byte(wc * 32 + fr, fq * 8);
#define PG8_SA(b, h) (((b) * 2 + (h)) * HTB)
#define PG8_SB(b, h) ((4 + (b) * 2 + (h)) * HTB)
#define PG8_STAGE(bufoff, gbase, voff) do { _Pragma("unroll") for (int _i = 0; _i < 2; ++_i) \
        __builtin_amdgcn_global_load_lds((const unsigned*)((const char*)(gbase) + (voff)[_i]), (PG8_LAS unsigned*)(lds + (bufoff) + ldsw + _i * 8192), 16, 0, 0); } while (0)
#define PG8_LDA(dst, b, h) do { _Pragma("unroll") for (int m = 0; m < 4; ++m) _Pragma("unroll") for (int k = 0; k < 2; ++k) dst[m][k] = *(const PG8_LAS bf16x8*)(lds + PG8_SA(b, h) + aoff + m * 2048 + k * 1024); } while (0)
#define PG8_LDB(dst, b, h) do { _Pragma("unroll") for (int n = 0; n < 2; ++n) _Pragma("unroll") for (int k = 0; k < 2; ++k) dst[n][k] = *(const PG8_LAS bf16x8*)(lds + PG8_SB(b, h) + boff + n * 2048 + k * 1024); } while (0)
#define PG8_MMA(ai, bj, At, Bt) do { __builtin_amdgcn_s_setprio(1); _Pragma("unroll") for (int m = 0; m < 4; ++m) _Pragma("unroll") for (int n = 0; n < 2; ++n) _Pragma("unroll") for (int k = 0; k < 2; ++k) \
        acc[ai][bj][m][n] = __builtin_amdgcn_mfma_f32_16x16x32_bf16(Bt[n][k], At[m][k], acc[ai][bj][m][n], 0, 0, 0); __builtin_amdgcn_s_setprio(0); } while (0)
#define PG8_WAIT_V(n) asm volatile("s_waitcnt vmcnt(" #n ")" ::: "memory")
#define PG8_WAIT_L(n) asm volatile("s_waitcnt lgkmcnt(" #n ")" ::: "memory")
#define PG8_BAR __builtin_amdgcn_s_barrier()
#define PG8_SCHED __builtin_amdgcn_sched_barrier(0)
    Unit cur, nxt; int ui = 0;
    if (!S.next(0, cur)) return;
    f32x4 acc[2][2][4][2];
#pragma unroll
    for (int a = 0; a < 2; ++a)
#pragma unroll
        for (int b = 0; b < 2; ++b)
#pragma unroll
            for (int m = 0; m < 4; ++m)
#pragma unroll
                for (int n = 0; n < 2; ++n) acc[a][b][m][n] = (f32x4){0.f, 0.f, 0.f, 0.f};
    bf16x8 At[4][2], B0[2][2], B1[2][2];
    const char* cA = (const char*)g.A + (size_t)cur.pm * tstep; const char* cB = (const char*)g.Bt + (size_t)cur.pn * tstep;
    S.a_ready(cur);
    if constexpr (SP2) {
        PG8_STAGE(PG8_SB(0, 0), cB, voffB); PG8_STAGE(PG8_SB(0, 1), cB + hstep, voffB); PG8_STAGE(PG8_SA(0, 0), cA, voffA); PG8_STAGE(PG8_SA(0, 1), cA + hstep, voffA);
        if (wr == 1) PG8_BAR;
        PG8_WAIT_V(2); PG8_BAR;
        PG8_STAGE(PG8_SB(1, 0), cB + kstep, voffB); PG8_STAGE(PG8_SA(1, 0), cA + kstep, voffA); PG8_STAGE(PG8_SB(1, 1), cB + hstep + kstep, voffB);
        PG8_WAIT_V(6); PG8_BAR;
    } else {
        PG8_STAGE(PG8_SB(0, 0), cB, voffB); PG8_STAGE(PG8_SA(0, 0), cA, voffA); PG8_STAGE(PG8_SB(0, 1), cB + hstep, voffB); PG8_STAGE(PG8_SA(0, 1), cA + hstep, voffA);
        if (wr == 1) PG8_BAR;
        PG8_WAIT_V(4); PG8_BAR;
        PG8_STAGE(PG8_SB(1, 0), cB + kstep, voffB); PG8_STAGE(PG8_SA(1, 0), cA + kstep, voffA); PG8_STAGE(PG8_SB(1, 1), cB + hstep + kstep, voffB);
        PG8_WAIT_V(6); PG8_BAR;
    }
    for (;;) {
        const bool has_next = S.next(ui + 1, nxt);
        const char* nA = has_next ? (const char*)g.A + (size_t)nxt.pm * tstep : cA; const char* nB = has_next ? (const char*)g.Bt + (size_t)nxt.pn * tstep : cB;
        for (int t = 0; t < nt; t += 2) {
            const bool last = (t == nt - 2);
            const char* a1 = cA + (size_t)(t + 1) * kstep;
            const char* a2 = last ? nA : cA + (size_t)(t + 2) * kstep; const char* b2 = last ? nB : cB + (size_t)(t + 2) * kstep;
            const char* a3 = a2 + kstep; const char* b3 = b2 + kstep;
            if (last && has_next) S.a_ready(nxt);
            if constexpr (SP2) {
            PG8_LDB(B0, 0, 0); PG8_LDB(B1, 0, 1); PG8_SCHED; PG8_LDA(At, 0, 0); PG8_STAGE(PG8_SA(1, 1), a1 + hstep, voffA);
            PG8_WAIT_V(8); PG8_WAIT_L(0); PG8_BAR; PG8_MMA(0, 0, At, B0); PG8_MMA(0, 1, At, B1); PG8_BAR; PG8_SCHED;
            PG8_LDA(At, 0, 1); PG8_STAGE(PG8_SB(0, 0), b2, voffB); PG8_STAGE(PG8_SB(0, 1), b2 + hstep, voffB); PG8_STAGE(PG8_SA(0, 0), a2, voffA);
            PG8_WAIT_V(8); PG8_WAIT_L(0); PG8_BAR; PG8_MMA(1, 0, At, B0); PG8_MMA(1, 1, At, B1); PG8_BAR; PG8_SCHED;
            PG8_LDB(B0, 1, 0); PG8_LDB(B1, 1, 1); PG8_SCHED; PG8_LDA(At, 1, 0); PG8_STAGE(PG8_SA(0, 1), a2 + hstep, voffA);
            PG8_WAIT_V(8); PG8_WAIT_L(0); PG8_BAR; PG8_MMA(0, 0, At, B0); PG8_MMA(0, 1, At, B1); PG8_BAR; PG8_SCHED;
            PG8_LDA(At, 1, 1); PG8_STAGE(PG8_SB(1, 0), b3, voffB); PG8_STAGE(PG8_SB(1, 1), b3 + hstep, voffB); PG8_STAGE(PG8_SA(1, 0), a3, voffA);
            PG8_WAIT_V(8); PG8_WAIT_L(0); PG8_BAR; PG8_MMA(1, 0, At, B0); PG8_MMA(1, 1, At, B1); PG8_BAR; PG8_SCHED;
            } else {
            PG8_LDB(B0, 0, 0); PG8_SCHED; PG8_LDA(At, 0, 0); PG8_STAGE(PG8_SA(1, 1), a1 + hstep, voffA);
            PG8_WAIT_L(8); PG8_BAR; PG8_WAIT_L(0); PG8_MMA(0, 0, At, B0); PG8_BAR; PG8_SCHED;
            PG8_LDB(B1, 0, 1); PG8_STAGE(PG8_SB(0, 0), b2, voffB);
            PG8_BAR; PG8_WAIT_L(0); PG8_MMA(0, 1, At, B1); PG8_BAR;
            PG8_LDA(At, 0, 1); PG8_STAGE(PG8_SA(0, 0), a2, voffA);
            PG8_BAR; PG8_WAIT_L(0); PG8_MMA(1, 0, At, B0); PG8_BAR; PG8_SCHED;
            PG8_STAGE(PG8_SB(0, 1), b2 + hstep, voffB);
            PG8_WAIT_V(6); PG8_BAR; PG8_MMA(1, 1, At, B1); PG8_BAR;
            PG8_LDB(B0, 1, 0); PG8_SCHED; PG8_LDA(At, 1, 0); PG8_STAGE(PG8_SA(0, 1), a2 + hstep, voffA);
            PG8_WAIT_L(8); PG8_BAR; PG8_WAIT_L(0); PG8_MMA(0, 0, At, B0); PG8_BAR; PG8_SCHED;
            PG8_LDB(B1, 1, 1); PG8_STAGE(PG8_SB(1, 0), b3, voffB);
            PG8_BAR; PG8_WAIT_L(0); PG8_MMA(0, 1, At, B1); PG8_BAR;
            PG8_LDA(At, 1, 1); PG8_STAGE(PG8_SA(1, 0), a3, voffA);
            PG8_BAR; PG8_WAIT_L(0); PG8_MMA(1, 0, At, B0); PG8_BAR; PG8_SCHED;
            PG8_STAGE(PG8_SB(1, 1), b3 + hstep, voffB);
            PG8_WAIT_V(6); PG8_BAR; PG8_MMA(1, 1, At, B1); PG8_BAR;
            }
        }
        if constexpr (ALIGN_EPI) { if (wr == 0) PG8_BAR; }
        if constexpr (!Epi::AFTER_DRAIN) { E(acc, cur, wr, wc, fr, fq); S.done(cur); }
        if (!has_next) break;
#pragma unroll
        for (int a = 0; a < 2; ++a)
#pragma unroll
            for (int b = 0; b < 2; ++b)
#pragma unroll
                for (int m = 0; m < 4; ++m)
#pragma unroll
                    for (int n = 0; n < 2; ++n) acc[a][b][m][n] = (f32x4){0.f, 0.f, 0.f, 0.f};
        cur = nxt; cA = nA; cB = nB; ++ui;
        if constexpr (ALIGN_EPI) { if (wr == 1) PG8_BAR; }
    }
    PG8_WAIT_V(0);
    if constexpr (!ALIGN_EPI) { if (wr == 0) PG8_BAR; }
    PG8_BAR;
    if constexpr (Epi::AFTER_DRAIN) { E.fused(acc, cur, wr, wc, fr, fq, lds, wid, lane); S.done(cur); }
#undef PG8_SA
#undef PG8_SB
#undef PG8_STAGE
#undef PG8_LDA
#undef PG8_LDB
#undef PG8_MMA
#undef PG8_WAIT_V
#undef PG8_WAIT_L
#undef PG8_BAR
#undef PG8_SCHED
}
}
constexpr int CW_BAR = 4096;
constexpr size_t CTL_BYTES = 65536;
#define XB_TMO      128
#define XB_XCNT(j)  (256  + 64 * (j))
#define XB_XSUB(j)  (1280 + 64 * (j))
#define XB_XGEN(j)  (2304 + 64 * (j))
#define XB_TOP      3328
#define XB_TOPGEN   3392
#define XCD_BAR_WORDS 3456
#define XB_SPIN_CAP (1u << 18)

__device__ __forceinline__ unsigned xb_ld(unsigned* p)              { return __hip_atomic_load(p, __ATOMIC_RELAXED, __HIP_MEMORY_SCOPE_AGENT); }
__device__ __forceinline__ unsigned xb_add(unsigned* p, unsigned v) { return __hip_atomic_fetch_add(p, v, __ATOMIC_RELAXED, __HIP_MEMORY_SCOPE_AGENT); }
__device__ __forceinline__ unsigned xb_xcc_id() { return (unsigned)__builtin_amdgcn_s_getreg((3 << 11) | 20) & 0xFu; }
#define XB_SPIN(cond, bar) do { unsigned _sp = 0; while (cond) { __builtin_amdgcn_s_sleep(1); \
    if ((++_sp & 255u) == 0u) { if (xb_ld(&(bar)[XB_TMO])) break; if (_sp > XB_SPIN_CAP) { atomicAdd(&(bar)[XB_TMO], 1u); break; } } } } while (0)

struct XcdBarrier {
    unsigned* bar; unsigned x; bool lead;
    volatile LAS unsigned* st;
};

__device__ __forceinline__ XcdBarrier xcd_barrier_post(unsigned* bar, volatile LAS unsigned* st, bool lead) {
    XcdBarrier b; b.bar = bar; b.x = xb_xcc_id(); b.st = st; b.lead = lead;
    if (b.lead) (void)xb_add(&bar[XB_XCNT(b.x)], 1u);
    return b;
}
__device__ __forceinline__ void xcd_barrier_complete(unsigned* bar, unsigned x, unsigned& nloc, unsigned& nx) {
    const unsigned G = gridDim.x * gridDim.y * gridDim.z;
    unsigned sum, cnt, mine, sp = 0u;
    for (;;) {
        sum = 0u; cnt = 0u; mine = 0u;
#pragma unroll
        for (unsigned j = 0; j < 16; ++j) { const unsigned c = xb_ld(&bar[XB_XCNT(j)]); sum += c; cnt += (c > 0u) ? 1u : 0u; mine = (j == x) ? c : mine; }
        if (sum == G) break;
        __builtin_amdgcn_s_sleep(1);
        if ((++sp & 255u) == 0u) { if (xb_ld(&bar[XB_TMO])) break; if (sp > XB_SPIN_CAP) { atomicAdd(&bar[XB_TMO], 1u); break; } }
    }
    nloc = mine > 0u ? mine : 1u; nx = cnt > 0u ? cnt : 1u;
}

__device__ __forceinline__ void xcd_barrier(const XcdBarrier& b) {
    asm volatile("s_waitcnt vmcnt(0)" ::: "memory");
    __syncthreads();
    if (b.lead) {
        unsigned* bar = b.bar;
        __builtin_amdgcn_s_waitcnt(0);
        unsigned nloc = b.st[0], nx = b.st[1];
        if (nloc == 0u) { xcd_barrier_complete(bar, b.x, nloc, nx); b.st[0] = nloc; b.st[1] = nx; }
        const unsigned old = xb_add(&bar[XB_XSUB(b.x)], 1u);
        const unsigned gen = old / nloc;
        if (old + 1u == (gen + 1u) * nloc) {
            __builtin_amdgcn_fence(__ATOMIC_RELEASE, "agent");
            asm volatile("s_waitcnt vmcnt(0)" ::: "memory");
            const unsigned og = xb_add(&bar[XB_TOP], 1u);
            const unsigned tg = og / nx;
            if (og + 1u == (tg + 1u) * nx) xb_add(&bar[XB_TOPGEN], 1u);
            else XB_SPIN(xb_ld(&bar[XB_TOPGEN]) == tg, bar);
            __builtin_amdgcn_fence(__ATOMIC_ACQUIRE, "agent");
            xb_add(&bar[XB_XGEN(b.x)], 1u);
            asm volatile("s_waitcnt vmcnt(0)" ::: "memory");
        } else {
            XB_SPIN(xb_ld(&bar[XB_XGEN(b.x)]) == gen, bar);
            __builtin_amdgcn_fence(__ATOMIC_ACQUIRE, "agent");
            asm volatile("s_waitcnt vmcnt(0)" ::: "memory");
        }
    }
    __syncthreads();
}


__device__ __forceinline__ void phase_mod1(KP p, int wv, int bid, int nb, float* lds) {
    float* red = lds;
    const int t = tid_opaque(wv), cg4 = t & 63, kg = t >> 6;
    for (int u = bid; u < DEPTH * 24 * 16; u += nb) {
        const int ks = u & 15, nblk = (u >> 4) % 24, l = u / (16 * 24);
        const int n = nblk * 256 + cg4 * 4;
        float4 wr[8];
#pragma unroll
        for (int kk = 0; kk < 8; ++kk) wr[kk] = *(const float4*)(p->w_mod + ((size_t)l * D + ks * 64 + kg * 8 + kk) * 6144 + n);
        float a[3][4];
#pragma unroll
        for (int v = 0; v < 3; ++v)
#pragma unroll
            for (int j = 0; j < 4; ++j) a[v][j] = 0.f;
#pragma unroll
        for (int kk = 0; kk < 8; ++kk) {
            const int k = ks * 64 + kg * 8 + kk;
            const float s0 = silu_f(p->c[k]), s1 = silu_f(p->c[D + k]), s2 = silu_f(p->c_ctx[k]);
            a[0][0] += s0 * wr[kk].x; a[0][1] += s0 * wr[kk].y; a[0][2] += s0 * wr[kk].z; a[0][3] += s0 * wr[kk].w;
            a[1][0] += s1 * wr[kk].x; a[1][1] += s1 * wr[kk].y; a[1][2] += s1 * wr[kk].z; a[1][3] += s1 * wr[kk].w;
            a[2][0] += s2 * wr[kk].x; a[2][1] += s2 * wr[kk].y; a[2][2] += s2 * wr[kk].z; a[2][3] += s2 * wr[kk].w;
        }
        __syncthreads();
#pragma unroll
        for (int v = 0; v < 3; ++v) *(float4*)(red + (v * 8 + kg) * 256 + cg4 * 4) = make_float4(a[v][0], a[v][1], a[v][2], a[v][3]);
        __syncthreads();
        for (int o = t; o < 768; o += NT) {
            const int v = o >> 8, col = o & 255;
            float sm = 0.f;
#pragma unroll
            for (int g = 0; g < 8; ++g) sm += red[(v * 8 + g) * 256 + col];
            p->modp[(((size_t)ks * DEPTH + l) * 3 + v) * 6144 + nblk * 256 + col] = sm;
        }
    }
    __syncthreads();
}
__device__ __forceinline__ void phase_mod2(KP p, int wv, int bid, int nb) {
    for (int i = bid * NT + tid_opaque(wv); i < DEPTH * 3 * 6144; i += nb * NT) {
        const int n = i % 6144, l = i / (3 * 6144);
        float s = p->b_mod[l * 6144 + n];
        for (int ks = 0; ks < 16; ++ks) s += p->modp[(size_t)ks * DEPTH * 3 * 6144 + i];
        p->mod[i] = s;
    }
}
__device__ __forceinline__ void transpose_item(const float* W, int K, int N, bf16* WT, float* scr, int item, int lane) {
    const int nblk = N / 64, kb = item / nblk, nbk = item % nblk, k0 = 64 * kb, n0 = 64 * nbk;
    const int r4 = lane >> 4, c4 = lane & 15;
#pragma unroll 8
    for (int i = 0; i < 16; ++i) { const int kk = 4 * i + r4; const float4 q = *(const float4*)(W + (size_t)(k0 + kk) * N + n0 + c4 * 4);
        float* d = scr + kk * 65 + c4 * 4; d[0] = q.x; d[1] = q.y; d[2] = q.z; d[3] = q.w; }
    __builtin_amdgcn_wave_barrier();
    const int c = lane & 7;
#pragma unroll
    for (int j = 0; j < 8; ++j) { const int n = (lane >> 3) + 8 * j; const float* sp = scr + (8 * c) * 65 + n;
        uint4 o; o.x = pk2(sp[0 * 65], sp[1 * 65]); o.y = pk2(sp[2 * 65], sp[3 * 65]); o.z = pk2(sp[4 * 65], sp[5 * 65]); o.w = pk2(sp[6 * 65], sp[7 * 65]);
        *(uint4*)(WT + (size_t)(n0 + n) * K + k0 + 8 * c) = o; }
    __builtin_amdgcn_wave_barrier();
}
__device__ __forceinline__ void phase_tables(KP p, int wv, int l, int vb, int nvb) {
    {
        const int lane_ = tid_opaque(wv) & 63, w_ = tid_opaque(wv) >> 6;
        for (int row0 = (vb * NW + w_) * 4; row0 < 2 * PEER_N; row0 += nvb * NW * 4) {
            float v[4][16];
#pragma unroll
            for (int q = 0; q < 4; ++q) {
                const int row = row0 + q; const bool isv = row >= PEER_N; const int rr = l * PEER_N + (isv ? row - PEER_N : row);
                const float* src_ = (isv ? p->pv : p->pu) + (size_t)rr * D;
#pragma unroll
                for (int i = 0; i < 4; ++i) { typedef float f4v_ __attribute__((ext_vector_type(4))); const f4v_ q4 = __builtin_nontemporal_load((const f4v_*)(src_ + i * 256 + lane_ * 4)); v[q][i * 4 + 0] = q4[0]; v[q][i * 4 + 1] = q4[1]; v[q][i * 4 + 2] = q4[2]; v[q][i * 4 + 3] = q4[3]; }
            }
#pragma unroll
            for (int q = 0; q < 4; ++q) {
                const int row = row0 + q; const bool isv = row >= PEER_N; const int rr = l * PEER_N + (isv ? row - PEER_N : row);
                float m = 0.f;
#pragma unroll
                for (int i = 0; i < 16; ++i) m = fmaxf(m, fabsf(v[q][i]));
#pragma unroll
                for (int o = 32; o >= 1; o >>= 1) m = fmaxf(m, shx(m, o, lane_));
                unsigned* dst = (unsigned*)((isv ? p->V8 : p->U8) + (size_t)rr * D);
                if (!isv) {
                    const float inv = m > 0.f ? 127.0f / m : 0.f;
#pragma unroll
                    for (int i = 0; i < 4; ++i) {
                        const int q0 = (int)rintf(v[q][i * 4 + 0] * inv), q1 = (int)rintf(v[q][i * 4 + 1] * inv), q2 = (int)rintf(v[q][i * 4 + 2] * inv), q3 = (int)rintf(v[q][i * 4 + 3] * inv);
                        dst[i * 64 + lane_] = (unsigned)(q0 & 0xff) | ((unsigned)(q1 & 0xff) << 8) | ((unsigned)(q2 & 0xff) << 16) | ((unsigned)(q3 & 0xff) << 24);
                    }
                    if (lane_ == 0) p->SU[rr] = m * (1.0f / 127.0f);
                } else {
                    const float inv = m > 0.f ? 240.0f / m : 0.f;
#pragma unroll
                    for (int i = 0; i < 4; ++i) {
                        int pk = __builtin_amdgcn_cvt_pk_fp8_f32(v[q][i * 4 + 0] * inv, v[q][i * 4 + 1] * inv, 0, false);
                        pk = __builtin_amdgcn_cvt_pk_fp8_f32(v[q][i * 4 + 2] * inv, v[q][i * 4 + 3] * inv, pk, true);
                        dst[i * 64 + lane_] = (unsigned)pk;
                    }
                    if (lane_ == 0) p->SV[rr] = m * (1.0f / 240.0f);
                }
            }
        }
    }
}

__device__ __forceinline__ void phase_weights(KP p, int wv, int bid, int nb, float* lds) {
    const int lane = tid_opaque(wv) & 63, w = tid_opaque(wv) >> 6;
    float* scr = lds + w * (64 * 65 + 32);
    constexpr int I_IN = 16 * 36, I_OUT = 16 * 16, I_Q = 16 * 32;
    constexpr int NITEMS = DEPTH * (I_IN + I_OUT + I_Q);
    for (int it = bid * NW + w; it < NITEMS; it += nb * NW) {
        int r = it;
        if (r < DEPTH * I_IN) { const int l = r / I_IN; transpose_item(p->w_in + (size_t)l * D * DIN, D, DIN, p->WtIn + (size_t)l * DIN * D, scr, r % I_IN, lane); continue; } r -= DEPTH * I_IN;
        if (r < DEPTH * I_OUT) { const int l = r / I_OUT; transpose_item(p->w_out + (size_t)l * D * D, D, D, p->WtOut + (size_t)l * D * D, scr, r % I_OUT, lane); continue; } r -= DEPTH * I_OUT;
        { const int l = r / I_Q; transpose_item(p->wq + (size_t)l * D * 2048, D, 2048, p->WtQ + (size_t)l * 2048 * D, scr, r % I_Q, lane); }
    }
    for (int i = bid * NT + tid_opaque(wv); i < 192 * 16; i += nb * NT) {
        const int idx = i >> 4, f = i & 15;
        const float inv = powf(10000.0f, -(float)f / 16.0f);
        const float ang = (float)(idx < 128 ? idx : idx - 128) * inv;
        p->rope[2 * i] = cosf(ang); p->rope[2 * i + 1] = sinf(ang);
    }
}

__device__ __forceinline__ void row_load(const float* src, float (&v)[16], int lane) {
#pragma unroll
    for (int i = 0; i < 4; ++i) { const float4 q = *(const float4*)(src + i * 256 + lane * 4); v[i * 4 + 0] = q.x; v[i * 4 + 1] = q.y; v[i * 4 + 2] = q.z; v[i * 4 + 3] = q.w; }
}
__device__ __forceinline__ void row_store(float* dst, const float (&v)[16], int lane) {
#pragma unroll
    for (int i = 0; i < 4; ++i) *(float4*)(dst + i * 256 + lane * 4) = make_float4(v[i * 4 + 0], v[i * 4 + 1], v[i * 4 + 2], v[i * 4 + 3]);
}
__device__ __forceinline__ void row_store_bf(bf16* dst, const float (&v)[16], int lane) {
#pragma unroll
    for (int i = 0; i < 4; ++i) *(uint2*)(dst + i * 256 + lane * 4) = make_uint2(pk2(v[i * 4 + 0], v[i * 4 + 1]), pk2(v[i * 4 + 2], v[i * 4 + 3]));
}
__device__ __forceinline__ void row_load_bf(const bf16* src, float (&v)[16], int lane) {
#pragma unroll
    for (int i = 0; i < 4; ++i) { const uint2 q = *(const uint2*)(src + i * 256 + lane * 4); v[i * 4 + 0] = bflo(q.x); v[i * 4 + 1] = bfhi(q.x); v[i * 4 + 2] = bflo(q.y); v[i * 4 + 3] = bfhi(q.y); }
}
__device__ __forceinline__ void row_ln(float (&v)[16], int lane) {
    float s = 0.f;
#pragma unroll
    for (int i = 0; i < 16; ++i) s += v[i];
    const float mu = wave_sum(s, lane) * (1.0f / D);
    float q = 0.f;
#pragma unroll
    for (int i = 0; i < 16; ++i) { v[i] -= mu; q += v[i] * v[i]; }
    const float rstd = rsqrtf(wave_sum(q, lane) * (1.0f / D) + LN_EPS);
#pragma unroll
    for (int i = 0; i < 16; ++i) v[i] *= rstd;
}
__device__ __forceinline__ const float* x_row(KP p, int l, int r) {
    if (l == 0) return r < TL ? p->x + (size_t)r * D : p->ctx + (size_t)(r - TL) * D;
    return nullptr;
}

__device__ __forceinline__ void phase_lnmod(KP p, int wv, int l, int bid, int nb) {
    const int lane = tid_opaque(wv) & 63, w = tid_opaque(wv) >> 6;
    for (int r = bid * NW + w; r < T; r += nb * NW) {
        float v[16], sh[16], sc[16];
        row_load(x_row(p, l, r), v, lane);
        const float* m = p->mod + ((size_t)l * 3 + mod_idx(r)) * 6144;
        row_load(m, sh, lane); row_load(m + 1024, sc, lane);
        row_ln(v, lane);
#pragma unroll
        for (int i = 0; i < 16; ++i) v[i] = v[i] * (1.0f + sc[i]) + sh[i];
        row_store_bf(p->H + (size_t)r * D, v, lane);
    }
}

typedef short bf16x8_t __attribute__((ext_vector_type(8)));
typedef short bf16x4_t __attribute__((ext_vector_type(4)));
typedef float f32x4_t __attribute__((ext_vector_type(4)));
#define MFMA16(a, b, c) __builtin_amdgcn_mfma_f32_16x16x32_bf16((a), (b), (c), 0, 0, 0)
constexpr int KROW = 72;
constexpr int TROW = 136;
__device__ __forceinline__ bf16x8_t lds_frag16(const bf16* p) { return *(const bf16x8_t*)p; }
__device__ __forceinline__ bf16x8_t lds_frag8x2(const bf16* p0, const bf16* p1) {
    const bf16x4_t a = *(const bf16x4_t*)p0, b = *(const bf16x4_t*)p1;
    bf16x8_t o; o[0] = a[0]; o[1] = a[1]; o[2] = a[2]; o[3] = a[3]; o[4] = b[0]; o[5] = b[1]; o[6] = b[2]; o[7] = b[3]; return o;
}
__device__ __forceinline__ bf16x8_t pack_p(const f32x4_t& x, const f32x4_t& y) {
    uint4 w; w.x = pk2(x[0], x[1]); w.y = pk2(x[2], x[3]); w.z = pk2(y[0], y[1]); w.w = pk2(y[2], y[3]);
    return __builtin_bit_cast(bf16x8_t, w);
}
__device__ __forceinline__ void st_tr8(bf16* dst_col0, int stride, const uint4& v) {
    dst_col0[0 * stride] = (bf16)(v.x & 0xffffu); dst_col0[1 * stride] = (bf16)(v.x >> 16);
    dst_col0[2 * stride] = (bf16)(v.y & 0xffffu); dst_col0[3 * stride] = (bf16)(v.y >> 16);
    dst_col0[4 * stride] = (bf16)(v.z & 0xffffu); dst_col0[5 * stride] = (bf16)(v.z >> 16);
    dst_col0[6 * stride] = (bf16)(v.w & 0xffffu); dst_col0[7 * stride] = (bf16)(v.w >> 16);
}

constexpr int ATT_BUF = 128 * KROW + 64 * TROW;
__device__ __forceinline__ void att_unit(KP p, int wv, int l, int u, bf16* lds) {
    const int t = tid_opaque(wv), lane = t & 63, w = t >> 6, r = lane & 15, g = lane >> 4;
    const bool lat = u < 256;
    int b, n, hkv;
    if (lat) { hkv = u & 1; n = (u >> 1) & 63; b = u >> 7; } else { const int v = u - 256; hkv = v & 1; n = (v >> 1) & 1; b = v >> 2; }
    const int hq = hkv * 4 + (w >> 1), qh = w & 1;
    const int qrow0 = (lat ? b * SEQ + n * 128 : TL + b * LC + n * 128) + qh * 64;
    int kb_lo = 0, kb_hi = -1;
    if (lat) { kb_lo = n > 0 ? n - 1 : 0; kb_hi = n < 63 ? n + 1 : 63; }
    const int nloc = kb_hi - kb_lo + 1, nblk = nloc + 2;
    const bf16* P = p->P;
    bf16x8_t qf[4][2];
#pragma unroll
    for (int qt = 0; qt < 4; ++qt)
#pragma unroll
        for (int ks = 0; ks < 2; ++ks) qf[qt][ks] = *(const bf16x8_t*)(P + (size_t)(qrow0 + qt * 16 + r) * DIN + C_AQ + hq * 64 + ks * 32 + g * 8);
    const float LOG2E = 1.4426950408889634f;
    const float sink2 = p->sink[l * 8 + hq] * LOG2E;
    float m[4], lsum[4];
    f32x4_t ot[4][4];
#pragma unroll
    for (int qt = 0; qt < 4; ++qt) { m[qt] = sink2; lsum[qt] = g == 0 ? 1.0f : 0.0f; }
#pragma unroll
    for (int dt = 0; dt < 4; ++dt)
#pragma unroll
        for (int qt = 0; qt < 4; ++qt) ot[dt][qt] = (f32x4_t){0.f, 0.f, 0.f, 0.f};
    uint4 kreg0, kreg1, vreg0, vreg1;
#define ATT_ROW0(bi) ((bi) < nloc ? b * SEQ + (kb_lo + (bi)) * 128 : TL + b * LC + ((bi) - nloc) * 128)
    const int key0 = t >> 3, key1 = key0 + 64, c8 = t & 7;
#define ATT_ISSUE(bi) do { const bf16* src_ = P + (size_t)(ATT_ROW0(bi) + key0) * DIN + hkv * 64 + c8 * 8; \
        kreg0 = *(const uint4*)(src_ + C_AK); vreg0 = *(const uint4*)(src_ + C_AV); \
        kreg1 = *(const uint4*)(src_ + 64 * DIN + C_AK); vreg1 = *(const uint4*)(src_ + 64 * DIN + C_AV); } while (0)
#define ATT_STAGE(buf) do { \
        *(uint4*)((buf) + key0 * KROW + c8 * 8) = kreg0; *(uint4*)((buf) + key1 * KROW + c8 * 8) = kreg1; \
        st_tr8((buf) + 128 * KROW + (c8 * 8) * TROW + key0, TROW, vreg0); st_tr8((buf) + 128 * KROW + (c8 * 8) * TROW + key1, TROW, vreg1); } while (0)
    __syncthreads();
    ATT_ISSUE(0);
    for (int bi = 0; bi < nblk; ++bi) {
        bf16* buf = lds + (bi & 1) * ATT_BUF;
        ATT_STAGE(buf);
        __syncthreads();
        if (bi + 1 < nblk) ATT_ISSUE(bi + 1);
        const bf16* Ks = buf; const bf16* Vt = buf + 128 * KROW;
        const int band = (bi < nloc) ? (kb_lo + bi) - n : 0;
#pragma unroll 1
        for (int sub = 0; sub < 2; ++sub) {
            if ((band < 0 && sub == 0 && qh == 1) || (band > 0 && sub == 1 && qh == 0)) continue;
            f32x4_t st[4][4];
#pragma unroll
            for (int kt = 0; kt < 4; ++kt) {
#pragma unroll
                for (int qt = 0; qt < 4; ++qt) st[kt][qt] = (f32x4_t){0.f, 0.f, 0.f, 0.f};
#pragma unroll
                for (int ks = 0; ks < 2; ++ks) {
                    const bf16x8_t a = lds_frag16(Ks + (sub * 64 + kt * 16 + r) * KROW + ks * 32 + g * 8);
#pragma unroll
                    for (int qt = 0; qt < 4; ++qt) st[kt][qt] = MFMA16(a, qf[qt][ks], st[kt][qt]);
                }
            }
            if (band != 0) {
#pragma unroll
                for (int qt = 0; qt < 4; ++qt) {
                    const int il = qh * 64 + qt * 16 + r;
#pragma unroll
                    for (int kt = 0; kt < 4; ++kt)
#pragma unroll
                        for (int i = 0; i < 4; ++i) {
                            const int jl = sub * 64 + kt * 16 + g * 4 + i;
                            if (band < 0 ? jl < il : jl > il) st[kt][qt][i] = -INFINITY;
                        }
                }
            }
            float mnew[4]; bool grow = false;
#pragma unroll
            for (int qt = 0; qt < 4; ++qt) {
                float mloc = fmaxf(fmaxf(fmaxf(st[0][qt][0], st[0][qt][1]), fmaxf(st[0][qt][2], st[0][qt][3])), fmaxf(fmaxf(st[1][qt][0], st[1][qt][1]), fmaxf(st[1][qt][2], st[1][qt][3])));
                mloc = fmaxf(mloc, fmaxf(fmaxf(fmaxf(st[2][qt][0], st[2][qt][1]), fmaxf(st[2][qt][2], st[2][qt][3])), fmaxf(fmaxf(st[3][qt][0], st[3][qt][1]), fmaxf(st[3][qt][2], st[3][qt][3]))));
                mloc = fmaxf(mloc, shx(mloc, 16, lane)); mloc = fmaxf(mloc, shx(mloc, 32, lane));
                mnew[qt] = fmaxf(m[qt], mloc);
                grow = grow || (mnew[qt] > m[qt]);
            }
            if (__any(grow)) {
#pragma unroll
                for (int qt = 0; qt < 4; ++qt) {
                    const float alpha = __builtin_amdgcn_exp2f(m[qt] - mnew[qt]);
                    m[qt] = mnew[qt]; lsum[qt] *= alpha;
#pragma unroll
                    for (int dt = 0; dt < 4; ++dt) ot[dt][qt] = ot[dt][qt] * alpha;
                }
            }
#pragma unroll
            for (int qt = 0; qt < 4; ++qt) {
                float ps = 0.f;
#pragma unroll
                for (int kt = 0; kt < 4; ++kt)
#pragma unroll
                    for (int i = 0; i < 4; ++i) { const float e = __builtin_amdgcn_exp2f(st[kt][qt][i] - m[qt]); st[kt][qt][i] = e; ps += e; }
                lsum[qt] += ps;
            }
#pragma unroll
            for (int kp = 0; kp < 2; ++kp) {
                bf16x8_t pf[4];
#pragma unroll
                for (int qt = 0; qt < 4; ++qt) pf[qt] = pack_p(st[2 * kp][qt], st[2 * kp + 1][qt]);
#pragma unroll
                for (int dt = 0; dt < 4; ++dt) {
                    const bf16* vrow = Vt + (dt * 16 + r) * TROW + sub * 64 + g * 4;
                    const bf16x8_t a = lds_frag8x2(vrow + (2 * kp) * 16, vrow + (2 * kp + 1) * 16);
#pragma unroll
                    for (int qt = 0; qt < 4; ++qt) ot[dt][qt] = MFMA16(a, pf[qt], ot[dt][qt]);
                }
            }
        }
    }
#pragma unroll
    for (int qt = 0; qt < 4; ++qt) {
        float ls = lsum[qt]; ls += shx(ls, 16, lane); ls += shx(ls, 32, lane);
        const float inv = 1.0f / ls;
        bf16* orow = p->MIX + (size_t)(qrow0 + qt * 16 + r) * D + 512 + hq * 64 + g * 4;
#pragma unroll
        for (int dt = 0; dt < 4; ++dt) {
            const f32x4_t o = ot[dt][qt] * inv;
            *(uint2*)(orow + dt * 16) = make_uint2(pk2(o[0], o[1]), pk2(o[2], o[3]));
        }
    }
}

__device__ __forceinline__ size_t kv_off(int dir, int b, int pos, int h) { return ((((size_t)dir * NB + b) * NPOS + pos) * 4 + h) * 4096; }
__device__ __forceinline__ void ret_kv_unit(KP p, int wv, int l, int u, bf16* lds) {
    const int h = u & 3, pos = (u >> 2) % NPOS, b = u / (4 * NPOS);
    const int t = tid_opaque(wv), lane = t & 63, w = t >> 6, r = lane & 15, g = lane >> 4;
    bf16* Ktf = lds; bf16* Ktb = lds + 64 * TROW; bf16* Vt = lds + 2 * 64 * TROW;
    const float lgf = log_sigmoid_f(p->rdf[l * 4 + h]), lgb = log_sigmoid_f(p->rdb[l * 4 + h]);
    const int r0 = chunk_row0(b, pos);
    const bf16* P = p->P;
    __syncthreads();
#pragma unroll
    for (int q = 0; q < 2; ++q) {
        const int pc = t + q * NT, j = pc >> 3, c8 = pc & 7;
        const bf16* src = P + (size_t)(r0 + j) * DIN + h * 64 + c8 * 8;
        const uint4 kv = *(const uint4*)(src + C_RK), vv = *(const uint4*)(src + C_RV);
        const float wf = expf(lgf * (float)(127 - j)), wb = expf(lgb * (float)j);
        uint4 kf, kb;
        kf.x = pk2(bflo(kv.x) * wf, bfhi(kv.x) * wf); kf.y = pk2(bflo(kv.y) * wf, bfhi(kv.y) * wf); kf.z = pk2(bflo(kv.z) * wf, bfhi(kv.z) * wf); kf.w = pk2(bflo(kv.w) * wf, bfhi(kv.w) * wf);
        kb.x = pk2(bflo(kv.x) * wb, bfhi(kv.x) * wb); kb.y = pk2(bflo(kv.y) * wb, bfhi(kv.y) * wb); kb.z = pk2(bflo(kv.z) * wb, bfhi(kv.z) * wb); kb.w = pk2(bflo(kv.w) * wb, bfhi(kv.w) * wb);
        st_tr8(Ktf + (c8 * 8) * TROW + j, TROW, kf);
        st_tr8(Ktb + (c8 * 8) * TROW + j, TROW, kb);
        st_tr8(Vt + (c8 * 8) * TROW + j, TROW, vv);
    }
    __syncthreads();
    const int dir = w >> 2, dvt = w & 3;
    const bf16* Kt = dir ? Ktb : Ktf;
    f32x4_t acc[4];
#pragma unroll
    for (int dkt = 0; dkt < 4; ++dkt) acc[dkt] = (f32x4_t){0.f, 0.f, 0.f, 0.f};
#pragma unroll
    for (int ks = 0; ks < 4; ++ks) {
        const bf16x8_t a = lds_frag16(Vt + (dvt * 16 + r) * TROW + ks * 32 + g * 8);
#pragma unroll
        for (int dkt = 0; dkt < 4; ++dkt) acc[dkt] = MFMA16(a, lds_frag16(Kt + (dkt * 16 + r) * TROW + ks * 32 + g * 8), acc[dkt]);
    }
    float* o = p->KV + kv_off(dir, b, pos, h);
#pragma unroll
    for (int dkt = 0; dkt < 4; ++dkt)
#pragma unroll
        for (int i = 0; i < 4; ++i) o[(dvt * 16 + g * 4 + i) * 64 + dkt * 16 + r] = acc[dkt][i];
}

__device__ __forceinline__ void phase_ret_scan(KP p, int wv, int l, int bid, int nb) {
    for (int i = bid * NT + tid_opaque(wv); i < 2 * NB * 4 * 4096; i += nb * NT) {
        const int e = i & 4095, h = (i >> 12) & 3, b = (i >> 14) & 1, dir = i >> 15;
        const float lg = log_sigmoid_f(dir ? p->rdb[l * 4 + h] : p->rdf[l * 4 + h]);
        const float cdec = expf(128.0f * lg);
        const float* kv = p->KV; bf16* st = p->ST16;
        float v[NPOS];
#pragma unroll
        for (int step = 0; step < NPOS; ++step) {
            const int pos = dir == 0 ? step : (step == 0 ? 1 : (step == 1 ? 0 : 67 - step));
            v[step] = kv[kv_off(dir, b, pos, h) + e];
        }
        float s = 0.f;
#pragma unroll
        for (int step = 0; step < NPOS; ++step) {
            const int pos = dir == 0 ? step : (step == 0 ? 1 : (step == 1 ? 0 : 67 - step));
            st[kv_off(dir, b, pos, h) + e] = (bf16)f2bf(s);
            s = s * cdec + v[step];
        }
    }
}

constexpr int RO_HEAD = 128 * KROW + 64 * TROW + 2 * 64 * KROW;
constexpr int RO_TAB = 2 * RO_HEAD;
__device__ __forceinline__ void ret_out_unit(KP p, int wv, int l, int u, bf16* lds) {
    const int hp = u & 1, pos = (u >> 1) % NPOS, b = u / (2 * NPOS);
    if (l == DEPTH - 1 && pos < 2) return;
    const int t = tid_opaque(wv), lane = t & 63, w = t >> 6, r = lane & 15, g = lane >> 4;
    const int r0 = chunk_row0(b, pos);
    const bf16* P = p->P;
    float* tabs = (float*)(lds + RO_TAB);
    __syncthreads();
#pragma unroll
    for (int q = 0; q < 4; ++q) {
        const int pc = t + q * NT, hh = pc >> 10, j = (pc >> 3) & 127, c8 = pc & 7, h = hp * 2 + hh;
        bf16* base = lds + hh * RO_HEAD;
        const bf16* src = P + (size_t)(r0 + j) * DIN + h * 64 + c8 * 8;
        *(uint4*)(base + j * KROW + c8 * 8) = *(const uint4*)(src + C_RK);
        const uint4 vv = *(const uint4*)(src + C_RV);
        st_tr8(base + 128 * KROW + (c8 * 8) * TROW + j, TROW, vv);
    }
#pragma unroll
    for (int q = 0; q < 4; ++q) {
        const int pc = t + q * NT, hh = pc >> 10, dir = (pc >> 9) & 1, dv = (pc >> 3) & 63, c8 = pc & 7, h = hp * 2 + hh;
        const uint4 sv = *(const uint4*)(p->ST16 + kv_off(dir, b, pos, h) + dv * 64 + c8 * 8);
        *(uint4*)(lds + hh * RO_HEAD + 128 * KROW + 64 * TROW + dir * 64 * KROW + dv * KROW + c8 * 8) = sv;
    }
    if (t < 4 * 132) {
        const int hh = t / 264, dir = (t / 132) & 1, k = t % 132, h = hp * 2 + hh;
        const float lg = log_sigmoid_f(dir ? p->rdb[l * 4 + h] : p->rdf[l * 4 + h]);
        tabs[(hh * 2 + dir) * 132 + k] = expf(lg * (float)k);
    }
    __syncthreads();
    const int hh = w >> 2, h = hp * 2 + hh, qw = w & 3;
    const bf16* Ks = lds + hh * RO_HEAD; const bf16* Vt = Ks + 128 * KROW; const bf16* Sft = Vt + 64 * TROW; const bf16* Sbt = Sft + 64 * KROW;
    const float* pf = tabs + (hh * 2) * 132; const float* pb = pf + 132;
    bf16x8_t qf[2][2];
#pragma unroll
    for (int qt = 0; qt < 2; ++qt)
#pragma unroll
        for (int ks = 0; ks < 2; ++ks) qf[qt][ks] = *(const bf16x8_t*)(P + (size_t)(r0 + qw * 32 + qt * 16 + r) * DIN + C_RQ + h * 64 + ks * 32 + g * 8);
    f32x4_t accI[4][2], accF[4][2], accB[4][2];
#pragma unroll
    for (int dt = 0; dt < 4; ++dt)
#pragma unroll
        for (int qt = 0; qt < 2; ++qt) { accI[dt][qt] = (f32x4_t){0.f, 0.f, 0.f, 0.f}; accF[dt][qt] = accI[dt][qt]; accB[dt][qt] = accI[dt][qt]; }
#pragma unroll
    for (int dt = 0; dt < 4; ++dt)
#pragma unroll
        for (int ks = 0; ks < 2; ++ks) {
            const bf16x8_t af = lds_frag16(Sft + (dt * 16 + r) * KROW + ks * 32 + g * 8), ab = lds_frag16(Sbt + (dt * 16 + r) * KROW + ks * 32 + g * 8);
#pragma unroll
            for (int qt = 0; qt < 2; ++qt) { accF[dt][qt] = MFMA16(af, qf[qt][ks], accF[dt][qt]); accB[dt][qt] = MFMA16(ab, qf[qt][ks], accB[dt][qt]); }
        }
#pragma unroll 1
    for (int sub = 0; sub < 2; ++sub) {
        f32x4_t st[4][2];
#pragma unroll
        for (int kt = 0; kt < 4; ++kt) {
#pragma unroll
            for (int qt = 0; qt < 2; ++qt) st[kt][qt] = (f32x4_t){0.f, 0.f, 0.f, 0.f};
#pragma unroll
            for (int ks = 0; ks < 2; ++ks) {
                const bf16x8_t a = lds_frag16(Ks + (sub * 64 + kt * 16 + r) * KROW + ks * 32 + g * 8);
#pragma unroll
                for (int qt = 0; qt < 2; ++qt) st[kt][qt] = MFMA16(a, qf[qt][ks], st[kt][qt]);
            }
        }
#pragma unroll
        for (int qt = 0; qt < 2; ++qt) {
            const int il = qw * 32 + qt * 16 + r;
#pragma unroll
            for (int kt = 0; kt < 4; ++kt)
#pragma unroll
                for (int i = 0; i < 4; ++i) {
                    const int rel = il - (sub * 64 + kt * 16 + g * 4 + i);
                    const float wgt = rel > 0 ? pf[rel] : (rel < 0 ? pb[-rel] : 2.0f);
                    st[kt][qt][i] *= wgt;
                }
        }
#pragma unroll
        for (int kp = 0; kp < 2; ++kp) {
            bf16x8_t pfr[2];
#pragma unroll
            for (int qt = 0; qt < 2; ++qt) pfr[qt] = pack_p(st[2 * kp][qt], st[2 * kp + 1][qt]);
#pragma unroll
            for (int dt = 0; dt < 4; ++dt) {
                const bf16* vrow = Vt + (dt * 16 + r) * TROW + sub * 64 + g * 4;
                const bf16x8_t a = lds_frag8x2(vrow + (2 * kp) * 16, vrow + (2 * kp + 1) * 16);
#pragma unroll
                for (int qt = 0; qt < 2; ++qt) accI[dt][qt] = MFMA16(a, pfr[qt], accI[dt][qt]);
            }
        }
    }
#pragma unroll
    for (int qt = 0; qt < 2; ++qt) {
        const int il = qw * 32 + qt * 16 + r;
        const float qfd = pf[il + 1], qbd = pb[128 - il];
        float s = 0.f;
#pragma unroll
        for (int dt = 0; dt < 4; ++dt) { accI[dt][qt] = accI[dt][qt] + accF[dt][qt] * qfd + accB[dt][qt] * qbd; s += (accI[dt][qt][0] + accI[dt][qt][1]) + (accI[dt][qt][2] + accI[dt][qt][3]); }
        s += shx(s, 16, lane); s += shx(s, 32, lane);
        const float mu = s * (1.0f / 64.0f);
        float qq = 0.f;
#pragma unroll
        for (int dt = 0; dt < 4; ++dt) { accI[dt][qt] = accI[dt][qt] - mu; qq += (accI[dt][qt][0] * accI[dt][qt][0] + accI[dt][qt][1] * accI[dt][qt][1]) + (accI[dt][qt][2] * accI[dt][qt][2] + accI[dt][qt][3] * accI[dt][qt][3]); }
        qq += shx(qq, 16, lane); qq += shx(qq, 32, lane);
        const float rstd = rsqrtf(qq * (1.0f / 64.0f) + LN_EPS);
        const size_t row = (size_t)(r0 + il);
#pragma unroll
        for (int dt = 0; dt < 4; ++dt) {
            const uint2 gw = *(const uint2*)(P + row * DIN + C_RG + h * 64 + dt * 16 + g * 4);
            const f32x4_t o = accI[dt][qt] * rstd;
            const float o0 = o[0] * silu_f(bflo(gw.x)), o1 = o[1] * silu_f(bfhi(gw.x)), o2 = o[2] * silu_f(bflo(gw.y)), o3 = o[3] * silu_f(bfhi(gw.y));
            *(uint2*)(p->MIX + row * D + h * 64 + dt * 16 + g * 4) = make_uint2(pk2(o0, o1), pk2(o2, o3));
        }
    }
}

__device__ __forceinline__ void sgu_unit(KP p, int wv, int l, int u, bf16* lds) {
    const int grp = u & 3, pos = (u >> 2) % NPOS, b = u / (4 * NPOS);
    if (l == DEPTH - 1 && pos < 2) return;
    const int t = tid_opaque(wv), lane = t & 63, w = t >> 6, r = lane & 15, g = lane >> 4;
    const int r0 = chunk_row0(b, pos);
    const bf16* P = p->P;
    bf16* vnT = lds;
    __syncthreads();
    {
        const int j = t >> 2, qd = t & 3;
        const uint4* src = (const uint4*)(P + (size_t)(r0 + j) * DIN + C_SV + grp * 64 + qd * 16);
        const uint4 a = src[0], c = src[1];
        float v[16] = {bflo(a.x), bfhi(a.x), bflo(a.y), bfhi(a.y), bflo(a.z), bfhi(a.z), bflo(a.w), bfhi(a.w), bflo(c.x), bfhi(c.x), bflo(c.y), bfhi(c.y), bflo(c.z), bfhi(c.z), bflo(c.w), bfhi(c.w)};
        float s = 0.f;
#pragma unroll
        for (int d = 0; d < 16; ++d) { v[d] = gelu_tanh(v[d]); s += v[d]; }
        s += shx(s, 1, lane); s += shx(s, 2, lane);
        const float mu = s * (1.0f / 64.0f);
        float qq = 0.f;
#pragma unroll
        for (int d = 0; d < 16; ++d) { v[d] -= mu; qq += v[d] * v[d]; }
        qq += shx(qq, 1, lane); qq += shx(qq, 2, lane);
        const float rstd = rsqrtf(qq * (1.0f / 64.0f) + LN_EPS);
#pragma unroll
        for (int d = 0; d < 16; ++d) vnT[(qd * 16 + d) * TROW + j] = (bf16)f2bf(v[d] * rstd);
    }
    bf16x8_t wf[4];
    {
        const float* wrow = p->sgu_w + (((size_t)l * 4 + grp) * 128 + w * 16 + r) * 128 + g * 8;
#pragma unroll
        for (int ks = 0; ks < 4; ++ks) {
            const float4 a = *(const float4*)(wrow + ks * 32), c = *(const float4*)(wrow + ks * 32 + 4);
            uint4 o; o.x = pk2(a.x, a.y); o.y = pk2(a.z, a.w); o.z = pk2(c.x, c.y); o.w = pk2(c.z, c.w);
            wf[ks] = __builtin_bit_cast(bf16x8_t, o);
        }
    }
    __syncthreads();
    const int i = w * 16 + r;
    const float bs = p->sgu_b[((size_t)l * 4 + grp) * 128 + i];
#pragma unroll
    for (int dt = 0; dt < 4; ++dt) {
        f32x4_t acc = {0.f, 0.f, 0.f, 0.f};
#pragma unroll
        for (int ks = 0; ks < 4; ++ks) acc = MFMA16(lds_frag16(vnT + (dt * 16 + r) * TROW + ks * 32 + g * 8), wf[ks], acc);
        const uint2 uw = *(const uint2*)(P + (size_t)(r0 + i) * DIN + C_SU + grp * 64 + dt * 16 + g * 4);
        const float o0 = gelu_tanh(bflo(uw.x)) * (acc[0] + bs), o1 = gelu_tanh(bfhi(uw.x)) * (acc[1] + bs), o2 = gelu_tanh(bflo(uw.y)) * (acc[2] + bs), o3 = gelu_tanh(bfhi(uw.y)) * (acc[3] + bs);
        *(uint2*)(p->MIX + (size_t)(r0 + i) * D + 256 + grp * 64 + dt * 16 + g * 4) = make_uint2(pk2(o0, o1), pk2(o2, o3));
    }
}

__device__ __forceinline__ void phase_mix_a(KP p, int wv, int l, int bid, int nb, float* ldsf) {
    bf16* lds = (bf16*)ldsf;
    const int n_kv = NB * NPOS * 4, n_sgu = NB * NPOS * 4, n_small = n_kv + n_sgu;
    for (int u = bid; u < 256; u += nb) att_unit(p, wv, l, u, lds);
    const int nctx = (l == DEPTH - 1) ? 0 : 8;
    const bool split = nb > 64 && nctx > 0;
    if (split ? bid < nctx : true) for (int u = 256 + bid; u < 256 + nctx; u += nb) att_unit(p, wv, l, u, lds);
    const int sb = split ? bid - nctx : bid, snb = split ? nb - nctx : nb;
    if (sb >= 0)
        for (int u = sb; u < n_small; u += snb) {
            if (u < n_kv) ret_kv_unit(p, wv, l, u, lds);
            else sgu_unit(p, wv, l, u - n_kv, lds);
        }
    __syncthreads();
}
__device__ __forceinline__ void phase_ret_out(KP p, int wv, int l, int bid, int nb, float* ldsf) {
    bf16* lds = (bf16*)ldsf;
    for (int u = bid; u < NB * NPOS * 2; u += nb) ret_out_unit(p, wv, l, u, lds);
    __syncthreads();
}

__device__ __forceinline__ void phase_ln1(KP p, int wv, int l, int bid, int nb) {
    const int lane = tid_opaque(wv) & 63, w = tid_opaque(wv) >> 6;
    const int Tn = (l == DEPTH - 1) ? TL : T;
    for (int r = bid * NW + w; r < Tn; r += nb * NW) {
        float v[16], a[16], c[16];
        if (l == 0) row_load(x_row(p, 0, r), v, lane); else row_load_bf(p->X + (size_t)r * D, v, lane);
        row_load_bf(p->Y + (size_t)r * D, a, lane);
        const float* m = p->mod + ((size_t)l * 3 + mod_idx(r)) * 6144;
        row_load(m + 2048, c, lane);
#pragma unroll
        for (int i = 0; i < 16; ++i) v[i] = ALPHA * v[i] + c[i] * a[i];
        row_ln(v, lane);
        row_load(p->lnm_g + l * D, a, lane); row_load(p->lnm_b + l * D, c, lane);
#pragma unroll
        for (int i = 0; i < 16; ++i) v[i] = v[i] * a[i] + c[i];
        row_store_bf(p->X1 + (size_t)r * D, v, lane);
        row_ln(v, lane);
        row_load(m + 3072, a, lane); row_load(m + 4096, c, lane);
#pragma unroll
        for (int i = 0; i < 16; ++i) v[i] = v[i] * (1.0f + c[i]) + a[i];
        row_store_bf(p->H + (size_t)r * D, v, lane);
        float mx = 0.f;
#pragma unroll
        for (int i = 0; i < 16; ++i) mx = fmaxf(mx, fabsf(v[i]));
#pragma unroll
        for (int o = 32; o >= 1; o >>= 1) mx = fmaxf(mx, shx(mx, o, lane));
        const float xinv = mx > 0.f ? 127.0f / mx : 0.f;
        unsigned* xq = (unsigned*)(p->XQ + (size_t)r * D);
#pragma unroll
        for (int i = 0; i < 4; ++i) {
            const int q0 = (int)rintf(v[i * 4 + 0] * xinv), q1 = (int)rintf(v[i * 4 + 1] * xinv), q2 = (int)rintf(v[i * 4 + 2] * xinv), q3 = (int)rintf(v[i * 4 + 3] * xinv);
            xq[i * 64 + lane] = (unsigned)(q0 & 0xff) | ((unsigned)(q1 & 0xff) << 8) | ((unsigned)(q2 & 0xff) << 16) | ((unsigned)(q3 & 0xff) << 24);
        }
        if (lane == 0) p->SX[r] = mx * (1.0f / 127.0f);
    }
}

template <int N> __device__ __forceinline__ void bitonic_sort_desc(float (&x)[N]) {
#pragma unroll
    for (int sz = 2; sz <= N; sz <<= 1)
#pragma unroll
        for (int t = sz >> 1; t > 0; t >>= 1)
#pragma unroll
            for (int i = 0; i < N; ++i)
                if ((i & t) == 0) {
                    const int j = i | t; const bool desc = (i & sz) == 0;
                    const float mx_ = fmaxf(x[i], x[j]), mn_ = fminf(x[i], x[j]);
                    x[i] = desc ? mx_ : mn_; x[j] = desc ? mn_ : mx_;
                }
}
__device__ __forceinline__ void bitonic_merge16_desc(float (&x)[16]) {
#pragma unroll
    for (int t = 8; t > 0; t >>= 1)
#pragma unroll
        for (int i = 0; i < 16; ++i)
            if ((i & t) == 0) { const int j = i | t; const float mx_ = fmaxf(x[i], x[j]), mn_ = fminf(x[i], x[j]); x[i] = mx_; x[j] = mn_; }
}
__device__ __forceinline__ void xmerge16_desc(float (&c)[16], int lane) {
#pragma unroll
    for (int o = 16; o <= 32; o <<= 1) {
        float pr[16];
#pragma unroll
        for (int i = 0; i < 16; ++i) pr[i] = shx(c[i], o, lane);
#pragma unroll
        for (int i = 0; i < 16; ++i) c[i] = fmaxf(c[i], pr[15 - i]);
        bitonic_merge16_desc(c);
    }
}
__device__ __forceinline__ void top16_keys(const float (&sc)[32], int fq, int lane, float (&c)[16]) {
    float a[16], b[16];
#pragma unroll
    for (int e = 0; e < 16; ++e) {
        a[e] = __builtin_bit_cast(float, (__builtin_bit_cast(unsigned, sc[e]) & ~127u) | (unsigned)((e >> 2) * 16 + (e & 3)) | ((unsigned)fq << 2));
        b[e] = __builtin_bit_cast(float, (__builtin_bit_cast(unsigned, sc[16 + e]) & ~127u) | (unsigned)(((16 + e) >> 2) * 16 + (e & 3)) | ((unsigned)fq << 2));
    }
    bitonic_sort_desc<16>(a); bitonic_sort_desc<16>(b);
#pragma unroll
    for (int i = 0; i < 16; ++i) c[i] = fmaxf(a[i], b[15 - i]);
    bitonic_merge16_desc(c);
    xmerge16_desc(c, lane);
}
constexpr int KS_STRIDE = 136;
__device__ __forceinline__ void phase_topk(KP p, int wv, int l, int bid, int nb, float* lds) {
    bf16* k1s = (bf16*)lds;
    bf16* k2s = k1s + 128 * KS_STRIDE;
    const int t = tid_opaque(wv), lane = t & 63, w = t >> 6;
    float* lists = lds + (2 * 128 * KS_STRIDE * 2) / 4 + w * 1536;
    float* v1 = lists; int* i1 = (int*)(lists + 256); float* v2 = lists + 512; int* i2 = (int*)(lists + 768); float* v3 = lists + 1024; int* c3 = (int*)(lists + 1280);
    unsigned char* ctab = (unsigned char*)(lds + (2 * 128 * KS_STRIDE * 2) / 4 + NW * 1536);
    __syncthreads();
    if (t < 64) {
        const int gq = t >> 4, k = t & 15; int ab = 0xff;
        if (gq == 0) { if (k < 13) ab = k; }
        else if (gq == 1) { if (k < 3) ab = 13 + k; else if (k < 11) ab = 0x10 | (k - 3); else if (k < 13) ab = 0x20 | (k - 11); }
        else if (gq == 2) { if (k < 3) ab = 0x20 | (k + 2); else if (k < 7) ab = 0x30 | (k - 3); else if (k < 10) ab = 0x40 | (k - 7); else if (k < 12) ab = 0x50 | (k - 10); else if (k < 13) ab = 0x60; }
        else { if (k == 0) ab = 0x61; else if (k < 3) ab = 0x70 | (k - 1); else if (k < 11) ab = (k + 5) << 4; }
        ctab[t] = (unsigned char)ab;
    }
    for (int e = t; e < 2 * 128 * 16; e += NT) {
        const int tab = e >> 11, r = (e >> 4) & 127, c8 = e & 15;
        const float* src = (tab ? p->k2 : p->k1) + (size_t)l * 128 * 128 + r * 128 + c8 * 8;
        const float4 a = *(const float4*)src, b = *(const float4*)(src + 4);
        uint4 o; o.x = pk2(a.x, a.y); o.y = pk2(a.z, a.w); o.z = pk2(b.x, b.y); o.w = pk2(b.z, b.w);
        *(uint4*)((tab ? k2s : k1s) + r * KS_STRIDE + c8 * 8) = o;
    }
    __syncthreads();
    const int fr = lane & 15, fq = lane >> 4;
    const int ntask = ((l == DEPTH - 1) ? TL : T) * 8 / 16;
    for (int task = bid * NW + w; task < ntask; task += nb * NW) {
        const int it0 = task * 16;
        const bf16* qrow = p->Qb + (size_t)(it0 + fr) * 256 + fq * 8;
        bf16x8_t bq[8];
#pragma unroll
        for (int ks = 0; ks < 8; ++ks) bq[ks] = *(const bf16x8_t*)(qrow + ks * 32);
        float s[32];
#pragma unroll
        for (int kt = 0; kt < 8; ++kt) {
            f32x4_t acc = {0.f, 0.f, 0.f, 0.f};
#pragma unroll
            for (int ks = 0; ks < 4; ++ks) {
                const bf16x8_t a = *(const bf16x8_t*)(k1s + (kt * 16 + fr) * KS_STRIDE + ks * 32 + fq * 8);
                acc = __builtin_amdgcn_mfma_f32_16x16x32_bf16(a, bq[ks], acc, 0, 0, 0);
            }
            s[kt * 4 + 0] = acc[0]; s[kt * 4 + 1] = acc[1]; s[kt * 4 + 2] = acc[2]; s[kt * 4 + 3] = acc[3];
        }
        { float ck[16]; top16_keys(s, fq, lane, ck);
          if (fq == 0) {
#pragma unroll
              for (int i = 0; i < 16; ++i) v1[fr * 16 + i] = ck[i]; } }
#pragma unroll
        for (int kt = 0; kt < 8; ++kt) {
            f32x4_t acc = {0.f, 0.f, 0.f, 0.f};
#pragma unroll
            for (int ks = 0; ks < 4; ++ks) {
                const bf16x8_t a = *(const bf16x8_t*)(k2s + (kt * 16 + fr) * KS_STRIDE + ks * 32 + fq * 8);
                acc = __builtin_amdgcn_mfma_f32_16x16x32_bf16(a, bq[4 + ks], acc, 0, 0, 0);
            }
            s[kt * 4 + 0] = acc[0]; s[kt * 4 + 1] = acc[1]; s[kt * 4 + 2] = acc[2]; s[kt * 4 + 3] = acc[3];
        }
        { float ck[16]; top16_keys(s, fq, lane, ck);
          if (fq == 0) {
#pragma unroll
              for (int i = 0; i < 16; ++i) v2[fr * 16 + i] = ck[i]; } }
        __builtin_amdgcn_wave_barrier();
        const uint4 tw = *(const uint4*)(ctab + fq * 16);
        const unsigned twd[4] = {tw.x, tw.y, tw.z, tw.w};
        float ck3[16];
        const float padv = __builtin_bit_cast(float, __builtin_bit_cast(unsigned, v1[fr * 16 + 15]) & ~127u) + __builtin_bit_cast(float, __builtin_bit_cast(unsigned, v2[fr * 16 + 15]) & ~127u) - 1.0f;
#pragma unroll
        for (int k = 0; k < 16; ++k) {
            const unsigned ab = k < 13 ? (twd[k >> 2] >> (8 * (k & 3))) & 0xffu : 0xffu;
            const float ka = __builtin_bit_cast(float, __builtin_bit_cast(unsigned, v1[fr * 16 + ((ab >> 4) & 15u)]) & ~127u);
            const float kb = __builtin_bit_cast(float, __builtin_bit_cast(unsigned, v2[fr * 16 + (ab & 15u)]) & ~127u);
            const float cvv = ab == 0xffu ? padv : ka + kb;
            ck3[k] = __builtin_bit_cast(float, (__builtin_bit_cast(unsigned, cvv) & ~255u) | ab);
        }
        bitonic_sort_desc<16>(ck3);
        xmerge16_desc(ck3, lane);
        float tv[4]; int tc[4];
#pragma unroll
        for (int k = 0; k < 4; ++k) {
            const float kk = fq == 0 ? ck3[k] : (fq == 1 ? ck3[4 + k] : (fq == 2 ? ck3[8 + k] : ck3[12 + k]));
            tv[k] = __builtin_bit_cast(float, __builtin_bit_cast(unsigned, kk) & ~255u); tc[k] = (int)(__builtin_bit_cast(unsigned, kk) & 255u);
        }
        float mx = fmaxf(fmaxf(tv[0], tv[1]), fmaxf(tv[2], tv[3]));
        mx = fmaxf(mx, shx(mx, 16, lane)); mx = fmaxf(mx, shx(mx, 32, lane));
        float ex[4], den = 0.f;
#pragma unroll
        for (int k = 0; k < 4; ++k) { ex[k] = expf(tv[k] - mx); den += ex[k]; }
        den += shx(den, 16, lane); den += shx(den, 32, lane);
        const float inv = 1.0f / den;
        int4 eo; float4 go;
#define TK_EID(c) ((int)(__builtin_bit_cast(unsigned, v1[fr * 16 + ((c) >> 4)]) & 127u) * 128 + (int)(__builtin_bit_cast(unsigned, v2[fr * 16 + ((c) & 15)]) & 127u))
        eo.x = TK_EID(tc[0]); eo.y = TK_EID(tc[1]); eo.z = TK_EID(tc[2]); eo.w = TK_EID(tc[3]);
#undef TK_EID
        go = make_float4(ex[0] * inv, ex[1] * inv, ex[2] * inv, ex[3] * inv);
        *(int4*)(p->EIDX + (size_t)(it0 + fr) * 16 + fq * 4) = eo;
        *(float4*)(p->GATE + (size_t)(it0 + fr) * 16 + fq * 4) = go;
        __builtin_amdgcn_wave_barrier();
    }
    __syncthreads();
}

typedef unsigned u32x4_t __attribute__((ext_vector_type(4)));
using bf16x2_t = __attribute__((ext_vector_type(2))) __bf16;
__device__ __forceinline__ float dot2bf(unsigned a, unsigned b, float acc) { return __builtin_amdgcn_fdot2_f32_bf16(__builtin_bit_cast(bf16x2_t, a), __builtin_bit_cast(bf16x2_t, b), acc, false); }
struct RowBf { u32x4_t a, b; };
__device__ __forceinline__ RowBf ld_row(const bf16* tab, int e, int lane) {
    const u32x4_t* r = (const u32x4_t*)(tab + (size_t)e * D) + lane;
    RowBf x; x.a = r[0]; x.b = r[64]; return x;
}
__device__ __forceinline__ float row_dot(const RowBf& x, const RowBf& u) {
    float d = 0.f;
#pragma unroll
    for (int k = 0; k < 4; ++k) { d = dot2bf(x.a[k], u.a[k], d); d = dot2bf(x.b[k], u.b[k], d); }
    return d;
}
__device__ __forceinline__ void row_axpy(float (&acc)[16], float a, const RowBf& v) {
#pragma unroll
    for (int k = 0; k < 4; ++k) {
        acc[2 * k] += a * bflo(v.a[k]); acc[2 * k + 1] += a * bfhi(v.a[k]);
        acc[8 + 2 * k] += a * bflo(v.b[k]); acc[8 + 2 * k + 1] += a * bfhi(v.b[k]);
    }
}
__device__ __forceinline__ float transpose_reduce16(float (&part)[16], int lane) {
#pragma unroll
    for (int st = 32, n = 8; n >= 1; st >>= 1, n >>= 1) {
        const bool up = (lane & st) != 0;
#pragma unroll
        for (int s = 0; s < n; ++s) {
            const float lo = part[s], hi = part[s + n];
            const float recv = shx(up ? lo : hi, st, lane);
            part[s] = (up ? hi : lo) + recv;
        }
    }
    float v = part[0];
    v += shx(v, 2, lane); v += shx(v, 1, lane);
    return v;
}
typedef float f32x2_t __attribute__((ext_vector_type(2)));
__device__ __forceinline__ float transpose_reduce8(float (&part)[8], int lane) {
#pragma unroll
    for (int st = 32, n = 4; n >= 1; st >>= 1, n >>= 1) {
        const bool up = (lane & st) != 0;
#pragma unroll
        for (int s = 0; s < n; ++s) {
            const float lo = part[s], hi = part[s + n];
            const float recv = shx(up ? lo : hi, st, lane);
            part[s] = (up ? hi : lo) + recv;
        }
    }
    float v = part[0];
    v += shx(v, 4, lane); v += shx(v, 2, lane); v += shx(v, 1, lane);
    return v;
}
typedef int v4i_t __attribute__((ext_vector_type(4)));
typedef unsigned u32x4v __attribute__((ext_vector_type(4)));
constexpr int EXU_CAP = 440, EXU_TROW = 1056, EXU_WAVE = 8 * EXU_CAP + 16 * EXU_TROW;
__device__ __forceinline__ void phase_expert_u(KP p, int wv, int l, int bid, int nb, float* lds) {
    const int lane = tid_opaque(wv) & 63, w = __builtin_amdgcn_readfirstlane(tid_opaque(wv) >> 6);
    const int G8 = nb >> 3;
    if (bid >= G8 * 8) return;
    const int rng = bid & 7, r = lane & 15, g = lane >> 4;
    const unsigned char* U = p->U8 + (size_t)l * PEER_N * D;
    const float* SU = p->SU + (size_t)l * PEER_N; const float* SV = p->SV + (size_t)l * PEER_N;
    unsigned char* wl = (unsigned char*)lds + w * EXU_WAVE;
    unsigned* lpk = (unsigned*)wl; float* lgt = (float*)(wl + 4 * EXU_CAP); unsigned char* tile = wl + 8 * EXU_CAP;
    const unsigned long long ltmask = (1ull << lane) - 1ull;
    const int tstride = G8 * NW, Tn = (l == DEPTH - 1) ? TL : T, t0 = (bid >> 3) * NW + w;
    if (t0 >= Tn) return;
    const int nitem = (Tn - t0 + tstride - 1) / tstride;
    int i0 = 0;
    while (i0 < nitem) {
        const int nt = nitem - i0 < 16 ? nitem - i0 : 16;
        v4i_t afr[16];
        {
            const unsigned char* xa = p->XQ + (size_t)(t0 + (i0 + (r < nt ? r : nt - 1)) * tstride) * D + g * 16;
#pragma unroll
            for (int ks = 0; ks < 16; ++ks) afr[ks] = *(const v4i_t*)(xa + ks * 64);
        }
        const float sxv = p->SX[t0 + (i0 + (lane < nt ? lane : nt - 1)) * tstride];
        int e0[16], e1[16];
#pragma unroll
        for (int j = 0; j < 16; ++j) {
            const size_t tb = (size_t)(t0 + (i0 + (j < nt ? j : nt - 1)) * tstride) * NSEL;
            e0[j] = p->EIDX[tb + lane]; e1[j] = p->EIDX[tb + 64 + lane];
        }
        int cnt = 0, ndone = 0; bool open = true;
#pragma unroll
        for (int j = 0; j < 16; ++j) {
            const bool in0 = (e0[j] >> 11) == rng, in1 = (e1[j] >> 11) == rng;
            const unsigned long long m0 = __ballot(in0), m1 = __ballot(in1);
            const int c0 = __popcll(m0), c = c0 + __popcll(m1);
            open = open && j < nt && cnt + c <= EXU_CAP;
            if (open) {
                if (in0) { const int pos = cnt + __popcll(m0 & ltmask); lpk[pos] = (unsigned)e0[j] | ((unsigned)j << 14) | ((unsigned)lane << 18); }
                if (in1) { const int pos = cnt + c0 + __popcll(m1 & ltmask); lpk[pos] = (unsigned)e1[j] | ((unsigned)j << 14) | ((unsigned)(lane + 64) << 18); }
                cnt += c; ndone = j + 1;
            }
        }
        __builtin_amdgcn_wave_barrier();
        const int ntile = (cnt + 15) >> 4;
        u32x4v rw[16]; unsigned pkv = 0u; float suv = 0.f;
#define EXU_ISSUE(q) do { const int idx_ = 16 * (q) + r < cnt ? 16 * (q) + r : cnt - 1; \
            pkv = lpk[idx_]; const unsigned e_ = pkv & 0x3fffu; \
            _Pragma("unroll") for (int k = 0; k < 16; ++k) rw[k] = *(const u32x4v*)(U + ((size_t)(__builtin_amdgcn_readlane((int)pkv, k) & 0x3fff) << 10) + lane * 16); \
            suv = SU[e_]; } while (0)
        if (ntile > 0) EXU_ISSUE(0);
#pragma unroll 1
        for (int q = 0; q < ntile; ++q) {
#pragma unroll
            for (int k = 0; k < 16; ++k) *(u32x4v*)(tile + k * EXU_TROW + lane * 16) = rw[k];
            const unsigned pk = pkv; const float su = suv;
            __builtin_amdgcn_wave_barrier();
            if (q + 1 < ntile) EXU_ISSUE(q + 1);
            v4i_t acc = {0, 0, 0, 0};
#pragma unroll
            for (int ks = 0; ks < 16; ++ks) {
                const v4i_t b = *(const v4i_t*)(tile + r * EXU_TROW + ks * 64 + g * 16);
                acc = __builtin_amdgcn_mfma_i32_16x16x64_i8(afr[ks], b, acc, 0, 0, 0);
            }
            const int j = (int)((pk >> 14) & 15u);
            const int d = (j & 2) ? ((j & 1) ? acc[3] : acc[2]) : ((j & 1) ? acc[1] : acc[0]);
            const float sx = shf(sxv, j);
            if (g == (j >> 2) && 16 * q + r < cnt) lgt[16 * q + r] = (float)d * su * sx;
            __builtin_amdgcn_wave_barrier();
        }
#undef EXU_ISSUE
        for (int idx = lane; idx < cnt; idx += 64) {
            const unsigned pk = lpk[idx]; const int e = (int)(pk & 0x3fffu), j = (int)((pk >> 14) & 15u), slot = (int)(pk >> 18);
            const size_t ao = (size_t)(t0 + (i0 + j) * tstride) * NSEL + slot;
            p->ACT[ao] = gelu_tanh(lgt[idx]) * p->GATE[ao] * SV[e];
        }
        __builtin_amdgcn_wave_barrier();
        i0 += ndone > 0 ? ndone : 1;
    }
}
__device__ __forceinline__ void phase_expert_v(KP p, int wv, int l, int bid, int nb) {
    const int lane = tid_opaque(wv) & 63, w = __builtin_amdgcn_readfirstlane(tid_opaque(wv) >> 6);
    const int G8 = nb >> 3;
    if (bid >= G8 * 8) return;
    const int sl = bid & 7, q = lane >> 3, c = lane & 7;
    const __amdgpu_buffer_rsrc_t rsV = __builtin_amdgcn_make_buffer_rsrc((void*)(p->V8 + (size_t)l * PEER_N * D), 0, PEER_N * D, 0x00020000);
    const int coff = sl * 128 + c * 16;
    const int tstride = G8 * NW, Tn = (l == DEPTH - 1) ? TL : T, t0 = (bid >> 3) * NW + w;
    const int nitem = t0 < Tn ? (Tn - t0 + tstride - 1) / tstride : 0;
    for (int j0 = 0; j0 < nitem; j0 += 8) {
        const bool valid = j0 + q < nitem;
        const int t = t0 + (valid ? j0 + q : nitem - 1) * tstride;
        int e[16]; float a[16];
        {
            const int4* ep = (const int4*)(p->EIDX + (size_t)t * NSEL + c * 16); const float4* ap = (const float4*)(p->ACT + (size_t)t * NSEL + c * 16);
#pragma unroll
            for (int k = 0; k < 4; ++k) { const int4 ev = ep[k]; const float4 av = ap[k];
                e[k * 4 + 0] = ev.x << 10; e[k * 4 + 1] = ev.y << 10; e[k * 4 + 2] = ev.z << 10; e[k * 4 + 3] = ev.w << 10;
                a[k * 4 + 0] = av.x; a[k * 4 + 1] = av.y; a[k * 4 + 2] = av.z; a[k * 4 + 3] = av.w; }
        }
        f32x2_t acc[8];
#pragma unroll
        for (int k = 0; k < 8; ++k) acc[k] = (f32x2_t){0.f, 0.f};
#pragma unroll 1
        for (int cc = 0; cc < 8; ++cc) {
            const int baddr = ((lane & 56) | cc) << 2;
#pragma unroll
            for (int hb = 0; hb < 2; ++hb) {
                u32x4v rv[8]; float av[8];
#pragma unroll
                for (int k = 0; k < 8; ++k) {
                    const int j = hb * 8 + k;
                    const int eo = __builtin_amdgcn_ds_bpermute(baddr, e[j]);
                    av[k] = __builtin_bit_cast(float, __builtin_amdgcn_ds_bpermute(baddr, __builtin_bit_cast(int, a[j])));
                    rv[k] = __builtin_amdgcn_raw_buffer_load_b128(rsV, eo + coff, 0, 0);
                }
#pragma unroll
                for (int k = 0; k < 8; ++k) {
                    const f32x2_t a2 = {av[k], av[k]};
                    acc[0] += a2 * __builtin_amdgcn_cvt_pk_f32_fp8((int)rv[k][0], false); acc[1] += a2 * __builtin_amdgcn_cvt_pk_f32_fp8((int)rv[k][0], true);
                    acc[2] += a2 * __builtin_amdgcn_cvt_pk_f32_fp8((int)rv[k][1], false); acc[3] += a2 * __builtin_amdgcn_cvt_pk_f32_fp8((int)rv[k][1], true);
                    acc[4] += a2 * __builtin_amdgcn_cvt_pk_f32_fp8((int)rv[k][2], false); acc[5] += a2 * __builtin_amdgcn_cvt_pk_f32_fp8((int)rv[k][2], true);
                    acc[6] += a2 * __builtin_amdgcn_cvt_pk_f32_fp8((int)rv[k][3], false); acc[7] += a2 * __builtin_amdgcn_cvt_pk_f32_fp8((int)rv[k][3], true);
                    __builtin_amdgcn_sched_barrier(0);
                }
            }
        }
        if (valid) {
            bf16* yr = p->Y + (size_t)t * D + coff;
            *(uint4*)yr = make_uint4(pk2(acc[0].x, acc[0].y), pk2(acc[1].x, acc[1].y), pk2(acc[2].x, acc[2].y), pk2(acc[3].x, acc[3].y));
            *(uint4*)(yr + 8) = make_uint4(pk2(acc[4].x, acc[4].y), pk2(acc[5].x, acc[5].y), pk2(acc[6].x, acc[6].y), pk2(acc[7].x, acc[7].y));
        }
    }
}

__device__ __forceinline__ void phase_ln2(KP p, int wv, int l, int bid, int nb) {
    const int lane = tid_opaque(wv) & 63, w = tid_opaque(wv) >> 6;
    const int Tn = (l == DEPTH - 1) ? TL : T;
    for (int r = bid * NW + w; r < Tn; r += nb * NW) {
        float v[16], a[16], c[16];
        row_load_bf(p->X1 + (size_t)r * D, v, lane);
        row_load_bf(p->Y + (size_t)r * D, a, lane);
        const float* m = p->mod + ((size_t)l * 3 + mod_idx(r)) * 6144;
        row_load(m + 5120, c, lane);
#pragma unroll
        for (int i = 0; i < 16; ++i) v[i] = ALPHA * v[i] + c[i] * a[i];
        row_ln(v, lane);
        row_load(p->lnf_g + l * D, a, lane); row_load(p->lnf_b + l * D, c, lane);
#pragma unroll
        for (int i = 0; i < 16; ++i) v[i] = v[i] * a[i] + c[i];
        if (l == DEPTH - 1) { if (r < TL) row_store(p->out + (size_t)r * D, v, lane); continue; }
        row_store_bf(p->X + (size_t)r * D, v, lane);
        const float* m2 = p->mod + ((size_t)(l + 1) * 3 + mod_idx(r)) * 6144;
        row_ln(v, lane);
        row_load(m2, a, lane); row_load(m2 + 1024, c, lane);
#pragma unroll
        for (int i = 0; i < 16; ++i) v[i] = v[i] * (1.0f + c[i]) + a[i];
        row_store_bf(p->H + (size_t)r * D, v, lane);
    }
}

__global__ void __launch_bounds__(NT, 2) mega(Params p_unused) {
    extern __shared__ __attribute__((aligned(16))) unsigned char lds_raw[];
    cg::grid_group grid = cg::this_grid();
    const int bid = blockIdx.x, nb = gridDim.x;
    const int wv = __builtin_amdgcn_readfirstlane(threadIdx.x >> 6);
    float* lds = (float*)lds_raw;
    LAS unsigned char* ldsl = (LAS unsigned char*)lds_raw;
    volatile LAS unsigned* MISC = (volatile LAS unsigned*)(ldsl + MISC_OFF);
    for (int u = threadIdx.x; u < 64; u += NT) ((LAS unsigned*)(ldsl + MISC_OFF))[u] = 0u;
    __syncthreads();
#define IS_LEAD() (wv == 0 && lane_opaque() == 0)
    (void)xcd_barrier_post(kparams()->ctl + CW_BAR, MISC + 8, IS_LEAD());
#define GRID_BAR() do { XcdBarrier b_; b_.bar = kparams()->ctl + CW_BAR; b_.x = xb_xcc_id(); b_.st = MISC + 8; b_.lead = IS_LEAD(); xcd_barrier(b_); } while (0)

    phase_mod1(kparams(), wv, bid, nb, lds);
    phase_weights(kparams(), wv, bid, nb, lds);
    grid.sync();
    phase_mod2(kparams(), wv, bid, nb);
    GRID_BAR();
    phase_lnmod(kparams(), wv, 0, bid, nb);
    GRID_BAR();
#define LAYER_BODY(l) do { \
        { KP p = kparams(); \
            pg8::Gemm g{p->H, p->WtIn + (size_t)l * DIN * D, T, DIN, D}; pg8::StaticOrder S; S.init(T, DIN, nb, bid); \
            pg8::EpiInProj E{p->P, p->rope}; \
            pg8::gemm_phase<pg8::EpiInProj, pg8::StaticOrder, true, true>(ldsl, g, S, E, wv); \
            { const int busy3 = 66 * 9 - 2 * nb;                       \
              if (busy3 > 0 && busy3 < nb) { if (bid >= busy3) phase_tables(p, wv, l, bid - busy3, nb - busy3); } else phase_tables(p, wv, l, bid, nb); } \
        } \
        GRID_BAR(); \
        phase_mix_a(kparams(), wv, l, bid, nb, lds); \
        GRID_BAR(); \
        phase_ret_scan(kparams(), wv, l, bid, nb); \
        GRID_BAR(); \
        phase_ret_out(kparams(), wv, l, bid, nb, lds); \
        GRID_BAR(); \
        { KP p = kparams(); \
            const int Mr = (l == DEPTH - 1) ? TL : T; pg8::Gemm g{p->MIX, p->WtOut + (size_t)l * D * D, Mr, D, D}; pg8::StaticOrder S; S.init(Mr, D, nb, bid); \
            pg8::EpiBf16Plain E{p->Y, D}; \
            pg8::gemm_phase<pg8::EpiBf16Plain, pg8::StaticOrder, true, true>(ldsl, g, S, E, wv); \
        } \
        GRID_BAR(); \
        phase_ln1(kparams(), wv, l, bid, nb); \
        GRID_BAR(); \
        { KP p = kparams(); \
            const int Mr = (l == DEPTH - 1) ? TL : T; pg8::Gemm g{p->H, p->WtQ + (size_t)l * 2048 * D, Mr, 2048, D}; pg8::StaticOrder S; S.init(Mr, 2048, nb, bid); \
            pg8::EpiBf16Plain E{p->Qb, 2048}; \
            pg8::gemm_phase<pg8::EpiBf16Plain, pg8::StaticOrder, true, true>(ldsl, g, S, E, wv); \
        } \
        GRID_BAR(); \
        phase_topk(kparams(), wv, l, bid, nb, lds); \
        GRID_BAR(); \
        phase_expert_u(kparams(), wv, l, bid, nb, lds); \
        GRID_BAR(); \
        phase_expert_v(kparams(), wv, l, bid, nb); \
        GRID_BAR(); \
        phase_ln2(kparams(), wv, l, bid, nb); \
        if (l + 1 < DEPTH) GRID_BAR(); \
    } while (0)
    LAYER_BODY(0); LAYER_BODY(1); LAYER_BODY(2); LAYER_BODY(3);
#undef LAYER_BODY
}

extern "C" void kernel_launch(void* const* d_in, const int* in_sizes, int n_in, void* d_out, int out_size, void* d_ws, size_t ws_size, hipStream_t stream) {
    static int grid_blocks = 0;
    if (!grid_blocks) {
        int dev = 0, cus = 0, per_cu = 0;
        (void)hipGetDevice(&dev);
        (void)hipDeviceGetAttribute(&cus, hipDeviceAttributeMultiprocessorCount, dev);
        (void)hipFuncSetAttribute((const void*)mega, hipFuncAttributeMaxDynamicSharedMemorySize, LDS_BYTES);
        (void)hipOccupancyMaxActiveBlocksPerMultiprocessor(&per_cu, mega, NT, LDS_BYTES);
        if (per_cu < 1) { fprintf(stderr, "occupancy query says %d blocks per CU\n", per_cu); per_cu = 1; }
        grid_blocks = cus;
    }
    Params p{};
    const float** ins = (const float**)&p;
    for (int i = 0; i < 22; ++i) ins[i] = (const float*)d_in[i];
    p.out = (float*)d_out;
    char* ws = (char*)d_ws;
    size_t off = 0;
    auto carve = [&](size_t bytes) { void* r = ws + off; off += (bytes + 255) & ~(size_t)255; return r; };
    p.ctl = (unsigned*)carve(CTL_BYTES);
    p.modp = (float*)carve((size_t)16 * DEPTH * 3 * 6144 * 4);
    p.mod = (float*)carve((size_t)DEPTH * 3 * 6144 * 4);
    p.rope = (float*)carve((size_t)192 * 16 * 2 * 4);
    p.WtIn = (bf16*)carve((size_t)DEPTH * DIN * D * 2);
    p.WtOut = (bf16*)carve((size_t)DEPTH * D * D * 2);
    p.WtQ = (bf16*)carve((size_t)DEPTH * 2048 * D * 2);
    p.X = (bf16*)carve((size_t)T * D * 2);
    p.H = (bf16*)carve((size_t)T * D * 2);
    p.P = (bf16*)carve((size_t)T * DIN * 2);
    p.KV = (float*)carve((size_t)2 * NB * NPOS * 4 * 4096 * 4);
    p.MIX = (bf16*)carve((size_t)T * D * 2);
    p.ST16 = (bf16*)carve((size_t)2 * NB * NPOS * 4 * 4096 * 2);
    p.Qb = (bf16*)carve((size_t)T * 2048 * 2);
    p.U8 = (unsigned char*)carve((size_t)DEPTH * PEER_N * D);
    p.V8 = (unsigned char*)carve((size_t)DEPTH * PEER_N * D);
    p.XQ = (unsigned char*)carve((size_t)T * D);
    p.SX = (float*)carve((size_t)T * 4);
    p.SU = (float*)carve((size_t)DEPTH * PEER_N * 4);
    p.SV = (float*)carve((size_t)DEPTH * PEER_N * 4);
    p.Y = (bf16*)carve((size_t)T * D * 2);
    p.X1 = (bf16*)carve((size_t)T * D * 2);
    p.GATE = (float*)carve((size_t)T * NSEL * 4);
    p.ACT = (float*)carve((size_t)T * NSEL * 4);
    p.EIDX = (int*)carve((size_t)T * NSEL * 4);
    if (off > ws_size) { fprintf(stderr, "workspace too small: need %zu have %zu\n", off, ws_size); return; }
    (void)hipMemsetAsync(p.ctl, 0, CTL_BYTES, stream);
    void* args[] = {&p};
    hipError_t e = hipLaunchCooperativeKernel((void*)mega, dim3(grid_blocks), dim3(NT), args, LDS_BYTES, stream);
    if (e != hipSuccess) fprintf(stderr, "cooperative launch failed: %s (grid %d)\n", hipGetErrorString(e), grid_blocks);
}
```

```cpp
#include <hip/hip_runtime.h>
#include <hip/hip_cooperative_groups.h>
#include <cstdio>
#include <cstdint>
namespace cg = cooperative_groups;

constexpr int D = 1024, NB = 2, SEQ = 8192, DEPTH = 4, LC = 256, HD = 64;
constexpr int TL = NB * SEQ, TC = NB * LC, T = TL + TC;
constexpr int DIN = 2304;
constexpr int C_RQ = 0, C_RK = 256, C_RV = 512, C_RG = 768, C_SU = 1024, C_SV = 1280, C_AQ = 1536, C_AK = 2048, C_AV = 2176;
constexpr int NPOS = 66;
constexpr int PEER_N = 16384, NSEL = 128;
constexpr float LN_EPS = 1e-5f;
constexpr float ALPHA = 1.681792830507429f;
constexpr int NT = 512;
constexpr int NW = 8;
constexpr int LDS_BYTES = 163840;
constexpr int MISC_OFF = LDS_BYTES - 256;

typedef unsigned short bf16;
#define LAS __attribute__((address_space(3)))

struct Params {
    const float *x, *c, *ctx, *c_ctx, *w_mod, *b_mod, *w_in, *w_out, *rdf, *rdb, *sgu_w, *sgu_b, *sink, *lnm_g, *lnm_b, *wq, *k1, *k2, *pu, *pv, *lnf_g, *lnf_b;
    float* out;
    unsigned* ctl;
    float *modp, *mod, *rope, *KV, *GATE, *ACT;
    bf16 *X, *X1, *Y;
    bf16 *WtIn, *WtOut, *WtQ, *H, *P, *MIX, *Qb, *ST16;
    unsigned char *U8, *V8, *XQ;
    float *SU, *SV, *SX;
    int *EIDX;
};

__device__ __forceinline__ unsigned f2bf(float f) { return (unsigned)__builtin_bit_cast(unsigned short, (__bf16)f); }
typedef float f32x2_pk __attribute__((ext_vector_type(2))); typedef __bf16 bf16x2_pk __attribute__((ext_vector_type(2)));
__device__ __forceinline__ unsigned pk2(float lo, float hi) { const f32x2_pk v = {lo, hi}; return __builtin_bit_cast(unsigned, __builtin_convertvector(v, bf16x2_pk)); }
__device__ __forceinline__ float bf2f(bf16 v) { return __builtin_bit_cast(float, (unsigned)v << 16); }
__device__ __forceinline__ float bflo(unsigned w) { return __builtin_bit_cast(float, w << 16); }
__device__ __forceinline__ float bfhi(unsigned w) { return __builtin_bit_cast(float, w & 0xffff0000u); }

__device__ __forceinline__ float gelu_tanh(float x) {
    const float u2 = x * (1.5957691216057308f + 0.07135481627f * x * x);
    return x * __builtin_amdgcn_rcpf(1.0f + __builtin_amdgcn_exp2f(-1.4426950408889634f * u2));
}
__device__ __forceinline__ float silu_f(float x) { return x * __builtin_amdgcn_rcpf(1.0f + __builtin_amdgcn_exp2f(-1.4426950408889634f * x)); }
__device__ __forceinline__ int chunk_row0(int b, int pos) { return pos < 2 ? TL + b * LC + pos * 128 : b * SEQ + (pos - 2) * 128; }
__device__ __forceinline__ int mod_idx(int r) { return r < TL ? r / SEQ : 2; }
__device__ __forceinline__ float log_sigmoid_f(float x) { return -log1pf(expf(-x)); }
typedef const __attribute__((address_space(4))) Params* KP;
__device__ __forceinline__ KP kparams() { KP k = (KP)__builtin_amdgcn_kernarg_segment_ptr(); asm volatile("" : "+s"(k)); return k; }
__device__ __forceinline__ float shx(float v, int m, int lane) { return __builtin_bit_cast(float, __builtin_amdgcn_ds_bpermute((lane ^ m) << 2, __builtin_bit_cast(int, v))); }
__device__ __forceinline__ int shx(int v, int m, int lane) { return __builtin_amdgcn_ds_bpermute((lane ^ m) << 2, v); }
__device__ __forceinline__ float shf(float v, int src) { return __builtin_bit_cast(float, __builtin_amdgcn_ds_bpermute(src << 2, __builtin_bit_cast(int, v))); }
__device__ __forceinline__ int shf(int v, int src) { return __builtin_amdgcn_ds_bpermute(src << 2, v); }
__device__ __forceinline__ float wave_sum(float v, int lane) {
#pragma unroll
    for (int o = 32; o >= 1; o >>= 1) v += shx(v, o, lane);
    return v;
}
__device__ __forceinline__ int lane_opaque() { unsigned m = ~0u; asm volatile("" : "+s"(m)); return (int)__builtin_amdgcn_mbcnt_hi(m, __builtin_amdgcn_mbcnt_lo(m, 0u)); }
__device__ __forceinline__ int tid_opaque(int wv) { return wv * 64 + lane_opaque(); }

namespace pg8 {
#define PG8_LAS __attribute__((address_space(3)))
typedef unsigned short bf16_t;
typedef short bf16x8 __attribute__((ext_vector_type(8)));
typedef float f32x4 __attribute__((ext_vector_type(4)));
typedef unsigned u32x4 __attribute__((ext_vector_type(4)));
constexpr int BM = 256, BK = 64, HALF = 128, HTB = HALF * BK * 2  , STAGE_BYTES = 8 * HTB, NXCD = 8, WGM = 8;

__host__ __device__ __forceinline__ int lds_byte(int r, int c) { const int st = (r >> 4) * 2 + (c >> 5), rr = r & 15, cc = c & 31, ob = rr * 64 + cc * 2; return st * 1024 + (ob ^ (((ob >> 9) & 1) << 5)); }
__host__ __device__ __forceinline__ void stage_rc(int b, int& R, int& C) { const int st = b / 1024, sb = b % 1024, swz = sb ^ (((sb >> 9) & 1) << 5); R = (st >> 1) * 16 + swz / 64; C = (st & 1) * 32 + (swz % 64) / 2; }
__host__ __device__ __forceinline__ int perm32(int rho) { const int n = rho >> 4, i = rho & 15; return 8 * (i >> 2) + 4 * n + (i & 3); }

struct Unit { int pm, pn; };
struct Gemm { const bf16_t* A; const bf16_t* Bt; int M, N, K; };

struct StaticOrder {
    int nM, nN, nwg, G, c;
    __host__ __device__ void init(int M, int N, int G_, int c_) { nM = M / BM; nN = N / BM; nwg = nM * nN; G = G_; c = c_; }
    __host__ __device__ bool next(int i, Unit& u) const {
        const long L = (long)i * G + c; if (L >= nwg) return false;
        int wgid = (int)L; { const int q = nwg / NXCD, r = nwg % NXCD, xcd = wgid % NXCD, off = wgid / NXCD; wgid = (xcd < r ? xcd * (q + 1) : r * (q + 1) + (xcd - r) * q) + off; }
        const int nig = WGM * nN, gid = wgid / nig, fm = gid * WGM, gsz = (nM - fm) < WGM ? (nM - fm) : WGM;
        u.pm = fm + ((wgid % nig) % gsz); u.pn = (wgid % nig) / gsz; return true;
    }
    __device__ __forceinline__ void a_ready(const Unit&) const {}
    __device__ __forceinline__ void done(const Unit&) const {}
};

__device__ __forceinline__ unsigned cvt_pk_bf16(float lo, float hi) { unsigned r; asm volatile("v_cvt_pk_bf16_f32 %0, %1, %2" : "=v"(r) : "v"(lo), "v"(hi)); return r; }
struct EpiInProj {
    static constexpr bool PERM = true, AFTER_DRAIN = false;
    bf16_t* P; const float* rope;
    __device__ __forceinline__ void operator()(const f32x4 (&acc)[2][2][4][2], const Unit& u, int wr, int wc, int fr, int fq) const {
        const int pn = u.pn; const bool lat = u.pm < 64; const int lane = fq * 16 + fr;
        const float sc = pn == 1 ? 0.125f : ((pn == 6 || pn == 7) ? 0.125f * 1.4426950408889634f : 1.0f);
        const float sgn = fq < 2 ? -1.0f : 1.0f;
#pragma unroll
        for (int bj = 0; bj < 2; ++bj) {
            const bool roped = lat && (pn == 0 || pn == 1 || pn == 6 || pn == 7 || (pn == 8 && bj == 0));
#pragma unroll
            for (int ai = 0; ai < 2; ++ai)
#pragma unroll
                for (int m = 0; m < 4; ++m) {
                    const int row = u.pm * BM + ai * HALF + wr * 64 + m * 16 + fr;
                    f32x4 v0 = acc[ai][bj][m][0], v1 = acc[ai][bj][m][1];
                    if (roped) {
                        const int pos = row & 8191, idx = (wc & 1) ? 128 + (pos & 63) : (pos >> 6);
                        const float2* tb = (const float2*)rope + idx * 16 + 8 * (fq & 1);
#pragma unroll
                        for (int e = 0; e < 4; ++e) {
                            const float p0 = shx(v0[e], 32, lane), p1 = shx(v1[e], 32, lane);
                            const float2 c0 = tb[e], c1 = tb[4 + e];
                            v0[e] = v0[e] * c0.x + sgn * p0 * c0.y;
                            v1[e] = v1[e] * c1.x + sgn * p1 * c1.y;
                        }
                    }
                    v0 = v0 * sc; v1 = v1 * sc;
                    u32x4 w; w.x = cvt_pk_bf16(v0[0], v0[1]); w.y = cvt_pk_bf16(v0[2], v0[3]); w.z = cvt_pk_bf16(v1[0], v1[1]); w.w = cvt_pk_bf16(v1[2], v1[3]);
                    *(u32x4*)(P + (size_t)row * 2304 + pn * BM + bj * HALF + wc * 32 + fq * 8) = w;
                    __builtin_amdgcn_sched_barrier(0);
                }
        }
    }
};
struct EpiF32 {
    static constexpr bool PERM = false, AFTER_DRAIN = false;
    float* O; int ldc;
    __device__ __forceinline__ void operator()(const f32x4 (&acc)[2][2][4][2], const Unit& u, int wr, int wc, int fr, int fq) const {
#pragma unroll
        for (int ai = 0; ai < 2; ++ai)
#pragma unroll
            for (int m = 0; m < 4; ++m) {
                float* rowp = O + (size_t)(u.pm * BM + ai * HALF + wr * 64 + m * 16 + fr) * ldc + u.pn * BM + wc * 32 + fq * 4;
#pragma unroll
                for (int bj = 0; bj < 2; ++bj)
#pragma unroll
                    for (int n = 0; n < 2; ++n) *(f32x4*)(rowp + bj * HALF + n * 16) = acc[ai][bj][m][n];
            }
    }
};


struct EpiBf16Plain {
    static constexpr bool PERM = true, AFTER_DRAIN = false;
    bf16_t* O; int ldc;
    __device__ __forceinline__ void operator()(const f32x4 (&acc)[2][2][4][2], const Unit& u, int wr, int wc, int fr, int fq) const {
#pragma unroll
        for (int ai = 0; ai < 2; ++ai)
#pragma unroll
            for (int m = 0; m < 4; ++m) {
                bf16_t* rowp = O + (size_t)(u.pm * BM + ai * HALF + wr * 64 + m * 16 + fr) * ldc + u.pn * BM + wc * 32 + fq * 8;
#pragma unroll
                for (int bj = 0; bj < 2; ++bj) {
                    const f32x4 v0 = acc[ai][bj][m][0], v1 = acc[ai][bj][m][1];
                    u32x4 w; w.x = cvt_pk_bf16(v0[0], v0[1]); w.y = cvt_pk_bf16(v0[2], v0[3]); w.z = cvt_pk_bf16(v1[0], v1[1]); w.w = cvt_pk_bf16(v1[2], v1[3]);
                    *(u32x4*)(rowp + bj * HALF) = w;
                }
            }
    }
};
template <class Epi, class Sched, bool ALIGN_EPI = false, bool SP2 = false>
__device__ __forceinline__ void gemm_phase(PG8_LAS unsigned char* lds, const Gemm g, const Sched& S, const Epi& E, int wv) {
    int tid_ = wv * 64; { unsigned m_ = ~0u; asm volatile("" : "+s"(m_)); tid_ += (int)__builtin_amdgcn_mbcnt_hi(m_, __builtin_amdgcn_mbcnt_lo(m_, 0u)); }
    const int tid = tid_, wid = __builtin_amdgcn_readfirstlane(tid >> 6), lane = tid & 63, wr = wid >> 2, wc = wid & 3, fr = lane & 15, fq = lane >> 4;
    const int K = g.K, nt = K / BK;
    unsigned voffA[2], voffB[2];
#pragma unroll
    for (int i = 0; i < 2; ++i) { int R, C; stage_rc(tid * 16 + i * 8192, R, C); const int Rb = Epi::PERM ? ((R & ~31) + perm32(R & 31)) : R;
        voffA[i] = (unsigned)(R * K + C) * 2u; voffB[i] = (unsigned)(Rb * K + C) * 2u; }
    const size_t kstep = (size_t)(BK * 2);
    const size_t hstep = (size_t)HALF * K * 2;
    const size_t tstep = 2 * hstep;
    const unsigned ldsw = (unsigned)wid * 1024u;
    const int aoff = lds_byte(wr * 64 + fr, fq * 8), boff = lds_byte(wc * 32 + fr, fq * 8);
#define PG8_SA(b, h) (((b) * 2 + (h)) * HTB)
#define PG8_SB(b, h) ((4 + (b) * 2 + (h)) * HTB)
#define PG8_STAGE(bufoff, gbase, voff) do { _Pragma("unroll") for (int _i = 0; _i < 2; ++_i) \
        __builtin_amdgcn_global_load_lds((const unsigned*)((const char*)(gbase) + (voff)[_i]), (PG8_LAS unsigned*)(lds + (bufoff) + ldsw + _i * 8192), 16, 0, 0); } while (0)
#define PG8_LDA(dst, b, h) do { _Pragma("unroll") for (int m = 0; m < 4; ++m) _Pragma("unroll") for (int k = 0; k < 2; ++k) dst[m][k] = *(const PG8_LAS bf16x8*)(lds + PG8_SA(b, h) + aoff + m * 2048 + k * 1024); } while (0)
#define PG8_LDB(dst, b, h) do { _Pragma("unroll") for (int n = 0; n < 2; ++n) _Pragma("unroll") for (int k = 0; k < 2; ++k) dst[n][k] = *(const PG8_LAS bf16x8*)(lds + PG8_SB(b, h) + boff + n * 2048 + k * 1024); } while (0)
#define PG8_MMA(ai, bj, At, Bt) do { __builtin_amdgcn_s_setprio(1); _Pragma("unroll") for (int m = 0; m < 4; ++m) _Pragma("unroll") for (int n = 0; n < 2; ++n) _Pragma("unroll") for (int k = 0; k < 2; ++k) \
        acc[ai][bj][m][n] = __builtin_amdgcn_mfma_f32_16x16x32_bf16(Bt[n][k], At[m][k], acc[ai][bj][m][n], 0, 0, 0); __builtin_amdgcn_s_setprio(0); } while (0)
#define PG8_WAIT_V(n) asm volatile("s_waitcnt vmcnt(" #n ")" ::: "memory")
#define PG8_WAIT_L(n) asm volatile("s_waitcnt lgkmcnt(" #n ")" ::: "memory")
#define PG8_BAR __builtin_amdgcn_s_barrier()
#define PG8_SCHED __builtin_amdgcn_sched_barrier(0)
    Unit cur, nxt; int ui = 0;
    if (!S.next(0, cur)) return;
    f32x4 acc[2][2][4][2];
#pragma unroll
    for (int a = 0; a < 2; ++a)
#pragma unroll
        for (int b = 0; b < 2; ++b)
#pragma unroll
            for (int m = 0; m < 4; ++m)
#pragma unroll
                for (int n = 0; n < 2; ++n) acc[a][b][m][n] = (f32x4){0.f, 0.f, 0.f, 0.f};
    bf16x8 At[4][2], B0[2][2], B1[2][2];
    const char* cA = (const char*)g.A + (size_t)cur.pm * tstep; const char* cB = (const char*)g.Bt + (size_t)cur.pn * tstep;
    S.a_ready(cur);
    if constexpr (SP2) {
        PG8_STAGE(PG8_SB(0, 0), cB, voffB); PG8_STAGE(PG8_SB(0, 1), cB + hstep, voffB); PG8_STAGE(PG8_SA(0, 0), cA, voffA); PG8_STAGE(PG8_SA(0, 1), cA + hstep, voffA);
        if (wr == 1) PG8_BAR;
        PG8_WAIT_V(2); PG8_BAR;
        PG8_STAGE(PG8_SB(1, 0), cB + kstep, voffB); PG8_STAGE(PG8_SA(1, 0), cA + kstep, voffA); PG8_STAGE(PG8_SB(1, 1), cB + hstep + kstep, voffB);
        PG8_WAIT_V(6); PG8_BAR;
    } else {
        PG8_STAGE(PG8_SB(0, 0), cB, voffB); PG8_STAGE(PG8_SA(0, 0), cA, voffA); PG8_STAGE(PG8_SB(0, 1), cB + hstep, voffB); PG8_STAGE(PG8_SA(0, 1), cA + hstep, voffA);
        if (wr == 1) PG8_BAR;
        PG8_WAIT_V(4); PG8_BAR;
        PG8_STAGE(PG8_SB(1, 0), cB + kstep, voffB); PG8_STAGE(PG8_SA(1, 0), cA + kstep, voffA); PG8_STAGE(PG8_SB(1, 1), cB + hstep + kstep, voffB);
        PG8_WAIT_V(6); PG8_BAR;
    }
    for (;;) {
        const bool has_next = S.next(ui + 1, nxt);
        const char* nA = has_next ? (const char*)g.A + (size_t)nxt.pm * tstep : cA; const char* nB = has_next ? (const char*)g.Bt + (size_t)nxt.pn * tstep : cB;
        for (int t = 0; t < nt; t += 2) {
            const bool last = (t == nt - 2);
            const char* a1 = cA + (size_t)(t + 1) * kstep;
            const char* a2 = last ? nA : cA + (size_t)(t + 2) * kstep; const char* b2 = last ? nB : cB + (size_t)(t + 2) * kstep;
            const char* a3 = a2 + kstep; const char* b3 = b2 + kstep;
            if (last && has_next) S.a_ready(nxt);
            if constexpr (SP2) {
            PG8_LDB(B0, 0, 0); PG8_LDB(B1, 0, 1); PG8_SCHED; PG8_LDA(At, 0, 0); PG8_STAGE(PG8_SA(1, 1), a1 + hstep, voffA);
            PG8_WAIT_V(8); PG8_WAIT_L(0); PG8_BAR; PG8_MMA(0, 0, At, B0); PG8_MMA(0, 1, At, B1); PG8_BAR; PG8_SCHED;
            PG8_LDA(At, 0, 1); PG8_STAGE(PG8_SB(0, 0), b2, voffB); PG8_STAGE(PG8_SB(0, 1), b2 + hstep, voffB); PG8_STAGE(PG8_SA(0, 0), a2, voffA);
            PG8_WAIT_V(8); PG8_WAIT_L(0); PG8_BAR; PG8_MMA(1, 0, At, B0); PG8_MMA(1, 1, At, B1); PG8_BAR; PG8_SCHED;
            PG8_LDB(B0, 1, 0); PG8_LDB(B1, 1, 1); PG8_SCHED; PG8_LDA(At, 1, 0); PG8_STAGE(PG8_SA(0, 1), a2 + hstep, voffA);
            PG8_WAIT_V(8); PG8_WAIT_L(0); PG8_BAR; PG8_MMA(0, 0, At, B0); PG8_MMA(0, 1, At, B1); PG8_BAR; PG8_SCHED;
            PG8_LDA(At, 1, 1); PG8_STAGE(PG8_SB(1, 0), b3, voffB); PG8_STAGE(PG8_SB(1, 1), b3 + hstep, voffB); PG8_STAGE(PG8_SA(1, 0), a3, voffA);
            PG8_WAIT_V(8); PG8_WAIT_L(0); PG8_BAR; PG8_MMA(1, 0, At, B0); PG8_MMA(1, 1, At, B1); PG8_BAR; PG8_SCHED;
            } else {
            PG8_LDB(B0, 0, 0); PG8_SCHED; PG8_LDA(At, 0, 0); PG8_STAGE(PG8_SA(1, 1), a1 + hstep, voffA);
            PG8_WAIT_L(8); PG8_BAR; PG8_WAIT_L(0); PG8_MMA(0, 0, At, B0); PG8_BAR; PG8_SCHED;
            PG8_LDB(B1, 0, 1); PG8_STAGE(PG8_SB(0, 0), b2, voffB);
            PG8_BAR; PG8_WAIT_L(0); PG8_MMA(0, 1, At, B1); PG8_BAR;
            PG8_LDA(At, 0, 1); PG8_STAGE(PG8_SA(0, 0), a2, voffA);
            PG8_BAR; PG8_WAIT_L(0); PG8_MMA(1, 0, At, B0); PG8_BAR; PG8_SCHED;
            PG8_STAGE(PG8_SB(0, 1), b2 + hstep, voffB);
            PG8_WAIT_V(6); PG8_BAR; PG8_MMA(1, 1, At, B1); PG8_BAR;
            PG8_LDB(B0, 1, 0); PG8_SCHED; PG8_LDA(At, 1, 0); PG8_STAGE(PG8_SA(0, 1), a2 + hstep, voffA);
            PG8_WAIT_L(8); PG8_BAR; PG8_WAIT_L(0); PG8_MMA(0, 0, At, B0); PG8_BAR; PG8_SCHED;
            PG8_LDB(B1, 1, 1); PG8_STAGE(PG8_SB(1, 0), b3, voffB);
            PG8_BAR; PG8_WAIT_L(0); PG8_MMA(0, 1, At, B1); PG8_BAR;
            PG8_LDA(At, 1, 1); PG8_STAGE(PG8_SA(1, 0), a3, voffA);
            PG8_BAR; PG8_WAIT_L(0); PG8_MMA(1, 0, At, B0); PG8_BAR; PG8_SCHED;
            PG8_STAGE(PG8_SB(1, 1), b3 + hstep, voffB);
            PG8_WAIT_V(6); PG8_BAR; PG8_MMA(1, 1, At, B1); PG8_BAR;
            }
        }
        if constexpr (ALIGN_EPI) { if (wr == 0) PG8_BAR; }
        if constexpr (!Epi::AFTER_DRAIN) { E(acc, cur, wr, wc, fr, fq); S.done(cur); }
        if (!has_next) break;
#pragma unroll
        for (int a = 0; a < 2; ++a)
#pragma unroll
            for (int b = 0; b < 2; ++b)
#pragma unroll
                for (int m = 0; m < 4; ++m)
#pragma unroll
                    for (int n = 0; n < 2; ++n) acc[a][b][m][n] = (f32x4){0.f, 0.f, 0.f, 0.f};
        cur = nxt; cA = nA; cB = nB; ++ui;
        if constexpr (ALIGN_EPI) { if (wr == 1) PG8_BAR; }
    }
    PG8_WAIT_V(0);
    if constexpr (!ALIGN_EPI) { if (wr == 0) PG8_BAR; }
    PG8_BAR;
    if constexpr (Epi::AFTER_DRAIN) { E.fused(acc, cur, wr, wc, fr, fq, lds, wid, lane); S.done(cur); }
#undef PG8_SA
#undef PG8_SB
#undef PG8_STAGE
#undef PG8_LDA
#undef PG8_LDB
#undef PG8_MMA
#undef PG8_WAIT_V
#undef PG8_WAIT_L
#undef PG8_BAR
#undef PG8_SCHED
}
}
constexpr int CW_BAR = 4096;
constexpr size_t CTL_BYTES = 65536;
#define XB_TMO      128
#define XB_XCNT(j)  (256  + 64 * (j))
#define XB_XSUB(j)  (1280 + 64 * (j))
#define XB_XGEN(j)  (2304 + 64 * (j))
#define XB_TOP      3328
#define XB_TOPGEN   3392
#define XCD_BAR_WORDS 3456
#define XB_SPIN_CAP (1u << 18)

__device__ __forceinline__ unsigned xb_ld(unsigned* p)              { return __hip_atomic_load(p, __ATOMIC_RELAXED, __HIP_MEMORY_SCOPE_AGENT); }
__device__ __forceinline__ unsigned xb_add(unsigned* p, unsigned v) { return __hip_atomic_fetch_add(p, v, __ATOMIC_RELAXED, __HIP_MEMORY_SCOPE_AGENT); }
__device__ __forceinline__ unsigned xb_xcc_id() { return (unsigned)__builtin_amdgcn_s_getreg((3 << 11) | 20) & 0xFu; }
#define XB_SPIN(cond, bar) do { unsigned _sp = 0; while (cond) { __builtin_amdgcn_s_sleep(1); \
    if ((++_sp & 255u) == 0u) { if (xb_ld(&(bar)[XB_TMO])) break; if (_sp > XB_SPIN_CAP) { atomicAdd(&(bar)[XB_TMO], 1u); break; } } } } while (0)

struct XcdBarrier {
    unsigned* bar; unsigned x; bool lead;
    volatile LAS unsigned* st;
};

__device__ __forceinline__ XcdBarrier xcd_barrier_post(unsigned* bar, volatile LAS unsigned* st, bool lead) {
    XcdBarrier b; b.bar = bar; b.x = xb_xcc_id(); b.st = st; b.lead = lead;
    if (b.lead) (void)xb_add(&bar[XB_XCNT(b.x)], 1u);
    return b;
}
__device__ __forceinline__ void xcd_barrier_complete(unsigned* bar, unsigned x, unsigned& nloc, unsigned& nx) {
    const unsigned G = gridDim.x * gridDim.y * gridDim.z;
    unsigned sum, cnt, mine, sp = 0u;
    for (;;) {
        sum = 0u; cnt = 0u; mine = 0u;
#pragma unroll
        for (unsigned j = 0; j < 16; ++j) { const unsigned c = xb_ld(&bar[XB_XCNT(j)]); sum += c; cnt += (c > 0u) ? 1u : 0u; mine = (j == x) ? c : mine; }
        if (sum == G) break;
        __builtin_amdgcn_s_sleep(1);
        if ((++sp & 255u) == 0u) { if (xb_ld(&bar[XB_TMO])) break; if (sp > XB_SPIN_CAP) { atomicAdd(&bar[XB_TMO], 1u); break; } }
    }
    nloc = mine > 0u ? mine : 1u; nx = cnt > 0u ? cnt : 1u;
}

__device__ __forceinline__ void xcd_barrier(const XcdBarrier& b) {
    asm volatile("s_waitcnt vmcnt(0)" ::: "memory");
    __syncthreads();
    if (b.lead) {
        unsigned* bar = b.bar;
        __builtin_amdgcn_s_waitcnt(0);
        unsigned nloc = b.st[0], nx = b.st[1];
        if (nloc == 0u) { xcd_barrier_complete(bar, b.x, nloc, nx); b.st[0] = nloc; b.st[1] = nx; }
        const unsigned old = xb_add(&bar[XB_XSUB(b.x)], 1u);
        const unsigned gen = old / nloc;
        if (old + 1u == (gen + 1u) * nloc) {
            __builtin_amdgcn_fence(__ATOMIC_RELEASE, "agent");
            asm volatile("s_waitcnt vmcnt(0)" ::: "memory");
            const unsigned og = xb_add(&bar[XB_TOP], 1u);
            const unsigned tg = og / nx;
            if (og + 1u == (tg + 1u) * nx) xb_add(&bar[XB_TOPGEN], 1u);
            else XB_SPIN(xb_ld(&bar[XB_TOPGEN]) == tg, bar);
            __builtin_amdgcn_fence(__ATOMIC_ACQUIRE, "agent");
            xb_add(&bar[XB_XGEN(b.x)], 1u);
            asm volatile("s_waitcnt vmcnt(0)" ::: "memory");
        } else {
            XB_SPIN(xb_ld(&bar[XB_XGEN(b.x)]) == gen, bar);
            __builtin_amdgcn_fence(__ATOMIC_ACQUIRE, "agent");
            asm volatile("s_waitcnt vmcnt(0)" ::: "memory");
        }
    }
    __syncthreads();
}


__device__ __forceinline__ void phase_mod1(KP p, int wv, int bid, int nb, float* lds) {
    float* red = lds;
    const int t = tid_opaque(wv), cg4 = t & 63, kg = t >> 6;
    for (int u = bid; u < DEPTH * 24 * 16; u += nb) {
        const int ks = u & 15, nblk = (u >> 4) % 24, l = u / (16 * 24);
        const int n = nblk * 256 + cg4 * 4;
        float4 wr[8];
#pragma unroll
        for (int kk = 0; kk < 8; ++kk) wr[kk] = *(const float4*)(p->w_mod + ((size_t)l * D + ks * 64 + kg * 8 + kk) * 6144 + n);
        float a[3][4];
#pragma unroll
        for (int v = 0; v < 3; ++v)
#pragma unroll
            for (int j = 0; j < 4; ++j) a[v][j] = 0.f;
#pragma unroll
        for (int kk = 0; kk < 8; ++kk) {
            const int k = ks * 64 + kg * 8 + kk;
            const float s0 = silu_f(p->c[k]), s1 = silu_f(p->c[D + k]), s2 = silu_f(p->c_ctx[k]);
            a[0][0] += s0 * wr[kk].x; a[0][1] += s0 * wr[kk].y; a[0][2] += s0 * wr[kk].z; a[0][3] += s0 * wr[kk].w;
            a[1][0] += s1 * wr[kk].x; a[1][1] += s1 * wr[kk].y; a[1][2] += s1 * wr[kk].z; a[1][3] += s1 * wr[kk].w;
            a[2][0] += s2 * wr[kk].x; a[2][1] += s2 * wr[kk].y; a[2][2] += s2 * wr[kk].z; a[2][3] += s2 * wr[kk].w;
        }
        __syncthreads();
#pragma unroll
        for (int v = 0; v < 3; ++v) *(float4*)(red + (v * 8 + kg) * 256 + cg4 * 4) = make_float4(a[v][0], a[v][1], a[v][2], a[v][3]);
        __syncthreads();
        for (int o = t; o < 768; o += NT) {
            const int v = o >> 8, col = o & 255;
            float sm = 0.f;
#pragma unroll
            for (int g = 0; g < 8; ++g) sm += red[(v * 8 + g) * 256 + col];
            p->modp[(((size_t)ks * DEPTH + l) * 3 + v) * 6144 + nblk * 256 + col] = sm;
        }
    }
    __syncthreads();
}
__device__ __forceinline__ void phase_mod2(KP p, int wv, int bid, int nb) {
    for (int i = bid * NT + tid_opaque(wv); i < DEPTH * 3 * 6144; i += nb * NT) {
        const int n = i % 6144, l = i / (3 * 6144);
        float s = p->b_mod[l * 6144 + n];
        for (int ks = 0; ks < 16; ++ks) s += p->modp[(size_t)ks * DEPTH * 3 * 6144 + i];
        p->mod[i] = s;
    }
}
__device__ __forceinline__ void transpose_item(const float* W, int K, int N, bf16* WT, float* scr, int item, int lane) {
    const int nblk = N / 64, kb = item / nblk, nbk = item % nblk, k0 = 64 * kb, n0 = 64 * nbk;
    const int r4 = lane >> 4, c4 = lane & 15;
#pragma unroll 8
    for (int i = 0; i < 16; ++i) { const int kk = 4 * i + r4; const float4 q = *(const float4*)(W + (size_t)(k0 + kk) * N + n0 + c4 * 4);
        float* d = scr + kk * 65 + c4 * 4; d[0] = q.x; d[1] = q.y; d[2] = q.z; d[3] = q.w; }
    __builtin_amdgcn_wave_barrier();
    const int c = lane & 7;
#pragma unroll
    for (int j = 0; j < 8; ++j) { const int n = (lane >> 3) + 8 * j; const float* sp = scr + (8 * c) * 65 + n;
        uint4 o; o.x = pk2(sp[0 * 65], sp[1 * 65]); o.y = pk2(sp[2 * 65], sp[3 * 65]); o.z = pk2(sp[4 * 65], sp[5 * 65]); o.w = pk2(sp[6 * 65], sp[7 * 65]);
        *(uint4*)(WT + (size_t)(n0 + n) * K + k0 + 8 * c) = o; }
    __builtin_amdgcn_wave_barrier();
}
__device__ __forceinline__ void phase_tables(KP p, int wv, int l, int vb, int nvb) {
    {
        const int lane_ = tid_opaque(wv) & 63, w_ = tid_opaque(wv) >> 6;
        for (int row0 = (vb * NW + w_) * 4; row0 < 2 * PEER_N; row0 += nvb * NW * 4) {
            float v[4][16];
#pragma unroll
            for (int q = 0; q < 4; ++q) {
                const int row = row0 + q; const bool isv = row >= PEER_N; const int rr = l * PEER_N + (isv ? row - PEER_N : row);
                const float* src_ = (isv ? p->pv : p->pu) + (size_t)rr * D;
#pragma unroll
                for (int i = 0; i < 4; ++i) { typedef float f4v_ __attribute__((ext_vector_type(4))); const f4v_ q4 = __builtin_nontemporal_load((const f4v_*)(src_ + i * 256 + lane_ * 4)); v[q][i * 4 + 0] = q4[0]; v[q][i * 4 + 1] = q4[1]; v[q][i * 4 + 2] = q4[2]; v[q][i * 4 + 3] = q4[3]; }
            }
#pragma unroll
            for (int q = 0; q < 4; ++q) {
                const int row = row0 + q; const bool isv = row >= PEER_N; const int rr = l * PEER_N + (isv ? row - PEER_N : row);
                float m = 0.f;
#pragma unroll
                for (int i = 0; i < 16; ++i) m = fmaxf(m, fabsf(v[q][i]));
#pragma unroll
                for (int o = 32; o >= 1; o >>= 1) m = fmaxf(m, shx(m, o, lane_));
                unsigned* dst = (unsigned*)((isv ? p->V8 : p->U8) + (size_t)rr * D);
                if (!isv) {
                    const float inv = m > 0.f ? 127.0f / m : 0.f;
#pragma unroll
                    for (int i = 0; i < 4; ++i) {
                        const int q0 = (int)rintf(v[q][i * 4 + 0] * inv), q1 = (int)rintf(v[q][i * 4 + 1] * inv), q2 = (int)rintf(v[q][i * 4 + 2] * inv), q3 = (int)rintf(v[q][i * 4 + 3] * inv);
                        dst[i * 64 + lane_] = (unsigned)(q0 & 0xff) | ((unsigned)(q1 & 0xff) << 8) | ((unsigned)(q2 & 0xff) << 16) | ((unsigned)(q3 & 0xff) << 24);
                    }
                    if (lane_ == 0) p->SU[rr] = m * (1.0f / 127.0f);
                } else {
                    const float inv = m > 0.f ? 240.0f / m : 0.f;
#pragma unroll
                    for (int i = 0; i < 4; ++i) {
                        int pk = __builtin_amdgcn_cvt_pk_fp8_f32(v[q][i * 4 + 0] * inv, v[q][i * 4 + 1] * inv, 0, false);
                        pk = __builtin_amdgcn_cvt_pk_fp8_f32(v[q][i * 4 + 2] * inv, v[q][i * 4 + 3] * inv, pk, true);
                        dst[i * 64 + lane_] = (unsigned)pk;
                    }
                    if (lane_ == 0) p->SV[rr] = m * (1.0f / 240.0f);
                }
            }
        }
    }
}

__device__ __forceinline__ void phase_weights(KP p, int wv, int bid, int nb, float* lds) {
    const int lane = tid_opaque(wv) & 63, w = tid_opaque(wv) >> 6;
    float* scr = lds + w * (64 * 65 + 32);
    constexpr int I_IN = 16 * 36, I_OUT = 16 * 16, I_Q = 16 * 32;
    constexpr int NITEMS = DEPTH * (I_IN + I_OUT + I_Q);
    for (int it = bid * NW + w; it < NITEMS; it += nb * NW) {
        int r = it;
        if (r < DEPTH * I_IN) { const int l = r / I_IN; transpose_item(p->w_in + (size_t)l * D * DIN, D, DIN, p->WtIn + (size_t)l * DIN * D, scr, r % I_IN, lane); continue; } r -= DEPTH * I_IN;
        if (r < DEPTH * I_OUT) { const int l = r / I_OUT; transpose_item(p->w_out + (size_t)l * D * D, D, D, p->WtOut + (size_t)l * D * D, scr, r % I_OUT, lane); continue; } r -= DEPTH * I_OUT;
        { const int l = r / I_Q; transpose_item(p->wq + (size_t)l * D * 2048, D, 2048, p->WtQ + (size_t)l * 2048 * D, scr, r % I_Q, lane); }
    }
    for (int i = bid * NT + tid_opaque(wv); i < 192 * 16; i += nb * NT) {
        const int idx = i >> 4, f = i & 15;
        const float inv = powf(10000.0f, -(float)f / 16.0f);
        const float ang = (float)(idx < 128 ? idx : idx - 128) * inv;
        p->rope[2 * i] = cosf(ang); p->rope[2 * i + 1] = sinf(ang);
    }
}

__device__ __forceinline__ void row_load(const float* src, float (&v)[16], int lane) {
#pragma unroll
    for (int i = 0; i < 4; ++i) { const float4 q = *(const float4*)(src + i * 256 + lane * 4); v[i * 4 + 0] = q.x; v[i * 4 + 1] = q.y; v[i * 4 + 2] = q.z; v[i * 4 + 3] = q.w; }
}
__device__ __forceinline__ void row_store(float* dst, const float (&v)[16], int lane) {
#pragma unroll
    for (int i = 0; i < 4; ++i) *(float4*)(dst + i * 256 + lane * 4) = make_float4(v[i * 4 + 0], v[i * 4 + 1], v[i * 4 + 2], v[i * 4 + 3]);
}
__device__ __forceinline__ void row_store_bf(bf16* dst, const float (&v)[16], int lane) {
#pragma unroll
    for (int i = 0; i < 4; ++i) *(uint2*)(dst + i * 256 + lane * 4) = make_uint2(pk2(v[i * 4 + 0], v[i * 4 + 1]), pk2(v[i * 4 + 2], v[i * 4 + 3]));
}
__device__ __forceinline__ void row_load_bf(const bf16* src, float (&v)[16], int lane) {
#pragma unroll
    for (int i = 0; i < 4; ++i) { const uint2 q = *(const uint2*)(src + i * 256 + lane * 4); v[i * 4 + 0] = bflo(q.x); v[i * 4 + 1] = bfhi(q.x); v[i * 4 + 2] = bflo(q.y); v[i * 4 + 3] = bfhi(q.y); }
}
__device__ __forceinline__ void row_ln(float (&v)[16], int lane) {
    float s = 0.f;
#pragma unroll
    for (int i = 0; i < 16; ++i) s += v[i];
    const float mu = wave_sum(s, lane) * (1.0f / D);
    float q = 0.f;
#pragma unroll
    for (int i = 0; i < 16; ++i) { v[i] -= mu; q += v[i] * v[i]; }
    const float rstd = rsqrtf(wave_sum(q, lane) * (1.0f / D) + LN_EPS);
#pragma unroll
    for (int i = 0; i < 16; ++i) v[i] *= rstd;
}
__device__ __forceinline__ const float* x_row(KP p, int l, int r) {
    if (l == 0) return r < TL ? p->x + (size_t)r * D : p->ctx + (size_t)(r - TL) * D;
    return nullptr;
}

__device__ __forceinline__ void phase_lnmod(KP p, int wv, int l, int bid, int nb) {
    const int lane = tid_opaque(wv) & 63, w = tid_opaque(wv) >> 6;
    for (int r = bid * NW + w; r < T; r += nb * NW) {
        float v[16], sh[16], sc[16];
        row_load(x_row(p, l, r), v, lane);
        const float* m = p->mod + ((size_t)l * 3 + mod_idx(r)) * 6144;
        row_load(m, sh, lane); row_load(m + 1024, sc, lane);
        row_ln(v, lane);
#pragma unroll
        for (int i = 0; i < 16; ++i) v[i] = v[i] * (1.0f + sc[i]) + sh[i];
        row_store_bf(p->H + (size_t)r * D, v, lane);
    }
}

typedef short bf16x8_t __attribute__((ext_vector_type(8)));
typedef short bf16x4_t __attribute__((ext_vector_type(4)));
typedef float f32x4_t __attribute__((ext_vector_type(4)));
#define MFMA16(a, b, c) __builtin_amdgcn_mfma_f32_16x16x32_bf16((a), (b), (c), 0, 0, 0)
constexpr int KROW = 72;
constexpr int TROW = 136;
__device__ __forceinline__ bf16x8_t lds_frag16(const bf16* p) { return *(const bf16x8_t*)p; }
__device__ __forceinline__ bf16x8_t lds_frag8x2(const bf16* p0, const bf16* p1) {
    const bf16x4_t a = *(const bf16x4_t*)p0, b = *(const bf16x4_t*)p1;
    bf16x8_t o; o[0] = a[0]; o[1] = a[1]; o[2] = a[2]; o[3] = a[3]; o[4] = b[0]; o[5] = b[1]; o[6] = b[2]; o[7] = b[3]; return o;
}
__device__ __forceinline__ bf16x8_t pack_p(const f32x4_t& x, const f32x4_t& y) {
    uint4 w; w.x = pk2(x[0], x[1]); w.y = pk2(x[2], x[3]); w.z = pk2(y[0], y[1]); w.w = pk2(y[2], y[3]);
    return __builtin_bit_cast(bf16x8_t, w);
}
__device__ __forceinline__ void st_tr8(bf16* dst_col0, int stride, const uint4& v) {
    dst_col0[0 * stride] = (bf16)(v.x & 0xffffu); dst_col0[1 * stride] = (bf16)(v.x >> 16);
    dst_col0[2 * stride] = (bf16)(v.y & 0xffffu); dst_col0[3 * stride] = (bf16)(v.y >> 16);
    dst_col0[4 * stride] = (bf16)(v.z & 0xffffu); dst_col0[5 * stride] = (bf16)(v.z >> 16);
    dst_col0[6 * stride] = (bf16)(v.w & 0xffffu); dst_col0[7 * stride] = (bf16)(v.w >> 16);
}

constexpr int ATT_BUF = 128 * KROW + 64 * TROW;
__device__ __forceinline__ void att_unit(KP p, int wv, int l, int u, bf16* lds) {
    const int t = tid_opaque(wv), lane = t & 63, w = t >> 6, r = lane & 15, g = lane >> 4;
    const bool lat = u < 256;
    int b, n, hkv;
    if (lat) { hkv = u & 1; n = (u >> 1) & 63; b = u >> 7; } else { const int v = u - 256; hkv = v & 1; n = (v >> 1) & 1; b = v >> 2; }
    const int hq = hkv * 4 + (w >> 1), qh = w & 1;
    const int qrow0 = (lat ? b * SEQ + n * 128 : TL + b * LC + n * 128) + qh * 64;
    int kb_lo = 0, kb_hi = -1;
    if (lat) { kb_lo = n > 0 ? n - 1 : 0; kb_hi = n < 63 ? n + 1 : 63; }
    const int nloc = kb_hi - kb_lo + 1, nblk = nloc + 2;
    const bf16* P = p->P;
    bf16x8_t qf[4][2];
#pragma unroll
    for (int qt = 0; qt < 4; ++qt)
#pragma unroll
        for (int ks = 0; ks < 2; ++ks) qf[qt][ks] = *(const bf16x8_t*)(P + (size_t)(qrow0 + qt * 16 + r) * DIN + C_AQ + hq * 64 + ks * 32 + g * 8);
    const float LOG2E = 1.4426950408889634f;
    const float sink2 = p->sink[l * 8 + hq] * LOG2E;
    float m[4], lsum[4];
    f32x4_t ot[4][4];
#pragma unroll
    for (int qt = 0; qt < 4; ++qt) { m[qt] = sink2; lsum[qt] = g == 0 ? 1.0f : 0.0f; }
#pragma unroll
    for (int dt = 0; dt < 4; ++dt)
#pragma unroll
        for (int qt = 0; qt < 4; ++qt) ot[dt][qt] = (f32x4_t){0.f, 0.f, 0.f, 0.f};
    uint4 kreg0, kreg1, vreg0, vreg1;
#define ATT_ROW0(bi) ((bi) < nloc ? b * SEQ + (kb_lo + (bi)) * 128 : TL + b * LC + ((bi) - nloc) * 128)
    const int key0 = t >> 3, key1 = key0 + 64, c8 = t & 7;
#define ATT_ISSUE(bi) do { const bf16* src_ = P + (size_t)(ATT_ROW0(bi) + key0) * DIN + hkv * 64 + c8 * 8; \
        kreg0 = *(const uint4*)(src_ + C_AK); vreg0 = *(const uint4*)(src_ + C_AV); \
        kreg1 = *(const uint4*)(src_ + 64 * DIN + C_AK); vreg1 = *(const uint4*)(src_ + 64 * DIN + C_AV); } while (0)
#define ATT_STAGE(buf) do { \
        *(uint4*)((buf) + key0 * KROW + c8 * 8) = kreg0; *(uint4*)((buf) + key1 * KROW + c8 * 8) = kreg1; \
        st_tr8((buf) + 128 * KROW + (c8 * 8) * TROW + (key0 ^ (c8 << 3)), TROW, vreg0); st_tr8((buf) + 128 * KROW + (c8 * 8) * TROW + (key1 ^ (c8 << 3)), TROW, vreg1); } while (0)
    __syncthreads();
    ATT_ISSUE(0);
    for (int bi = 0; bi < nblk; ++bi) {
        bf16* buf = lds + (bi & 1) * ATT_BUF;
        ATT_STAGE(buf);
        __syncthreads();
        if (bi + 1 < nblk) ATT_ISSUE(bi + 1);
        const bf16* Ks = buf; const bf16* Vt = buf + 128 * KROW;
        const int band = (bi < nloc) ? (kb_lo + bi) - n : 0;
#pragma unroll 1
        for (int sub = 0; sub < 2; ++sub) {
            if ((band < 0 && sub == 0 && qh == 1) || (band > 0 && sub == 1 && qh == 0)) continue;
            f32x4_t st[4][4];
#pragma unroll
            for (int kt = 0; kt < 4; ++kt) {
#pragma unroll
                for (int qt = 0; qt < 4; ++qt) st[kt][qt] = (f32x4_t){0.f, 0.f, 0.f, 0.f};
#pragma unroll
                for (int ks = 0; ks < 2; ++ks) {
                    const bf16x8_t a = lds_frag16(Ks + (sub * 64 + kt * 16 + r) * KROW + ks * 32 + g * 8);
#pragma unroll
                    for (int qt = 0; qt < 4; ++qt) st[kt][qt] = MFMA16(a, qf[qt][ks], st[kt][qt]);
                }
            }
            if (band != 0) {
                const int sb = band * (sub * 64 + g * 4 - qh * 64 - r);
#pragma unroll
                for (int qt = 0; qt < 4; ++qt)
#pragma unroll
                    for (int kt = 0; kt < 4; ++kt)
#pragma unroll
                        for (int i = 0; i < 4; ++i) {
                            const int c = -band * ((kt - qt) * 16 + i);
                            st[kt][qt][i] = sb > c ? -INFINITY : st[kt][qt][i];
                        }
            }
            float mnew[4]; bool grow = false;
#pragma unroll
            for (int qt = 0; qt < 4; ++qt) {
                float mloc = fmaxf(fmaxf(fmaxf(st[0][qt][0], st[0][qt][1]), fmaxf(st[0][qt][2], st[0][qt][3])), fmaxf(fmaxf(st[1][qt][0], st[1][qt][1]), fmaxf(st[1][qt][2], st[1][qt][3])));
                mloc = fmaxf(mloc, fmaxf(fmaxf(fmaxf(st[2][qt][0], st[2][qt][1]), fmaxf(st[2][qt][2], st[2][qt][3])), fmaxf(fmaxf(st[3][qt][0], st[3][qt][1]), fmaxf(st[3][qt][2], st[3][qt][3]))));
                mloc = fmaxf(mloc, shx(mloc, 16, lane)); mloc = fmaxf(mloc, shx(mloc, 32, lane));
                mnew[qt] = fmaxf(m[qt], mloc);
                grow = grow || (mnew[qt] > m[qt]);
            }
            if (__any(grow)) {
#pragma unroll
                for (int qt = 0; qt < 4; ++qt) {
                    const float alpha = __builtin_amdgcn_exp2f(m[qt] - mnew[qt]);
                    m[qt] = mnew[qt]; lsum[qt] *= alpha;
#pragma unroll
                    for (int dt = 0; dt < 4; ++dt) ot[dt][qt] = ot[dt][qt] * alpha;
                }
            }
#pragma unroll
            for (int qt = 0; qt < 4; ++qt) {
                float ps = 0.f;
#pragma unroll
                for (int kt = 0; kt < 4; ++kt)
#pragma unroll
                    for (int i = 0; i < 4; ++i) { const float e = __builtin_amdgcn_exp2f(st[kt][qt][i] - m[qt]); st[kt][qt][i] = e; ps += e; }
                lsum[qt] += ps;
            }
#pragma unroll
            for (int kp = 0; kp < 2; ++kp) {
                bf16x8_t pf[4];
#pragma unroll
                for (int qt = 0; qt < 4; ++qt) pf[qt] = pack_p(st[2 * kp][qt], st[2 * kp + 1][qt]);
#pragma unroll
                for (int dt = 0; dt < 4; ++dt) {
                    const bf16* vrow = Vt + (dt * 16 + r) * TROW; const int vsw = ((2 * dt + (r >> 3)) & 7) << 3, vk = sub * 64 + g * 4 + (2 * kp) * 16;
                    const bf16x8_t a = lds_frag8x2(vrow + (vk ^ vsw), vrow + ((vk + 16) ^ vsw));
#pragma unroll
                    for (int qt = 0; qt < 4; ++qt) ot[dt][qt] = MFMA16(a, pf[qt], ot[dt][qt]);
                }
            }
        }
    }
#pragma unroll
    for (int qt = 0; qt < 4; ++qt) {
        float ls = lsum[qt]; ls += shx(ls, 16, lane); ls += shx(ls, 32, lane);
        const float inv = 1.0f / ls;
        bf16* orow = p->MIX + (size_t)(qrow0 + qt * 16 + r) * D + 512 + hq * 64 + g * 4;
#pragma unroll
        for (int dt = 0; dt < 4; ++dt) {
            const f32x4_t o = ot[dt][qt] * inv;
            *(uint2*)(orow + dt * 16) = make_uint2(pk2(o[0], o[1]), pk2(o[2], o[3]));
        }
    }
}

__device__ __forceinline__ size_t kv_off(int dir, int b, int pos, int h) { return ((((size_t)dir * NB + b) * NPOS + pos) * 4 + h) * 4096; }
__device__ __forceinline__ void ret_kv_unit(KP p, int wv, int l, int u, bf16* lds) {
    const int h = u & 3, pos = (u >> 2) % NPOS, b = u / (4 * NPOS);
    const int t = tid_opaque(wv), lane = t & 63, w = t >> 6, r = lane & 15, g = lane >> 4;
    bf16* Ktf = lds; bf16* Ktb = lds + 64 * TROW; bf16* Vt = lds + 2 * 64 * TROW;
    const float lgf = log_sigmoid_f(p->rdf[l * 4 + h]), lgb = log_sigmoid_f(p->rdb[l * 4 + h]);
    const int r0 = chunk_row0(b, pos);
    const bf16* P = p->P;
    __syncthreads();
#pragma unroll
    for (int q = 0; q < 2; ++q) {
        const int pc = t + q * NT, j = pc >> 3, c8 = pc & 7;
        const bf16* src = P + (size_t)(r0 + j) * DIN + h * 64 + c8 * 8;
        const uint4 kv = *(const uint4*)(src + C_RK), vv = *(const uint4*)(src + C_RV);
        const float wf = expf(lgf * (float)(127 - j)), wb = expf(lgb * (float)j);
        uint4 kf, kb;
        kf.x = pk2(bflo(kv.x) * wf, bfhi(kv.x) * wf); kf.y = pk2(bflo(kv.y) * wf, bfhi(kv.y) * wf); kf.z = pk2(bflo(kv.z) * wf, bfhi(kv.z) * wf); kf.w = pk2(bflo(kv.w) * wf, bfhi(kv.w) * wf);
        kb.x = pk2(bflo(kv.x) * wb, bfhi(kv.x) * wb); kb.y = pk2(bflo(kv.y) * wb, bfhi(kv.y) * wb); kb.z = pk2(bflo(kv.z) * wb, bfhi(kv.z) * wb); kb.w = pk2(bflo(kv.w) * wb, bfhi(kv.w) * wb);
        st_tr8(Ktf + (c8 * 8) * TROW + j, TROW, kf);
        st_tr8(Ktb + (c8 * 8) * TROW + j, TROW, kb);
        st_tr8(Vt + (c8 * 8) * TROW + j, TROW, vv);
    }
    __syncthreads();
    const int dir = w >> 2, dvt = w & 3;
    const bf16* Kt = dir ? Ktb : Ktf;
    f32x4_t acc[4];
#pragma unroll
    for (int dkt = 0; dkt < 4; ++dkt) acc[dkt] = (f32x4_t){0.f, 0.f, 0.f, 0.f};
#pragma unroll
    for (int ks = 0; ks < 4; ++ks) {
        const bf16x8_t a = lds_frag16(Vt + (dvt * 16 + r) * TROW + ks * 32 + g * 8);
#pragma unroll
        for (int dkt = 0; dkt < 4; ++dkt) acc[dkt] = MFMA16(a, lds_frag16(Kt + (dkt * 16 + r) * TROW + ks * 32 + g * 8), acc[dkt]);
    }
    float* o = p->KV + kv_off(dir, b, pos, h);
#pragma unroll
    for (int dkt = 0; dkt < 4; ++dkt)
#pragma unroll
        for (int i = 0; i < 4; ++i) o[(dvt * 16 + g * 4 + i) * 64 + dkt * 16 + r] = acc[dkt][i];
}

__device__ __forceinline__ void phase_ret_scan(KP p, int wv, int l, int bid, int nb) {
    for (int i = bid * NT + tid_opaque(wv); i < 2 * NB * 4 * 4096; i += nb * NT) {
        const int e = i & 4095, h = (i >> 12) & 3, b = (i >> 14) & 1, dir = i >> 15;
        const float lg = log_sigmoid_f(dir ? p->rdb[l * 4 + h] : p->rdf[l * 4 + h]);
        const float cdec = expf(128.0f * lg);
        const float* kv = p->KV; bf16* st = p->ST16;
        float v[NPOS];
#pragma unroll
        for (int step = 0; step < NPOS; ++step) {
            const int pos = dir == 0 ? step : (step == 0 ? 1 : (step == 1 ? 0 : 67 - step));
            v[step] = kv[kv_off(dir, b, pos, h) + e];
        }
        float s = 0.f;
#pragma unroll
        for (int step = 0; step < NPOS; ++step) {
            const int pos = dir == 0 ? step : (step == 0 ? 1 : (step == 1 ? 0 : 67 - step));
            st[kv_off(dir, b, pos, h) + e] = (bf16)f2bf(s);
            s = s * cdec + v[step];
        }
    }
}

constexpr int RO_HEAD = 128 * KROW + 64 * TROW + 2 * 64 * KROW;
constexpr int RO_TAB = 2 * RO_HEAD;
__device__ __forceinline__ void ret_out_unit(KP p, int wv, int l, int u, bf16* lds) {
    const int hp = u & 1, pos = (u >> 1) % NPOS, b = u / (2 * NPOS);
    if (l == DEPTH - 1 && pos < 2) return;
    const int t = tid_opaque(wv), lane = t & 63, w = t >> 6, r = lane & 15, g = lane >> 4;
    const int r0 = chunk_row0(b, pos);
    const bf16* P = p->P;
    float* tabs = (float*)(lds + RO_TAB);
    __syncthreads();
#pragma unroll
    for (int q = 0; q < 4; ++q) {
        const int pc = t + q * NT, hh = pc >> 10, j = (pc >> 3) & 127, c8 = pc & 7, h = hp * 2 + hh;
        bf16* base = lds + hh * RO_HEAD;
        const bf16* src = P + (size_t)(r0 + j) * DIN + h * 64 + c8 * 8;
        *(uint4*)(base + j * KROW + c8 * 8) = *(const uint4*)(src + C_RK);
        const uint4 vv = *(const uint4*)(src + C_RV);
        st_tr8(base + 128 * KROW + (c8 * 8) * TROW + j, TROW, vv);
    }
#pragma unroll
    for (int q = 0; q < 4; ++q) {
        const int pc = t + q * NT, hh = pc >> 10, dir = (pc >> 9) & 1, dv = (pc >> 3) & 63, c8 = pc & 7, h = hp * 2 + hh;
        const uint4 sv = *(const uint4*)(p->ST16 + kv_off(dir, b, pos, h) + dv * 64 + c8 * 8);
        *(uint4*)(lds + hh * RO_HEAD + 128 * KROW + 64 * TROW + dir * 64 * KROW + dv * KROW + c8 * 8) = sv;
    }
    if (t < 4 * 132) {
        const int hh = t / 264, dir = (t / 132) & 1, k = t % 132, h = hp * 2 + hh;
        const float lg = log_sigmoid_f(dir ? p->rdb[l * 4 + h] : p->rdf[l * 4 + h]);
        tabs[(hh * 2 + dir) * 132 + k] = expf(lg * (float)k);
    }
    __syncthreads();
    const int hh = w >> 2, h = hp * 2 + hh, qw = w & 3;
    const bf16* Ks = lds + hh * RO_HEAD; const bf16* Vt = Ks + 128 * KROW; const bf16* Sft = Vt + 64 * TROW; const bf16* Sbt = Sft + 64 * KROW;
    const float* pf = tabs + (hh * 2) * 132; const float* pb = pf + 132;
    bf16x8_t qf[2][2];
#pragma unroll
    for (int qt = 0; qt < 2; ++qt)
#pragma unroll
        for (int ks = 0; ks < 2; ++ks) qf[qt][ks] = *(const bf16x8_t*)(P + (size_t)(r0 + qw * 32 + qt * 16 + r) * DIN + C_RQ + h * 64 + ks * 32 + g * 8);
    f32x4_t accI[4][2], accF[4][2], accB[4][2];
#pragma unroll
    for (int dt = 0; dt < 4; ++dt)
#pragma unroll
        for (int qt = 0; qt < 2; ++qt) { accI[dt][qt] = (f32x4_t){0.f, 0.f, 0.f, 0.f}; accF[dt][qt] = accI[dt][qt]; accB[dt][qt] = accI[dt][qt]; }
#pragma unroll
    for (int dt = 0; dt < 4; ++dt)
#pragma unroll
        for (int ks = 0; ks < 2; ++ks) {
            const bf16x8_t af = lds_frag16(Sft + (dt * 16 + r) * KROW + ks * 32 + g * 8), ab = lds_frag16(Sbt + (dt * 16 + r) * KROW + ks * 32 + g * 8);
#pragma unroll
            for (int qt = 0; qt < 2; ++qt) { accF[dt][qt] = MFMA16(af, qf[qt][ks], accF[dt][qt]); accB[dt][qt] = MFMA16(ab, qf[qt][ks], accB[dt][qt]); }
        }
#pragma unroll 1
    for (int sub = 0; sub < 2; ++sub) {
        f32x4_t st[4][2];
#pragma unroll
        for (int kt = 0; kt < 4; ++kt) {
#pragma unroll
            for (int qt = 0; qt < 2; ++qt) st[kt][qt] = (f32x4_t){0.f, 0.f, 0.f, 0.f};
#pragma unroll
            for (int ks = 0; ks < 2; ++ks) {
                const bf16x8_t a = lds_frag16(Ks + (sub * 64 + kt * 16 + r) * KROW + ks * 32 + g * 8);
#pragma unroll
                for (int qt = 0; qt < 2; ++qt) st[kt][qt] = MFMA16(a, qf[qt][ks], st[kt][qt]);
            }
        }
#pragma unroll
        for (int qt = 0; qt < 2; ++qt) {
            const int il = qw * 32 + qt * 16 + r;
#pragma unroll
            for (int kt = 0; kt < 4; ++kt)
#pragma unroll
                for (int i = 0; i < 4; ++i) {
                    const int rel = il - (sub * 64 + kt * 16 + g * 4 + i);
                    const float wgt = rel > 0 ? pf[rel] : (rel < 0 ? pb[-rel] : 2.0f);
                    st[kt][qt][i] *= wgt;
                }
        }
#pragma unroll
        for (int kp = 0; kp < 2; ++kp) {
            bf16x8_t pfr[2];
#pragma unroll
            for (int qt = 0; qt < 2; ++qt) pfr[qt] = pack_p(st[2 * kp][qt], st[2 * kp + 1][qt]);
#pragma unroll
            for (int dt = 0; dt < 4; ++dt) {
                const bf16* vrow = Vt + (dt * 16 + r) * TROW + sub * 64 + g * 4;
                const bf16x8_t a = lds_frag8x2(vrow + (2 * kp) * 16, vrow + (2 * kp + 1) * 16);
#pragma unroll
                for (int qt = 0; qt < 2; ++qt) accI[dt][qt] = MFMA16(a, pfr[qt], accI[dt][qt]);
            }
        }
    }
#pragma unroll
    for (int qt = 0; qt < 2; ++qt) {
        const int il = qw * 32 + qt * 16 + r;
        const float qfd = pf[il + 1], qbd = pb[128 - il];
        float s = 0.f;
#pragma unroll
        for (int dt = 0; dt < 4; ++dt) { accI[dt][qt] = accI[dt][qt] + accF[dt][qt] * qfd + accB[dt][qt] * qbd; s += (accI[dt][qt][0] + accI[dt][qt][1]) + (accI[dt][qt][2] + accI[dt][qt][3]); }
        s += shx(s, 16, lane); s += shx(s, 32, lane);
        const float mu = s * (1.0f / 64.0f);
        float qq = 0.f;
#pragma unroll
        for (int dt = 0; dt < 4; ++dt) { accI[dt][qt] = accI[dt][qt] - mu; qq += (accI[dt][qt][0] * accI[dt][qt][0] + accI[dt][qt][1] * accI[dt][qt][1]) + (accI[dt][qt][2] * accI[dt][qt][2] + accI[dt][qt][3] * accI[dt][qt][3]); }
        qq += shx(qq, 16, lane); qq += shx(qq, 32, lane);
        const float rstd = rsqrtf(qq * (1.0f / 64.0f) + LN_EPS);
        const size_t row = (size_t)(r0 + il);
#pragma unroll
        for (int dt = 0; dt < 4; ++dt) {
            const uint2 gw = *(const uint2*)(P + row * DIN + C_RG + h * 64 + dt * 16 + g * 4);
            const f32x4_t o = accI[dt][qt] * rstd;
            const float o0 = o[0] * silu_f(bflo(gw.x)), o1 = o[1] * silu_f(bfhi(gw.x)), o2 = o[2] * silu_f(bflo(gw.y)), o3 = o[3] * silu_f(bfhi(gw.y));
            *(uint2*)(p->MIX + row * D + h * 64 + dt * 16 + g * 4) = make_uint2(pk2(o0, o1), pk2(o2, o3));
        }
    }
}

__device__ __forceinline__ void sgu_unit(KP p, int wv, int l, int u, bf16* lds) {
    const int grp = u & 3, pos = (u >> 2) % NPOS, b = u / (4 * NPOS);
    if (l == DEPTH - 1 && pos < 2) return;
    const int t = tid_opaque(wv), lane = t & 63, w = t >> 6, r = lane & 15, g = lane >> 4;
    const int r0 = chunk_row0(b, pos);
    const bf16* P = p->P;
    bf16* vnT = lds;
    __syncthreads();
    {
        const int j = t >> 2, qd = t & 3;
        const uint4* src = (const uint4*)(P + (size_t)(r0 + j) * DIN + C_SV + grp * 64 + qd * 16);
        const uint4 a = src[0], c = src[1];
        float v[16] = {bflo(a.x), bfhi(a.x), bflo(a.y), bfhi(a.y), bflo(a.z), bfhi(a.z), bflo(a.w), bfhi(a.w), bflo(c.x), bfhi(c.x), bflo(c.y), bfhi(c.y), bflo(c.z), bfhi(c.z), bflo(c.w), bfhi(c.w)};
        float s = 0.f;
#pragma unroll
        for (int d = 0; d < 16; ++d) { v[d] = gelu_tanh(v[d]); s += v[d]; }
        s += shx(s, 1, lane); s += shx(s, 2, lane);
        const float mu = s * (1.0f / 64.0f);
        float qq = 0.f;
#pragma unroll
        for (int d = 0; d < 16; ++d) { v[d] -= mu; qq += v[d] * v[d]; }
        qq += shx(qq, 1, lane); qq += shx(qq, 2, lane);
        const float rstd = rsqrtf(qq * (1.0f / 64.0f) + LN_EPS);
#pragma unroll
        for (int d = 0; d < 16; ++d) vnT[(qd * 16 + d) * TROW + j] = (bf16)f2bf(v[d] * rstd);
    }
    bf16x8_t wf[4];
    {
        const float* wrow = p->sgu_w + (((size_t)l * 4 + grp) * 128 + w * 16 + r) * 128 + g * 8;
#pragma unroll
        for (int ks = 0; ks < 4; ++ks) {
            const float4 a = *(const float4*)(wrow + ks * 32), c = *(const float4*)(wrow + ks * 32 + 4);
            uint4 o; o.x = pk2(a.x, a.y); o.y = pk2(a.z, a.w); o.z = pk2(c.x, c.y); o.w = pk2(c.z, c.w);
            wf[ks] = __builtin_bit_cast(bf16x8_t, o);
        }
    }
    __syncthreads();
    const int i = w * 16 + r;
    const float bs = p->sgu_b[((size_t)l * 4 + grp) * 128 + i];
#pragma unroll
    for (int dt = 0; dt < 4; ++dt) {
        f32x4_t acc = {0.f, 0.f, 0.f, 0.f};
#pragma unroll
        for (int ks = 0; ks < 4; ++ks) acc = MFMA16(lds_frag16(vnT + (dt * 16 + r) * TROW + ks * 32 + g * 8), wf[ks], acc);
        const uint2 uw = *(const uint2*)(P + (size_t)(r0 + i) * DIN + C_SU + grp * 64 + dt * 16 + g * 4);
        const float o0 = gelu_tanh(bflo(uw.x)) * (acc[0] + bs), o1 = gelu_tanh(bfhi(uw.x)) * (acc[1] + bs), o2 = gelu_tanh(bflo(uw.y)) * (acc[2] + bs), o3 = gelu_tanh(bfhi(uw.y)) * (acc[3] + bs);
        *(uint2*)(p->MIX + (size_t)(r0 + i) * D + 256 + grp * 64 + dt * 16 + g * 4) = make_uint2(pk2(o0, o1), pk2(o2, o3));
    }
}

__device__ __forceinline__ void phase_mix_a(KP p, int wv, int l, int bid, int nb, float* ldsf) {
    bf16* lds = (bf16*)ldsf;
    const int n_kv = NB * NPOS * 4, n_sgu = NB * NPOS * 4, n_small = n_kv + n_sgu;
    for (int u = bid; u < 256; u += nb) att_unit(p, wv, l, u, lds);
    const int nctx = (l == DEPTH - 1) ? 0 : 8;
    const bool split = nb > 64 && nctx > 0;
    if (split ? bid < nctx : true) for (int u = 256 + bid; u < 256 + nctx; u += nb) att_unit(p, wv, l, u, lds);
    const int sb = split ? bid - nctx : bid, snb = split ? nb - nctx : nb;
    if (sb >= 0)
        for (int u = sb; u < n_small; u += snb) {
            if (u < n_kv) ret_kv_unit(p, wv, l, u, lds);
            else sgu_unit(p, wv, l, u - n_kv, lds);
        }
    __syncthreads();
}
__device__ __forceinline__ void phase_ret_out(KP p, int wv, int l, int bid, int nb, float* ldsf) {
    bf16* lds = (bf16*)ldsf;
    for (int u = bid; u < NB * NPOS * 2; u += nb) ret_out_unit(p, wv, l, u, lds);
    __syncthreads();
}

__device__ __forceinline__ void phase_ln1(KP p, int wv, int l, int bid, int nb) {
    const int lane = tid_opaque(wv) & 63, w = tid_opaque(wv) >> 6;
    const int Tn = (l == DEPTH - 1) ? TL : T;
    for (int r = bid * NW + w; r < Tn; r += nb * NW) {
        float v[16], a[16], c[16];
        if (l == 0) row_load(x_row(p, 0, r), v, lane); else row_load_bf(p->X + (size_t)r * D, v, lane);
        row_load_bf(p->Y + (size_t)r * D, a, lane);
        const float* m = p->mod + ((size_t)l * 3 + mod_idx(r)) * 6144;
        row_load(m + 2048, c, lane);
#pragma unroll
        for (int i = 0; i < 16; ++i) v[i] = ALPHA * v[i] + c[i] * a[i];
        row_ln(v, lane);
        row_load(p->lnm_g + l * D, a, lane); row_load(p->lnm_b + l * D, c, lane);
#pragma unroll
        for (int i = 0; i < 16; ++i) v[i] = v[i] * a[i] + c[i];
        row_store_bf(p->X1 + (size_t)r * D, v, lane);
        row_ln(v, lane);
        row_load(m + 3072, a, lane); row_load(m + 4096, c, lane);
#pragma unroll
        for (int i = 0; i < 16; ++i) v[i] = v[i] * (1.0f + c[i]) + a[i];
        row_store_bf(p->H + (size_t)r * D, v, lane);
        float mx = 0.f;
#pragma unroll
        for (int i = 0; i < 16; ++i) mx = fmaxf(mx, fabsf(v[i]));
#pragma unroll
        for (int o = 32; o >= 1; o >>= 1) mx = fmaxf(mx, shx(mx, o, lane));
        const float xinv = mx > 0.f ? 127.0f / mx : 0.f;
        unsigned* xq = (unsigned*)(p->XQ + (size_t)r * D);
#pragma unroll
        for (int i = 0; i < 4; ++i) {
            const int q0 = (int)rintf(v[i * 4 + 0] * xinv), q1 = (int)rintf(v[i * 4 + 1] * xinv), q2 = (int)rintf(v[i * 4 + 2] * xinv), q3 = (int)rintf(v[i * 4 + 3] * xinv);
            xq[i * 64 + lane] = (unsigned)(q0 & 0xff) | ((unsigned)(q1 & 0xff) << 8) | ((unsigned)(q2 & 0xff) << 16) | ((unsigned)(q3 & 0xff) << 24);
        }
        if (lane == 0) p->SX[r] = mx * (1.0f / 127.0f);
    }
}

template <int N> __device__ __forceinline__ void bitonic_sort_desc(float (&x)[N]) {
#pragma unroll
    for (int sz = 2; sz <= N; sz <<= 1)
#pragma unroll
        for (int t = sz >> 1; t > 0; t >>= 1)
#pragma unroll
            for (int i = 0; i < N; ++i)
                if ((i & t) == 0) {
                    const int j = i | t; const bool desc = (i & sz) == 0;
                    const float mx_ = fmaxf(x[i], x[j]), mn_ = fminf(x[i], x[j]);
                    x[i] = desc ? mx_ : mn_; x[j] = desc ? mn_ : mx_;
                }
}
__device__ __forceinline__ void bitonic_merge16_desc(float (&x)[16]) {
#pragma unroll
    for (int t = 8; t > 0; t >>= 1)
#pragma unroll
        for (int i = 0; i < 16; ++i)
            if ((i & t) == 0) { const int j = i | t; const float mx_ = fmaxf(x[i], x[j]), mn_ = fminf(x[i], x[j]); x[i] = mx_; x[j] = mn_; }
}
__device__ __forceinline__ void xmerge16_desc(float (&c)[16], int lane) {
#pragma unroll
    for (int o = 16; o <= 32; o <<= 1) {
        float pr[16];
#pragma unroll
        for (int i = 0; i < 16; ++i) pr[i] = shx(c[i], o, lane);
#pragma unroll
        for (int i = 0; i < 16; ++i) c[i] = fmaxf(c[i], pr[15 - i]);
        bitonic_merge16_desc(c);
    }
}
__device__ __forceinline__ void top16_keys(const float (&sc)[32], int fq, int lane, float (&c)[16]) {
    float a[16], b[16];
#pragma unroll
    for (int e = 0; e < 16; ++e) {
        a[e] = __builtin_bit_cast(float, (__builtin_bit_cast(unsigned, sc[e]) & ~127u) | (unsigned)((e >> 2) * 16 + (e & 3)) | ((unsigned)fq << 2));
        b[e] = __builtin_bit_cast(float, (__builtin_bit_cast(unsigned, sc[16 + e]) & ~127u) | (unsigned)(((16 + e) >> 2) * 16 + (e & 3)) | ((unsigned)fq << 2));
    }
    bitonic_sort_desc<16>(a); bitonic_sort_desc<16>(b);
#pragma unroll
    for (int i = 0; i < 16; ++i) c[i] = fmaxf(a[i], b[15 - i]);
    bitonic_merge16_desc(c);
    xmerge16_desc(c, lane);
}
constexpr int KS_STRIDE = 136;
__device__ __forceinline__ void phase_topk(KP p, int wv, int l, int bid, int nb, float* lds) {
    bf16* k1s = (bf16*)lds;
    bf16* k2s = k1s + 128 * KS_STRIDE;
    const int t = tid_opaque(wv), lane = t & 63, w = t >> 6;
    float* lists = lds + (2 * 128 * KS_STRIDE * 2) / 4 + w * 1536;
    float* v1 = lists; int* i1 = (int*)(lists + 256); float* v2 = lists + 512; int* i2 = (int*)(lists + 768); float* v3 = lists + 1024; int* c3 = (int*)(lists + 1280);
    unsigned char* ctab = (unsigned char*)(lds + (2 * 128 * KS_STRIDE * 2) / 4 + NW * 1536);
    __syncthreads();
    if (t < 64) {
        const int gq = t >> 4, k = t & 15; int ab = 0xff;
        if (gq == 0) { if (k < 13) ab = k; }
        else if (gq == 1) { if (k < 3) ab = 13 + k; else if (k < 11) ab = 0x10 | (k - 3); else if (k < 13) ab = 0x20 | (k - 11); }
        else if (gq == 2) { if (k < 3) ab = 0x20 | (k + 2); else if (k < 7) ab = 0x30 | (k - 3); else if (k < 10) ab = 0x40 | (k - 7); else if (k < 12) ab = 0x50 | (k - 10); else if (k < 13) ab = 0x60; }
        else { if (k == 0) ab = 0x61; else if (k < 3) ab = 0x70 | (k - 1); else if (k < 11) ab = (k + 5) << 4; }
        ctab[t] = (unsigned char)ab;
    }
    for (int e = t; e < 2 * 128 * 16; e += NT) {
        const int tab = e >> 11, r = (e >> 4) & 127, c8 = e & 15;
        const float* src = (tab ? p->k2 : p->k1) + (size_t)l * 128 * 128 + r * 128 + c8 * 8;
        const float4 a = *(const float4*)src, b = *(const float4*)(src + 4);
        uint4 o; o.x = pk2(a.x, a.y); o.y = pk2(a.z, a.w); o.z = pk2(b.x, b.y); o.w = pk2(b.z, b.w);
        *(uint4*)((tab ? k2s : k1s) + r * KS_STRIDE + c8 * 8) = o;
    }
    __syncthreads();
    const int fr = lane & 15, fq = lane >> 4;
    const int ntask = ((l == DEPTH - 1) ? TL : T) * 8 / 16;
    for (int task = bid * NW + w; task < ntask; task += nb * NW) {
        const int it0 = task * 16;
        const bf16* qrow = p->Qb + (size_t)(it0 + fr) * 256 + fq * 8;
        bf16x8_t bq[8];
#pragma unroll
        for (int ks = 0; ks < 8; ++ks) bq[ks] = *(const bf16x8_t*)(qrow + ks * 32);
        float s[32];
#pragma unroll
        for (int kt = 0; kt < 8; ++kt) {
            f32x4_t acc = {0.f, 0.f, 0.f, 0.f};
#pragma unroll
            for (int ks = 0; ks < 4; ++ks) {
                const bf16x8_t a = *(const bf16x8_t*)(k1s + (kt * 16 + fr) * KS_STRIDE + ks * 32 + fq * 8);
                acc = __builtin_amdgcn_mfma_f32_16x16x32_bf16(a, bq[ks], acc, 0, 0, 0);
            }
            s[kt * 4 + 0] = acc[0]; s[kt * 4 + 1] = acc[1]; s[kt * 4 + 2] = acc[2]; s[kt * 4 + 3] = acc[3];
        }
        { float ck[16]; top16_keys(s, fq, lane, ck);
          if (fq == 0) {
#pragma unroll
              for (int i = 0; i < 16; ++i) v1[fr * 16 + i] = ck[i]; } }
#pragma unroll
        for (int kt = 0; kt < 8; ++kt) {
            f32x4_t acc = {0.f, 0.f, 0.f, 0.f};
#pragma unroll
            for (int ks = 0; ks < 4; ++ks) {
                const bf16x8_t a = *(const bf16x8_t*)(k2s + (kt * 16 + fr) * KS_STRIDE + ks * 32 + fq * 8);
                acc = __builtin_amdgcn_mfma_f32_16x16x32_bf16(a, bq[4 + ks], acc, 0, 0, 0);
            }
            s[kt * 4 + 0] = acc[0]; s[kt * 4 + 1] = acc[1]; s[kt * 4 + 2] = acc[2]; s[kt * 4 + 3] = acc[3];
        }
        { float ck[16]; top16_keys(s, fq, lane, ck);
          if (fq == 0) {
#pragma unroll
              for (int i = 0; i < 16; ++i) v2[fr * 16 + i] = ck[i]; } }
        __builtin_amdgcn_wave_barrier();
        const uint4 tw = *(const uint4*)(ctab + fq * 16);
        const unsigned twd[4] = {tw.x, tw.y, tw.z, tw.w};
        float ck3[16];
        const float padv = __builtin_bit_cast(float, __builtin_bit_cast(unsigned, v1[fr * 16 + 15]) & ~127u) + __builtin_bit_cast(float, __builtin_bit_cast(unsigned, v2[fr * 16 + 15]) & ~127u) - 1.0f;
#pragma unroll
        for (int k = 0; k < 16; ++k) {
            const unsigned ab = k < 13 ? (twd[k >> 2] >> (8 * (k & 3))) & 0xffu : 0xffu;
            const float ka = __builtin_bit_cast(float, __builtin_bit_cast(unsigned, v1[fr * 16 + ((ab >> 4) & 15u)]) & ~127u);
            const float kb = __builtin_bit_cast(float, __builtin_bit_cast(unsigned, v2[fr * 16 + (ab & 15u)]) & ~127u);
            const float cvv = ab == 0xffu ? padv : ka + kb;
            ck3[k] = __builtin_bit_cast(float, (__builtin_bit_cast(unsigned, cvv) & ~255u) | ab);
        }
        bitonic_sort_desc<16>(ck3);
        xmerge16_desc(ck3, lane);
        float tv[4]; int tc[4];
#pragma unroll
        for (int k = 0; k < 4; ++k) {
            const float kk = fq == 0 ? ck3[k] : (fq == 1 ? ck3[4 + k] : (fq == 2 ? ck3[8 + k] : ck3[12 + k]));
            tv[k] = __builtin_bit_cast(float, __builtin_bit_cast(unsigned, kk) & ~255u); tc[k] = (int)(__builtin_bit_cast(unsigned, kk) & 255u);
        }
        float mx = fmaxf(fmaxf(tv[0], tv[1]), fmaxf(tv[2], tv[3]));
        mx = fmaxf(mx, shx(mx, 16, lane)); mx = fmaxf(mx, shx(mx, 32, lane));
        float ex[4], den = 0.f;
#pragma unroll
        for (int k = 0; k < 4; ++k) { ex[k] = expf(tv[k] - mx); den += ex[k]; }
        den += shx(den, 16, lane); den += shx(den, 32, lane);
        const float inv = 1.0f / den;
        int4 eo; float4 go;
#define TK_EID(c) ((int)(__builtin_bit_cast(unsigned, v1[fr * 16 + ((c) >> 4)]) & 127u) * 128 + (int)(__builtin_bit_cast(unsigned, v2[fr * 16 + ((c) & 15)]) & 127u))
        eo.x = TK_EID(tc[0]); eo.y = TK_EID(tc[1]); eo.z = TK_EID(tc[2]); eo.w = TK_EID(tc[3]);
#undef TK_EID
        go = make_float4(ex[0] * inv, ex[1] * inv, ex[2] * inv, ex[3] * inv);
        *(int4*)(p->EIDX + (size_t)(it0 + fr) * 16 + fq * 4) = eo;
        *(float4*)(p->GATE + (size_t)(it0 + fr) * 16 + fq * 4) = go;
        __builtin_amdgcn_wave_barrier();
    }
    __syncthreads();
}

typedef unsigned u32x4_t __attribute__((ext_vector_type(4)));
using bf16x2_t = __attribute__((ext_vector_type(2))) __bf16;
__device__ __forceinline__ float dot2bf(unsigned a, unsigned b, float acc) { return __builtin_amdgcn_fdot2_f32_bf16(__builtin_bit_cast(bf16x2_t, a), __builtin_bit_cast(bf16x2_t, b), acc, false); }
struct RowBf { u32x4_t a, b; };
__device__ __forceinline__ RowBf ld_row(const bf16* tab, int e, int lane) {
    const u32x4_t* r = (const u32x4_t*)(tab + (size_t)e * D) + lane;
    RowBf x; x.a = r[0]; x.b = r[64]; return x;
}
__device__ __forceinline__ float row_dot(const RowBf& x, const RowBf& u) {
    float d = 0.f;
#pragma unroll
    for (int k = 0; k < 4; ++k) { d = dot2bf(x.a[k], u.a[k], d); d = dot2bf(x.b[k], u.b[k], d); }
    return d;
}
__device__ __forceinline__ void row_axpy(float (&acc)[16], float a, const RowBf& v) {
#pragma unroll
    for (int k = 0; k < 4; ++k) {
        acc[2 * k] += a * bflo(v.a[k]); acc[2 * k + 1] += a * bfhi(v.a[k]);
        acc[8 + 2 * k] += a * bflo(v.b[k]); acc[8 + 2 * k + 1] += a * bfhi(v.b[k]);
    }
}
__device__ __forceinline__ float transpose_reduce16(float (&part)[16], int lane) {
#pragma unroll
    for (int st = 32, n = 8; n >= 1; st >>= 1, n >>= 1) {
        const bool up = (lane & st) != 0;
#pragma unroll
        for (int s = 0; s < n; ++s) {
            const float lo = part[s], hi = part[s + n];
            const float recv = shx(up ? lo : hi, st, lane);
            part[s] = (up ? hi : lo) + recv;
        }
    }
    float v = part[0];
    v += shx(v, 2, lane); v += shx(v, 1, lane);
    return v;
}
typedef float f32x2_t __attribute__((ext_vector_type(2)));
__device__ __forceinline__ float transpose_reduce8(float (&part)[8], int lane) {
#pragma unroll
    for (int st = 32, n = 4; n >= 1; st >>= 1, n >>= 1) {
        const bool up = (lane & st) != 0;
#pragma unroll
        for (int s = 0; s < n; ++s) {
            const float lo = part[s], hi = part[s + n];
            const float recv = shx(up ? lo : hi, st, lane);
            part[s] = (up ? hi : lo) + recv;
        }
    }
    float v = part[0];
    v += shx(v, 4, lane); v += shx(v, 2, lane); v += shx(v, 1, lane);
    return v;
}
typedef int v4i_t __attribute__((ext_vector_type(4)));
typedef unsigned u32x4v __attribute__((ext_vector_type(4)));
constexpr int EXU_CAP = 440, EXU_TROW = 1056, EXU_WAVE = 8 * EXU_CAP + 16 * EXU_TROW;
__device__ __forceinline__ void phase_expert_u(KP p, int wv, int l, int bid, int nb, float* lds) {
    const int lane = tid_opaque(wv) & 63, w = __builtin_amdgcn_readfirstlane(tid_opaque(wv) >> 6);
    const int G8 = nb >> 3;
    if (bid >= G8 * 8) return;
    const int rng = bid & 7, r = lane & 15, g = lane >> 4;
    const unsigned char* U = p->U8 + (size_t)l * PEER_N * D;
    const float* SU = p->SU + (size_t)l * PEER_N; const float* SV = p->SV + (size_t)l * PEER_N;
    unsigned char* wl = (unsigned char*)lds + w * EXU_WAVE;
    unsigned* lpk = (unsigned*)wl; float* lgt = (float*)(wl + 4 * EXU_CAP); unsigned char* tile = wl + 8 * EXU_CAP;
    const unsigned long long ltmask = (1ull << lane) - 1ull;
    const int tstride = G8 * NW, Tn = (l == DEPTH - 1) ? TL : T, t0 = (bid >> 3) * NW + w;
    if (t0 >= Tn) return;
    const int nitem = (Tn - t0 + tstride - 1) / tstride;
    int i0 = 0;
    while (i0 < nitem) {
        const int nt = nitem - i0 < 16 ? nitem - i0 : 16;
        v4i_t afr[16];
        {
            const unsigned char* xa = p->XQ + (size_t)(t0 + (i0 + (r < nt ? r : nt - 1)) * tstride) * D + g * 16;
#pragma unroll
            for (int ks = 0; ks < 16; ++ks) afr[ks] = *(const v4i_t*)(xa + ks * 64);
        }
        const float sxv = p->SX[t0 + (i0 + (lane < nt ? lane : nt - 1)) * tstride];
        int e0[16], e1[16];
#pragma unroll
        for (int j = 0; j < 16; ++j) {
            const size_t tb = (size_t)(t0 + (i0 + (j < nt ? j : nt - 1)) * tstride) * NSEL;
            e0[j] = p->EIDX[tb + lane]; e1[j] = p->EIDX[tb + 64 + lane];
        }
        int cnt = 0, ndone = 0; bool open = true;
#pragma unroll
        for (int j = 0; j < 16; ++j) {
            const bool in0 = (e0[j] >> 11) == rng, in1 = (e1[j] >> 11) == rng;
            const unsigned long long m0 = __ballot(in0), m1 = __ballot(in1);
            const int c0 = __popcll(m0), c = c0 + __popcll(m1);
            open = open && j < nt && cnt + c <= EXU_CAP;
            if (open) {
                if (in0) { const int pos = cnt + __popcll(m0 & ltmask); lpk[pos] = (unsigned)e0[j] | ((unsigned)j << 14) | ((unsigned)lane << 18); }
                if (in1) { const int pos = cnt + c0 + __popcll(m1 & ltmask); lpk[pos] = (unsigned)e1[j] | ((unsigned)j << 14) | ((unsigned)(lane + 64) << 18); }
                cnt += c; ndone = j + 1;
            }
        }
        __builtin_amdgcn_wave_barrier();
        const int ntile = (cnt + 15) >> 4;
        u32x4v rw[16]; unsigned pkv = 0u; float suv = 0.f;
#define EXU_ISSUE(q) do { const int idx_ = 16 * (q) + r < cnt ? 16 * (q) + r : cnt - 1; \
            pkv = lpk[idx_]; const unsigned e_ = pkv & 0x3fffu; \
            _Pragma("unroll") for (int k = 0; k < 16; ++k) rw[k] = *(const u32x4v*)(U + ((size_t)(__builtin_amdgcn_readlane((int)pkv, k) & 0x3fff) << 10) + lane * 16); \
            suv = SU[e_]; } while (0)
        if (ntile > 0) EXU_ISSUE(0);
#pragma unroll 1
        for (int q = 0; q < ntile; ++q) {
#pragma unroll
            for (int k = 0; k < 16; ++k) *(u32x4v*)(tile + k * EXU_TROW + lane * 16) = rw[k];
            const unsigned pk = pkv; const float su = suv;
            __builtin_amdgcn_wave_barrier();
            if (q + 1 < ntile) EXU_ISSUE(q + 1);
            v4i_t acc = {0, 0, 0, 0};
#pragma unroll
            for (int ks = 0; ks < 16; ++ks) {
                const v4i_t b = *(const v4i_t*)(tile + r * EXU_TROW + ks * 64 + g * 16);
                acc = __builtin_amdgcn_mfma_i32_16x16x64_i8(afr[ks], b, acc, 0, 0, 0);
            }
            const int j = (int)((pk >> 14) & 15u);
            const int d = (j & 2) ? ((j & 1) ? acc[3] : acc[2]) : ((j & 1) ? acc[1] : acc[0]);
            const float sx = shf(sxv, j);
            if (g == (j >> 2) && 16 * q + r < cnt) lgt[16 * q + r] = (float)d * su * sx;
            __builtin_amdgcn_wave_barrier();
        }
#undef EXU_ISSUE
        for (int idx = lane; idx < cnt; idx += 64) {
            const unsigned pk = lpk[idx]; const int e = (int)(pk & 0x3fffu), j = (int)((pk >> 14) & 15u), slot = (int)(pk >> 18);
            const size_t ao = (size_t)(t0 + (i0 + j) * tstride) * NSEL + slot;
            p->ACT[ao] = gelu_tanh(lgt[idx]) * p->GATE[ao] * SV[e];
        }
        __builtin_amdgcn_wave_barrier();
        i0 += ndone > 0 ? ndone : 1;
    }
}
__device__ __forceinline__ void phase_expert_v(KP p, int wv, int l, int bid, int nb) {
    const int lane = tid_opaque(wv) & 63, w = __builtin_amdgcn_readfirstlane(tid_opaque(wv) >> 6);
    const int G8 = nb >> 3;
    if (bid >= G8 * 8) return;
    const int sl = bid & 7, q = lane >> 3, c = lane & 7;
    const __amdgpu_buffer_rsrc_t rsV = __builtin_amdgcn_make_buffer_rsrc((void*)(p->V8 + (size_t)l * PEER_N * D), 0, PEER_N * D, 0x00020000);
    const int coff = sl * 128 + c * 16;
    const int tstride = G8 * NW, Tn = (l == DEPTH - 1) ? TL : T, t0 = (bid >> 3) * NW + w;
    const int nitem = t0 < Tn ? (Tn - t0 + tstride - 1) / tstride : 0;
    for (int j0 = 0; j0 < nitem; j0 += 8) {
        const bool valid = j0 + q < nitem;
        const int t = t0 + (valid ? j0 + q : nitem - 1) * tstride;
        int e[16]; float a[16];
        {
            const int4* ep = (const int4*)(p->EIDX + (size_t)t * NSEL + c * 16); const float4* ap = (const float4*)(p->ACT + (size_t)t * NSEL + c * 16);
#pragma unroll
            for (int k = 0; k < 4; ++k) { const int4 ev = ep[k]; const float4 av = ap[k];
                e[k * 4 + 0] = ev.x << 10; e[k * 4 + 1] = ev.y << 10; e[k * 4 + 2] = ev.z << 10; e[k * 4 + 3] = ev.w << 10;
                a[k * 4 + 0] = av.x; a[k * 4 + 1] = av.y; a[k * 4 + 2] = av.z; a[k * 4 + 3] = av.w; }
        }
        f32x2_t acc[8];
#pragma unroll
        for (int k = 0; k < 8; ++k) acc[k] = (f32x2_t){0.f, 0.f};
#pragma unroll 1
        for (int cc = 0; cc < 8; ++cc) {
            const int baddr = ((lane & 56) | cc) << 2;
#pragma unroll
            for (int hb = 0; hb < 2; ++hb) {
                u32x4v rv[8]; float av[8];
#pragma unroll
                for (int k = 0; k < 8; ++k) {
                    const int j = hb * 8 + k;
                    const int eo = __builtin_amdgcn_ds_bpermute(baddr, e[j]);
                    av[k] = __builtin_bit_cast(float, __builtin_amdgcn_ds_bpermute(baddr, __builtin_bit_cast(int, a[j])));
                    rv[k] = __builtin_amdgcn_raw_buffer_load_b128(rsV, eo + coff, 0, 0);
                }
#pragma unroll
                for (int k = 0; k < 8; ++k) {
                    const f32x2_t a2 = {av[k], av[k]};
                    acc[0] += a2 * __builtin_amdgcn_cvt_pk_f32_fp8((int)rv[k][0], false); acc[1] += a2 * __builtin_amdgcn_cvt_pk_f32_fp8((int)rv[k][0], true);
                    acc[2] += a2 * __builtin_amdgcn_cvt_pk_f32_fp8((int)rv[k][1], false); acc[3] += a2 * __builtin_amdgcn_cvt_pk_f32_fp8((int)rv[k][1], true);
                    acc[4] += a2 * __builtin_amdgcn_cvt_pk_f32_fp8((int)rv[k][2], false); acc[5] += a2 * __builtin_amdgcn_cvt_pk_f32_fp8((int)rv[k][2], true);
                    acc[6] += a2 * __builtin_amdgcn_cvt_pk_f32_fp8((int)rv[k][3], false); acc[7] += a2 * __builtin_amdgcn_cvt_pk_f32_fp8((int)rv[k][3], true);
                    __builtin_amdgcn_sched_barrier(0);
                }
            }
        }
        if (valid) {
            bf16* yr = p->Y + (size_t)t * D + coff;
            *(uint4*)yr = make_uint4(pk2(acc[0].x, acc[0].y), pk2(acc[1].x, acc[1].y), pk2(acc[2].x, acc[2].y), pk2(acc[3].x, acc[3].y));
            *(uint4*)(yr + 8) = make_uint4(pk2(acc[4].x, acc[4].y), pk2(acc[5].x, acc[5].y), pk2(acc[6].x, acc[6].y), pk2(acc[7].x, acc[7].y));
        }
    }
}

__device__ __forceinline__ void phase_ln2(KP p, int wv, int l, int bid, int nb) {
    const int lane = tid_opaque(wv) & 63, w = tid_opaque(wv) >> 6;
    const int Tn = (l == DEPTH - 1) ? TL : T;
    for (int r = bid * NW + w; r < Tn; r += nb * NW) {
        float v[16], a[16], c[16];
        row_load_bf(p->X1 + (size_t)r * D, v, lane);
        row_load_bf(p->Y + (size_t)r * D, a, lane);
        const float* m = p->mod + ((size_t)l * 3 + mod_idx(r)) * 6144;
        row_load(m + 5120, c, lane);
#pragma unroll
        for (int i = 0; i < 16; ++i) v[i] = ALPHA * v[i] + c[i] * a[i];
        row_ln(v, lane);
        row_load(p->lnf_g + l * D, a, lane); row_load(p->lnf_b + l * D, c, lane);
#pragma unroll
        for (int i = 0; i < 16; ++i) v[i] = v[i] * a[i] + c[i];
        if (l == DEPTH - 1) { if (r < TL) row_store(p->out + (size_t)r * D, v, lane); continue; }
        row_store_bf(p->X + (size_t)r * D, v, lane);
        const float* m2 = p->mod + ((size_t)(l + 1) * 3 + mod_idx(r)) * 6144;
        row_ln(v, lane);
        row_load(m2, a, lane); row_load(m2 + 1024, c, lane);
#pragma unroll
        for (int i = 0; i < 16; ++i) v[i] = v[i] * (1.0f + c[i]) + a[i];
        row_store_bf(p->H + (size_t)r * D, v, lane);
    }
}

__global__ void __launch_bounds__(NT, 2) mega(Params p_unused) {
    extern __shared__ __attribute__((aligned(16))) unsigned char lds_raw[];
    cg::grid_group grid = cg::this_grid();
    const int bid = blockIdx.x, nb = gridDim.x;
    const int wv = __builtin_amdgcn_readfirstlane(threadIdx.x >> 6);
    float* lds = (float*)lds_raw;
    LAS unsigned char* ldsl = (LAS unsigned char*)lds_raw;
    volatile LAS unsigned* MISC = (volatile LAS unsigned*)(ldsl + MISC_OFF);
    for (int u = threadIdx.x; u < 64; u += NT) ((LAS unsigned*)(ldsl + MISC_OFF))[u] = 0u;
    __syncthreads();
#define IS_LEAD() (wv == 0 && lane_opaque() == 0)
    (void)xcd_barrier_post(kparams()->ctl + CW_BAR, MISC + 8, IS_LEAD());
#define GRID_BAR() do { XcdBarrier b_; b_.bar = kparams()->ctl + CW_BAR; b_.x = xb_xcc_id(); b_.st = MISC + 8; b_.lead = IS_LEAD(); xcd_barrier(b_); } while (0)

    phase_mod1(kparams(), wv, bid, nb, lds);
    phase_weights(kparams(), wv, bid, nb, lds);
    grid.sync();
    phase_mod2(kparams(), wv, bid, nb);
    GRID_BAR();
    phase_lnmod(kparams(), wv, 0, bid, nb);
    GRID_BAR();
#define LAYER_BODY(l) do { \
        { KP p = kparams(); \
            pg8::Gemm g{p->H, p->WtIn + (size_t)l * DIN * D, T, DIN, D}; pg8::StaticOrder S; S.init(T, DIN, nb, bid); \
            pg8::EpiInProj E{p->P, p->rope}; \
            pg8::gemm_phase<pg8::EpiInProj, pg8::StaticOrder, true, true>(ldsl, g, S, E, wv); \
            { const int busy3 = 66 * 9 - 2 * nb;                       \
              if (busy3 > 0 && busy3 < nb) { if (bid >= busy3) phase_tables(p, wv, l, bid - busy3, nb - busy3); } else phase_tables(p, wv, l, bid, nb); } \
        } \
        GRID_BAR(); \
        phase_mix_a(kparams(), wv, l, bid, nb, lds); \
        GRID_BAR(); \
        phase_ret_scan(kparams(), wv, l, bid, nb); \
        GRID_BAR(); \
        phase_ret_out(kparams(), wv, l, bid, nb, lds); \
        GRID_BAR(); \
        { KP p = kparams(); \
            const int Mr = (l == DEPTH - 1) ? TL : T; pg8::Gemm g{p->MIX, p->WtOut + (size_t)l * D * D, Mr, D, D}; pg8::StaticOrder S; S.init(Mr, D, nb, bid); \
            pg8::EpiBf16Plain E{p->Y, D}; \
            pg8::gemm_phase<pg8::EpiBf16Plain, pg8::StaticOrder, true, true>(ldsl, g, S, E, wv); \
        } \
        GRID_BAR(); \
        phase_ln1(kparams(), wv, l, bid, nb); \
        GRID_BAR(); \
        { KP p = kparams(); \
            const int Mr = (l == DEPTH - 1) ? TL : T; pg8::Gemm g{p->H, p->WtQ + (size_t)l * 2048 * D, Mr, 2048, D}; pg8::StaticOrder S; S.init(Mr, 2048, nb, bid); \
            pg8::EpiBf16Plain E{p->Qb, 2048}; \
            pg8::gemm_phase<pg8::EpiBf16Plain, pg8::StaticOrder, true, true>(ldsl, g, S, E, wv); \
        } \
        GRID_BAR(); \
        phase_topk(kparams(), wv, l, bid, nb, lds); \
        GRID_BAR(); \
        phase_expert_u(kparams(), wv, l, bid, nb, lds); \
        GRID_BAR(); \
        phase_expert_v(kparams(), wv, l, bid, nb); \
        GRID_BAR(); \
        phase_ln2(kparams(), wv, l, bid, nb); \
        if (l + 1 < DEPTH) GRID_BAR(); \
    } while (0)
    LAYER_BODY(0); LAYER_BODY(1); LAYER_BODY(2); LAYER_BODY(3);
#undef LAYER_BODY
}

extern "C" void kernel_launch(void* const* d_in, const int* in_sizes, int n_in, void* d_out, int out_size, void* d_ws, size_t ws_size, hipStream_t stream) {
    static int grid_blocks = 0;
    if (!grid_blocks) {
        int dev = 0, cus = 0, per_cu = 0;
        (void)hipGetDevice(&dev);
        (void)hipDeviceGetAttribute(&cus, hipDeviceAttributeMultiprocessorCount, dev);
        (void)hipFuncSetAttribute((const void*)mega, hipFuncAttributeMaxDynamicSharedMemorySize, LDS_BYTES);
        (void)hipOccupancyMaxActiveBlocksPerMultiprocessor(&per_cu, mega, NT, LDS_BYTES);
        if (per_cu < 1) { fprintf(stderr, "occupancy query says %d blocks per CU\n", per_cu); per_cu = 1; }
        grid_blocks = cus;
    }
    Params p{};
    const float** ins = (const float**)&p;
    for (int i = 0; i < 22; ++i) ins[i] = (const float*)d_in[i];
    p.out = (float*)d_out;
    char* ws = (char*)d_ws;
    size_t off = 0;
    auto carve = [&](size_t bytes) { void* r = ws + off; off += (bytes + 255) & ~(size_t)255; return r; };
    p.ctl = (unsigned*)carve(CTL_BYTES);
    p.modp = (float*)carve((size_t)16 * DEPTH * 3 * 6144 * 4);
    p.mod = (float*)carve((size_t)DEPTH * 3 * 6144 * 4);
    p.rope = (float*)carve((size_t)192 * 16 * 2 * 4);
    p.WtIn = (bf16*)carve((size_t)DEPTH * DIN * D * 2);
    p.WtOut = (bf16*)carve((size_t)DEPTH * D * D * 2);
    p.WtQ = (bf16*)carve((size_t)DEPTH * 2048 * D * 2);
    p.X = (bf16*)carve((size_t)T * D * 2);
    p.H = (bf16*)carve((size_t)T * D * 2);
    p.P = (bf16*)carve((size_t)T * DIN * 2);
    p.KV = (float*)carve((size_t)2 * NB * NPOS * 4 * 4096 * 4);
    p.MIX = (bf16*)carve((size_t)T * D * 2);
    p.ST16 = (bf16*)carve((size_t)2 * NB * NPOS * 4 * 4096 * 2);
    p.Qb = (bf16*)carve((size_t)T * 2048 * 2);
    p.U8 = (unsigned char*)carve((size_t)DEPTH * PEER_N * D);
    p.V8 = (unsigned char*)carve((size_t)DEPTH * PEER_N * D);
    p.XQ = (unsigned char*)carve((size_t)T * D);
    p.SX = (float*)carve((size_t)T * 4);
    p.SU = (float*)carve((size_t)DEPTH * PEER_N * 4);
    p.SV = (float*)carve((size_t)DEPTH * PEER_N * 4);
    p.Y = (bf16*)carve((size_t)T * D * 2);
    p.X1 = (bf16*)carve((size_t)T * D * 2);
    p.GATE = (float*)carve((size_t)T * NSEL * 4);
    p.ACT = (float*)carve((size_t)T * NSEL * 4);
    p.EIDX = (int*)carve((size_t)T * NSEL * 4);
    if (off > ws_size) { fprintf(stderr, "workspace too small: need %zu have %zu\n", off, ws_size); return; }
    (void)hipMemsetAsync(p.ctl, 0, CTL_BYTES, stream);
    void* args[] = {&p};
    hipError_t e = hipLaunchCooperativeKernel((void*)mega, dim3(grid_blocks), dim3(NT), args, LDS_BYTES, stream);
    if (e != hipSuccess) fprintf(stderr, "cooperative launch failed: %s (grid %d)\n", hipGetErrorString(e), grid_blocks);
}
```

```cpp
#include <hip/hip_runtime.h>
#include <hip/hip_cooperative_groups.h>
#include <cstdio>
#include <cstdint>
namespace cg = cooperative_groups;

constexpr int D = 1024, NB = 2, SEQ = 8192, DEPTH = 4, LC = 256, HD = 64;
constexpr int TL = NB * SEQ, TC = NB * LC, T = TL + TC;
constexpr int DIN = 2304;
constexpr int C_RQ = 0, C_RK = 256, C_RV = 512, C_RG = 768, C_SU = 1024, C_SV = 1280, C_AQ = 1536, C_AK = 2048, C_AV = 2176;
constexpr int NPOS = 66;
constexpr int PEER_N = 16384, NSEL = 128;
constexpr float LN_EPS = 1e-5f;
constexpr float ALPHA = 1.681792830507429f;
constexpr int NT = 512;
constexpr int NW = 8;
constexpr int LDS_BYTES = 163840;
constexpr int MISC_OFF = LDS_BYTES - 256;

typedef unsigned short bf16;
#define LAS __attribute__((address_space(3)))

struct Params {
    const float *x, *c, *ctx, *c_ctx, *w_mod, *b_mod, *w_in, *w_out, *rdf, *rdb, *sgu_w, *sgu_b, *sink, *lnm_g, *lnm_b, *wq, *k1, *k2, *pu, *pv, *lnf_g, *lnf_b;
    float* out;
    unsigned* ctl;
    float *modp, *mod, *rope, *KV, *GATE, *ACT;
    bf16 *X, *X1, *Y;
    bf16 *WtIn, *WtOut, *WtQ, *H, *P, *MIX, *Qb, *ST16;
    unsigned char *U8, *V8, *XQ;
    float *SU, *SV, *SX;
    int *EIDX;
};

__device__ __forceinline__ unsigned f2bf(float f) { return (unsigned)__builtin_bit_cast(unsigned short, (__bf16)f); }
typedef float f32x2_pk __attribute__((ext_vector_type(2))); typedef __bf16 bf16x2_pk __attribute__((ext_vector_type(2)));
__device__ __forceinline__ unsigned pk2(float lo, float hi) { const f32x2_pk v = {lo, hi}; return __builtin_bit_cast(unsigned, __builtin_convertvector(v, bf16x2_pk)); }
__device__ __forceinline__ float bf2f(bf16 v) { return __builtin_bit_cast(float, (unsigned)v << 16); }
__device__ __forceinline__ float bflo(unsigned w) { return __builtin_bit_cast(float, w << 16); }
__device__ __forceinline__ float bfhi(unsigned w) { return __builtin_bit_cast(float, w & 0xffff0000u); }

__device__ __forceinline__ float gelu_tanh(float x) {
    const float u2 = x * (1.5957691216057308f + 0.07135481627f * x * x);
    return x * __builtin_amdgcn_rcpf(1.0f + __builtin_amdgcn_exp2f(-1.4426950408889634f * u2));
}
__device__ __forceinline__ float silu_f(float x) { return x * __builtin_amdgcn_rcpf(1.0f + __builtin_amdgcn_exp2f(-1.4426950408889634f * x)); }
__device__ __forceinline__ int chunk_row0(int b, int pos) { return pos < 2 ? TL + b * LC + pos * 128 : b * SEQ + (pos - 2) * 128; }
__device__ __forceinline__ int mod_idx(int r) { return r < TL ? r / SEQ : 2; }
__device__ __forceinline__ float log_sigmoid_f(float x) { return -log1pf(expf(-x)); }
typedef const __attribute__((address_space(4))) Params* KP;
__device__ __forceinline__ KP kparams() { KP k = (KP)__builtin_amdgcn_kernarg_segment_ptr(); asm volatile("" : "+s"(k)); return k; }
__device__ __forceinline__ float shx(float v, int m, int lane) { return __builtin_bit_cast(float, __builtin_amdgcn_ds_bpermute((lane ^ m) << 2, __builtin_bit_cast(int, v))); }
__device__ __forceinline__ int shx(int v, int m, int lane) { return __builtin_amdgcn_ds_bpermute((lane ^ m) << 2, v); }
__device__ __forceinline__ float shf(float v, int src) { return __builtin_bit_cast(float, __builtin_amdgcn_ds_bpermute(src << 2, __builtin_bit_cast(int, v))); }
__device__ __forceinline__ int shf(int v, int src) { return __builtin_amdgcn_ds_bpermute(src << 2, v); }
__device__ __forceinline__ float wave_sum(float v, int lane) {
#pragma unroll
    for (int o = 32; o >= 1; o >>= 1) v += shx(v, o, lane);
    return v;
}
__device__ __forceinline__ int lane_opaque() { unsigned m = ~0u; asm volatile("" : "+s"(m)); return (int)__builtin_amdgcn_mbcnt_hi(m, __builtin_amdgcn_mbcnt_lo(m, 0u)); }
__device__ __forceinline__ int tid_opaque(int wv) { return wv * 64 + lane_opaque(); }

namespace pg8 {
#define PG8_LAS __attribute__((address_space(3)))
typedef unsigned short bf16_t;
typedef short bf16x8 __attribute__((ext_vector_type(8)));
typedef float f32x4 __attribute__((ext_vector_type(4)));
typedef unsigned u32x4 __attribute__((ext_vector_type(4)));
constexpr int BM = 256, BK = 64, HALF = 128, HTB = HALF * BK * 2  , STAGE_BYTES = 8 * HTB, NXCD = 8, WGM = 8;

__host__ __device__ __forceinline__ int lds_byte(int r, int c) { const int st = (r >> 4) * 2 + (c >> 5), rr = r & 15, cc = c & 31, ob = rr * 64 + cc * 2; return st * 1024 + (ob ^ (((ob >> 9) & 1) << 5)); }
__host__ __device__ __forceinline__ void stage_rc(int b, int& R, int& C) { const int st = b / 1024, sb = b % 1024, swz = sb ^ (((sb >> 9) & 1) << 5); R = (st >> 1) * 16 + swz / 64; C = (st & 1) * 32 + (swz % 64) / 2; }
__host__ __device__ __forceinline__ int perm32(int rho) { const int n = rho >> 4, i = rho & 15; return 8 * (i >> 2) + 4 * n + (i & 3); }

struct Unit { int pm, pn; };
struct Gemm { const bf16_t* A; const bf16_t* Bt; int M, N, K; };

struct StaticOrder {
    int nM, nN, nwg, G, c;
    __host__ __device__ void init(int M, int N, int G_, int c_) { nM = M / BM; nN = N / BM; nwg = nM * nN; G = G_; c = c_; }
    __host__ __device__ __forceinline__ bool next(int i, Unit& u) const {
        const long L = (long)i * G + c; if (L >= nwg) return false;
        int wgid = (int)L; { const int q = nwg / NXCD, r = nwg % NXCD, xcd = wgid % NXCD, off = wgid / NXCD; wgid = (xcd < r ? xcd * (q + 1) : r * (q + 1) + (xcd - r) * q) + off; }
        const int nig = WGM * nN, gid = wgid / nig, fm = gid * WGM, gsz = (nM - fm) < WGM ? (nM - fm) : WGM;
        u.pm = fm + ((wgid % nig) % gsz); u.pn = (wgid % nig) / gsz; return true;
    }
    __device__ __forceinline__ void a_ready(const Unit&) const {}
    __device__ __forceinline__ void done(const Unit&) const {}
};

__device__ __forceinline__ unsigned cvt_pk_bf16(float lo, float hi) { unsigned r; asm volatile("v_cvt_pk_bf16_f32 %0, %1, %2" : "=v"(r) : "v"(lo), "v"(hi)); return r; }
struct EpiInProj {
    static constexpr bool PERM = true, AFTER_DRAIN = false;
    bf16_t* P; const float* rope;
    __device__ __forceinline__ void operator()(const f32x4 (&acc)[2][2][4][2], const Unit& u, int wr, int wc, int fr, int fq) const {
        const int pn = u.pn; const bool lat = u.pm < 64; const int lane = fq * 16 + fr;
        const float sc = pn == 1 ? 0.125f : ((pn == 6 || pn == 7) ? 0.125f * 1.4426950408889634f : 1.0f);
        const float sgn = fq < 2 ? -1.0f : 1.0f;
#pragma unroll
        for (int bj = 0; bj < 2; ++bj) {
            const bool roped = lat && (pn == 0 || pn == 1 || pn == 6 || pn == 7 || (pn == 8 && bj == 0));
#pragma unroll
            for (int ai = 0; ai < 2; ++ai)
#pragma unroll
                for (int m = 0; m < 4; ++m) {
                    const int row = u.pm * BM + ai * HALF + wr * 64 + m * 16 + fr;
                    f32x4 v0 = acc[ai][bj][m][0], v1 = acc[ai][bj][m][1];
                    if (roped) {
                        const int pos = row & 8191, idx = (wc & 1) ? 128 + (pos & 63) : (pos >> 6);
                        const float2* tb = (const float2*)rope + idx * 16 + 8 * (fq & 1);
#pragma unroll
                        for (int e = 0; e < 4; ++e) {
                            const float p0 = shx(v0[e], 32, lane), p1 = shx(v1[e], 32, lane);
                            const float2 c0 = tb[e], c1 = tb[4 + e];
                            v0[e] = v0[e] * c0.x + sgn * p0 * c0.y;
                            v1[e] = v1[e] * c1.x + sgn * p1 * c1.y;
                        }
                    }
                    v0 = v0 * sc; v1 = v1 * sc;
                    u32x4 w; w.x = cvt_pk_bf16(v0[0], v0[1]); w.y = cvt_pk_bf16(v0[2], v0[3]); w.z = cvt_pk_bf16(v1[0], v1[1]); w.w = cvt_pk_bf16(v1[2], v1[3]);
                    *(u32x4*)(P + (size_t)row * 2304 + pn * BM + bj * HALF + wc * 32 + fq * 8) = w;
                    __builtin_amdgcn_sched_barrier(0);
                }
        }
    }
};
struct EpiF32 {
    static constexpr bool PERM = false, AFTER_DRAIN = false;
    float* O; int ldc;
    __device__ __forceinline__ void operator()(const f32x4 (&acc)[2][2][4][2], const Unit& u, int wr, int wc, int fr, int fq) const {
#pragma unroll
        for (int ai = 0; ai < 2; ++ai)
#pragma unroll
            for (int m = 0; m < 4; ++m) {
                float* rowp = O + (size_t)(u.pm * BM + ai * HALF + wr * 64 + m * 16 + fr) * ldc + u.pn * BM + wc * 32 + fq * 4;
#pragma unroll
                for (int bj = 0; bj < 2; ++bj)
#pragma unroll
                    for (int n = 0; n < 2; ++n) *(f32x4*)(rowp + bj * HALF + n * 16) = acc[ai][bj][m][n];
            }
    }
};


struct EpiBf16Plain {
    static constexpr bool PERM = true, AFTER_DRAIN = false;
    bf16_t* O; int ldc;
    __device__ __forceinline__ void operator()(const f32x4 (&acc)[2][2][4][2], const Unit& u, int wr, int wc, int fr, int fq) const {
#pragma unroll
        for (int ai = 0; ai < 2; ++ai)
#pragma unroll
            for (int m = 0; m < 4; ++m) {
                bf16_t* rowp = O + (size_t)(u.pm * BM + ai * HALF + wr * 64 + m * 16 + fr) * ldc + u.pn * BM + wc * 32 + fq * 8;
#pragma unroll
                for (int bj = 0; bj < 2; ++bj) {
                    const f32x4 v0 = acc[ai][bj][m][0], v1 = acc[ai][bj][m][1];
                    u32x4 w; w.x = cvt_pk_bf16(v0[0], v0[1]); w.y = cvt_pk_bf16(v0[2], v0[3]); w.z = cvt_pk_bf16(v1[0], v1[1]); w.w = cvt_pk_bf16(v1[2], v1[3]);
                    *(u32x4*)(rowp + bj * HALF) = w;
                }
            }
    }
};
template <class Epi, class Sched, bool ALIGN_EPI = false, bool SP2 = false>
__device__ __forceinline__ void gemm_phase(PG8_LAS unsigned char* lds, const Gemm g, const Sched& S, const Epi& E, int wv) {
    int tid_ = wv * 64; { unsigned m_ = ~0u; asm volatile("" : "+s"(m_)); tid_ += (int)__builtin_amdgcn_mbcnt_hi(m_, __builtin_amdgcn_mbcnt_lo(m_, 0u)); }
    const int tid = tid_, wid = __builtin_amdgcn_readfirstlane(tid >> 6), lane = tid & 63, wr = wid >> 2, wc = wid & 3, fr = lane & 15, fq = lane >> 4;
    const int K = g.K, nt = K / BK;
    unsigned voffA[2], voffB[2];
#pragma unroll
    for (int i = 0; i < 2; ++i) { int R, C; stage_rc(tid * 16 + i * 8192, R, C); const int Rb = Epi::PERM ? ((R & ~31) + perm32(R & 31)) : R;
        voffA[i] = (unsigned)(R * K + C) * 2u; voffB[i] = (unsigned)(Rb * K + C) * 2u; }
    const size_t kstep = (size_t)(BK * 2);
    const size_t hstep = (size_t)HALF * K * 2;
    const size_t tstep = 2 * hstep;
    const unsigned ldsw = (unsigned)wid * 1024u;
    const int aoff = lds_byte(wr * 64 + fr, fq * 8), boff = lds_byte(wc * 32 + fr, fq * 8);
#define PG8_SA(b, h) (((b) * 2 + (h)) * HTB)
#define PG8_SB(b, h) ((4 + (b) * 2 + (h)) * HTB)
#define PG8_STAGE(bufoff, gbase, voff) do { _Pragma("unroll") for (int _i = 0; _i < 2; ++_i) \
        __builtin_amdgcn_global_load_lds((const unsigned*)((const char*)(gbase) + (voff)[_i]), (PG8_LAS unsigned*)(lds + (bufoff) + ldsw + _i * 8192), 16, 0, 0); } while (0)
#define PG8_LDA(dst, b, h) do { _Pragma("unroll") for (int m = 0; m < 4; ++m) _Pragma("unroll") for (int k = 0; k < 2; ++k) dst[m][k] = *(const PG8_LAS bf16x8*)(lds + PG8_SA(b, h) + aoff + m * 2048 + k * 1024); } while (0)
#define PG8_LDB(dst, b, h) do { _Pragma("unroll") for (int n = 0; n < 2; ++n) _Pragma("unroll") for (int k = 0; k < 2; ++k) dst[n][k] = *(const PG8_LAS bf16x8*)(lds + PG8_SB(b, h) + boff + n * 2048 + k * 1024); } while (0)
#define PG8_MMA(ai, bj, At, Bt) do { __builtin_amdgcn_s_setprio(1); _Pragma("unroll") for (int m = 0; m < 4; ++m) _Pragma("unroll") for (int n = 0; n < 2; ++n) _Pragma("unroll") for (int k = 0; k < 2; ++k) \
        acc[ai][bj][m][n] = __builtin_amdgcn_mfma_f32_16x16x32_bf16(Bt[n][k], At[m][k], acc[ai][bj][m][n], 0, 0, 0); __builtin_amdgcn_s_setprio(0); } while (0)
#define PG8_WAIT_V(n) asm volatile("s_waitcnt vmcnt(" #n ")" ::: "memory")
#define PG8_WAIT_L(n) asm volatile("s_waitcnt lgkmcnt(" #n ")" ::: "memory")
#define PG8_BAR __builtin_amdgcn_s_barrier()
#define PG8_SCHED __builtin_amdgcn_sched_barrier(0)
    Unit cur, nxt; int ui = 0;
    if (!S.next(0, cur)) return;
    f32x4 acc[2][2][4][2];
#pragma unroll
    for (int a = 0; a < 2; ++a)
#pragma unroll
        for (int b = 0; b < 2; ++b)
#pragma unroll
            for (int m = 0; m < 4; ++m)
#pragma unroll
                for (int n = 0; n < 2; ++n) acc[a][b][m][n] = (f32x4){0.f, 0.f, 0.f, 0.f};
    bf16x8 At[4][2], B0[2][2], B1[2][2];
    const char* cA = (const char*)g.A + (size_t)cur.pm * tstep; const char* cB = (const char*)g.Bt + (size_t)cur.pn * tstep;
    S.a_ready(cur);
    if constexpr (SP2) {
        PG8_STAGE(PG8_SB(0, 0), cB, voffB); PG8_STAGE(PG8_SB(0, 1), cB + hstep, voffB); PG8_STAGE(PG8_SA(0, 0), cA, voffA); PG8_STAGE(PG8_SA(0, 1), cA + hstep, voffA);
        if (wr == 1) PG8_BAR;
        PG8_WAIT_V(2); PG8_BAR;
        PG8_STAGE(PG8_SB(1, 0), cB + kstep, voffB); PG8_STAGE(PG8_SA(1, 0), cA + kstep, voffA); PG8_STAGE(PG8_SB(1, 1), cB + hstep + kstep, voffB);
        PG8_WAIT_V(6); PG8_BAR;
    } else {
        PG8_STAGE(PG8_SB(0, 0), cB, voffB); PG8_STAGE(PG8_SA(0, 0), cA, voffA); PG8_STAGE(PG8_SB(0, 1), cB + hstep, voffB); PG8_STAGE(PG8_SA(0, 1), cA + hstep, voffA);
        if (wr == 1) PG8_BAR;
        PG8_WAIT_V(4); PG8_BAR;
        PG8_STAGE(PG8_SB(1, 0), cB + kstep, voffB); PG8_STAGE(PG8_SA(1, 0), cA + kstep, voffA); PG8_STAGE(PG8_SB(1, 1), cB + hstep + kstep, voffB);
        PG8_WAIT_V(6); PG8_BAR;
    }
    for (;;) {
        const bool has_next = S.next(ui + 1, nxt);
        const char* nA = has_next ? (const char*)g.A + (size_t)nxt.pm * tstep : cA; const char* nB = has_next ? (const char*)g.Bt + (size_t)nxt.pn * tstep : cB;
        for (int t = 0; t < nt; t += 2) {
            const bool last = (t == nt - 2);
            const char* a1 = cA + (size_t)(t + 1) * kstep;
            const char* a2 = last ? nA : cA + (size_t)(t + 2) * kstep; const char* b2 = last ? nB : cB + (size_t)(t + 2) * kstep;
            const char* a3 = a2 + kstep; const char* b3 = b2 + kstep;
            if (last && has_next) S.a_ready(nxt);
            if constexpr (SP2) {
            PG8_LDB(B0, 0, 0); PG8_LDB(B1, 0, 1); PG8_SCHED; PG8_LDA(At, 0, 0); PG8_STAGE(PG8_SA(1, 1), a1 + hstep, voffA);
            PG8_WAIT_V(8); PG8_WAIT_L(0); PG8_BAR; PG8_MMA(0, 0, At, B0); PG8_MMA(0, 1, At, B1); PG8_BAR; PG8_SCHED;
            PG8_LDA(At, 0, 1); PG8_STAGE(PG8_SB(0, 0), b2, voffB); PG8_STAGE(PG8_SB(0, 1), b2 + hstep, voffB); PG8_STAGE(PG8_SA(0, 0), a2, voffA);
            PG8_WAIT_V(8); PG8_WAIT_L(0); PG8_BAR; PG8_MMA(1, 0, At, B0); PG8_MMA(1, 1, At, B1); PG8_BAR; PG8_SCHED;
            PG8_LDB(B0, 1, 0); PG8_LDB(B1, 1, 1); PG8_SCHED; PG8_LDA(At, 1, 0); PG8_STAGE(PG8_SA(0, 1), a2 + hstep, voffA);
            PG8_WAIT_V(8); PG8_WAIT_L(0); PG8_BAR; PG8_MMA(0, 0, At, B0); PG8_MMA(0, 1, At, B1); PG8_BAR; PG8_SCHED;
            PG8_LDA(At, 1, 1); PG8_STAGE(PG8_SB(1, 0), b3, voffB); PG8_STAGE(PG8_SB(1, 1), b3 + hstep, voffB); PG8_STAGE(PG8_SA(1, 0), a3, voffA);
            PG8_WAIT_V(8); PG8_WAIT_L(0); PG8_BAR; PG8_MMA(1, 0, At, B0); PG8_MMA(1, 1, At, B1); PG8_BAR; PG8_SCHED;
            } else {
            PG8_LDB(B0, 0, 0); PG8_SCHED; PG8_LDA(At, 0, 0); PG8_STAGE(PG8_SA(1, 1), a1 + hstep, voffA);
            PG8_WAIT_L(8); PG8_BAR; PG8_WAIT_L(0); PG8_MMA(0, 0, At, B0); PG8_BAR; PG8_SCHED;
            PG8_LDB(B1, 0, 1); PG8_STAGE(PG8_SB(0, 0), b2, voffB);
            PG8_BAR; PG8_WAIT_L(0); PG8_MMA(0, 1, At, B1); PG8_BAR;
            PG8_LDA(At, 0, 1); PG8_STAGE(PG8_SA(0, 0), a2, voffA);
            PG8_BAR; PG8_WAIT_L(0); PG8_MMA(1, 0, At, B0); PG8_BAR; PG8_SCHED;
            PG8_STAGE(PG8_SB(0, 1), b2 + hstep, voffB);
            PG8_WAIT_V(6); PG8_BAR; PG8_MMA(1, 1, At, B1); PG8_BAR;
            PG8_LDB(B0, 1, 0); PG8_SCHED; PG8_LDA(At, 1, 0); PG8_STAGE(PG8_SA(0, 1), a2 + hstep, voffA);
            PG8_WAIT_L(8); PG8_BAR; PG8_WAIT_L(0); PG8_MMA(0, 0, At, B0); PG8_BAR; PG8_SCHED;
            PG8_LDB(B1, 1, 1); PG8_STAGE(PG8_SB(1, 0), b3, voffB);
            PG8_BAR; PG8_WAIT_L(0); PG8_MMA(0, 1, At, B1); PG8_BAR;
            PG8_LDA(At, 1, 1); PG8_STAGE(PG8_SA(1, 0), a3, voffA);
            PG8_BAR; PG8_WAIT_L(0); PG8_MMA(1, 0, At, B0); PG8_BAR; PG8_SCHED;
            PG8_STAGE(PG8_SB(1, 1), b3 + hstep, voffB);
            PG8_WAIT_V(6); PG8_BAR; PG8_MMA(1, 1, At, B1); PG8_BAR;
            }
        }
        if constexpr (ALIGN_EPI) { if (wr == 0) PG8_BAR; }
        if constexpr (!Epi::AFTER_DRAIN) { E(acc, cur, wr, wc, fr, fq); S.done(cur); }
        if (!has_next) break;
#pragma unroll
        for (int a = 0; a < 2; ++a)
#pragma unroll
            for (int b = 0; b < 2; ++b)
#pragma unroll
                for (int m = 0; m < 4; ++m)
#pragma unroll
                    for (int n = 0; n < 2; ++n) acc[a][b][m][n] = (f32x4){0.f, 0.f, 0.f, 0.f};
        cur = nxt; cA = nA; cB = nB; ++ui;
        if constexpr (ALIGN_EPI) { if (wr == 1) PG8_BAR; }
    }
    PG8_WAIT_V(0);
    if constexpr (!ALIGN_EPI) { if (wr == 0) PG8_BAR; }
    PG8_BAR;
    if constexpr (Epi::AFTER_DRAIN) { E.fused(acc, cur, wr, wc, fr, fq, lds, wid, lane); S.done(cur); }
#undef PG8_SA
#undef PG8_SB
#undef PG8_STAGE
#undef PG8_LDA
#undef PG8_LDB
#undef PG8_MMA
#undef PG8_WAIT_V
#undef PG8_WAIT_L
#undef PG8_BAR
#undef PG8_SCHED
}
}
constexpr int CW_BAR = 4096;
constexpr size_t CTL_BYTES = 65536;
#define XB_TMO      128
#define XB_XCNT(j)  (256  + 64 * (j))
#define XB_XSUB(j)  (1280 + 64 * (j))
#define XB_XGEN(j)  (2304 + 64 * (j))
#define XB_TOP      3328
#define XB_TOPGEN   3392
#define XCD_BAR_WORDS 3456
#define XB_SPIN_CAP (1u << 18)

__device__ __forceinline__ unsigned xb_ld(unsigned* p)              { return __hip_atomic_load(p, __ATOMIC_RELAXED, __HIP_MEMORY_SCOPE_AGENT); }
__device__ __forceinline__ unsigned xb_add(unsigned* p, unsigned v) { return __hip_atomic_fetch_add(p, v, __ATOMIC_RELAXED, __HIP_MEMORY_SCOPE_AGENT); }
__device__ __forceinline__ unsigned xb_xcc_id() { return (unsigned)__builtin_amdgcn_s_getreg((3 << 11) | 20) & 0xFu; }
#define XB_SPIN(cond, bar) do { unsigned _sp = 0; while (cond) { __builtin_amdgcn_s_sleep(1); \
    if ((++_sp & 255u) == 0u) { if (xb_ld(&(bar)[XB_TMO])) break; if (_sp > XB_SPIN_CAP) { atomicAdd(&(bar)[XB_TMO], 1u); break; } } } } while (0)

struct XcdBarrier {
    unsigned* bar; unsigned x; bool lead;
    volatile LAS unsigned* st;
};

__device__ __forceinline__ XcdBarrier xcd_barrier_post(unsigned* bar, volatile LAS unsigned* st, bool lead) {
    XcdBarrier b; b.bar = bar; b.x = xb_xcc_id(); b.st = st; b.lead = lead;
    if (b.lead) (void)xb_add(&bar[XB_XCNT(b.x)], 1u);
    return b;
}
__device__ __forceinline__ void xcd_barrier_complete(unsigned* bar, unsigned x, unsigned& nloc, unsigned& nx) {
    const unsigned G = gridDim.x * gridDim.y * gridDim.z;
    unsigned sum, cnt, mine, sp = 0u;
    for (;;) {
        sum = 0u; cnt = 0u; mine = 0u;
#pragma unroll
        for (unsigned j = 0; j < 16; ++j) { const unsigned c = xb_ld(&bar[XB_XCNT(j)]); sum += c; cnt += (c > 0u) ? 1u : 0u; mine = (j == x) ? c : mine; }
        if (sum == G) break;
        __builtin_amdgcn_s_sleep(1);
        if ((++sp & 255u) == 0u) { if (xb_ld(&bar[XB_TMO])) break; if (sp > XB_SPIN_CAP) { atomicAdd(&bar[XB_TMO], 1u); break; } }
    }
    nloc = mine > 0u ? mine : 1u; nx = cnt > 0u ? cnt : 1u;
}

__device__ __forceinline__ void xcd_barrier(const XcdBarrier& b) {
    asm volatile("s_waitcnt vmcnt(0)" ::: "memory");
    __syncthreads();
    if (b.lead) {
        unsigned* bar = b.bar;
        __builtin_amdgcn_s_waitcnt(0);
        unsigned nloc = b.st[0], nx = b.st[1];
        if (nloc == 0u) { xcd_barrier_complete(bar, b.x, nloc, nx); b.st[0] = nloc; b.st[1] = nx; }
        const unsigned old = xb_add(&bar[XB_XSUB(b.x)], 1u);
        const unsigned gen = old / nloc;
        if (old + 1u == (gen + 1u) * nloc) {
            __builtin_amdgcn_fence(__ATOMIC_RELEASE, "agent");
            asm volatile("s_waitcnt vmcnt(0)" ::: "memory");
            const unsigned og = xb_add(&bar[XB_TOP], 1u);
            const unsigned tg = og / nx;
            if (og + 1u == (tg + 1u) * nx) xb_add(&bar[XB_TOPGEN], 1u);
            else XB_SPIN(xb_ld(&bar[XB_TOPGEN]) == tg, bar);
            __builtin_amdgcn_fence(__ATOMIC_ACQUIRE, "agent");
            xb_add(&bar[XB_XGEN(b.x)], 1u);
            asm volatile("s_waitcnt vmcnt(0)" ::: "memory");
        } else {
            XB_SPIN(xb_ld(&bar[XB_XGEN(b.x)]) == gen, bar);
            __builtin_amdgcn_fence(__ATOMIC_ACQUIRE, "agent");
            asm volatile("s_waitcnt vmcnt(0)" ::: "memory");
        }
    }
    __syncthreads();
}


__device__ __forceinline__ void phase_mod1(KP p, int wv, int bid, int nb, float* lds) {
    float* red = lds;
    const int t = tid_opaque(wv), cg4 = t & 63, kg = t >> 6;
    for (int u = bid; u < DEPTH * 24 * 16; u += nb) {
        const int ks = u & 15, nblk = (u >> 4) % 24, l = u / (16 * 24);
        const int n = nblk * 256 + cg4 * 4;
        float4 wr[8];
#pragma unroll
        for (int kk = 0; kk < 8; ++kk) wr[kk] = *(const float4*)(p->w_mod + ((size_t)l * D + ks * 64 + kg * 8 + kk) * 6144 + n);
        float a[3][4];
#pragma unroll
        for (int v = 0; v < 3; ++v)
#pragma unroll
            for (int j = 0; j < 4; ++j) a[v][j] = 0.f;
#pragma unroll
        for (int kk = 0; kk < 8; ++kk) {
            const int k = ks * 64 + kg * 8 + kk;
            const float s0 = silu_f(p->c[k]), s1 = silu_f(p->c[D + k]), s2 = silu_f(p->c_ctx[k]);
            a[0][0] += s0 * wr[kk].x; a[0][1] += s0 * wr[kk].y; a[0][2] += s0 * wr[kk].z; a[0][3] += s0 * wr[kk].w;
            a[1][0] += s1 * wr[kk].x; a[1][1] += s1 * wr[kk].y; a[1][2] += s1 * wr[kk].z; a[1][3] += s1 * wr[kk].w;
            a[2][0] += s2 * wr[kk].x; a[2][1] += s2 * wr[kk].y; a[2][2] += s2 * wr[kk].z; a[2][3] += s2 * wr[kk].w;
        }
        __syncthreads();
#pragma unroll
        for (int v = 0; v < 3; ++v) *(float4*)(red + (v * 8 + kg) * 256 + cg4 * 4) = make_float4(a[v][0], a[v][1], a[v][2], a[v][3]);
        __syncthreads();
        for (int o = t; o < 768; o += NT) {
            const int v = o >> 8, col = o & 255;
            float sm = 0.f;
#pragma unroll
            for (int g = 0; g < 8; ++g) sm += red[(v * 8 + g) * 256 + col];
            p->modp[(((size_t)ks * DEPTH + l) * 3 + v) * 6144 + nblk * 256 + col] = sm;
        }
    }
    __syncthreads();
}
__device__ __forceinline__ void phase_mod2(KP p, int wv, int bid, int nb) {
    for (int i = bid * NT + tid_opaque(wv); i < DEPTH * 3 * 6144; i += nb * NT) {
        const int n = i % 6144, l = i / (3 * 6144);
        float s = p->b_mod[l * 6144 + n];
        for (int ks = 0; ks < 16; ++ks) s += p->modp[(size_t)ks * DEPTH * 3 * 6144 + i];
        p->mod[i] = s;
    }
}
__device__ __forceinline__ void transpose_item(const float* W, int K, int N, bf16* WT, float* scr, int item, int lane) {
    const int nblk = N / 64, kb = item / nblk, nbk = item % nblk, k0 = 64 * kb, n0 = 64 * nbk;
    const int r4 = lane >> 4, c4 = lane & 15;
#pragma unroll 8
    for (int i = 0; i < 16; ++i) { const int kk = 4 * i + r4; const float4 q = *(const float4*)(W + (size_t)(k0 + kk) * N + n0 + c4 * 4);
        float* d = scr + kk * 65 + c4 * 4; d[0] = q.x; d[1] = q.y; d[2] = q.z; d[3] = q.w; }
    __builtin_amdgcn_wave_barrier();
    const int c = lane & 7;
#pragma unroll
    for (int j = 0; j < 8; ++j) { const int n = (lane >> 3) + 8 * j; const float* sp = scr + (8 * c) * 65 + n;
        uint4 o; o.x = pk2(sp[0 * 65], sp[1 * 65]); o.y = pk2(sp[2 * 65], sp[3 * 65]); o.z = pk2(sp[4 * 65], sp[5 * 65]); o.w = pk2(sp[6 * 65], sp[7 * 65]);
        *(uint4*)(WT + (size_t)(n0 + n) * K + k0 + 8 * c) = o; }
    __builtin_amdgcn_wave_barrier();
}
__device__ __forceinline__ void phase_tables(KP p, int wv, int l, int vb, int nvb) {
    {
        const int lane_ = tid_opaque(wv) & 63, w_ = tid_opaque(wv) >> 6;
        for (int row0 = (vb * NW + w_) * 4; row0 < 2 * PEER_N; row0 += nvb * NW * 4) {
            float v[4][16];
#pragma unroll
            for (int q = 0; q < 4; ++q) {
                const int row = row0 + q; const bool isv = row >= PEER_N; const int rr = l * PEER_N + (isv ? row - PEER_N : row);
                const float* src_ = (isv ? p->pv : p->pu) + (size_t)rr * D;
#pragma unroll
                for (int i = 0; i < 4; ++i) { typedef float f4v_ __attribute__((ext_vector_type(4))); const f4v_ q4 = __builtin_nontemporal_load((const f4v_*)(src_ + i * 256 + lane_ * 4)); v[q][i * 4 + 0] = q4[0]; v[q][i * 4 + 1] = q4[1]; v[q][i * 4 + 2] = q4[2]; v[q][i * 4 + 3] = q4[3]; }
            }
#pragma unroll
            for (int q = 0; q < 4; ++q) {
                const int row = row0 + q; const bool isv = row >= PEER_N; const int rr = l * PEER_N + (isv ? row - PEER_N : row);
                float m = 0.f;
#pragma unroll
                for (int i = 0; i < 16; ++i) m = fmaxf(m, fabsf(v[q][i]));
#pragma unroll
                for (int o = 32; o >= 1; o >>= 1) m = fmaxf(m, shx(m, o, lane_));
                unsigned* dst = (unsigned*)((isv ? p->V8 : p->U8) + (size_t)rr * D);
                if (!isv) {
                    const float inv = m > 0.f ? 127.0f / m : 0.f;
#pragma unroll
                    for (int i = 0; i < 4; ++i) {
                        const int q0 = (int)rintf(v[q][i * 4 + 0] * inv), q1 = (int)rintf(v[q][i * 4 + 1] * inv), q2 = (int)rintf(v[q][i * 4 + 2] * inv), q3 = (int)rintf(v[q][i * 4 + 3] * inv);
                        dst[i * 64 + lane_] = (unsigned)(q0 & 0xff) | ((unsigned)(q1 & 0xff) << 8) | ((unsigned)(q2 & 0xff) << 16) | ((unsigned)(q3 & 0xff) << 24);
                    }
                    if (lane_ == 0) p->SU[rr] = m * (1.0f / 127.0f);
                } else {
                    const float inv = m > 0.f ? 240.0f / m : 0.f;
#pragma unroll
                    for (int i = 0; i < 4; ++i) {
                        int pk = __builtin_amdgcn_cvt_pk_fp8_f32(v[q][i * 4 + 0] * inv, v[q][i * 4 + 1] * inv, 0, false);
                        pk = __builtin_amdgcn_cvt_pk_fp8_f32(v[q][i * 4 + 2] * inv, v[q][i * 4 + 3] * inv, pk, true);
                        dst[i * 64 + lane_] = (unsigned)pk;
                    }
                    if (lane_ == 0) p->SV[rr] = m * (1.0f / 240.0f);
                }
            }
        }
    }
}

__device__ __forceinline__ void phase_weights(KP p, int wv, int bid, int nb, float* lds) {
    const int lane = tid_opaque(wv) & 63, w = tid_opaque(wv) >> 6;
    float* scr = lds + w * (64 * 65 + 32);
    constexpr int I_IN = 16 * 36, I_OUT = 16 * 16, I_Q = 16 * 32;
    constexpr int NITEMS = DEPTH * (I_IN + I_OUT + I_Q);
    for (int it = bid * NW + w; it < NITEMS; it += nb * NW) {
        int r = it;
        if (r < DEPTH * I_IN) { const int l = r / I_IN; transpose_item(p->w_in + (size_t)l * D * DIN, D, DIN, p->WtIn + (size_t)l * DIN * D, scr, r % I_IN, lane); continue; } r -= DEPTH * I_IN;
        if (r < DEPTH * I_OUT) { const int l = r / I_OUT; transpose_item(p->w_out + (size_t)l * D * D, D, D, p->WtOut + (size_t)l * D * D, scr, r % I_OUT, lane); continue; } r -= DEPTH * I_OUT;
        { const int l = r / I_Q; transpose_item(p->wq + (size_t)l * D * 2048, D, 2048, p->WtQ + (size_t)l * 2048 * D, scr, r % I_Q, lane); }
    }
    for (int i = bid * NT + tid_opaque(wv); i < 192 * 16; i += nb * NT) {
        const int idx = i >> 4, f = i & 15;
        const float inv = powf(10000.0f, -(float)f / 16.0f);
        const float ang = (float)(idx < 128 ? idx : idx - 128) * inv;
        p->rope[2 * i] = cosf(ang); p->rope[2 * i + 1] = sinf(ang);
    }
}

__device__ __forceinline__ void row_load(const float* src, float (&v)[16], int lane) {
#pragma unroll
    for (int i = 0; i < 4; ++i) { const float4 q = *(const float4*)(src + i * 256 + lane * 4); v[i * 4 + 0] = q.x; v[i * 4 + 1] = q.y; v[i * 4 + 2] = q.z; v[i * 4 + 3] = q.w; }
}
__device__ __forceinline__ void row_store(float* dst, const float (&v)[16], int lane) {
#pragma unroll
    for (int i = 0; i < 4; ++i) *(float4*)(dst + i * 256 + lane * 4) = make_float4(v[i * 4 + 0], v[i * 4 + 1], v[i * 4 + 2], v[i * 4 + 3]);
}
__device__ __forceinline__ void row_store_bf(bf16* dst, const float (&v)[16], int lane) {
#pragma unroll
    for (int i = 0; i < 4; ++i) *(uint2*)(dst + i * 256 + lane * 4) = make_uint2(pk2(v[i * 4 + 0], v[i * 4 + 1]), pk2(v[i * 4 + 2], v[i * 4 + 3]));
}
__device__ __forceinline__ void row_load_bf(const bf16* src, float (&v)[16], int lane) {
#pragma unroll
    for (int i = 0; i < 4; ++i) { const uint2 q = *(const uint2*)(src + i * 256 + lane * 4); v[i * 4 + 0] = bflo(q.x); v[i * 4 + 1] = bfhi(q.x); v[i * 4 + 2] = bflo(q.y); v[i * 4 + 3] = bfhi(q.y); }
}
__device__ __forceinline__ void row_ln(float (&v)[16], int lane) {
    float s = 0.f;
#pragma unroll
    for (int i = 0; i < 16; ++i) s += v[i];
    const float mu = wave_sum(s, lane) * (1.0f / D);
    float q = 0.f;
#pragma unroll
    for (int i = 0; i < 16; ++i) { v[i] -= mu; q += v[i] * v[i]; }
    const float rstd = rsqrtf(wave_sum(q, lane) * (1.0f / D) + LN_EPS);
#pragma unroll
    for (int i = 0; i < 16; ++i) v[i] *= rstd;
}
__device__ __forceinline__ const float* x_row(KP p, int l, int r) {
    if (l == 0) return r < TL ? p->x + (size_t)r * D : p->ctx + (size_t)(r - TL) * D;
    return nullptr;
}

__device__ __forceinline__ void phase_lnmod(KP p, int wv, int l, int bid, int nb) {
    const int lane = tid_opaque(wv) & 63, w = tid_opaque(wv) >> 6;
    for (int r = bid * NW + w; r < T; r += nb * NW) {
        float v[16], sh[16], sc[16];
        row_load(x_row(p, l, r), v, lane);
        const float* m = p->mod + ((size_t)l * 3 + mod_idx(r)) * 6144;
        row_load(m, sh, lane); row_load(m + 1024, sc, lane);
        row_ln(v, lane);
#pragma unroll
        for (int i = 0; i < 16; ++i) v[i] = v[i] * (1.0f + sc[i]) + sh[i];
        row_store_bf(p->H + (size_t)r * D, v, lane);
    }
}

typedef short bf16x8_t __attribute__((ext_vector_type(8)));
typedef short bf16x4_t __attribute__((ext_vector_type(4)));
typedef float f32x4_t __attribute__((ext_vector_type(4)));
#define MFMA16(a, b, c) __builtin_amdgcn_mfma_f32_16x16x32_bf16((a), (b), (c), 0, 0, 0)
constexpr int KROW = 72;
constexpr int TROW = 136;
__device__ __forceinline__ bf16x8_t lds_frag16(const bf16* p) { return *(const bf16x8_t*)p; }
__device__ __forceinline__ bf16x8_t lds_frag8x2(const bf16* p0, const bf16* p1) {
    const bf16x4_t a = *(const bf16x4_t*)p0, b = *(const bf16x4_t*)p1;
    bf16x8_t o; o[0] = a[0]; o[1] = a[1]; o[2] = a[2]; o[3] = a[3]; o[4] = b[0]; o[5] = b[1]; o[6] = b[2]; o[7] = b[3]; return o;
}
__device__ __forceinline__ int tsw(int row) { return ((row >> 3) & 7) << 3; }
__device__ __forceinline__ bf16x8_t pack_p(const f32x4_t& x, const f32x4_t& y) {
    uint4 w; w.x = pk2(x[0], x[1]); w.y = pk2(x[2], x[3]); w.z = pk2(y[0], y[1]); w.w = pk2(y[2], y[3]);
    return __builtin_bit_cast(bf16x8_t, w);
}
__device__ __forceinline__ void st_tr8(bf16* dst_col0, int stride, const uint4& v) {
    dst_col0[0 * stride] = (bf16)(v.x & 0xffffu); dst_col0[1 * stride] = (bf16)(v.x >> 16);
    dst_col0[2 * stride] = (bf16)(v.y & 0xffffu); dst_col0[3 * stride] = (bf16)(v.y >> 16);
    dst_col0[4 * stride] = (bf16)(v.z & 0xffffu); dst_col0[5 * stride] = (bf16)(v.z >> 16);
    dst_col0[6 * stride] = (bf16)(v.w & 0xffffu); dst_col0[7 * stride] = (bf16)(v.w >> 16);
}

constexpr int ATT_BUF = 128 * KROW + 64 * TROW;
__device__ __forceinline__ void att_unit(KP p, int wv, int l, int u, bf16* lds) {
    const int t = tid_opaque(wv), lane = t & 63, w = t >> 6, r = lane & 15, g = lane >> 4;
    const bool lat = u < 256;
    int b, n, hkv;
    if (lat) { hkv = u & 1; n = (u >> 1) & 63; b = u >> 7; } else { const int v = u - 256; hkv = v & 1; n = (v >> 1) & 1; b = v >> 2; }
    const int hq = hkv * 4 + (w >> 1), qh = w & 1;
    const int qrow0 = (lat ? b * SEQ + n * 128 : TL + b * LC + n * 128) + qh * 64;
    int kb_lo = 0, kb_hi = -1;
    if (lat) { kb_lo = n > 0 ? n - 1 : 0; kb_hi = n < 63 ? n + 1 : 63; }
    const int nloc = kb_hi - kb_lo + 1, nblk = nloc + 2;
    const bf16* P = p->P;
    bf16x8_t qf[4][2];
#pragma unroll
    for (int qt = 0; qt < 4; ++qt)
#pragma unroll
        for (int ks = 0; ks < 2; ++ks) qf[qt][ks] = *(const bf16x8_t*)(P + (size_t)(qrow0 + qt * 16 + r) * DIN + C_AQ + hq * 64 + ks * 32 + g * 8);
    const float LOG2E = 1.4426950408889634f;
    const float sink2 = p->sink[l * 8 + hq] * LOG2E;
    float m[4], lsum[4];
    f32x4_t ot[4][4];
#pragma unroll
    for (int qt = 0; qt < 4; ++qt) { m[qt] = sink2; lsum[qt] = g == 0 ? 1.0f : 0.0f; }
#pragma unroll
    for (int dt = 0; dt < 4; ++dt)
#pragma unroll
        for (int qt = 0; qt < 4; ++qt) ot[dt][qt] = (f32x4_t){0.f, 0.f, 0.f, 0.f};
    uint4 kreg0, kreg1, vreg0, vreg1;
#define ATT_ROW0(bi) ((bi) < nloc ? b * SEQ + (kb_lo + (bi)) * 128 : TL + b * LC + ((bi) - nloc) * 128)
    const int key0 = t >> 3, key1 = key0 + 64, c8 = t & 7;
#define ATT_ISSUE(bi) do { const bf16* src_ = P + (size_t)(ATT_ROW0(bi) + key0) * DIN + hkv * 64 + c8 * 8; \
        kreg0 = *(const uint4*)(src_ + C_AK); vreg0 = *(const uint4*)(src_ + C_AV); \
        kreg1 = *(const uint4*)(src_ + 64 * DIN + C_AK); vreg1 = *(const uint4*)(src_ + 64 * DIN + C_AV); } while (0)
#define ATT_STAGE(buf) do { \
        *(uint4*)((buf) + key0 * KROW + c8 * 8) = kreg0; *(uint4*)((buf) + key1 * KROW + c8 * 8) = kreg1; \
        st_tr8((buf) + 128 * KROW + (c8 * 8) * TROW + (key0 ^ (c8 << 3)), TROW, vreg0); st_tr8((buf) + 128 * KROW + (c8 * 8) * TROW + (key1 ^ (c8 << 3)), TROW, vreg1); } while (0)
    __syncthreads();
    ATT_ISSUE(0);
    for (int bi = 0; bi < nblk; ++bi) {
        bf16* buf = lds + (bi & 1) * ATT_BUF;
        ATT_STAGE(buf);
        __syncthreads();
        if (bi + 1 < nblk) ATT_ISSUE(bi + 1);
        const bf16* Ks = buf; const bf16* Vt = buf + 128 * KROW;
        const int band = (bi < nloc) ? (kb_lo + bi) - n : 0;
#pragma unroll 1
        for (int sub = 0; sub < 2; ++sub) {
            if ((band < 0 && sub == 0 && qh == 1) || (band > 0 && sub == 1 && qh == 0)) continue;
            f32x4_t st[4][4];
#pragma unroll
            for (int kt = 0; kt < 4; ++kt) {
#pragma unroll
                for (int qt = 0; qt < 4; ++qt) st[kt][qt] = (f32x4_t){0.f, 0.f, 0.f, 0.f};
#pragma unroll
                for (int ks = 0; ks < 2; ++ks) {
                    const bf16x8_t a = lds_frag16(Ks + (sub * 64 + kt * 16 + r) * KROW + ks * 32 + g * 8);
#pragma unroll
                    for (int qt = 0; qt < 4; ++qt) st[kt][qt] = MFMA16(a, qf[qt][ks], st[kt][qt]);
                }
            }
            if (band != 0) {
                const int sb = band * (sub * 64 + g * 4 - qh * 64 - r);
#pragma unroll
                for (int qt = 0; qt < 4; ++qt)
#pragma unroll
                    for (int kt = 0; kt < 4; ++kt)
#pragma unroll
                        for (int i = 0; i < 4; ++i) {
                            const int c = -band * ((kt - qt) * 16 + i);
                            st[kt][qt][i] = sb > c ? -INFINITY : st[kt][qt][i];
                        }
            }
            float mnew[4]; bool grow = false;
#pragma unroll
            for (int qt = 0; qt < 4; ++qt) {
                float mloc = fmaxf(fmaxf(fmaxf(st[0][qt][0], st[0][qt][1]), fmaxf(st[0][qt][2], st[0][qt][3])), fmaxf(fmaxf(st[1][qt][0], st[1][qt][1]), fmaxf(st[1][qt][2], st[1][qt][3])));
                mloc = fmaxf(mloc, fmaxf(fmaxf(fmaxf(st[2][qt][0], st[2][qt][1]), fmaxf(st[2][qt][2], st[2][qt][3])), fmaxf(fmaxf(st[3][qt][0], st[3][qt][1]), fmaxf(st[3][qt][2], st[3][qt][3]))));
                mloc = fmaxf(mloc, shx(mloc, 16, lane)); mloc = fmaxf(mloc, shx(mloc, 32, lane));
                mnew[qt] = fmaxf(m[qt], mloc);
                grow = grow || (mnew[qt] > m[qt]);
            }
            if (__any(grow)) {
#pragma unroll
                for (int qt = 0; qt < 4; ++qt) {
                    const float alpha = __builtin_amdgcn_exp2f(m[qt] - mnew[qt]);
                    m[qt] = mnew[qt]; lsum[qt] *= alpha;
#pragma unroll
                    for (int dt = 0; dt < 4; ++dt) ot[dt][qt] = ot[dt][qt] * alpha;
                }
            }
#pragma unroll
            for (int qt = 0; qt < 4; ++qt) {
                float ps = 0.f;
#pragma unroll
                for (int kt = 0; kt < 4; ++kt)
#pragma unroll
                    for (int i = 0; i < 4; ++i) { const float e = __builtin_amdgcn_exp2f(st[kt][qt][i] - m[qt]); st[kt][qt][i] = e; ps += e; }
                lsum[qt] += ps;
            }
#pragma unroll
            for (int kp = 0; kp < 2; ++kp) {
                bf16x8_t pf[4];
#pragma unroll
                for (int qt = 0; qt < 4; ++qt) pf[qt] = pack_p(st[2 * kp][qt], st[2 * kp + 1][qt]);
#pragma unroll
                for (int dt = 0; dt < 4; ++dt) {
                    const bf16* vrow = Vt + (dt * 16 + r) * TROW; const int vsw = ((2 * dt + (r >> 3)) & 7) << 3, vk = sub * 64 + g * 4 + (2 * kp) * 16;
                    const bf16x8_t a = lds_frag8x2(vrow + (vk ^ vsw), vrow + ((vk + 16) ^ vsw));
#pragma unroll
                    for (int qt = 0; qt < 4; ++qt) ot[dt][qt] = MFMA16(a, pf[qt], ot[dt][qt]);
                }
            }
        }
    }
#pragma unroll
    for (int qt = 0; qt < 4; ++qt) {
        float ls = lsum[qt]; ls += shx(ls, 16, lane); ls += shx(ls, 32, lane);
        const float inv = 1.0f / ls;
        bf16* orow = p->MIX + (size_t)(qrow0 + qt * 16 + r) * D + 512 + hq * 64 + g * 4;
#pragma unroll
        for (int dt = 0; dt < 4; ++dt) {
            const f32x4_t o = ot[dt][qt] * inv;
            *(uint2*)(orow + dt * 16) = make_uint2(pk2(o[0], o[1]), pk2(o[2], o[3]));
        }
    }
}

__device__ __forceinline__ size_t kv_off(int dir, int b, int pos, int h) { return ((((size_t)dir * NB + b) * NPOS + pos) * 4 + h) * 4096; }
__device__ __forceinline__ void ret_kv_unit(KP p, int wv, int l, int u, bf16* lds) {
    const int h = u & 3, pos = (u >> 2) % NPOS, b = u / (4 * NPOS);
    const int t = tid_opaque(wv), lane = t & 63, w = t >> 6, r = lane & 15, g = lane >> 4;
    bf16* Ktf = lds; bf16* Ktb = lds + 64 * TROW; bf16* Vt = lds + 2 * 64 * TROW;
    const float lgf = log_sigmoid_f(p->rdf[l * 4 + h]), lgb = log_sigmoid_f(p->rdb[l * 4 + h]);
    const int r0 = chunk_row0(b, pos);
    const bf16* P = p->P;
    __syncthreads();
#pragma unroll
    for (int q = 0; q < 2; ++q) {
        const int pc = t + q * NT, j = pc >> 3, c8 = pc & 7;
        const bf16* src = P + (size_t)(r0 + j) * DIN + h * 64 + c8 * 8;
        const uint4 kv = *(const uint4*)(src + C_RK), vv = *(const uint4*)(src + C_RV);
        const float wf = expf(lgf * (float)(127 - j)), wb = expf(lgb * (float)j);
        uint4 kf, kb;
        kf.x = pk2(bflo(kv.x) * wf, bfhi(kv.x) * wf); kf.y = pk2(bflo(kv.y) * wf, bfhi(kv.y) * wf); kf.z = pk2(bflo(kv.z) * wf, bfhi(kv.z) * wf); kf.w = pk2(bflo(kv.w) * wf, bfhi(kv.w) * wf);
        kb.x = pk2(bflo(kv.x) * wb, bfhi(kv.x) * wb); kb.y = pk2(bflo(kv.y) * wb, bfhi(kv.y) * wb); kb.z = pk2(bflo(kv.z) * wb, bfhi(kv.z) * wb); kb.w = pk2(bflo(kv.w) * wb, bfhi(kv.w) * wb);
        st_tr8(Ktf + (c8 * 8) * TROW + (j ^ (c8 << 3)), TROW, kf);
        st_tr8(Ktb + (c8 * 8) * TROW + (j ^ (c8 << 3)), TROW, kb);
        st_tr8(Vt + (c8 * 8) * TROW + (j ^ (c8 << 3)), TROW, vv);
    }
    __syncthreads();
    const int dir = w >> 2, dvt = w & 3;
    const bf16* Kt = dir ? Ktb : Ktf;
    f32x4_t acc[4];
#pragma unroll
    for (int dkt = 0; dkt < 4; ++dkt) acc[dkt] = (f32x4_t){0.f, 0.f, 0.f, 0.f};
#pragma unroll
    for (int ks = 0; ks < 4; ++ks) {
        const bf16x8_t a = lds_frag16(Vt + (dvt * 16 + r) * TROW + ((ks * 32 + g * 8) ^ tsw(dvt * 16 + r)));
#pragma unroll
        for (int dkt = 0; dkt < 4; ++dkt) acc[dkt] = MFMA16(a, lds_frag16(Kt + (dkt * 16 + r) * TROW + ((ks * 32 + g * 8) ^ tsw(dkt * 16 + r))), acc[dkt]);
    }
    float* o = p->KV + kv_off(dir, b, pos, h);
#pragma unroll
    for (int dkt = 0; dkt < 4; ++dkt)
#pragma unroll
        for (int i = 0; i < 4; ++i) o[(dvt * 16 + g * 4 + i) * 64 + dkt * 16 + r] = acc[dkt][i];
}

__device__ __forceinline__ void phase_ret_scan(KP p, int wv, int l, int bid, int nb) {
    for (int i = bid * NT + tid_opaque(wv); i < 2 * NB * 4 * 4096; i += nb * NT) {
        const int e = i & 4095, h = (i >> 12) & 3, b = (i >> 14) & 1, dir = i >> 15;
        const float lg = log_sigmoid_f(dir ? p->rdb[l * 4 + h] : p->rdf[l * 4 + h]);
        const float cdec = expf(128.0f * lg);
        const float* kv = p->KV; bf16* st = p->ST16;
        float v[NPOS];
#pragma unroll
        for (int step = 0; step < NPOS; ++step) {
            const int pos = dir == 0 ? step : (step == 0 ? 1 : (step == 1 ? 0 : 67 - step));
            v[step] = kv[kv_off(dir, b, pos, h) + e];
        }
        float s = 0.f;
#pragma unroll
        for (int step = 0; step < NPOS; ++step) {
            const int pos = dir == 0 ? step : (step == 0 ? 1 : (step == 1 ? 0 : 67 - step));
            st[kv_off(dir, b, pos, h) + e] = (bf16)f2bf(s);
            s = s * cdec + v[step];
        }
    }
}

constexpr int RO_HEAD = 128 * KROW + 64 * TROW + 2 * 64 * KROW;
constexpr int RO_TAB = 2 * RO_HEAD;
__device__ __forceinline__ void ret_out_unit(KP p, int wv, int l, int u, bf16* lds) {
    const int hp = u & 1, pos = (u >> 1) % NPOS, b = u / (2 * NPOS);
    if (l == DEPTH - 1 && pos < 2) return;
    const int t = tid_opaque(wv), lane = t & 63, w = t >> 6, r = lane & 15, g = lane >> 4;
    const int r0 = chunk_row0(b, pos);
    const bf16* P = p->P;
    float* tabs = (float*)(lds + RO_TAB);
    __syncthreads();
#pragma unroll
    for (int q = 0; q < 4; ++q) {
        const int pc = t + q * NT, hh = pc >> 10, j = (pc >> 3) & 127, c8 = pc & 7, h = hp * 2 + hh;
        bf16* base = lds + hh * RO_HEAD;
        const bf16* src = P + (size_t)(r0 + j) * DIN + h * 64 + c8 * 8;
        *(uint4*)(base + j * KROW + c8 * 8) = *(const uint4*)(src + C_RK);
        const uint4 vv = *(const uint4*)(src + C_RV);
        st_tr8(base + 128 * KROW + (c8 * 8) * TROW + (j ^ (c8 << 3)), TROW, vv);
    }
#pragma unroll
    for (int q = 0; q < 4; ++q) {
        const int pc = t + q * NT, hh = pc >> 10, dir = (pc >> 9) & 1, dv = (pc >> 3) & 63, c8 = pc & 7, h = hp * 2 + hh;
        const uint4 sv = *(const uint4*)(p->ST16 + kv_off(dir, b, pos, h) + dv * 64 + c8 * 8);
        *(uint4*)(lds + hh * RO_HEAD + 128 * KROW + 64 * TROW + dir * 64 * KROW + dv * KROW + c8 * 8) = sv;
    }
    if (t < 4 * 132) {
        const int hh = t / 264, dir = (t / 132) & 1, k = t % 132, h = hp * 2 + hh;
        const float lg = log_sigmoid_f(dir ? p->rdb[l * 4 + h] : p->rdf[l * 4 + h]);
        tabs[(hh * 2 + dir) * 132 + k] = expf(lg * (float)k);
    }
    __syncthreads();
    const int hh = w >> 2, h = hp * 2 + hh, qw = w & 3;
    const bf16* Ks = lds + hh * RO_HEAD; const bf16* Vt = Ks + 128 * KROW; const bf16* Sft = Vt + 64 * TROW; const bf16* Sbt = Sft + 64 * KROW;
    const float* pf = tabs + (hh * 2) * 132; const float* pb = pf + 132;
    bf16x8_t qf[2][2];
#pragma unroll
    for (int qt = 0; qt < 2; ++qt)
#pragma unroll
        for (int ks = 0; ks < 2; ++ks) qf[qt][ks] = *(const bf16x8_t*)(P + (size_t)(r0 + qw * 32 + qt * 16 + r) * DIN + C_RQ + h * 64 + ks * 32 + g * 8);
    f32x4_t accI[4][2], accF[4][2], accB[4][2];
#pragma unroll
    for (int dt = 0; dt < 4; ++dt)
#pragma unroll
        for (int qt = 0; qt < 2; ++qt) { accI[dt][qt] = (f32x4_t){0.f, 0.f, 0.f, 0.f}; accF[dt][qt] = accI[dt][qt]; accB[dt][qt] = accI[dt][qt]; }
#pragma unroll
    for (int dt = 0; dt < 4; ++dt)
#pragma unroll
        for (int ks = 0; ks < 2; ++ks) {
            const bf16x8_t af = lds_frag16(Sft + (dt * 16 + r) * KROW + ks * 32 + g * 8), ab = lds_frag16(Sbt + (dt * 16 + r) * KROW + ks * 32 + g * 8);
#pragma unroll
            for (int qt = 0; qt < 2; ++qt) { accF[dt][qt] = MFMA16(af, qf[qt][ks], accF[dt][qt]); accB[dt][qt] = MFMA16(ab, qf[qt][ks], accB[dt][qt]); }
        }
#pragma unroll 1
    for (int sub = 0; sub < 2; ++sub) {
        f32x4_t st[4][2];
#pragma unroll
        for (int kt = 0; kt < 4; ++kt) {
#pragma unroll
            for (int qt = 0; qt < 2; ++qt) st[kt][qt] = (f32x4_t){0.f, 0.f, 0.f, 0.f};
#pragma unroll
            for (int ks = 0; ks < 2; ++ks) {
                const bf16x8_t a = lds_frag16(Ks + (sub * 64 + kt * 16 + r) * KROW + ks * 32 + g * 8);
#pragma unroll
                for (int qt = 0; qt < 2; ++qt) st[kt][qt] = MFMA16(a, qf[qt][ks], st[kt][qt]);
            }
        }
#pragma unroll
        for (int qt = 0; qt < 2; ++qt) {
            const int il = qw * 32 + qt * 16 + r;
#pragma unroll
            for (int kt = 0; kt < 4; ++kt)
#pragma unroll
                for (int i = 0; i < 4; ++i) {
                    const int rel = il - (sub * 64 + kt * 16 + g * 4 + i);
                    const float wgt = rel > 0 ? pf[rel] : (rel < 0 ? pb[-rel] : 2.0f);
                    st[kt][qt][i] *= wgt;
                }
        }
#pragma unroll
        for (int kp = 0; kp < 2; ++kp) {
            bf16x8_t pfr[2];
#pragma unroll
            for (int qt = 0; qt < 2; ++qt) pfr[qt] = pack_p(st[2 * kp][qt], st[2 * kp + 1][qt]);
#pragma unroll
            for (int dt = 0; dt < 4; ++dt) {
                const bf16* vrow = Vt + (dt * 16 + r) * TROW; const int vsw = tsw(dt * 16 + r), vk = sub * 64 + g * 4 + (2 * kp) * 16;
                const bf16x8_t a = lds_frag8x2(vrow + (vk ^ vsw), vrow + ((vk + 16) ^ vsw));
#pragma unroll
                for (int qt = 0; qt < 2; ++qt) accI[dt][qt] = MFMA16(a, pfr[qt], accI[dt][qt]);
            }
        }
    }
#pragma unroll
    for (int qt = 0; qt < 2; ++qt) {
        const int il = qw * 32 + qt * 16 + r;
        const float qfd = pf[il + 1], qbd = pb[128 - il];
        float s = 0.f;
#pragma unroll
        for (int dt = 0; dt < 4; ++dt) { accI[dt][qt] = accI[dt][qt] + accF[dt][qt] * qfd + accB[dt][qt] * qbd; s += (accI[dt][qt][0] + accI[dt][qt][1]) + (accI[dt][qt][2] + accI[dt][qt][3]); }
        s += shx(s, 16, lane); s += shx(s, 32, lane);
        const float mu = s * (1.0f / 64.0f);
        float qq = 0.f;
#pragma unroll
        for (int dt = 0; dt < 4; ++dt) { accI[dt][qt] = accI[dt][qt] - mu; qq += (accI[dt][qt][0] * accI[dt][qt][0] + accI[dt][qt][1] * accI[dt][qt][1]) + (accI[dt][qt][2] * accI[dt][qt][2] + accI[dt][qt][3] * accI[dt][qt][3]); }
        qq += shx(qq, 16, lane); qq += shx(qq, 32, lane);
        const float rstd = rsqrtf(qq * (1.0f / 64.0f) + LN_EPS);
        const size_t row = (size_t)(r0 + il);
#pragma unroll
        for (int dt = 0; dt < 4; ++dt) {
            const uint2 gw = *(const uint2*)(P + row * DIN + C_RG + h * 64 + dt * 16 + g * 4);
            const f32x4_t o = accI[dt][qt] * rstd;
            const float o0 = o[0] * silu_f(bflo(gw.x)), o1 = o[1] * silu_f(bfhi(gw.x)), o2 = o[2] * silu_f(bflo(gw.y)), o3 = o[3] * silu_f(bfhi(gw.y));
            *(uint2*)(p->MIX + row * D + h * 64 + dt * 16 + g * 4) = make_uint2(pk2(o0, o1), pk2(o2, o3));
        }
    }
}

__device__ __forceinline__ void sgu_unit(KP p, int wv, int l, int u, bf16* lds) {
    const int grp = u & 3, pos = (u >> 2) % NPOS, b = u / (4 * NPOS);
    if (l == DEPTH - 1 && pos < 2) return;
    const int t = tid_opaque(wv), lane = t & 63, w = t >> 6, r = lane & 15, g = lane >> 4;
    const int r0 = chunk_row0(b, pos);
    const bf16* P = p->P;
    bf16* vnT = lds;
    __syncthreads();
    {
        const int j = t >> 2, qd = t & 3;
        const uint4* src = (const uint4*)(P + (size_t)(r0 + j) * DIN + C_SV + grp * 64 + qd * 16);
        const uint4 a = src[0], c = src[1];
        float v[16] = {bflo(a.x), bfhi(a.x), bflo(a.y), bfhi(a.y), bflo(a.z), bfhi(a.z), bflo(a.w), bfhi(a.w), bflo(c.x), bfhi(c.x), bflo(c.y), bfhi(c.y), bflo(c.z), bfhi(c.z), bflo(c.w), bfhi(c.w)};
        float s = 0.f;
#pragma unroll
        for (int d = 0; d < 16; ++d) { v[d] = gelu_tanh(v[d]); s += v[d]; }
        s += shx(s, 1, lane); s += shx(s, 2, lane);
        const float mu = s * (1.0f / 64.0f);
        float qq = 0.f;
#pragma unroll
        for (int d = 0; d < 16; ++d) { v[d] -= mu; qq += v[d] * v[d]; }
        qq += shx(qq, 1, lane); qq += shx(qq, 2, lane);
        const float rstd = rsqrtf(qq * (1.0f / 64.0f) + LN_EPS);
#pragma unroll
        for (int d = 0; d < 16; ++d) vnT[(qd * 16 + d) * TROW + (j ^ tsw(qd * 16 + d))] = (bf16)f2bf(v[d] * rstd);
    }
    bf16x8_t wf[4];
    {
        const float* wrow = p->sgu_w + (((size_t)l * 4 + grp) * 128 + w * 16 + r) * 128 + g * 8;
#pragma unroll
        for (int ks = 0; ks < 4; ++ks) {
            const float4 a = *(const float4*)(wrow + ks * 32), c = *(const float4*)(wrow + ks * 32 + 4);
            uint4 o; o.x = pk2(a.x, a.y); o.y = pk2(a.z, a.w); o.z = pk2(c.x, c.y); o.w = pk2(c.z, c.w);
            wf[ks] = __builtin_bit_cast(bf16x8_t, o);
        }
    }
    __syncthreads();
    const int i = w * 16 + r;
    const float bs = p->sgu_b[((size_t)l * 4 + grp) * 128 + i];
#pragma unroll
    for (int dt = 0; dt < 4; ++dt) {
        f32x4_t acc = {0.f, 0.f, 0.f, 0.f};
#pragma unroll
        for (int ks = 0; ks < 4; ++ks) acc = MFMA16(lds_frag16(vnT + (dt * 16 + r) * TROW + ((ks * 32 + g * 8) ^ tsw(dt * 16 + r))), wf[ks], acc);
        const uint2 uw = *(const uint2*)(P + (size_t)(r0 + i) * DIN + C_SU + grp * 64 + dt * 16 + g * 4);
        const float o0 = gelu_tanh(bflo(uw.x)) * (acc[0] + bs), o1 = gelu_tanh(bfhi(uw.x)) * (acc[1] + bs), o2 = gelu_tanh(bflo(uw.y)) * (acc[2] + bs), o3 = gelu_tanh(bfhi(uw.y)) * (acc[3] + bs);
        *(uint2*)(p->MIX + (size_t)(r0 + i) * D + 256 + grp * 64 + dt * 16 + g * 4) = make_uint2(pk2(o0, o1), pk2(o2, o3));
    }
}

__device__ __forceinline__ void phase_mix_a(KP p, int wv, int l, int bid, int nb, float* ldsf) {
    bf16* lds = (bf16*)ldsf;
    const int n_kv = NB * NPOS * 4, n_sgu = NB * NPOS * 4, n_small = n_kv + n_sgu;
    for (int u = bid; u < 256; u += nb) att_unit(p, wv, l, u, lds);
    const int nctx = (l == DEPTH - 1) ? 0 : 8;
    const bool split = nb > 64 && nctx > 0;
    if (split ? bid < nctx : true) for (int u = 256 + bid; u < 256 + nctx; u += nb) att_unit(p, wv, l, u, lds);
    const int sb = split ? bid - nctx : bid, snb = split ? nb - nctx : nb;
    if (sb >= 0)
        for (int u = sb; u < n_small; u += snb) {
            if (u < n_kv) ret_kv_unit(p, wv, l, u, lds);
            else sgu_unit(p, wv, l, u - n_kv, lds);
        }
    __syncthreads();
}
__device__ __forceinline__ void phase_ret_out(KP p, int wv, int l, int bid, int nb, float* ldsf) {
    bf16* lds = (bf16*)ldsf;
    for (int u = bid; u < NB * NPOS * 2; u += nb) ret_out_unit(p, wv, l, u, lds);
    __syncthreads();
}

__device__ __forceinline__ void phase_ln1(KP p, int wv, int l, int bid, int nb, int rbeg, int rend) {
    const int lane = tid_opaque(wv) & 63, w = tid_opaque(wv) >> 6;
    for (int r = rbeg + bid * NW + w; r < rend; r += nb * NW) {
        float v[16], a[16], c[16];
        if (l == 0) row_load(x_row(p, 0, r), v, lane); else row_load_bf(p->X + (size_t)r * D, v, lane);
        row_load_bf(p->Y + (size_t)r * D, a, lane);
        const float* m = p->mod + ((size_t)l * 3 + mod_idx(r)) * 6144;
        row_load(m + 2048, c, lane);
#pragma unroll
        for (int i = 0; i < 16; ++i) v[i] = ALPHA * v[i] + c[i] * a[i];
        row_ln(v, lane);
        row_load(p->lnm_g + l * D, a, lane); row_load(p->lnm_b + l * D, c, lane);
#pragma unroll
        for (int i = 0; i < 16; ++i) v[i] = v[i] * a[i] + c[i];
        row_store_bf(p->X1 + (size_t)r * D, v, lane);
        row_ln(v, lane);
        row_load(m + 3072, a, lane); row_load(m + 4096, c, lane);
#pragma unroll
        for (int i = 0; i < 16; ++i) v[i] = v[i] * (1.0f + c[i]) + a[i];
        row_store_bf(p->H + (size_t)r * D, v, lane);
        float mx = 0.f;
#pragma unroll
        for (int i = 0; i < 16; ++i) mx = fmaxf(mx, fabsf(v[i]));
#pragma unroll
        for (int o = 32; o >= 1; o >>= 1) mx = fmaxf(mx, shx(mx, o, lane));
        const float xinv = mx > 0.f ? 127.0f / mx : 0.f;
        unsigned* xq = (unsigned*)(p->XQ + (size_t)r * D);
#pragma unroll
        for (int i = 0; i < 4; ++i) {
            const int q0 = (int)rintf(v[i * 4 + 0] * xinv), q1 = (int)rintf(v[i * 4 + 1] * xinv), q2 = (int)rintf(v[i * 4 + 2] * xinv), q3 = (int)rintf(v[i * 4 + 3] * xinv);
            xq[i * 64 + lane] = (unsigned)(q0 & 0xff) | ((unsigned)(q1 & 0xff) << 8) | ((unsigned)(q2 & 0xff) << 16) | ((unsigned)(q3 & 0xff) << 24);
        }
        if (lane == 0) p->SX[r] = mx * (1.0f / 127.0f);
    }
}

template <int N> __device__ __forceinline__ void bitonic_sort_desc(float (&x)[N]) {
#pragma unroll
    for (int sz = 2; sz <= N; sz <<= 1)
#pragma unroll
        for (int t = sz >> 1; t > 0; t >>= 1)
#pragma unroll
            for (int i = 0; i < N; ++i)
                if ((i & t) == 0) {
                    const int j = i | t; const bool desc = (i & sz) == 0;
                    const float mx_ = fmaxf(x[i], x[j]), mn_ = fminf(x[i], x[j]);
                    x[i] = desc ? mx_ : mn_; x[j] = desc ? mn_ : mx_;
                }
}
__device__ __forceinline__ void bitonic_merge16_desc(float (&x)[16]) {
#pragma unroll
    for (int t = 8; t > 0; t >>= 1)
#pragma unroll
        for (int i = 0; i < 16; ++i)
            if ((i & t) == 0) { const int j = i | t; const float mx_ = fmaxf(x[i], x[j]), mn_ = fminf(x[i], x[j]); x[i] = mx_; x[j] = mn_; }
}
__device__ __forceinline__ void xmerge16_desc(float (&c)[16], int lane) {
#pragma unroll
    for (int o = 16; o <= 32; o <<= 1) {
        float pr[16];
#pragma unroll
        for (int i = 0; i < 16; ++i) pr[i] = shx(c[i], o, lane);
#pragma unroll
        for (int i = 0; i < 16; ++i) c[i] = fmaxf(c[i], pr[15 - i]);
        bitonic_merge16_desc(c);
    }
}
__device__ __forceinline__ void top16_keys(const float (&sc)[32], int fq, int lane, float (&c)[16]) {
    float a[16], b[16];
#pragma unroll
    for (int e = 0; e < 16; ++e) {
        a[e] = __builtin_bit_cast(float, (__builtin_bit_cast(unsigned, sc[e]) & ~127u) | (unsigned)((e >> 2) * 16 + (e & 3)) | ((unsigned)fq << 2));
        b[e] = __builtin_bit_cast(float, (__builtin_bit_cast(unsigned, sc[16 + e]) & ~127u) | (unsigned)(((16 + e) >> 2) * 16 + (e & 3)) | ((unsigned)fq << 2));
    }
    bitonic_sort_desc<16>(a); bitonic_sort_desc<16>(b);
#pragma unroll
    for (int i = 0; i < 16; ++i) c[i] = fmaxf(a[i], b[15 - i]);
    bitonic_merge16_desc(c);
    xmerge16_desc(c, lane);
}
constexpr int KS_STRIDE = 136;
__device__ __forceinline__ void phase_topk(KP p, int wv, int l, int bid, int nb, int ntask, int item_base, int item_stride, float* lds) {
    bf16* k1s = (bf16*)lds;
    bf16* k2s = k1s + 128 * KS_STRIDE;
    const int t = tid_opaque(wv), lane = t & 63, w = t >> 6;
    float* lists = lds + (2 * 128 * KS_STRIDE * 2) / 4 + w * 1536;
    float* v1 = lists; int* i1 = (int*)(lists + 256); float* v2 = lists + 512; int* i2 = (int*)(lists + 768); float* v3 = lists + 1024; int* c3 = (int*)(lists + 1280);
    unsigned char* ctab = (unsigned char*)(lds + (2 * 128 * KS_STRIDE * 2) / 4 + NW * 1536);
    __syncthreads();
    if (t < 64) {
        const int gq = t >> 4, k = t & 15; int ab = 0xff;
        if (gq == 0) { if (k < 13) ab = k; }
        else if (gq == 1) { if (k < 3) ab = 13 + k; else if (k < 11) ab = 0x10 | (k - 3); else if (k < 13) ab = 0x20 | (k - 11); }
        else if (gq == 2) { if (k < 3) ab = 0x20 | (k + 2); else if (k < 7) ab = 0x30 | (k - 3); else if (k < 10) ab = 0x40 | (k - 7); else if (k < 12) ab = 0x50 | (k - 10); else if (k < 13) ab = 0x60; }
        else { if (k == 0) ab = 0x61; else if (k < 3) ab = 0x70 | (k - 1); else if (k < 11) ab = (k + 5) << 4; }
        ctab[t] = (unsigned char)ab;
    }
    for (int e = t; e < 2 * 128 * 16; e += NT) {
        const int tab = e >> 11, r = (e >> 4) & 127, c8 = e & 15;
        const float* src = (tab ? p->k2 : p->k1) + (size_t)l * 128 * 128 + r * 128 + c8 * 8;
        const float4 a = *(const float4*)src, b = *(const float4*)(src + 4);
        uint4 o; o.x = pk2(a.x, a.y); o.y = pk2(a.z, a.w); o.z = pk2(b.x, b.y); o.w = pk2(b.z, b.w);
        *(uint4*)((tab ? k2s : k1s) + r * KS_STRIDE + c8 * 8) = o;
    }
    __syncthreads();
    const int fr = lane & 15, fq = lane >> 4;
    for (int task = bid * NW + w; task < ntask; task += nb * NW) {
        const size_t item = (size_t)item_base + (size_t)(task * 16 + fr) * item_stride;
        const bf16* qrow = p->Qb + item * 256 + fq * 8;
        bf16x8_t bq[8];
#pragma unroll
        for (int ks = 0; ks < 8; ++ks) bq[ks] = *(const bf16x8_t*)(qrow + ks * 32);
        float s[32];
#pragma unroll
        for (int kt = 0; kt < 8; ++kt) {
            f32x4_t acc = {0.f, 0.f, 0.f, 0.f};
#pragma unroll
            for (int ks = 0; ks < 4; ++ks) {
                const bf16x8_t a = *(const bf16x8_t*)(k1s + (kt * 16 + fr) * KS_STRIDE + ks * 32 + fq * 8);
                acc = __builtin_amdgcn_mfma_f32_16x16x32_bf16(a, bq[ks], acc, 0, 0, 0);
            }
            s[kt * 4 + 0] = acc[0]; s[kt * 4 + 1] = acc[1]; s[kt * 4 + 2] = acc[2]; s[kt * 4 + 3] = acc[3];
        }
        { float ck[16]; top16_keys(s, fq, lane, ck);
          if (fq == 0) {
#pragma unroll
              for (int i = 0; i < 16; ++i) v1[fr * 16 + i] = ck[i]; } }
#pragma unroll
        for (int kt = 0; kt < 8; ++kt) {
            f32x4_t acc = {0.f, 0.f, 0.f, 0.f};
#pragma unroll
            for (int ks = 0; ks < 4; ++ks) {
                const bf16x8_t a = *(const bf16x8_t*)(k2s + (kt * 16 + fr) * KS_STRIDE + ks * 32 + fq * 8);
                acc = __builtin_amdgcn_mfma_f32_16x16x32_bf16(a, bq[4 + ks], acc, 0, 0, 0);
            }
            s[kt * 4 + 0] = acc[0]; s[kt * 4 + 1] = acc[1]; s[kt * 4 + 2] = acc[2]; s[kt * 4 + 3] = acc[3];
        }
        { float ck[16]; top16_keys(s, fq, lane, ck);
          if (fq == 0) {
#pragma unroll
              for (int i = 0; i < 16; ++i) v2[fr * 16 + i] = ck[i]; } }
        __builtin_amdgcn_wave_barrier();
        const uint4 tw = *(const uint4*)(ctab + fq * 16);
        const unsigned twd[4] = {tw.x, tw.y, tw.z, tw.w};
        float ck3[16];
        const float padv = __builtin_bit_cast(float, __builtin_bit_cast(unsigned, v1[fr * 16 + 15]) & ~127u) + __builtin_bit_cast(float, __builtin_bit_cast(unsigned, v2[fr * 16 + 15]) & ~127u) - 1.0f;
#pragma unroll
        for (int k = 0; k < 16; ++k) {
            const unsigned ab = k < 13 ? (twd[k >> 2] >> (8 * (k & 3))) & 0xffu : 0xffu;
            const float ka = __builtin_bit_cast(float, __builtin_bit_cast(unsigned, v1[fr * 16 + ((ab >> 4) & 15u)]) & ~127u);
            const float kb = __builtin_bit_cast(float, __builtin_bit_cast(unsigned, v2[fr * 16 + (ab & 15u)]) & ~127u);
            const float cvv = ab == 0xffu ? padv : ka + kb;
            ck3[k] = __builtin_bit_cast(float, (__builtin_bit_cast(unsigned, cvv) & ~255u) | ab);
        }
        bitonic_sort_desc<16>(ck3);
        xmerge16_desc(ck3, lane);
        float tv[4]; int tc[4];
#pragma unroll
        for (int k = 0; k < 4; ++k) {
            const float kk = fq == 0 ? ck3[k] : (fq == 1 ? ck3[4 + k] : (fq == 2 ? ck3[8 + k] : ck3[12 + k]));
            tv[k] = __builtin_bit_cast(float, __builtin_bit_cast(unsigned, kk) & ~255u); tc[k] = (int)(__builtin_bit_cast(unsigned, kk) & 255u);
        }
        float mx = fmaxf(fmaxf(tv[0], tv[1]), fmaxf(tv[2], tv[3]));
        mx = fmaxf(mx, shx(mx, 16, lane)); mx = fmaxf(mx, shx(mx, 32, lane));
        float ex[4], den = 0.f;
#pragma unroll
        for (int k = 0; k < 4; ++k) { ex[k] = expf(tv[k] - mx); den += ex[k]; }
        den += shx(den, 16, lane); den += shx(den, 32, lane);
        const float inv = 1.0f / den;
        int4 eo; float4 go;
#define TK_EID(c) ((int)(__builtin_bit_cast(unsigned, v1[fr * 16 + ((c) >> 4)]) & 127u) * 128 + (int)(__builtin_bit_cast(unsigned, v2[fr * 16 + ((c) & 15)]) & 127u))
        eo.x = TK_EID(tc[0]); eo.y = TK_EID(tc[1]); eo.z = TK_EID(tc[2]); eo.w = TK_EID(tc[3]);
#undef TK_EID
        go = make_float4(ex[0] * inv, ex[1] * inv, ex[2] * inv, ex[3] * inv);
        *(int4*)(p->EIDX + item * 16 + fq * 4) = eo;
        *(float4*)(p->GATE + item * 16 + fq * 4) = go;
        __builtin_amdgcn_wave_barrier();
    }
    __syncthreads();
}

typedef unsigned u32x4_t __attribute__((ext_vector_type(4)));
using bf16x2_t = __attribute__((ext_vector_type(2))) __bf16;
__device__ __forceinline__ float dot2bf(unsigned a, unsigned b, float acc) { return __builtin_amdgcn_fdot2_f32_bf16(__builtin_bit_cast(bf16x2_t, a), __builtin_bit_cast(bf16x2_t, b), acc, false); }
struct RowBf { u32x4_t a, b; };
__device__ __forceinline__ RowBf ld_row(const bf16* tab, int e, int lane) {
    const u32x4_t* r = (const u32x4_t*)(tab + (size_t)e * D) + lane;
    RowBf x; x.a = r[0]; x.b = r[64]; return x;
}
__device__ __forceinline__ float row_dot(const RowBf& x, const RowBf& u) {
    float d = 0.f;
#pragma unroll
    for (int k = 0; k < 4; ++k) { d = dot2bf(x.a[k], u.a[k], d); d = dot2bf(x.b[k], u.b[k], d); }
    return d;
}
__device__ __forceinline__ void row_axpy(float (&acc)[16], float a, const RowBf& v) {
#pragma unroll
    for (int k = 0; k < 4; ++k) {
        acc[2 * k] += a * bflo(v.a[k]); acc[2 * k + 1] += a * bfhi(v.a[k]);
        acc[8 + 2 * k] += a * bflo(v.b[k]); acc[8 + 2 * k + 1] += a * bfhi(v.b[k]);
    }
}
__device__ __forceinline__ float transpose_reduce16(float (&part)[16], int lane) {
#pragma unroll
    for (int st = 32, n = 8; n >= 1; st >>= 1, n >>= 1) {
        const bool up = (lane & st) != 0;
#pragma unroll
        for (int s = 0; s < n; ++s) {
            const float lo = part[s], hi = part[s + n];
            const float recv = shx(up ? lo : hi, st, lane);
            part[s] = (up ? hi : lo) + recv;
        }
    }
    float v = part[0];
    v += shx(v, 2, lane); v += shx(v, 1, lane);
    return v;
}
typedef float f32x2_t __attribute__((ext_vector_type(2)));
__device__ __forceinline__ float transpose_reduce8(float (&part)[8], int lane) {
#pragma unroll
    for (int st = 32, n = 4; n >= 1; st >>= 1, n >>= 1) {
        const bool up = (lane & st) != 0;
#pragma unroll
        for (int s = 0; s < n; ++s) {
            const float lo = part[s], hi = part[s + n];
            const float recv = shx(up ? lo : hi, st, lane);
            part[s] = (up ? hi : lo) + recv;
        }
    }
    float v = part[0];
    v += shx(v, 4, lane); v += shx(v, 2, lane); v += shx(v, 1, lane);
    return v;
}
typedef int v4i_t __attribute__((ext_vector_type(4)));
typedef unsigned u32x4v __attribute__((ext_vector_type(4)));
constexpr int EXU_CAP = 440, EXU_TROW = 1056, EXU_WAVE = 8 * EXU_CAP + 16 * EXU_TROW;
__device__ __forceinline__ void phase_expert_u(KP p, int wv, int l, int bid, int nb, float* lds) {
    const int lane = tid_opaque(wv) & 63, w = __builtin_amdgcn_readfirstlane(tid_opaque(wv) >> 6);
    const int G8 = nb >> 3;
    if (bid >= G8 * 8) return;
    const int rng = bid & 7, r = lane & 15, g = lane >> 4;
    const unsigned char* U = p->U8 + (size_t)l * PEER_N * D;
    const float* SU = p->SU + (size_t)l * PEER_N; const float* SV = p->SV + (size_t)l * PEER_N;
    unsigned char* wl = (unsigned char*)lds + w * EXU_WAVE;
    unsigned* lpk = (unsigned*)wl; float* lgt = (float*)(wl + 4 * EXU_CAP); unsigned char* tile = wl + 8 * EXU_CAP;
    const unsigned long long ltmask = (1ull << lane) - 1ull;
    const int tstride = G8 * NW, Tn = (l == DEPTH - 1) ? TL : T, t0 = (bid >> 3) * NW + w;
    if (t0 >= Tn) return;
    const int nitem = (Tn - t0 + tstride - 1) / tstride;
    int i0 = 0;
    while (i0 < nitem) {
        const int nt = nitem - i0 < 16 ? nitem - i0 : 16;
        v4i_t afr[16];
        {
            const unsigned char* xa = p->XQ + (size_t)(t0 + (i0 + (r < nt ? r : nt - 1)) * tstride) * D + g * 16;
#pragma unroll
            for (int ks = 0; ks < 16; ++ks) afr[ks] = *(const v4i_t*)(xa + ks * 64);
        }
        const float sxv = p->SX[t0 + (i0 + (lane < nt ? lane : nt - 1)) * tstride];
        int e0[16], e1[16];
#pragma unroll
        for (int j = 0; j < 16; ++j) {
            const size_t tb = (size_t)(t0 + (i0 + (j < nt ? j : nt - 1)) * tstride) * NSEL;
            e0[j] = p->EIDX[tb + lane]; e1[j] = p->EIDX[tb + 64 + lane];
        }
        int cnt = 0, ndone = 0; bool open = true;
#pragma unroll
        for (int j = 0; j < 16; ++j) {
            const bool in0 = (e0[j] >> 11) == rng, in1 = (e1[j] >> 11) == rng;
            const unsigned long long m0 = __ballot(in0), m1 = __ballot(in1);
            const int c0 = __popcll(m0), c = c0 + __popcll(m1);
            open = open && j < nt && cnt + c <= EXU_CAP;
            if (open) {
                if (in0) { const int pos = cnt + __popcll(m0 & ltmask); lpk[pos] = (unsigned)e0[j] | ((unsigned)j << 14) | ((unsigned)lane << 18); }
                if (in1) { const int pos = cnt + c0 + __popcll(m1 & ltmask); lpk[pos] = (unsigned)e1[j] | ((unsigned)j << 14) | ((unsigned)(lane + 64) << 18); }
                cnt += c; ndone = j + 1;
            }
        }
        __builtin_amdgcn_wave_barrier();
        const int ntile = (cnt + 15) >> 4;
        u32x4v rw[16]; unsigned pkv = 0u; float suv = 0.f;
#define EXU_ISSUE(q) do { const int idx_ = 16 * (q) + r < cnt ? 16 * (q) + r : cnt - 1; \
            pkv = lpk[idx_]; const unsigned e_ = pkv & 0x3fffu; \
            _Pragma("unroll") for (int k = 0; k < 16; ++k) rw[k] = *(const u32x4v*)(U + ((size_t)(__builtin_amdgcn_readlane((int)pkv, k) & 0x3fff) << 10) + lane * 16); \
            suv = SU[e_]; } while (0)
        if (ntile > 0) EXU_ISSUE(0);
#pragma unroll 1
        for (int q = 0; q < ntile; ++q) {
#pragma unroll
            for (int k = 0; k < 16; ++k) *(u32x4v*)(tile + k * EXU_TROW + lane * 16) = rw[k];
            const unsigned pk = pkv; const float su = suv;
            __builtin_amdgcn_wave_barrier();
            if (q + 1 < ntile) EXU_ISSUE(q + 1);
            v4i_t acc = {0, 0, 0, 0};
#pragma unroll
            for (int ks = 0; ks < 16; ++ks) {
                const v4i_t b = *(const v4i_t*)(tile + r * EXU_TROW + ks * 64 + g * 16);
                acc = __builtin_amdgcn_mfma_i32_16x16x64_i8(afr[ks], b, acc, 0, 0, 0);
            }
            const int j = (int)((pk >> 14) & 15u);
            const int d = (j & 2) ? ((j & 1) ? acc[3] : acc[2]) : ((j & 1) ? acc[1] : acc[0]);
            const float sx = shf(sxv, j);
            if (g == (j >> 2) && 16 * q + r < cnt) lgt[16 * q + r] = (float)d * su * sx;
            __builtin_amdgcn_wave_barrier();
        }
#undef EXU_ISSUE
        for (int idx = lane; idx < cnt; idx += 64) {
            const unsigned pk = lpk[idx]; const int e = (int)(pk & 0x3fffu), j = (int)((pk >> 14) & 15u), slot = (int)(pk >> 18);
            const size_t ao = (size_t)(t0 + (i0 + j) * tstride) * NSEL + slot;
            p->ACT[ao] = gelu_tanh(lgt[idx]) * p->GATE[ao] * SV[e];
        }
        __builtin_amdgcn_wave_barrier();
        i0 += ndone > 0 ? ndone : 1;
    }
}
__device__ __forceinline__ void phase_expert_v(KP p, int wv, int l, int bid, int nb) {
    const int lane = tid_opaque(wv) & 63, w = __builtin_amdgcn_readfirstlane(tid_opaque(wv) >> 6);
    const int G8 = nb >> 3;
    if (bid >= G8 * 8) return;
    const int sl = bid & 7, q = lane >> 3, c = lane & 7;
    const __amdgpu_buffer_rsrc_t rsV = __builtin_amdgcn_make_buffer_rsrc((void*)(p->V8 + (size_t)l * PEER_N * D), 0, PEER_N * D, 0x00020000);
    const int coff = sl * 128 + c * 16;
    const int tstride = G8 * NW, Tn = (l == DEPTH - 1) ? TL : T, t0 = (bid >> 3) * NW + w;
    const int nitem = t0 < Tn ? (Tn - t0 + tstride - 1) / tstride : 0;
    for (int j0 = 0; j0 < nitem; j0 += 8) {
        const bool valid = j0 + q < nitem;
        const int t = t0 + (valid ? j0 + q : nitem - 1) * tstride;
        int e[16]; float a[16];
        {
            const int4* ep = (const int4*)(p->EIDX + (size_t)t * NSEL + c * 16); const float4* ap = (const float4*)(p->ACT + (size_t)t * NSEL + c * 16);
#pragma unroll
            for (int k = 0; k < 4; ++k) { const int4 ev = ep[k]; const float4 av = ap[k];
                e[k * 4 + 0] = ev.x << 10; e[k * 4 + 1] = ev.y << 10; e[k * 4 + 2] = ev.z << 10; e[k * 4 + 3] = ev.w << 10;
                a[k * 4 + 0] = av.x; a[k * 4 + 1] = av.y; a[k * 4 + 2] = av.z; a[k * 4 + 3] = av.w; }
        }
        f32x2_t acc[8];
#pragma unroll
        for (int k = 0; k < 8; ++k) acc[k] = (f32x2_t){0.f, 0.f};
#pragma unroll 1
        for (int cc = 0; cc < 8; ++cc) {
            const int baddr = ((lane & 56) | cc) << 2;
#pragma unroll
            for (int hb = 0; hb < 2; ++hb) {
                u32x4v rv[8]; float av[8];
#pragma unroll
                for (int k = 0; k < 8; ++k) {
                    const int j = hb * 8 + k;
                    const int eo = __builtin_amdgcn_ds_bpermute(baddr, e[j]);
                    av[k] = __builtin_bit_cast(float, __builtin_amdgcn_ds_bpermute(baddr, __builtin_bit_cast(int, a[j])));
                    rv[k] = __builtin_amdgcn_raw_buffer_load_b128(rsV, eo + coff, 0, 0);
                }
#pragma unroll
                for (int k = 0; k < 8; ++k) {
                    const f32x2_t a2 = {av[k], av[k]};
                    acc[0] += a2 * __builtin_amdgcn_cvt_pk_f32_fp8((int)rv[k][0], false); acc[1] += a2 * __builtin_amdgcn_cvt_pk_f32_fp8((int)rv[k][0], true);
                    acc[2] += a2 * __builtin_amdgcn_cvt_pk_f32_fp8((int)rv[k][1], false); acc[3] += a2 * __builtin_amdgcn_cvt_pk_f32_fp8((int)rv[k][1], true);
                    acc[4] += a2 * __builtin_amdgcn_cvt_pk_f32_fp8((int)rv[k][2], false); acc[5] += a2 * __builtin_amdgcn_cvt_pk_f32_fp8((int)rv[k][2], true);
                    acc[6] += a2 * __builtin_amdgcn_cvt_pk_f32_fp8((int)rv[k][3], false); acc[7] += a2 * __builtin_amdgcn_cvt_pk_f32_fp8((int)rv[k][3], true);
                    __builtin_amdgcn_sched_barrier(0);
                }
            }
        }
        if (valid) {
            bf16* yr = p->Y + (size_t)t * D + coff;
            *(uint4*)yr = make_uint4(pk2(acc[0].x, acc[0].y), pk2(acc[1].x, acc[1].y), pk2(acc[2].x, acc[2].y), pk2(acc[3].x, acc[3].y));
            *(uint4*)(yr + 8) = make_uint4(pk2(acc[4].x, acc[4].y), pk2(acc[5].x, acc[5].y), pk2(acc[6].x, acc[6].y), pk2(acc[7].x, acc[7].y));
        }
    }
}

__device__ __forceinline__ void phase_ln2(KP p, int wv, int l, int bid, int nb) {
    const int lane = tid_opaque(wv) & 63, w = tid_opaque(wv) >> 6;
    const int Tn = (l == DEPTH - 1) ? TL : T;
    for (int r = bid * NW + w; r < Tn; r += nb * NW) {
        float v[16], a[16], c[16];
        row_load_bf(p->X1 + (size_t)r * D, v, lane);
        row_load_bf(p->Y + (size_t)r * D, a, lane);
        const float* m = p->mod + ((size_t)l * 3 + mod_idx(r)) * 6144;
        row_load(m + 5120, c, lane);
#pragma unroll
        for (int i = 0; i < 16; ++i) v[i] = ALPHA * v[i] + c[i] * a[i];
        row_ln(v, lane);
        row_load(p->lnf_g + l * D, a, lane); row_load(p->lnf_b + l * D, c, lane);
#pragma unroll
        for (int i = 0; i < 16; ++i) v[i] = v[i] * a[i] + c[i];
        if (l == DEPTH - 1) { if (r < TL) row_store(p->out + (size_t)r * D, v, lane); continue; }
        row_store_bf(p->X + (size_t)r * D, v, lane);
        const float* m2 = p->mod + ((size_t)(l + 1) * 3 + mod_idx(r)) * 6144;
        row_ln(v, lane);
        row_load(m2, a, lane); row_load(m2 + 1024, c, lane);
#pragma unroll
        for (int i = 0; i < 16; ++i) v[i] = v[i] * (1.0f + c[i]) + a[i];
        row_store_bf(p->H + (size_t)r * D, v, lane);
    }
}

__global__ void __launch_bounds__(NT, 2) mega(Params p_unused) {
    extern __shared__ __attribute__((aligned(16))) unsigned char lds_raw[];
    cg::grid_group grid = cg::this_grid();
    const int bid = blockIdx.x, nb = gridDim.x;
    const int wv = __builtin_amdgcn_readfirstlane(threadIdx.x >> 6);
    float* lds = (float*)lds_raw;
    LAS unsigned char* ldsl = (LAS unsigned char*)lds_raw;
    volatile LAS unsigned* MISC = (volatile LAS unsigned*)(ldsl + MISC_OFF);
    for (int u = threadIdx.x; u < 64; u += NT) ((LAS unsigned*)(ldsl + MISC_OFF))[u] = 0u;
    __syncthreads();
#define IS_LEAD() (wv == 0 && lane_opaque() == 0)
    (void)xcd_barrier_post(kparams()->ctl + CW_BAR, MISC + 8, IS_LEAD());
#define GRID_BAR() do { XcdBarrier b_; b_.bar = kparams()->ctl + CW_BAR; b_.x = xb_xcc_id(); b_.st = MISC + 8; b_.lead = IS_LEAD(); xcd_barrier(b_); } while (0)

    phase_mod1(kparams(), wv, bid, nb, lds);
    phase_weights(kparams(), wv, bid, nb, lds);
    grid.sync();
    phase_mod2(kparams(), wv, bid, nb);
    GRID_BAR();
    phase_lnmod(kparams(), wv, 0, bid, nb);
    GRID_BAR();
#define CTX_LAG(l) ((l) < DEPTH - 1 && nb >= 64 && (T - TL) == 512)
#define LAYER_BODY(l) do { \
        { KP p = kparams(); \
            pg8::Gemm g{p->H, p->WtIn + (size_t)l * DIN * D, T, DIN, D}; pg8::StaticOrder S; S.init(T, DIN, nb, bid); \
            pg8::EpiInProj E{p->P, p->rope}; \
            pg8::gemm_phase<pg8::EpiInProj, pg8::StaticOrder, true, true>(ldsl, g, S, E, wv); \
            { const int busy3 = 66 * 9 - 2 * nb;                       \
              if (busy3 > 0 && busy3 < nb) { if (bid >= busy3) phase_tables(p, wv, l, bid - busy3, nb - busy3); } else phase_tables(p, wv, l, bid, nb); } \
        } \
        GRID_BAR(); \
        phase_mix_a(kparams(), wv, l, bid, nb, lds); \
        GRID_BAR(); \
        phase_ret_scan(kparams(), wv, l, bid, nb); \
        GRID_BAR(); \
        phase_ret_out(kparams(), wv, l, bid, nb, lds); \
        GRID_BAR(); \
          \
          \
        { KP p = kparams(); \
            pg8::Gemm g{p->MIX, p->WtOut + (size_t)l * D * D, CTX_LAG(l) ? TL : ((l == DEPTH - 1) ? TL : T), D, D}; pg8::StaticOrder S; S.init(g.M, D, nb, bid); \
            pg8::EpiBf16Plain E{p->Y, D}; \
            pg8::gemm_phase<pg8::EpiBf16Plain, pg8::StaticOrder, true, true>(ldsl, g, S, E, wv); \
        } \
        GRID_BAR(); \
        if (CTX_LAG(l)) { \
            if (bid < 8) { KP p = kparams(); \
                pg8::Gemm g{p->MIX + (size_t)TL * D, p->WtOut + (size_t)l * D * D, T - TL, D, D}; pg8::StaticOrder S; S.init(T - TL, D, 8, bid); \
                pg8::EpiBf16Plain E{p->Y + (size_t)TL * D, D}; \
                pg8::gemm_phase<pg8::EpiBf16Plain, pg8::StaticOrder, true, true>(ldsl, g, S, E, wv); \
            } else phase_ln1(kparams(), wv, l, bid - 8, nb - 8, 0, TL); \
        } else phase_ln1(kparams(), wv, l, bid, nb, 0, (l == DEPTH - 1) ? TL : T); \
        GRID_BAR(); \
        { KP p = kparams(); \
            if (CTX_LAG(l)) phase_ln1(p, wv, l, bid, nb, TL, T); \
            pg8::Gemm g{p->H, p->WtQ + (size_t)l * 2048 * D, CTX_LAG(l) ? TL : ((l == DEPTH - 1) ? TL : T), 2048, D}; pg8::StaticOrder S; S.init(g.M, 2048, nb, bid); \
            pg8::EpiBf16Plain E{p->Qb, 2048}; \
            pg8::gemm_phase<pg8::EpiBf16Plain, pg8::StaticOrder, true, true>(ldsl, g, S, E, wv); \
        } \
        GRID_BAR(); \
        if (CTX_LAG(l)) { \
            if (bid < 16) { KP p = kparams(); \
                pg8::Gemm g{p->H + (size_t)TL * D, p->WtQ + (size_t)l * 2048 * D, T - TL, 2048, D}; pg8::StaticOrder S; S.init(T - TL, 2048, 16, bid); \
                pg8::EpiBf16Plain E{p->Qb + (size_t)TL * 2048, 2048}; \
                pg8::gemm_phase<pg8::EpiBf16Plain, pg8::StaticOrder, true, true>(ldsl, g, S, E, wv); \
                asm volatile("s_waitcnt vmcnt(0)" ::: "memory"); __syncthreads();        \
                pg8::Unit u_; (void)S.next(0, u_); \
                phase_topk(p, wv, l, 0, 1, 16, (TL + u_.pm * 256) * 8 + u_.pn, 8, lds); \
            } else phase_topk(kparams(), wv, l, bid - 16, nb - 16, TL * 8 / 16, 0, 1, lds); \
        } else phase_topk(kparams(), wv, l, bid, nb, ((l == DEPTH - 1) ? TL : T) * 8 / 16, 0, 1, lds); \
        GRID_BAR(); \
        phase_expert_u(kparams(), wv, l, bid, nb, lds); \
        GRID_BAR(); \
        phase_expert_v(kparams(), wv, l, bid, nb); \
        GRID_BAR(); \
        phase_ln2(kparams(), wv, l, bid, nb); \
        if (l + 1 < DEPTH) GRID_BAR(); \
    } while (0)
    LAYER_BODY(0); LAYER_BODY(1); LAYER_BODY(2); LAYER_BODY(3);
#undef LAYER_BODY
#undef CTX_LAG
}

extern "C" void kernel_launch(void* const* d_in, const int* in_sizes, int n_in, void* d_out, int out_size, void* d_ws, size_t ws_size, hipStream_t stream) {
    static int grid_blocks = 0;
    if (!grid_blocks) {
        int dev = 0, cus = 0, per_cu = 0;
        (void)hipGetDevice(&dev);
        (void)hipDeviceGetAttribute(&cus, hipDeviceAttributeMultiprocessorCount, dev);
        (void)hipFuncSetAttribute((const void*)mega, hipFuncAttributeMaxDynamicSharedMemorySize, LDS_BYTES);
        (void)hipOccupancyMaxActiveBlocksPerMultiprocessor(&per_cu, mega, NT, LDS_BYTES);
        if (per_cu < 1) { fprintf(stderr, "occupancy query says %d blocks per CU\n", per_cu); per_cu = 1; }
        grid_blocks = cus;
    }
    Params p{};
    const float** ins = (const float**)&p;
    for (int i = 0; i < 22; ++i) ins[i] = (const float*)d_in[i];
    p.out = (float*)d_out;
    char* ws = (char*)d_ws;
    size_t off = 0;
    auto carve = [&](size_t bytes) { void* r = ws + off; off += (bytes + 255) & ~(size_t)255; return r; };
    p.ctl = (unsigned*)carve(CTL_BYTES);
    p.modp = (float*)carve((size_t)16 * DEPTH * 3 * 6144 * 4);
    p.mod = (float*)carve((size_t)DEPTH * 3 * 6144 * 4);
    p.rope = (float*)carve((size_t)192 * 16 * 2 * 4);
    p.WtIn = (bf16*)carve((size_t)DEPTH * DIN * D * 2);
    p.WtOut = (bf16*)carve((size_t)DEPTH * D * D * 2);
    p.WtQ = (bf16*)carve((size_t)DEPTH * 2048 * D * 2);
    p.X = (bf16*)carve((size_t)T * D * 2);
    p.H = (bf16*)carve((size_t)T * D * 2);
    p.P = (bf16*)carve((size_t)T * DIN * 2);
    p.KV = (float*)carve((size_t)2 * NB * NPOS * 4 * 4096 * 4);
    p.MIX = (bf16*)carve((size_t)T * D * 2);
    p.ST16 = (bf16*)carve((size_t)2 * NB * NPOS * 4 * 4096 * 2);
    p.Qb = (bf16*)carve((size_t)T * 2048 * 2);
    p.U8 = (unsigned char*)carve((size_t)DEPTH * PEER_N * D);
    p.V8 = (unsigned char*)carve((size_t)DEPTH * PEER_N * D);
    p.XQ = (unsigned char*)carve((size_t)T * D);
    p.SX = (float*)carve((size_t)T * 4);
    p.SU = (float*)carve((size_t)DEPTH * PEER_N * 4);
    p.SV = (float*)carve((size_t)DEPTH * PEER_N * 4);
    p.Y = (bf16*)carve((size_t)T * D * 2);
    p.X1 = (bf16*)carve((size_t)T * D * 2);
    p.GATE = (float*)carve((size_t)T * NSEL * 4);
    p.ACT = (float*)carve((size_t)T * NSEL * 4);
    p.EIDX = (int*)carve((size_t)T * NSEL * 4);
    if (off > ws_size) { fprintf(stderr, "workspace too small: need %zu have %zu\n", off, ws_size); return; }
    (void)hipMemsetAsync(p.ctl, 0, CTL_BYTES, stream);
    void* args[] = {&p};
    hipError_t e = hipLaunchCooperativeKernel((void*)mega, dim3(grid_blocks), dim3(NT), args, LDS_BYTES, stream);
    if (e != hipSuccess) fprintf(stderr, "cooperative launch failed: %s (grid %d)\n", hipGetErrorString(e), grid_blocks);
}
```

```cpp
#include <hip/hip_runtime.h>
#include <hip/hip_cooperative_groups.h>
#include <cstdio>
#include <cstdint>
namespace cg = cooperative_groups;

constexpr int D = 1024, NB = 2, SEQ = 8192, DEPTH = 4, LC = 256, HD = 64;
constexpr int TL = NB * SEQ, TC = NB * LC, T = TL + TC;
constexpr int DIN = 2304;
constexpr int C_RQ = 0, C_RK = 256, C_RV = 512, C_RG = 768, C_SU = 1024, C_SV = 1280, C_AQ = 1536, C_AK = 2048, C_AV = 2176;
constexpr int NPOS = 66;
constexpr int PEER_N = 16384, NSEL = 128;
constexpr float LN_EPS = 1e-5f;
constexpr float ALPHA = 1.681792830507429f;
constexpr int NT = 512;
constexpr int NW = 8;
constexpr int LDS_BYTES = 163840;
constexpr int MISC_OFF = LDS_BYTES - 256;

typedef unsigned short bf16;
#define LAS __attribute__((address_space(3)))

struct Params {
    const float *x, *c, *ctx, *c_ctx, *w_mod, *b_mod, *w_in, *w_out, *rdf, *rdb, *sgu_w, *sgu_b, *sink, *lnm_g, *lnm_b, *wq, *k1, *k2, *pu, *pv, *lnf_g, *lnf_b;
    float* out;
    unsigned* ctl;
    float *modp, *mod, *rope, *KV, *GATE, *ACT;
    bf16 *X, *X1, *Y;
    bf16 *WtIn, *WtOut, *WtQ, *H, *P, *MIX, *Qb, *ST16;
    unsigned char *U8, *V8, *XQ;
    float *SU, *SV; float2* SX;
    int *EIDX;
};

__device__ __forceinline__ unsigned f2bf(float f) { return (unsigned)__builtin_bit_cast(unsigned short, (__bf16)f); }
typedef float f32x2_pk __attribute__((ext_vector_type(2))); typedef __bf16 bf16x2_pk __attribute__((ext_vector_type(2)));
__device__ __forceinline__ unsigned pk2(float lo, float hi) { const f32x2_pk v = {lo, hi}; return __builtin_bit_cast(unsigned, __builtin_convertvector(v, bf16x2_pk)); }
__device__ __forceinline__ float bf2f(bf16 v) { return __builtin_bit_cast(float, (unsigned)v << 16); }
__device__ __forceinline__ float bflo(unsigned w) { return __builtin_bit_cast(float, w << 16); }
__device__ __forceinline__ float bfhi(unsigned w) { return __builtin_bit_cast(float, w & 0xffff0000u); }

__device__ __forceinline__ float gelu_tanh(float x) {
    const float u2 = x * (1.5957691216057308f + 0.07135481627f * x * x);
    return x * __builtin_amdgcn_rcpf(1.0f + __builtin_amdgcn_exp2f(-1.4426950408889634f * u2));
}
__device__ __forceinline__ float silu_f(float x) { return x * __builtin_amdgcn_rcpf(1.0f + __builtin_amdgcn_exp2f(-1.4426950408889634f * x)); }
__device__ __forceinline__ int chunk_row0(int b, int pos) { return pos < 2 ? TL + b * LC + pos * 128 : b * SEQ + (pos - 2) * 128; }
__device__ __forceinline__ int mod_idx(int r) { return r < TL ? r / SEQ : 2; }
__device__ __forceinline__ float log_sigmoid_f(float x) { return -log1pf(expf(-x)); }
typedef const __attribute__((address_space(4))) Params* KP;
__device__ __forceinline__ KP kparams() { KP k = (KP)__builtin_amdgcn_kernarg_segment_ptr(); asm volatile("" : "+s"(k)); return k; }
__device__ __forceinline__ float shx(float v, int m, int lane) { return __builtin_bit_cast(float, __builtin_amdgcn_ds_bpermute((lane ^ m) << 2, __builtin_bit_cast(int, v))); }
__device__ __forceinline__ int shx(int v, int m, int lane) { return __builtin_amdgcn_ds_bpermute((lane ^ m) << 2, v); }
__device__ __forceinline__ float shf(float v, int src) { return __builtin_bit_cast(float, __builtin_amdgcn_ds_bpermute(src << 2, __builtin_bit_cast(int, v))); }
__device__ __forceinline__ int shf(int v, int src) { return __builtin_amdgcn_ds_bpermute(src << 2, v); }
__device__ __forceinline__ float rmax(float a, float b) { float r; asm("v_max_f32 %0, %1, %2" : "=v"(r) : "v"(a), "v"(b)); return r; }
__device__ __forceinline__ float rmin(float a, float b) { float r; asm("v_min_f32 %0, %1, %2" : "=v"(r) : "v"(a), "v"(b)); return r; }
__device__ __forceinline__ float rmax3(float a, float b, float c) { float r; asm("v_max3_f32 %0, %1, %2, %3" : "=v"(r) : "v"(a), "v"(b), "v"(c)); return r; }
#define DPP_F(v, ctrl) __builtin_bit_cast(float, __builtin_amdgcn_update_dpp(0, __builtin_bit_cast(int, (v)), (ctrl), 0xf, 0xf, true))
#define RDL_F(v, l) __builtin_bit_cast(float, __builtin_amdgcn_readlane(__builtin_bit_cast(int, (v)), (l)))
__device__ __forceinline__ float wave_sum(float v, int) {
    v += DPP_F(v, 0xB1); v += DPP_F(v, 0x4E); v += DPP_F(v, 0x141); v += DPP_F(v, 0x140);
    return (RDL_F(v, 0) + RDL_F(v, 16)) + (RDL_F(v, 32) + RDL_F(v, 48));
}
__device__ __forceinline__ float wave_max(float v) {
    v = fmaxf(v, DPP_F(v, 0xB1)); v = fmaxf(v, DPP_F(v, 0x4E)); v = fmaxf(v, DPP_F(v, 0x141)); v = fmaxf(v, DPP_F(v, 0x140));
    return fmaxf(fmaxf(RDL_F(v, 0), RDL_F(v, 16)), fmaxf(RDL_F(v, 32), RDL_F(v, 48)));
}
__device__ __forceinline__ int lane_opaque() { unsigned m = ~0u; asm volatile("" : "+s"(m)); return (int)__builtin_amdgcn_mbcnt_hi(m, __builtin_amdgcn_mbcnt_lo(m, 0u)); }
__device__ __forceinline__ int tid_opaque(int wv) { return wv * 64 + lane_opaque(); }

namespace pg8 {
#define PG8_LAS __attribute__((address_space(3)))
typedef unsigned short bf16_t;
typedef short bf16x8 __attribute__((ext_vector_type(8)));
typedef float f32x4 __attribute__((ext_vector_type(4)));
typedef unsigned u32x4 __attribute__((ext_vector_type(4)));
constexpr int BM = 256, BK = 64, HALF = 128, HTB = HALF * BK * 2  , STAGE_BYTES = 8 * HTB, NXCD = 8, WGM = 8;

__host__ __device__ __forceinline__ int lds_byte(int r, int c) { const int st = (r >> 4) * 2 + (c >> 5), rr = r & 15, cc = c & 31, ob = rr * 64 + cc * 2; return st * 1024 + (ob ^ (((ob >> 9) & 1) << 5)); }
__host__ __device__ __forceinline__ void stage_rc(int b, int& R, int& C) { const int st = b / 1024, sb = b % 1024, swz = sb ^ (((sb >> 9) & 1) << 5); R = (st >> 1) * 16 + swz / 64; C = (st & 1) * 32 + (swz % 64) / 2; }
__host__ __device__ __forceinline__ int perm32(int rho) { const int n = rho >> 4, i = rho & 15; return 8 * (i >> 2) + 4 * n + (i & 3); }

struct Unit { int pm, pn; };
struct Gemm { const bf16_t* A; const bf16_t* Bt; int M, N, K; };

struct StaticOrder {
    int nM, nN, nwg, G, c;
    __host__ __device__ void init(int M, int N, int G_, int c_) { nM = M / BM; nN = N / BM; nwg = nM * nN; G = G_; c = c_; }
    __host__ __device__ __forceinline__ bool next(int i, Unit& u) const {
        const long L = (long)i * G + c; if (L >= nwg) return false;
        int wgid = (int)L; { const int q = nwg / NXCD, r = nwg % NXCD, xcd = wgid % NXCD, off = wgid / NXCD; wgid = (xcd < r ? xcd * (q + 1) : r * (q + 1) + (xcd - r) * q) + off; }
        const int nig = WGM * nN, gid = wgid / nig, fm = gid * WGM, gsz = (nM - fm) < WGM ? (nM - fm) : WGM;
        u.pm = fm + ((wgid % nig) % gsz); u.pn = (wgid % nig) / gsz; return true;
    }
    __device__ __forceinline__ void a_ready(const Unit&) const {}
    __device__ __forceinline__ void done(const Unit&) const {}
};

__device__ __forceinline__ unsigned cvt_pk_bf16(float lo, float hi) { unsigned r; asm volatile("v_cvt_pk_bf16_f32 %0, %1, %2" : "=v"(r) : "v"(lo), "v"(hi)); return r; }
struct EpiInProj {
    static constexpr bool PERM = true, AFTER_DRAIN = false;
    bf16_t* P; const float* rope;
    __device__ __forceinline__ void operator()(const f32x4 (&acc)[2][2][4][2], const Unit& u, int wr, int wc, int fr, int fq) const {
        const int pn = u.pn; const bool lat = u.pm < 64; const int lane = fq * 16 + fr;
        const float sc = pn == 1 ? 0.125f : ((pn == 6 || pn == 7) ? 0.125f * 1.4426950408889634f : 1.0f);
        const float sgn = fq < 2 ? -1.0f : 1.0f;
#pragma unroll
        for (int bj = 0; bj < 2; ++bj) {
            const bool roped = lat && (pn == 0 || pn == 1 || pn == 6 || pn == 7 || (pn == 8 && bj == 0));
#pragma unroll
            for (int ai = 0; ai < 2; ++ai)
#pragma unroll
                for (int m = 0; m < 4; ++m) {
                    const int row = u.pm * BM + ai * HALF + wr * 64 + m * 16 + fr;
                    f32x4 v0 = acc[ai][bj][m][0], v1 = acc[ai][bj][m][1];
                    if (roped) {
                        const int pos = row & 8191, idx = (wc & 1) ? 128 + (pos & 63) : (pos >> 6);
                        const float2* tb = (const float2*)rope + idx * 16 + 8 * (fq & 1);
#pragma unroll
                        for (int e = 0; e < 4; ++e) {
                            const float p0 = shx(v0[e], 32, lane), p1 = shx(v1[e], 32, lane);
                            const float2 c0 = tb[e], c1 = tb[4 + e];
                            v0[e] = v0[e] * c0.x + sgn * p0 * c0.y;
                            v1[e] = v1[e] * c1.x + sgn * p1 * c1.y;
                        }
                    }
                    v0 = v0 * sc; v1 = v1 * sc;
                    u32x4 w; w.x = cvt_pk_bf16(v0[0], v0[1]); w.y = cvt_pk_bf16(v0[2], v0[3]); w.z = cvt_pk_bf16(v1[0], v1[1]); w.w = cvt_pk_bf16(v1[2], v1[3]);
                    *(u32x4*)(P + (size_t)row * 2304 + pn * BM + bj * HALF + wc * 32 + fq * 8) = w;
                    __builtin_amdgcn_sched_barrier(0);
                }
        }
    }
};
struct EpiF32 {
    static constexpr bool PERM = false, AFTER_DRAIN = false;
    float* O; int ldc;
    __device__ __forceinline__ void operator()(const f32x4 (&acc)[2][2][4][2], const Unit& u, int wr, int wc, int fr, int fq) const {
#pragma unroll
        for (int ai = 0; ai < 2; ++ai)
#pragma unroll
            for (int m = 0; m < 4; ++m) {
                float* rowp = O + (size_t)(u.pm * BM + ai * HALF + wr * 64 + m * 16 + fr) * ldc + u.pn * BM + wc * 32 + fq * 4;
#pragma unroll
                for (int bj = 0; bj < 2; ++bj)
#pragma unroll
                    for (int n = 0; n < 2; ++n) *(f32x4*)(rowp + bj * HALF + n * 16) = acc[ai][bj][m][n];
            }
    }
};


struct EpiBf16Plain {
    static constexpr bool PERM = true, AFTER_DRAIN = false;
    bf16_t* O; int ldc;
    __device__ __forceinline__ void operator()(const f32x4 (&acc)[2][2][4][2], const Unit& u, int wr, int wc, int fr, int fq) const {
#pragma unroll
        for (int ai = 0; ai < 2; ++ai)
#pragma unroll
            for (int m = 0; m < 4; ++m) {
                bf16_t* rowp = O + (size_t)(u.pm * BM + ai * HALF + wr * 64 + m * 16 + fr) * ldc + u.pn * BM + wc * 32 + fq * 8;
#pragma unroll
                for (int bj = 0; bj < 2; ++bj) {
                    const f32x4 v0 = acc[ai][bj][m][0], v1 = acc[ai][bj][m][1];
                    u32x4 w; w.x = cvt_pk_bf16(v0[0], v0[1]); w.y = cvt_pk_bf16(v0[2], v0[3]); w.z = cvt_pk_bf16(v1[0], v1[1]); w.w = cvt_pk_bf16(v1[2], v1[3]);
                    *(u32x4*)(rowp + bj * HALF) = w;
                }
            }
    }
};
template <class Epi, class Sched, bool ALIGN_EPI = false, bool SP2 = false>
__device__ __forceinline__ void gemm_phase(PG8_LAS unsigned char* lds, const Gemm g, const Sched& S, const Epi& E, int wv) {
    int tid_ = wv * 64; { unsigned m_ = ~0u; asm volatile("" : "+s"(m_)); tid_ += (int)__builtin_amdgcn_mbcnt_hi(m_, __builtin_amdgcn_mbcnt_lo(m_, 0u)); }
    const int tid = tid_, wid = __builtin_amdgcn_readfirstlane(tid >> 6), lane = tid & 63, wr = wid >> 2, wc = wid & 3, fr = lane & 15, fq = lane >> 4;
    const int K = g.K, nt = K / BK;
    unsigned voffA[2], voffB[2];
#pragma unroll
    for (int i = 0; i < 2; ++i) { int R, C; stage_rc(tid * 16 + i * 8192, R, C); const int Rb = Epi::PERM ? ((R & ~31) + perm32(R & 31)) : R;
        voffA[i] = (unsigned)(R * K + C) * 2u; voffB[i] = (unsigned)(Rb * K + C) * 2u; }
    const size_t kstep = (size_t)(BK * 2);
    const size_t hstep = (size_t)HALF * K * 2;
    const size_t tstep = 2 * hstep;
    const unsigned ldsw = (unsigned)wid * 1024u;
    const int aoff = lds_byte(wr * 64 + fr, fq * 8), boff = lds_byte(wc * 32 + fr, fq * 8);
#define PG8_SA(b, h) (((b) * 2 + (h)) * HTB)
#define PG8_SB(b, h) ((4 + (b) * 2 + (h)) * HTB)
#define PG8_STAGE(bufoff, gbase, voff) do { _Pragma("unroll") for (int _i = 0; _i < 2; ++_i) \
        __builtin_amdgcn_global_load_lds((const unsigned*)((const char*)(gbase) + (voff)[_i]), (PG8_LAS unsigned*)(lds + (bufoff) + ldsw + _i * 8192), 16, 0, 0); } while (0)
#define PG8_LDA(dst, b, h) do { _Pragma("unroll") for (int m = 0; m < 4; ++m) _Pragma("unroll") for (int k = 0; k < 2; ++k) dst[m][k] = *(const PG8_LAS bf16x8*)(lds + PG8_SA(b, h) + aoff + m * 2048 + k * 1024); } while (0)
#define PG8_LDB(dst, b, h) do { _Pragma("unroll") for (int n = 0; n < 2; ++n) _Pragma("unroll") for (int k = 0; k < 2; ++k) dst[n][k] = *(const PG8_LAS bf16x8*)(lds + PG8_SB(b, h) + boff + n * 2048 + k * 1024); } while (0)
#define PG8_MMA(ai, bj, At, Bt) do { __builtin_amdgcn_s_setprio(1); _Pragma("unroll") for (int m = 0; m < 4; ++m) _Pragma("unroll") for (int n = 0; n < 2; ++n) _Pragma("unroll") for (int k = 0; k < 2; ++k) \
        acc[ai][bj][m][n] = __builtin_amdgcn_mfma_f32_16x16x32_bf16(Bt[n][k], At[m][k], acc[ai][bj][m][n], 0, 0, 0); __builtin_amdgcn_s_setprio(0); } while (0)
#define PG8_WAIT_V(n) asm volatile("s_waitcnt vmcnt(" #n ")" ::: "memory")
#define PG8_WAIT_L(n) asm volatile("s_waitcnt lgkmcnt(" #n ")" ::: "memory")
#define PG8_BAR __builtin_amdgcn_s_barrier()
#define PG8_SCHED __builtin_amdgcn_sched_barrier(0)
    Unit cur, nxt; int ui = 0;
    if (!S.next(0, cur)) return;
    f32x4 acc[2][2][4][2];
#pragma unroll
    for (int a = 0; a < 2; ++a)
#pragma unroll
        for (int b = 0; b < 2; ++b)
#pragma unroll
            for (int m = 0; m < 4; ++m)
#pragma unroll
                for (int n = 0; n < 2; ++n) acc[a][b][m][n] = (f32x4){0.f, 0.f, 0.f, 0.f};
    bf16x8 At[4][2], B0[2][2], B1[2][2];
    const char* cA = (const char*)g.A + (size_t)cur.pm * tstep; const char* cB = (const char*)g.Bt + (size_t)cur.pn * tstep;
    S.a_ready(cur);
    if constexpr (SP2) {
        PG8_STAGE(PG8_SB(0, 0), cB, voffB); PG8_STAGE(PG8_SB(0, 1), cB + hstep, voffB); PG8_STAGE(PG8_SA(0, 0), cA, voffA); PG8_STAGE(PG8_SA(0, 1), cA + hstep, voffA);
        if (wr == 1) PG8_BAR;
        PG8_WAIT_V(2); PG8_BAR;
        PG8_STAGE(PG8_SB(1, 0), cB + kstep, voffB); PG8_STAGE(PG8_SA(1, 0), cA + kstep, voffA); PG8_STAGE(PG8_SB(1, 1), cB + hstep + kstep, voffB);
        PG8_WAIT_V(6); PG8_BAR;
    } else {
        PG8_STAGE(PG8_SB(0, 0), cB, voffB); PG8_STAGE(PG8_SA(0, 0), cA, voffA); PG8_STAGE(PG8_SB(0, 1), cB + hstep, voffB); PG8_STAGE(PG8_SA(0, 1), cA + hstep, voffA);
        if (wr == 1) PG8_BAR;
        PG8_WAIT_V(4); PG8_BAR;
        PG8_STAGE(PG8_SB(1, 0), cB + kstep, voffB); PG8_STAGE(PG8_SA(1, 0), cA + kstep, voffA); PG8_STAGE(PG8_SB(1, 1), cB + hstep + kstep, voffB);
        PG8_WAIT_V(6); PG8_BAR;
    }
    for (;;) {
        const bool has_next = S.next(ui + 1, nxt);
        const char* nA = has_next ? (const char*)g.A + (size_t)nxt.pm * tstep : cA; const char* nB = has_next ? (const char*)g.Bt + (size_t)nxt.pn * tstep : cB;
        for (int t = 0; t < nt; t += 2) {
            const bool last = (t == nt - 2);
            const char* a1 = cA + (size_t)(t + 1) * kstep;
            const char* a2 = last ? nA : cA + (size_t)(t + 2) * kstep; const char* b2 = last ? nB : cB + (size_t)(t + 2) * kstep;
            const char* a3 = a2 + kstep; const char* b3 = b2 + kstep;
            if (last && has_next) S.a_ready(nxt);
            if constexpr (SP2) {
            PG8_LDB(B0, 0, 0); PG8_LDB(B1, 0, 1); PG8_SCHED; PG8_LDA(At, 0, 0); PG8_STAGE(PG8_SA(1, 1), a1 + hstep, voffA);
            PG8_WAIT_V(8); PG8_WAIT_L(0); PG8_BAR; PG8_MMA(0, 0, At, B0); PG8_MMA(0, 1, At, B1); PG8_BAR; PG8_SCHED;
            PG8_LDA(At, 0, 1); PG8_STAGE(PG8_SB(0, 0), b2, voffB); PG8_STAGE(PG8_SB(0, 1), b2 + hstep, voffB); PG8_STAGE(PG8_SA(0, 0), a2, voffA);
            PG8_WAIT_V(8); PG8_WAIT_L(0); PG8_BAR; PG8_MMA(1, 0, At, B0); PG8_MMA(1, 1, At, B1); PG8_BAR; PG8_SCHED;
            PG8_LDB(B0, 1, 0); PG8_LDB(B1, 1, 1); PG8_SCHED; PG8_LDA(At, 1, 0); PG8_STAGE(PG8_SA(0, 1), a2 + hstep, voffA);
            PG8_WAIT_V(8); PG8_WAIT_L(0); PG8_BAR; PG8_MMA(0, 0, At, B0); PG8_MMA(0, 1, At, B1); PG8_BAR; PG8_SCHED;
            PG8_LDA(At, 1, 1); PG8_STAGE(PG8_SB(1, 0), b3, voffB); PG8_STAGE(PG8_SB(1, 1), b3 + hstep, voffB); PG8_STAGE(PG8_SA(1, 0), a3, voffA);
            PG8_WAIT_V(8); PG8_WAIT_L(0); PG8_BAR; PG8_MMA(1, 0, At, B0); PG8_MMA(1, 1, At, B1); PG8_BAR; PG8_SCHED;
            } else {
            PG8_LDB(B0, 0, 0); PG8_SCHED; PG8_LDA(At, 0, 0); PG8_STAGE(PG8_SA(1, 1), a1 + hstep, voffA);
            PG8_WAIT_L(8); PG8_BAR; PG8_WAIT_L(0); PG8_MMA(0, 0, At, B0); PG8_BAR; PG8_SCHED;
            PG8_LDB(B1, 0, 1); PG8_STAGE(PG8_SB(0, 0), b2, voffB);
            PG8_BAR; PG8_WAIT_L(0); PG8_MMA(0, 1, At, B1); PG8_BAR;
            PG8_LDA(At, 0, 1); PG8_STAGE(PG8_SA(0, 0), a2, voffA);
            PG8_BAR; PG8_WAIT_L(0); PG8_MMA(1, 0, At, B0); PG8_BAR; PG8_SCHED;
            PG8_STAGE(PG8_SB(0, 1), b2 + hstep, voffB);
            PG8_WAIT_V(6); PG8_BAR; PG8_MMA(1, 1, At, B1); PG8_BAR;
            PG8_LDB(B0, 1, 0); PG8_SCHED; PG8_LDA(At, 1, 0); PG8_STAGE(PG8_SA(0, 1), a2 + hstep, voffA);
            PG8_WAIT_L(8); PG8_BAR; PG8_WAIT_L(0); PG8_MMA(0, 0, At, B0); PG8_BAR; PG8_SCHED;
            PG8_LDB(B1, 1, 1); PG8_STAGE(PG8_SB(1, 0), b3, voffB);
            PG8_BAR; PG8_WAIT_L(0); PG8_MMA(0, 1, At, B1); PG8_BAR;
            PG8_LDA(At, 1, 1); PG8_STAGE(PG8_SA(1, 0), a3, voffA);
            PG8_BAR; PG8_WAIT_L(0); PG8_MMA(1, 0, At, B0); PG8_BAR; PG8_SCHED;
            PG8_STAGE(PG8_SB(1, 1), b3 + hstep, voffB);
            PG8_WAIT_V(6); PG8_BAR; PG8_MMA(1, 1, At, B1); PG8_BAR;
            }
        }
        if constexpr (ALIGN_EPI) { if (wr == 0) PG8_BAR; }
        if constexpr (!Epi::AFTER_DRAIN) { E(acc, cur, wr, wc, fr, fq); S.done(cur); }
        if (!has_next) break;
#pragma unroll
        for (int a = 0; a < 2; ++a)
#pragma unroll
            for (int b = 0; b < 2; ++b)
#pragma unroll
                for (int m = 0; m < 4; ++m)
#pragma unroll
                    for (int n = 0; n < 2; ++n) acc[a][b][m][n] = (f32x4){0.f, 0.f, 0.f, 0.f};
        cur = nxt; cA = nA; cB = nB; ++ui;
        if constexpr (ALIGN_EPI) { if (wr == 1) PG8_BAR; }
    }
    PG8_WAIT_V(0);
    if constexpr (!ALIGN_EPI) { if (wr == 0) PG8_BAR; }
    PG8_BAR;
    if constexpr (Epi::AFTER_DRAIN) { E.fused(acc, cur, wr, wc, fr, fq, lds, wid, lane); S.done(cur); }
#undef PG8_SA
#undef PG8_SB
#undef PG8_STAGE
#undef PG8_LDA
#undef PG8_LDB
#undef PG8_MMA
#undef PG8_WAIT_V
#undef PG8_WAIT_L
#undef PG8_BAR
#undef PG8_SCHED
}
}
constexpr int CW_BAR = 4096;
constexpr size_t CTL_BYTES = 65536;
#define XB_TMO      128
#define XB_XCNT(j)  (256  + 64 * (j))
#define XB_XSUB(j)  (1280 + 64 * (j))
#define XB_XGEN(j)  (2304 + 64 * (j))
#define XB_TOP      3328
#define XB_TOPGEN   3392
#define XCD_BAR_WORDS 3456
#define XB_SPIN_CAP (1u << 18)

__device__ __forceinline__ unsigned xb_ld(unsigned* p)              { return __hip_atomic_load(p, __ATOMIC_RELAXED, __HIP_MEMORY_SCOPE_AGENT); }
__device__ __forceinline__ unsigned xb_add(unsigned* p, unsigned v) { return __hip_atomic_fetch_add(p, v, __ATOMIC_RELAXED, __HIP_MEMORY_SCOPE_AGENT); }
__device__ __forceinline__ unsigned xb_xcc_id() { return (unsigned)__builtin_amdgcn_s_getreg((3 << 11) | 20) & 0xFu; }
#define XB_SPIN(cond, bar) do { unsigned _sp = 0; while (cond) { __builtin_amdgcn_s_sleep(1); \
    if ((++_sp & 255u) == 0u) { if (xb_ld(&(bar)[XB_TMO])) break; if (_sp > XB_SPIN_CAP) { atomicAdd(&(bar)[XB_TMO], 1u); break; } } } } while (0)

struct XcdBarrier {
    unsigned* bar; unsigned x; bool lead;
    volatile LAS unsigned* st;
};

__device__ __forceinline__ XcdBarrier xcd_barrier_post(unsigned* bar, volatile LAS unsigned* st, bool lead) {
    XcdBarrier b; b.bar = bar; b.x = xb_xcc_id(); b.st = st; b.lead = lead;
    if (b.lead) (void)xb_add(&bar[XB_XCNT(b.x)], 1u);
    return b;
}
__device__ __forceinline__ void xcd_barrier_complete(unsigned* bar, unsigned x, unsigned& nloc, unsigned& nx) {
    const unsigned G = gridDim.x * gridDim.y * gridDim.z;
    unsigned sum, cnt, mine, sp = 0u;
    for (;;) {
        sum = 0u; cnt = 0u; mine = 0u;
#pragma unroll
        for (unsigned j = 0; j < 16; ++j) { const unsigned c = xb_ld(&bar[XB_XCNT(j)]); sum += c; cnt += (c > 0u) ? 1u : 0u; mine = (j == x) ? c : mine; }
        if (sum == G) break;
        __builtin_amdgcn_s_sleep(1);
        if ((++sp & 255u) == 0u) { if (xb_ld(&bar[XB_TMO])) break; if (sp > XB_SPIN_CAP) { atomicAdd(&bar[XB_TMO], 1u); break; } }
    }
    nloc = mine > 0u ? mine : 1u; nx = cnt > 0u ? cnt : 1u;
}

__device__ __forceinline__ void xcd_barrier(const XcdBarrier& b) {
    asm volatile("s_waitcnt vmcnt(0)" ::: "memory");
    __syncthreads();
    if (b.lead) {
        unsigned* bar = b.bar;
        __builtin_amdgcn_s_waitcnt(0);
        unsigned nloc = b.st[0], nx = b.st[1];
        if (nloc == 0u) { xcd_barrier_complete(bar, b.x, nloc, nx); b.st[0] = nloc; b.st[1] = nx; }
        const unsigned old = xb_add(&bar[XB_XSUB(b.x)], 1u);
        const unsigned gen = old / nloc;
        if (old + 1u == (gen + 1u) * nloc) {
            __builtin_amdgcn_fence(__ATOMIC_RELEASE, "agent");
            asm volatile("s_waitcnt vmcnt(0)" ::: "memory");
            const unsigned og = xb_add(&bar[XB_TOP], 1u);
            const unsigned tg = og / nx;
            if (og + 1u == (tg + 1u) * nx) xb_add(&bar[XB_TOPGEN], 1u);
            else XB_SPIN(xb_ld(&bar[XB_TOPGEN]) == tg, bar);
            __builtin_amdgcn_fence(__ATOMIC_ACQUIRE, "agent");
            xb_add(&bar[XB_XGEN(b.x)], 1u);
            asm volatile("s_waitcnt vmcnt(0)" ::: "memory");
        } else {
            XB_SPIN(xb_ld(&bar[XB_XGEN(b.x)]) == gen, bar);
            __builtin_amdgcn_fence(__ATOMIC_ACQUIRE, "agent");
            asm volatile("s_waitcnt vmcnt(0)" ::: "memory");
        }
    }
    __syncthreads();
}


__device__ __forceinline__ void phase_mod1(KP p, int wv, int bid, int nb, float* lds) {
    float* red = lds;
    const int t = tid_opaque(wv), cg4 = t & 63, kg = t >> 6;
    for (int u = bid; u < DEPTH * 24 * 16; u += nb) {
        const int ks = u & 15, nblk = (u >> 4) % 24, l = u / (16 * 24);
        const int n = nblk * 256 + cg4 * 4;
        float4 wr[8];
#pragma unroll
        for (int kk = 0; kk < 8; ++kk) wr[kk] = *(const float4*)(p->w_mod + ((size_t)l * D + ks * 64 + kg * 8 + kk) * 6144 + n);
        float a[3][4];
#pragma unroll
        for (int v = 0; v < 3; ++v)
#pragma unroll
            for (int j = 0; j < 4; ++j) a[v][j] = 0.f;
#pragma unroll
        for (int kk = 0; kk < 8; ++kk) {
            const int k = ks * 64 + kg * 8 + kk;
            const float s0 = silu_f(p->c[k]), s1 = silu_f(p->c[D + k]), s2 = silu_f(p->c_ctx[k]);
            a[0][0] += s0 * wr[kk].x; a[0][1] += s0 * wr[kk].y; a[0][2] += s0 * wr[kk].z; a[0][3] += s0 * wr[kk].w;
            a[1][0] += s1 * wr[kk].x; a[1][1] += s1 * wr[kk].y; a[1][2] += s1 * wr[kk].z; a[1][3] += s1 * wr[kk].w;
            a[2][0] += s2 * wr[kk].x; a[2][1] += s2 * wr[kk].y; a[2][2] += s2 * wr[kk].z; a[2][3] += s2 * wr[kk].w;
        }
        __syncthreads();
#pragma unroll
        for (int v = 0; v < 3; ++v) *(float4*)(red + (v * 8 + kg) * 256 + cg4 * 4) = make_float4(a[v][0], a[v][1], a[v][2], a[v][3]);
        __syncthreads();
        for (int o = t; o < 768; o += NT) {
            const int v = o >> 8, col = o & 255;
            float sm = 0.f;
#pragma unroll
            for (int g = 0; g < 8; ++g) sm += red[(v * 8 + g) * 256 + col];
            p->modp[(((size_t)ks * DEPTH + l) * 3 + v) * 6144 + nblk * 256 + col] = sm;
        }
    }
    __syncthreads();
}
__device__ __forceinline__ void phase_mod2(KP p, int wv, int bid, int nb) {
    for (int i = bid * NT + tid_opaque(wv); i < DEPTH * 3 * 6144; i += nb * NT) {
        const int n = i % 6144, l = i / (3 * 6144);
        float s = p->b_mod[l * 6144 + n];
        for (int ks = 0; ks < 16; ++ks) s += p->modp[(size_t)ks * DEPTH * 3 * 6144 + i];
        p->mod[i] = s;
    }
}
__device__ __forceinline__ void transpose_item(const float* W, int K, int N, bf16* WT, float* scr, int item, int lane) {
    const int nblk = N / 64, kb = item / nblk, nbk = item % nblk, k0 = 64 * kb, n0 = 64 * nbk;
    const int r4 = lane >> 4, c4 = lane & 15;
#pragma unroll 8
    for (int i = 0; i < 16; ++i) { const int kk = 4 * i + r4; const float4 q = *(const float4*)(W + (size_t)(k0 + kk) * N + n0 + c4 * 4);
        float* d = scr + kk * 65 + c4 * 4; d[0] = q.x; d[1] = q.y; d[2] = q.z; d[3] = q.w; }
    __builtin_amdgcn_wave_barrier();
    const int c = lane & 7;
#pragma unroll
    for (int j = 0; j < 8; ++j) { const int n = (lane >> 3) + 8 * j; const float* sp = scr + (8 * c) * 65 + n;
        uint4 o; o.x = pk2(sp[0 * 65], sp[1 * 65]); o.y = pk2(sp[2 * 65], sp[3 * 65]); o.z = pk2(sp[4 * 65], sp[5 * 65]); o.w = pk2(sp[6 * 65], sp[7 * 65]);
        *(uint4*)(WT + (size_t)(n0 + n) * K + k0 + 8 * c) = o; }
    __builtin_amdgcn_wave_barrier();
}
__device__ __forceinline__ void phase_tables(KP p, int wv, int l, int vb, int nvb) {
    {
        const int lane_ = tid_opaque(wv) & 63, w_ = tid_opaque(wv) >> 6;
        for (int row0 = (vb * NW + w_) * 8; row0 < 2 * PEER_N; row0 += nvb * NW * 8) {
            float v[8][16];
#pragma unroll
            for (int q = 0; q < 8; ++q) {
                const int row = row0 + q; const bool isv = row >= PEER_N; const int rr = l * PEER_N + (isv ? row - PEER_N : row);
                const float* src_ = (isv ? p->pv : p->pu) + (size_t)rr * D;
#pragma unroll
                for (int i = 0; i < 4; ++i) { typedef float f4v_ __attribute__((ext_vector_type(4))); const f4v_ q4 = __builtin_nontemporal_load((const f4v_*)(src_ + i * 256 + lane_ * 4)); v[q][i * 4 + 0] = q4[0]; v[q][i * 4 + 1] = q4[1]; v[q][i * 4 + 2] = q4[2]; v[q][i * 4 + 3] = q4[3]; }
            }
#pragma unroll
            for (int q = 0; q < 8; ++q) {
                const int row = row0 + q; const bool isv = row >= PEER_N; const int rr = l * PEER_N + (isv ? row - PEER_N : row);
                float m = 0.f;
#pragma unroll
                for (int i = 0; i < 16; ++i) m = fmaxf(m, fabsf(v[q][i]));
                m = wave_max(m);
                unsigned* dst = (unsigned*)((isv ? p->V8 : p->U8) + (size_t)rr * D);
                if (!isv) {
                    float ss = 0.f;
#pragma unroll
                    for (int i = 0; i < 16; ++i) ss += v[q][i] * v[q][i];
                    const float rms = sqrtf(wave_sum(ss, lane_) * (1.0f / D));
                    const float step = m > 0.f ? fmaxf(0.335f * rms, 0.1f * m) : 1.0f, inv = 1.0f / step;
                    unsigned char* drow = p->U8 + (size_t)rr * 512;
#pragma unroll
                    for (int i = 0; i < 2; ++i) {
                        unsigned pk = 0u;
#pragma unroll
                        for (int k = 0; k < 4; ++k) {
                            const int lo = (int)fminf(fmaxf(rintf(v[q][i * 4 + k] * inv), -7.0f), 7.0f) + 8, hi = (int)fminf(fmaxf(rintf(v[q][(i + 2) * 4 + k] * inv), -7.0f), 7.0f) + 8;
                            pk |= (unsigned)(lo | (hi << 4)) << (8 * k);
                        }
                        *(unsigned*)(drow + i * 256 + lane_ * 4) = pk;
                    }
                    if (lane_ == 0) p->SU[rr] = step;
                } else {
                    const float inv = m > 0.f ? 6.0f / m : 0.f;
                    unsigned short* drow = (unsigned short*)(p->V8 + (size_t)rr * 512);
#pragma unroll
                    for (int i = 0; i < 4; ++i) {
                        unsigned pk = __builtin_amdgcn_cvt_scalef32_pk_fp4_f32(0u, v[q][i * 4 + 0] * inv, v[q][i * 4 + 1] * inv, 1.0f, 0);
                        pk = __builtin_amdgcn_cvt_scalef32_pk_fp4_f32(pk, v[q][i * 4 + 2] * inv, v[q][i * 4 + 3] * inv, 1.0f, 1);
                        drow[i * 64 + lane_] = (unsigned short)pk;
                    }
                    if (lane_ == 0) p->SV[rr] = m * (1.0f / 6.0f);
                }
            }
        }
    }
}

__device__ __forceinline__ void phase_weights(KP p, int wv, int bid, int nb, float* lds) {
    const int lane = tid_opaque(wv) & 63, w = tid_opaque(wv) >> 6;
    float* scr = lds + w * (64 * 65 + 32);
    constexpr int I_IN = 16 * 36, I_OUT = 16 * 16, I_Q = 16 * 32;
    constexpr int NITEMS = DEPTH * (I_IN + I_OUT + I_Q);
    for (int it = bid * NW + w; it < NITEMS; it += nb * NW) {
        int r = it;
        if (r < DEPTH * I_IN) { const int l = r / I_IN; transpose_item(p->w_in + (size_t)l * D * DIN, D, DIN, p->WtIn + (size_t)l * DIN * D, scr, r % I_IN, lane); continue; } r -= DEPTH * I_IN;
        if (r < DEPTH * I_OUT) { const int l = r / I_OUT; transpose_item(p->w_out + (size_t)l * D * D, D, D, p->WtOut + (size_t)l * D * D, scr, r % I_OUT, lane); continue; } r -= DEPTH * I_OUT;
        { const int l = r / I_Q; transpose_item(p->wq + (size_t)l * D * 2048, D, 2048, p->WtQ + (size_t)l * 2048 * D, scr, r % I_Q, lane); }
    }
    for (int i = bid * NT + tid_opaque(wv); i < 192 * 16; i += nb * NT) {
        const int idx = i >> 4, f = i & 15;
        const float inv = powf(10000.0f, -(float)f / 16.0f);
        const float ang = (float)(idx < 128 ? idx : idx - 128) * inv;
        p->rope[2 * i] = cosf(ang); p->rope[2 * i + 1] = sinf(ang);
    }
}

__device__ __forceinline__ void row_load(const float* src, float (&v)[16], int lane) {
#pragma unroll
    for (int i = 0; i < 4; ++i) { const float4 q = *(const float4*)(src + i * 256 + lane * 4); v[i * 4 + 0] = q.x; v[i * 4 + 1] = q.y; v[i * 4 + 2] = q.z; v[i * 4 + 3] = q.w; }
}
__device__ __forceinline__ void row_store(float* dst, const float (&v)[16], int lane) {
#pragma unroll
    for (int i = 0; i < 4; ++i) *(float4*)(dst + i * 256 + lane * 4) = make_float4(v[i * 4 + 0], v[i * 4 + 1], v[i * 4 + 2], v[i * 4 + 3]);
}
__device__ __forceinline__ void row_store_bf(bf16* dst, const float (&v)[16], int lane) {
#pragma unroll
    for (int i = 0; i < 4; ++i) *(uint2*)(dst + i * 256 + lane * 4) = make_uint2(pk2(v[i * 4 + 0], v[i * 4 + 1]), pk2(v[i * 4 + 2], v[i * 4 + 3]));
}
__device__ __forceinline__ void row_load_bf(const bf16* src, float (&v)[16], int lane) {
#pragma unroll
    for (int i = 0; i < 4; ++i) { const uint2 q = *(const uint2*)(src + i * 256 + lane * 4); v[i * 4 + 0] = bflo(q.x); v[i * 4 + 1] = bfhi(q.x); v[i * 4 + 2] = bflo(q.y); v[i * 4 + 3] = bfhi(q.y); }
}
__device__ __forceinline__ void row_ln(float (&v)[16], int lane) {
    float s = 0.f;
#pragma unroll
    for (int i = 0; i < 16; ++i) s += v[i];
    const float mu = wave_sum(s, lane) * (1.0f / D);
    float q = 0.f;
#pragma unroll
    for (int i = 0; i < 16; ++i) { v[i] -= mu; q += v[i] * v[i]; }
    const float rstd = rsqrtf(wave_sum(q, lane) * (1.0f / D) + LN_EPS);
#pragma unroll
    for (int i = 0; i < 16; ++i) v[i] *= rstd;
}
__device__ __forceinline__ const float* x_row(KP p, int l, int r) {
    if (l == 0) return r < TL ? p->x + (size_t)r * D : p->ctx + (size_t)(r - TL) * D;
    return nullptr;
}

__device__ __forceinline__ void phase_lnmod(KP p, int wv, int l, int bid, int nb) {
    const int lane = tid_opaque(wv) & 63, w = tid_opaque(wv) >> 6;
    const int rfirst = bid * NW + w, rstep = nb * NW;
    if (rfirst >= T) return;
    float sh[16], sc[16], xf[16];
    int cur_mi = -1;
    row_load(x_row(p, l, rfirst), xf, lane);
#pragma unroll 1
    for (int r = rfirst; r < T; r += rstep) {
        float v[16];
#pragma unroll
        for (int i = 0; i < 16; ++i) v[i] = xf[i];
        row_load(x_row(p, l, r + rstep < T ? r + rstep : r), xf, lane);
        const int mi = mod_idx(r);
        if (mi != cur_mi) { cur_mi = mi; const float* m = p->mod + ((size_t)l * 3 + mi) * 6144; row_load(m, sh, lane); row_load(m + 1024, sc, lane); }
        row_ln(v, lane);
#pragma unroll
        for (int i = 0; i < 16; ++i) v[i] = v[i] * (1.0f + sc[i]) + sh[i];
        row_store_bf(p->H + (size_t)r * D, v, lane);
    }
}

typedef short bf16x8_t __attribute__((ext_vector_type(8)));
typedef short bf16x4_t __attribute__((ext_vector_type(4)));
typedef float f32x4_t __attribute__((ext_vector_type(4)));
#define MFMA16(a, b, c) __builtin_amdgcn_mfma_f32_16x16x32_bf16((a), (b), (c), 0, 0, 0)
constexpr int KROW = 72;
constexpr int TROW = 136;
__device__ __forceinline__ bf16x8_t lds_frag16(const bf16* p) { return *(const bf16x8_t*)p; }
__device__ __forceinline__ bf16x8_t lds_frag8x2(const bf16* p0, const bf16* p1) {
    const bf16x4_t a = *(const bf16x4_t*)p0, b = *(const bf16x4_t*)p1;
    bf16x8_t o; o[0] = a[0]; o[1] = a[1]; o[2] = a[2]; o[3] = a[3]; o[4] = b[0]; o[5] = b[1]; o[6] = b[2]; o[7] = b[3]; return o;
}
__device__ __forceinline__ int tsw(int row) { return ((row >> 3) & 7) << 3; }
__device__ __forceinline__ bf16x8_t pack_p(const f32x4_t& x, const f32x4_t& y) {
    uint4 w; w.x = pk2(x[0], x[1]); w.y = pk2(x[2], x[3]); w.z = pk2(y[0], y[1]); w.w = pk2(y[2], y[3]);
    return __builtin_bit_cast(bf16x8_t, w);
}
__device__ __forceinline__ void st_tr8(bf16* dst_col0, int stride, const uint4& v) {
    dst_col0[0 * stride] = (bf16)(v.x & 0xffffu); dst_col0[1 * stride] = (bf16)(v.x >> 16);
    dst_col0[2 * stride] = (bf16)(v.y & 0xffffu); dst_col0[3 * stride] = (bf16)(v.y >> 16);
    dst_col0[4 * stride] = (bf16)(v.z & 0xffffu); dst_col0[5 * stride] = (bf16)(v.z >> 16);
    dst_col0[6 * stride] = (bf16)(v.w & 0xffffu); dst_col0[7 * stride] = (bf16)(v.w >> 16);
}

constexpr int ATT_BUF = 128 * KROW + 64 * TROW;
__device__ __forceinline__ void att_unit(KP p, int wv, int l, int u, bf16* lds) {
    const int t = tid_opaque(wv), lane = t & 63, w = t >> 6, r = lane & 15, g = lane >> 4;
    const bool lat = u < 256;
    int b, n, hkv;
    if (lat) { hkv = u & 1; n = (u >> 1) & 63; b = u >> 7; } else { const int v = u - 256; hkv = v & 1; n = (v >> 1) & 1; b = v >> 2; }
    const int hq = hkv * 4 + (w >> 1), qh = w & 1;
    const int qrow0 = (lat ? b * SEQ + n * 128 : TL + b * LC + n * 128) + qh * 64;
    int kb_lo = 0, kb_hi = -1;
    if (lat) { kb_lo = n > 0 ? n - 1 : 0; kb_hi = n < 63 ? n + 1 : 63; }
    const int nloc = kb_hi - kb_lo + 1, nblk = nloc + 2;
    const bf16* P = p->P;
    bf16x8_t qf[4][2];
#pragma unroll
    for (int qt = 0; qt < 4; ++qt)
#pragma unroll
        for (int ks = 0; ks < 2; ++ks) qf[qt][ks] = *(const bf16x8_t*)(P + (size_t)(qrow0 + qt * 16 + r) * DIN + C_AQ + hq * 64 + ks * 32 + g * 8);
    const float LOG2E = 1.4426950408889634f;
    const float sink2 = p->sink[l * 8 + hq] * LOG2E;
    float m[4], lsum[4];
    f32x4_t ot[4][4];
#pragma unroll
    for (int qt = 0; qt < 4; ++qt) { m[qt] = sink2; lsum[qt] = g == 0 ? 1.0f : 0.0f; }
#pragma unroll
    for (int dt = 0; dt < 4; ++dt)
#pragma unroll
        for (int qt = 0; qt < 4; ++qt) ot[dt][qt] = (f32x4_t){0.f, 0.f, 0.f, 0.f};
    uint4 kreg0, kreg1, vreg0, vreg1;
#define ATT_ROW0(bi) ((bi) < nloc ? b * SEQ + (kb_lo + (bi)) * 128 : TL + b * LC + ((bi) - nloc) * 128)
    const int key0 = t >> 3, key1 = key0 + 64, c8 = t & 7;
#define ATT_ISSUE(bi) do { const bf16* src_ = P + (size_t)(ATT_ROW0(bi) + key0) * DIN + hkv * 64 + c8 * 8; \
        kreg0 = *(const uint4*)(src_ + C_AK); vreg0 = *(const uint4*)(src_ + C_AV); \
        kreg1 = *(const uint4*)(src_ + 64 * DIN + C_AK); vreg1 = *(const uint4*)(src_ + 64 * DIN + C_AV); } while (0)
#define ATT_STAGE(buf) do { \
        *(uint4*)((buf) + key0 * KROW + c8 * 8) = kreg0; *(uint4*)((buf) + key1 * KROW + c8 * 8) = kreg1; \
        st_tr8((buf) + 128 * KROW + (c8 * 8) * TROW + (key0 ^ (c8 << 3)), TROW, vreg0); st_tr8((buf) + 128 * KROW + (c8 * 8) * TROW + (key1 ^ (c8 << 3)), TROW, vreg1); } while (0)
    __syncthreads();
    ATT_ISSUE(0);
    for (int bi = 0; bi < nblk; ++bi) {
        bf16* buf = lds + (bi & 1) * ATT_BUF;
        ATT_STAGE(buf);
        __syncthreads();
        if (bi + 1 < nblk) ATT_ISSUE(bi + 1);
        const bf16* Ks = buf; const bf16* Vt = buf + 128 * KROW;
        const int band = (bi < nloc) ? (kb_lo + bi) - n : 0;
#pragma unroll 1
        for (int sub = 0; sub < 2; ++sub) {
            if ((band < 0 && sub == 0 && qh == 1) || (band > 0 && sub == 1 && qh == 0)) continue;
            f32x4_t st[4][4];
#pragma unroll
            for (int kt = 0; kt < 4; ++kt) {
#pragma unroll
                for (int qt = 0; qt < 4; ++qt) st[kt][qt] = (f32x4_t){0.f, 0.f, 0.f, 0.f};
#pragma unroll
                for (int ks = 0; ks < 2; ++ks) {
                    const bf16x8_t a = lds_frag16(Ks + (sub * 64 + kt * 16 + r) * KROW + ks * 32 + g * 8);
#pragma unroll
                    for (int qt = 0; qt < 4; ++qt) st[kt][qt] = MFMA16(a, qf[qt][ks], st[kt][qt]);
                }
            }
            if (band != 0) {
                const int sb = band * (sub * 64 + g * 4 - qh * 64 - r);
#pragma unroll
                for (int qt = 0; qt < 4; ++qt)
#pragma unroll
                    for (int kt = 0; kt < 4; ++kt)
#pragma unroll
                        for (int i = 0; i < 4; ++i) {
                            const int c = -band * ((kt - qt) * 16 + i);
                            st[kt][qt][i] = sb > c ? -INFINITY : st[kt][qt][i];
                        }
            }
            float mnew[4]; bool grow = false;
#pragma unroll
            for (int qt = 0; qt < 4; ++qt) {
                float mloc = rmax3(rmax3(st[0][qt][0], st[0][qt][1], st[0][qt][2]), rmax3(st[0][qt][3], st[1][qt][0], st[1][qt][1]), rmax3(st[1][qt][2], st[1][qt][3], st[2][qt][0]));
                mloc = rmax3(mloc, rmax3(st[2][qt][1], st[2][qt][2], st[2][qt][3]), rmax3(st[3][qt][0], st[3][qt][1], rmax(st[3][qt][2], st[3][qt][3])));
                mloc = rmax(mloc, shx(mloc, 16, lane)); mloc = rmax(mloc, shx(mloc, 32, lane));
                mnew[qt] = rmax(m[qt], mloc);
                grow = grow || (mnew[qt] > m[qt]);
            }
            if (__any(grow)) {
#pragma unroll
                for (int qt = 0; qt < 4; ++qt) {
                    const float alpha = __builtin_amdgcn_exp2f(m[qt] - mnew[qt]);
                    m[qt] = mnew[qt]; lsum[qt] *= alpha;
#pragma unroll
                    for (int dt = 0; dt < 4; ++dt) ot[dt][qt] = ot[dt][qt] * alpha;
                }
            }
#pragma unroll
            for (int qt = 0; qt < 4; ++qt) {
                float ps = 0.f;
#pragma unroll
                for (int kt = 0; kt < 4; ++kt)
#pragma unroll
                    for (int i = 0; i < 4; ++i) { const float e = __builtin_amdgcn_exp2f(st[kt][qt][i] - m[qt]); st[kt][qt][i] = e; ps += e; }
                lsum[qt] += ps;
            }
#pragma unroll
            for (int kp = 0; kp < 2; ++kp) {
                bf16x8_t pf[4];
#pragma unroll
                for (int qt = 0; qt < 4; ++qt) pf[qt] = pack_p(st[2 * kp][qt], st[2 * kp + 1][qt]);
#pragma unroll
                for (int dt = 0; dt < 4; ++dt) {
                    const bf16* vrow = Vt + (dt * 16 + r) * TROW; const int vsw = ((2 * dt + (r >> 3)) & 7) << 3, vk = sub * 64 + g * 4 + (2 * kp) * 16;
                    const bf16x8_t a = lds_frag8x2(vrow + (vk ^ vsw), vrow + ((vk + 16) ^ vsw));
#pragma unroll
                    for (int qt = 0; qt < 4; ++qt) ot[dt][qt] = MFMA16(a, pf[qt], ot[dt][qt]);
                }
            }
        }
    }
#pragma unroll
    for (int qt = 0; qt < 4; ++qt) {
        float ls = lsum[qt]; ls += shx(ls, 16, lane); ls += shx(ls, 32, lane);
        const float inv = 1.0f / ls;
        bf16* orow = p->MIX + (size_t)(qrow0 + qt * 16 + r) * D + 512 + hq * 64 + g * 4;
#pragma unroll
        for (int dt = 0; dt < 4; ++dt) {
            const f32x4_t o = ot[dt][qt] * inv;
            *(uint2*)(orow + dt * 16) = make_uint2(pk2(o[0], o[1]), pk2(o[2], o[3]));
        }
    }
}

__device__ __forceinline__ size_t kv_off(int dir, int b, int pos, int h) { return ((((size_t)dir * NB + b) * NPOS + pos) * 4 + h) * 4096; }
__device__ __forceinline__ void ret_kv_unit(KP p, int wv, int l, int u, bf16* lds) {
    const int h = u & 3, pos = (u >> 2) % NPOS, b = u / (4 * NPOS);
    const int t = tid_opaque(wv), lane = t & 63, w = t >> 6, r = lane & 15, g = lane >> 4;
    bf16* Ktf = lds; bf16* Ktb = lds + 64 * TROW; bf16* Vt = lds + 2 * 64 * TROW;
    const float lgf = log_sigmoid_f(p->rdf[l * 4 + h]), lgb = log_sigmoid_f(p->rdb[l * 4 + h]);
    const int r0 = chunk_row0(b, pos);
    const bf16* P = p->P;
    uint4 kvr[2], vvr[2];
#pragma unroll
    for (int q = 0; q < 2; ++q) {
        const int pc = t + q * NT, j = pc >> 3, c8 = pc & 7;
        const bf16* src = P + (size_t)(r0 + j) * DIN + h * 64 + c8 * 8;
        kvr[q] = *(const uint4*)(src + C_RK); vvr[q] = *(const uint4*)(src + C_RV);
    }
    __syncthreads();
#pragma unroll
    for (int q = 0; q < 2; ++q) {
        const int pc = t + q * NT, j = pc >> 3, c8 = pc & 7;
        const uint4 kv = kvr[q], vv = vvr[q];
        const float wf = expf(lgf * (float)(127 - j)), wb = expf(lgb * (float)j);
        uint4 kf, kb;
        kf.x = pk2(bflo(kv.x) * wf, bfhi(kv.x) * wf); kf.y = pk2(bflo(kv.y) * wf, bfhi(kv.y) * wf); kf.z = pk2(bflo(kv.z) * wf, bfhi(kv.z) * wf); kf.w = pk2(bflo(kv.w) * wf, bfhi(kv.w) * wf);
        kb.x = pk2(bflo(kv.x) * wb, bfhi(kv.x) * wb); kb.y = pk2(bflo(kv.y) * wb, bfhi(kv.y) * wb); kb.z = pk2(bflo(kv.z) * wb, bfhi(kv.z) * wb); kb.w = pk2(bflo(kv.w) * wb, bfhi(kv.w) * wb);
        st_tr8(Ktf + (c8 * 8) * TROW + (j ^ (c8 << 3)), TROW, kf);
        st_tr8(Ktb + (c8 * 8) * TROW + (j ^ (c8 << 3)), TROW, kb);
        st_tr8(Vt + (c8 * 8) * TROW + (j ^ (c8 << 3)), TROW, vv);
    }
    __syncthreads();
    const int dir = w >> 2, dvt = w & 3;
    const bf16* Kt = dir ? Ktb : Ktf;
    f32x4_t acc[4];
#pragma unroll
    for (int dkt = 0; dkt < 4; ++dkt) acc[dkt] = (f32x4_t){0.f, 0.f, 0.f, 0.f};
#pragma unroll
    for (int ks = 0; ks < 4; ++ks) {
        const bf16x8_t a = lds_frag16(Vt + (dvt * 16 + r) * TROW + ((ks * 32 + g * 8) ^ tsw(dvt * 16 + r)));
#pragma unroll
        for (int dkt = 0; dkt < 4; ++dkt) acc[dkt] = MFMA16(a, lds_frag16(Kt + (dkt * 16 + r) * TROW + ((ks * 32 + g * 8) ^ tsw(dkt * 16 + r))), acc[dkt]);
    }
    float* o = p->KV + kv_off(dir, b, pos, h);
#pragma unroll
    for (int dkt = 0; dkt < 4; ++dkt)
#pragma unroll
        for (int i = 0; i < 4; ++i) o[(dvt * 16 + g * 4 + i) * 64 + dkt * 16 + r] = acc[dkt][i];
}

__device__ __forceinline__ void phase_ret_scan(KP p, int wv, int l, int bid, int nb) {
    for (int i = bid * NT + tid_opaque(wv); i < 2 * NB * 4 * 4096; i += nb * NT) {
        const int e = i & 4095, h = (i >> 12) & 3, b = (i >> 14) & 1, dir = i >> 15;
        const float lg = log_sigmoid_f(dir ? p->rdb[l * 4 + h] : p->rdf[l * 4 + h]);
        const float cdec = expf(128.0f * lg);
        const float* kv = p->KV; bf16* st = p->ST16;
        float v[NPOS];
#pragma unroll
        for (int step = 0; step < NPOS; ++step) {
            const int pos = dir == 0 ? step : (step == 0 ? 1 : (step == 1 ? 0 : 67 - step));
            v[step] = kv[kv_off(dir, b, pos, h) + e];
        }
        float s = 0.f;
#pragma unroll
        for (int step = 0; step < NPOS; ++step) {
            const int pos = dir == 0 ? step : (step == 0 ? 1 : (step == 1 ? 0 : 67 - step));
            st[kv_off(dir, b, pos, h) + e] = (bf16)f2bf(s);
            s = s * cdec + v[step];
        }
    }
}

constexpr int RO_HEAD = 128 * KROW + 64 * TROW + 2 * 64 * KROW;
constexpr int RO_TAB = 2 * RO_HEAD;
__device__ __forceinline__ void ret_out_unit(KP p, int wv, int l, int u, bf16* lds) {
    const int hp = u & 1, pos = (u >> 1) % NPOS, b = u / (2 * NPOS);
    if (l == DEPTH - 1 && pos < 2) return;
    const int t = tid_opaque(wv), lane = t & 63, w = t >> 6, r = lane & 15, g = lane >> 4;
    const int r0 = chunk_row0(b, pos);
    const bf16* P = p->P;
    float* tabs = (float*)(lds + RO_TAB);
    bf16x8_t qf[2][2];
    {
        const int hq_ = hp * 2 + (w >> 2), qw_ = w & 3;
#pragma unroll
        for (int qt = 0; qt < 2; ++qt) {
#pragma unroll
            for (int ks = 0; ks < 2; ++ks) qf[qt][ks] = *(const bf16x8_t*)(P + (size_t)(r0 + qw_ * 32 + qt * 16 + r) * DIN + C_RQ + hq_ * 64 + ks * 32 + g * 8);
        }
    }
    __syncthreads();
#pragma unroll
    for (int q = 0; q < 4; ++q) {
        const int pc = t + q * NT, hh = pc >> 10, j = (pc >> 3) & 127, c8 = pc & 7, h = hp * 2 + hh;
        bf16* base = lds + hh * RO_HEAD;
        const bf16* src = P + (size_t)(r0 + j) * DIN + h * 64 + c8 * 8;
        *(uint4*)(base + j * KROW + c8 * 8) = *(const uint4*)(src + C_RK);
        const uint4 vv = *(const uint4*)(src + C_RV);
        st_tr8(base + 128 * KROW + (c8 * 8) * TROW + (j ^ (c8 << 3)), TROW, vv);
    }
#pragma unroll
    for (int q = 0; q < 4; ++q) {
        const int pc = t + q * NT, hh = pc >> 10, dir = (pc >> 9) & 1, dv = (pc >> 3) & 63, c8 = pc & 7, h = hp * 2 + hh;
        const uint4 sv = *(const uint4*)(p->ST16 + kv_off(dir, b, pos, h) + dv * 64 + c8 * 8);
        *(uint4*)(lds + hh * RO_HEAD + 128 * KROW + 64 * TROW + dir * 64 * KROW + dv * KROW + c8 * 8) = sv;
    }
    if (t < 4 * 132) {
        const int hh = t / 264, dir = (t / 132) & 1, k = t % 132, h = hp * 2 + hh;
        const float lg = log_sigmoid_f(dir ? p->rdb[l * 4 + h] : p->rdf[l * 4 + h]);
        tabs[(hh * 2 + dir) * 132 + k] = expf(lg * (float)k);
    }
    __syncthreads();
    const int hh = w >> 2, h = hp * 2 + hh, qw = w & 3;
    const bf16* Ks = lds + hh * RO_HEAD; const bf16* Vt = Ks + 128 * KROW; const bf16* Sft = Vt + 64 * TROW; const bf16* Sbt = Sft + 64 * KROW;
    const float* pf = tabs + (hh * 2) * 132; const float* pb = pf + 132;
    f32x4_t accI[4][2], accF[4][2], accB[4][2];
#pragma unroll
    for (int dt = 0; dt < 4; ++dt)
#pragma unroll
        for (int qt = 0; qt < 2; ++qt) { accI[dt][qt] = (f32x4_t){0.f, 0.f, 0.f, 0.f}; accF[dt][qt] = accI[dt][qt]; accB[dt][qt] = accI[dt][qt]; }
#pragma unroll
    for (int dt = 0; dt < 4; ++dt)
#pragma unroll
        for (int ks = 0; ks < 2; ++ks) {
            const bf16x8_t af = lds_frag16(Sft + (dt * 16 + r) * KROW + ks * 32 + g * 8), ab = lds_frag16(Sbt + (dt * 16 + r) * KROW + ks * 32 + g * 8);
#pragma unroll
            for (int qt = 0; qt < 2; ++qt) { accF[dt][qt] = MFMA16(af, qf[qt][ks], accF[dt][qt]); accB[dt][qt] = MFMA16(ab, qf[qt][ks], accB[dt][qt]); }
        }
#pragma unroll 1
    for (int sub = 0; sub < 2; ++sub) {
        f32x4_t st[4][2];
#pragma unroll
        for (int kt = 0; kt < 4; ++kt) {
#pragma unroll
            for (int qt = 0; qt < 2; ++qt) st[kt][qt] = (f32x4_t){0.f, 0.f, 0.f, 0.f};
#pragma unroll
            for (int ks = 0; ks < 2; ++ks) {
                const bf16x8_t a = lds_frag16(Ks + (sub * 64 + kt * 16 + r) * KROW + ks * 32 + g * 8);
#pragma unroll
                for (int qt = 0; qt < 2; ++qt) st[kt][qt] = MFMA16(a, qf[qt][ks], st[kt][qt]);
            }
        }
#pragma unroll
        for (int qt = 0; qt < 2; ++qt) {
            const int il = qw * 32 + qt * 16 + r;
#pragma unroll
            for (int kt = 0; kt < 4; ++kt)
#pragma unroll
                for (int i = 0; i < 4; ++i) {
                    const int rel = il - (sub * 64 + kt * 16 + g * 4 + i);
                    const float wgt = rel > 0 ? pf[rel] : (rel < 0 ? pb[-rel] : 2.0f);
                    st[kt][qt][i] *= wgt;
                }
        }
#pragma unroll
        for (int kp = 0; kp < 2; ++kp) {
            bf16x8_t pfr[2];
#pragma unroll
            for (int qt = 0; qt < 2; ++qt) pfr[qt] = pack_p(st[2 * kp][qt], st[2 * kp + 1][qt]);
#pragma unroll
            for (int dt = 0; dt < 4; ++dt) {
                const bf16* vrow = Vt + (dt * 16 + r) * TROW; const int vsw = tsw(dt * 16 + r), vk = sub * 64 + g * 4 + (2 * kp) * 16;
                const bf16x8_t a = lds_frag8x2(vrow + (vk ^ vsw), vrow + ((vk + 16) ^ vsw));
#pragma unroll
                for (int qt = 0; qt < 2; ++qt) accI[dt][qt] = MFMA16(a, pfr[qt], accI[dt][qt]);
            }
        }
    }
#pragma unroll
    for (int qt = 0; qt < 2; ++qt) {
        const int il = qw * 32 + qt * 16 + r;
        const float qfd = pf[il + 1], qbd = pb[128 - il];
        float s = 0.f;
#pragma unroll
        for (int dt = 0; dt < 4; ++dt) { accI[dt][qt] = accI[dt][qt] + accF[dt][qt] * qfd + accB[dt][qt] * qbd; s += (accI[dt][qt][0] + accI[dt][qt][1]) + (accI[dt][qt][2] + accI[dt][qt][3]); }
        s += shx(s, 16, lane); s += shx(s, 32, lane);
        const float mu = s * (1.0f / 64.0f);
        float qq = 0.f;
#pragma unroll
        for (int dt = 0; dt < 4; ++dt) { accI[dt][qt] = accI[dt][qt] - mu; qq += (accI[dt][qt][0] * accI[dt][qt][0] + accI[dt][qt][1] * accI[dt][qt][1]) + (accI[dt][qt][2] * accI[dt][qt][2] + accI[dt][qt][3] * accI[dt][qt][3]); }
        qq += shx(qq, 16, lane); qq += shx(qq, 32, lane);
        const float rstd = rsqrtf(qq * (1.0f / 64.0f) + LN_EPS);
        const size_t row = (size_t)(r0 + il);
#pragma unroll
        for (int dt = 0; dt < 4; ++dt) {
            const uint2 gw = *(const uint2*)(P + row * DIN + C_RG + h * 64 + dt * 16 + g * 4);
            const f32x4_t o = accI[dt][qt] * rstd;
            const float o0 = o[0] * silu_f(bflo(gw.x)), o1 = o[1] * silu_f(bfhi(gw.x)), o2 = o[2] * silu_f(bflo(gw.y)), o3 = o[3] * silu_f(bfhi(gw.y));
            *(uint2*)(p->MIX + row * D + h * 64 + dt * 16 + g * 4) = make_uint2(pk2(o0, o1), pk2(o2, o3));
        }
    }
}

__device__ __forceinline__ void sgu_unit(KP p, int wv, int l, int u, bf16* lds) {
    const int grp = u & 3, pos = (u >> 2) % NPOS, b = u / (4 * NPOS);
    if (l == DEPTH - 1 && pos < 2) return;
    const int t = tid_opaque(wv), lane = t & 63, w = t >> 6, r = lane & 15, g = lane >> 4;
    const int r0 = chunk_row0(b, pos);
    const bf16* P = p->P;
    bf16* vnT = lds;
    uint4 ar_, cr_;
    { const uint4* src = (const uint4*)(P + (size_t)(r0 + (t >> 2)) * DIN + C_SV + grp * 64 + (t & 3) * 16); ar_ = src[0]; cr_ = src[1]; }
    uint2 uwr[4];
#pragma unroll
    for (int dt = 0; dt < 4; ++dt) uwr[dt] = *(const uint2*)(P + (size_t)(r0 + w * 16 + r) * DIN + C_SU + grp * 64 + dt * 16 + g * 4);
    __syncthreads();
    {
        const int j = t >> 2, qd = t & 3;
        const uint4 a = ar_, c = cr_;
        float v[16] = {bflo(a.x), bfhi(a.x), bflo(a.y), bfhi(a.y), bflo(a.z), bfhi(a.z), bflo(a.w), bfhi(a.w), bflo(c.x), bfhi(c.x), bflo(c.y), bfhi(c.y), bflo(c.z), bfhi(c.z), bflo(c.w), bfhi(c.w)};
        float s = 0.f;
#pragma unroll
        for (int d = 0; d < 16; ++d) { v[d] = gelu_tanh(v[d]); s += v[d]; }
        s += shx(s, 1, lane); s += shx(s, 2, lane);
        const float mu = s * (1.0f / 64.0f);
        float qq = 0.f;
#pragma unroll
        for (int d = 0; d < 16; ++d) { v[d] -= mu; qq += v[d] * v[d]; }
        qq += shx(qq, 1, lane); qq += shx(qq, 2, lane);
        const float rstd = rsqrtf(qq * (1.0f / 64.0f) + LN_EPS);
#pragma unroll
        for (int d = 0; d < 16; ++d) vnT[(qd * 16 + d) * TROW + (j ^ tsw(qd * 16 + d))] = (bf16)f2bf(v[d] * rstd);
    }
    bf16x8_t wf[4];
    {
        const float* wrow = p->sgu_w + (((size_t)l * 4 + grp) * 128 + w * 16 + r) * 128 + g * 8;
#pragma unroll
        for (int ks = 0; ks < 4; ++ks) {
            const float4 a = *(const float4*)(wrow + ks * 32), c = *(const float4*)(wrow + ks * 32 + 4);
            uint4 o; o.x = pk2(a.x, a.y); o.y = pk2(a.z, a.w); o.z = pk2(c.x, c.y); o.w = pk2(c.z, c.w);
            wf[ks] = __builtin_bit_cast(bf16x8_t, o);
        }
    }
    __syncthreads();
    const int i = w * 16 + r;
    const float bs = p->sgu_b[((size_t)l * 4 + grp) * 128 + i];
#pragma unroll
    for (int dt = 0; dt < 4; ++dt) {
        f32x4_t acc = {0.f, 0.f, 0.f, 0.f};
#pragma unroll
        for (int ks = 0; ks < 4; ++ks) acc = MFMA16(lds_frag16(vnT + (dt * 16 + r) * TROW + ((ks * 32 + g * 8) ^ tsw(dt * 16 + r))), wf[ks], acc);
        const uint2 uw = uwr[dt];
        const float o0 = gelu_tanh(bflo(uw.x)) * (acc[0] + bs), o1 = gelu_tanh(bfhi(uw.x)) * (acc[1] + bs), o2 = gelu_tanh(bflo(uw.y)) * (acc[2] + bs), o3 = gelu_tanh(bfhi(uw.y)) * (acc[3] + bs);
        *(uint2*)(p->MIX + (size_t)(r0 + i) * D + 256 + grp * 64 + dt * 16 + g * 4) = make_uint2(pk2(o0, o1), pk2(o2, o3));
    }
}

__device__ __forceinline__ int sgu_in_mix(int n_kv, int n_sgu, int snb) { const int slots = ((n_kv + snb - 1) / snb) * snb - n_kv; return slots < n_sgu ? slots : n_sgu; }
__device__ __forceinline__ void phase_mix_a(KP p, int wv, int l, int bid, int nb, float* ldsf) {
    bf16* lds = (bf16*)ldsf;
    const int n_kv = NB * NPOS * 4, n_sgu = NB * NPOS * 4;
    for (int u = bid; u < 256; u += nb) att_unit(p, wv, l, u, lds);
    const int nctx = (l == DEPTH - 1) ? 0 : 8;
    const bool split = nb > 64 && nctx > 0;
    if (split ? bid < nctx : true) for (int u = 256 + bid; u < 256 + nctx; u += nb) att_unit(p, wv, l, u, lds);
    const int sb = split ? bid - nctx : bid, snb = split ? nb - nctx : nb;
    const int n_small = n_kv + sgu_in_mix(n_kv, n_sgu, snb);
    if (sb >= 0)
        for (int u = sb; u < n_small; u += snb) {
            if (u < n_kv) ret_kv_unit(p, wv, l, u, lds);
            else sgu_unit(p, wv, l, u - n_kv, lds);
        }
    __syncthreads();
}
__device__ __forceinline__ void phase_ret_out(KP p, int wv, int l, int bid, int nb, float* ldsf) {
    bf16* lds = (bf16*)ldsf;
    const int n_ro = NB * NPOS * 2, n_kv = NB * NPOS * 4, n_sgu = NB * NPOS * 4;
    for (int u = bid; u < n_ro; u += nb) ret_out_unit(p, wv, l, u, lds);
    const int nctx = (l == DEPTH - 1) ? 0 : 8;
    const int snb = (nb > 64 && nctx > 0) ? nb - nctx : nb;
    const int first = (n_ro > nb && n_ro < 2 * nb) ? n_ro - nb : 0;
    if (bid >= first) for (int u = sgu_in_mix(n_kv, n_sgu, snb) + bid - first; u < n_sgu; u += nb - first) sgu_unit(p, wv, l, u, lds);
    __syncthreads();
}

__device__ __forceinline__ void raw_to_f(const uint2 (&q)[4], float (&v)[16]) {
#pragma unroll
    for (int i = 0; i < 4; ++i) { v[i * 4 + 0] = bflo(q[i].x); v[i * 4 + 1] = bfhi(q[i].x); v[i * 4 + 2] = bflo(q[i].y); v[i * 4 + 3] = bfhi(q[i].y); }
}
__device__ __forceinline__ void raw_load_bf(const bf16* src, uint2 (&q)[4], int lane) {
#pragma unroll
    for (int i = 0; i < 4; ++i) q[i] = *(const uint2*)(src + i * 256 + lane * 4);
}
__device__ __forceinline__ void phase_ln1(KP p, int wv, int l, int bid, int nb, int rbeg, int rend) {
    const int lane = tid_opaque(wv) & 63, w = tid_opaque(wv) >> 6;
    const int rfirst = rbeg + bid * NW + w, rstep = nb * NW;
    if (rfirst >= rend) return;
    float g[16], b[16], c[16], sh[16], sc[16];
    row_load(p->lnm_g + l * D, g, lane); row_load(p->lnm_b + l * D, b, lane);
    int cur_mi = -1;
    uint2 xr[4], yr[4]; float xf[16];
    if (l == 0) row_load(x_row(p, 0, rfirst), xf, lane); else raw_load_bf(p->X + (size_t)rfirst * D, xr, lane);
    raw_load_bf(p->Y + (size_t)rfirst * D, yr, lane);
#pragma unroll 1
    for (int r = rfirst; r < rend; r += rstep) {
        float v[16], a[16];
        if (l == 0) {
#pragma unroll
            for (int i = 0; i < 16; ++i) v[i] = xf[i];
        } else raw_to_f(xr, v);
        raw_to_f(yr, a);
        { const int rn = r + rstep < rend ? r + rstep : r;
          if (l == 0) row_load(x_row(p, 0, rn), xf, lane); else raw_load_bf(p->X + (size_t)rn * D, xr, lane);
          raw_load_bf(p->Y + (size_t)rn * D, yr, lane); }
        const int mi = mod_idx(r);
        if (mi != cur_mi) {
            cur_mi = mi;
            const float* m = p->mod + ((size_t)l * 3 + mi) * 6144;
            row_load(m + 2048, c, lane); row_load(m + 3072, sh, lane); row_load(m + 4096, sc, lane);
        }
#pragma unroll
        for (int i = 0; i < 16; ++i) v[i] = ALPHA * v[i] + c[i] * a[i];
        row_ln(v, lane);
#pragma unroll
        for (int i = 0; i < 16; ++i) v[i] = v[i] * g[i] + b[i];
        row_store_bf(p->X1 + (size_t)r * D, v, lane);
        row_ln(v, lane);
#pragma unroll
        for (int i = 0; i < 16; ++i) v[i] = v[i] * (1.0f + sc[i]) + sh[i];
        row_store_bf(p->H + (size_t)r * D, v, lane);
        float mx = 0.f;
#pragma unroll
        for (int i = 0; i < 16; ++i) mx = fmaxf(mx, fabsf(v[i]));
        mx = wave_max(mx);
        const float xinv = mx > 0.f ? 127.0f / mx : 0.f;
        unsigned* xq = (unsigned*)(p->XQ + (size_t)r * D);
        int isum = 0;
#pragma unroll
        for (int i = 0; i < 4; ++i) {
            const int q0 = (int)rintf(v[i * 4 + 0] * xinv), q1 = (int)rintf(v[i * 4 + 1] * xinv), q2 = (int)rintf(v[i * 4 + 2] * xinv), q3 = (int)rintf(v[i * 4 + 3] * xinv);
            xq[i * 64 + lane] = (unsigned)(q0 & 0xff) | ((unsigned)(q1 & 0xff) << 8) | ((unsigned)(q2 & 0xff) << 16) | ((unsigned)(q3 & 0xff) << 24);
            isum += (q0 + q1) + (q2 + q3);
        }
        const float rsum = wave_sum((float)isum, lane);
        if (lane == 0) p->SX[r] = make_float2(mx * (1.0f / 127.0f), 8.0f * rsum * (mx * (1.0f / 127.0f)));
    }
}

template <int N> __device__ __forceinline__ void bitonic_sort_desc(float (&x)[N]) {
#pragma unroll
    for (int sz = 2; sz <= N; sz <<= 1)
#pragma unroll
        for (int t = sz >> 1; t > 0; t >>= 1)
#pragma unroll
            for (int i = 0; i < N; ++i)
                if ((i & t) == 0) {
                    const int j = i | t; const bool desc = (i & sz) == 0;
                    const float mx_ = rmax(x[i], x[j]), mn_ = rmin(x[i], x[j]);
                    x[i] = desc ? mx_ : mn_; x[j] = desc ? mn_ : mx_;
                }
}
__device__ __forceinline__ void sort16_desc(float (&x)[16]) {
#define SN_CE(i, j) { const float mx_ = rmax(x[i], x[j]), mn_ = rmin(x[i], x[j]); x[i] = mx_; x[j] = mn_; }
    SN_CE(0, 1) SN_CE(2, 3) SN_CE(0, 2) SN_CE(1, 3) SN_CE(1, 2) SN_CE(4, 5) SN_CE(6, 7) SN_CE(4, 6) SN_CE(5, 7) SN_CE(5, 6) SN_CE(0, 4) SN_CE(2, 6) SN_CE(2, 4) SN_CE(1, 5) SN_CE(3, 7) SN_CE(3, 5) SN_CE(1, 2) SN_CE(3, 4) SN_CE(5, 6) SN_CE(8, 9) SN_CE(10, 11) SN_CE(8, 10) SN_CE(9, 11) SN_CE(9, 10) SN_CE(12, 13) SN_CE(14, 15) SN_CE(12, 14) SN_CE(13, 15) SN_CE(13, 14) SN_CE(8, 12) SN_CE(10, 14) SN_CE(10, 12) SN_CE(9, 13) SN_CE(11, 15) SN_CE(11, 13) SN_CE(9, 10) SN_CE(11, 12) SN_CE(13, 14) SN_CE(0, 8) SN_CE(4, 12) SN_CE(4, 8) SN_CE(2, 10) SN_CE(6, 14) SN_CE(6, 10) SN_CE(2, 4) SN_CE(6, 8) SN_CE(10, 12) SN_CE(1, 9) SN_CE(5, 13) SN_CE(5, 9) SN_CE(3, 11) SN_CE(7, 15) SN_CE(7, 11) SN_CE(3, 5) SN_CE(7, 9) SN_CE(11, 13) SN_CE(1, 2) SN_CE(3, 4) SN_CE(5, 6) SN_CE(7, 8) SN_CE(9, 10) SN_CE(11, 12) SN_CE(13, 14)
#undef SN_CE
}
__device__ __forceinline__ void bitonic_merge16_desc(float (&x)[16]) {
#pragma unroll
    for (int t = 8; t > 0; t >>= 1)
#pragma unroll
        for (int i = 0; i < 16; ++i)
            if ((i & t) == 0) { const int j = i | t; const float mx_ = rmax(x[i], x[j]), mn_ = rmin(x[i], x[j]); x[i] = mx_; x[j] = mn_; }
}
__device__ __forceinline__ void xmerge16_desc(float (&c)[16], int lane) {
#pragma unroll
    for (int o = 16; o <= 32; o <<= 1) {
        float pr[16];
#pragma unroll
        for (int i = 0; i < 16; ++i) pr[i] = shx(c[i], o, lane);
#pragma unroll
        for (int i = 0; i < 16; ++i) c[i] = rmax(c[i], pr[15 - i]);
        bitonic_merge16_desc(c);
    }
}
__device__ __forceinline__ void top16_keys(const float (&sc)[32], int fq, int lane, float (&c)[16]) {
    float a[16], b[16];
#pragma unroll
    for (int e = 0; e < 16; ++e) {
        a[e] = __builtin_bit_cast(float, (__builtin_bit_cast(unsigned, sc[e]) & ~127u) | (unsigned)((e >> 2) * 16 + (e & 3)) | ((unsigned)fq << 2));
        b[e] = __builtin_bit_cast(float, (__builtin_bit_cast(unsigned, sc[16 + e]) & ~127u) | (unsigned)(((16 + e) >> 2) * 16 + (e & 3)) | ((unsigned)fq << 2));
    }
    sort16_desc(a); sort16_desc(b);
#pragma unroll
    for (int i = 0; i < 16; ++i) c[i] = rmax(a[i], b[15 - i]);
    bitonic_merge16_desc(c);
    xmerge16_desc(c, lane);
}
constexpr int KS_STRIDE = 136;
__device__ __forceinline__ void phase_topk(KP p, int wv, int l, int bid, int nb, int ntask, int item_base, int item_stride, float* lds) {
    bf16* k1s = (bf16*)lds;
    bf16* k2s = k1s + 128 * KS_STRIDE;
    const int t = tid_opaque(wv), lane = t & 63, w = t >> 6;
    float* lists = lds + (2 * 128 * KS_STRIDE * 2) / 4 + w * 1536;
    float* v1 = lists; int* i1 = (int*)(lists + 256); float* v2 = lists + 512; int* i2 = (int*)(lists + 768); float* v3 = lists + 1024; int* c3 = (int*)(lists + 1280);
    unsigned char* ctab = (unsigned char*)(lds + (2 * 128 * KS_STRIDE * 2) / 4 + NW * 1536);
    __syncthreads();
    if (t < 64) {
        const int gq = t >> 4, k = t & 15; int ab = 0xff;
        if (gq == 0) { if (k < 13) ab = k; }
        else if (gq == 1) { if (k < 3) ab = 13 + k; else if (k < 11) ab = 0x10 | (k - 3); else if (k < 13) ab = 0x20 | (k - 11); }
        else if (gq == 2) { if (k < 3) ab = 0x20 | (k + 2); else if (k < 7) ab = 0x30 | (k - 3); else if (k < 10) ab = 0x40 | (k - 7); else if (k < 12) ab = 0x50 | (k - 10); else if (k < 13) ab = 0x60; }
        else { if (k == 0) ab = 0x61; else if (k < 3) ab = 0x70 | (k - 1); else if (k < 11) ab = (k + 5) << 4; }
        ctab[t] = (unsigned char)ab;
    }
    for (int e = t; e < 2 * 128 * 16; e += NT) {
        const int tab = e >> 11, r = (e >> 4) & 127, c8 = e & 15;
        const float* src = (tab ? p->k2 : p->k1) + (size_t)l * 128 * 128 + r * 128 + c8 * 8;
        const float4 a = *(const float4*)src, b = *(const float4*)(src + 4);
        uint4 o; o.x = pk2(a.x, a.y); o.y = pk2(a.z, a.w); o.z = pk2(b.x, b.y); o.w = pk2(b.z, b.w);
        *(uint4*)((tab ? k2s : k1s) + r * KS_STRIDE + c8 * 8) = o;
    }
    __syncthreads();
    const int fr = lane & 15, fq = lane >> 4;
    for (int task = bid * NW + w; task < ntask; task += nb * NW) {
        const size_t item = (size_t)item_base + (size_t)(task * 16 + fr) * item_stride;
        const bf16* qrow = p->Qb + item * 256 + fq * 8;
        bf16x8_t bq[8];
#pragma unroll
        for (int ks = 0; ks < 8; ++ks) bq[ks] = *(const bf16x8_t*)(qrow + ks * 32);
        float s[32];
#pragma unroll
        for (int kt = 0; kt < 8; ++kt) {
            f32x4_t acc = {0.f, 0.f, 0.f, 0.f};
#pragma unroll
            for (int ks = 0; ks < 4; ++ks) {
                const bf16x8_t a = *(const bf16x8_t*)(k1s + (kt * 16 + fr) * KS_STRIDE + ks * 32 + fq * 8);
                acc = __builtin_amdgcn_mfma_f32_16x16x32_bf16(a, bq[ks], acc, 0, 0, 0);
            }
            s[kt * 4 + 0] = acc[0]; s[kt * 4 + 1] = acc[1]; s[kt * 4 + 2] = acc[2]; s[kt * 4 + 3] = acc[3];
        }
        { float ck[16]; top16_keys(s, fq, lane, ck);
          if (fq == 0) {
#pragma unroll
              for (int i = 0; i < 16; ++i) v1[fr * 16 + i] = ck[i]; } }
#pragma unroll
        for (int kt = 0; kt < 8; ++kt) {
            f32x4_t acc = {0.f, 0.f, 0.f, 0.f};
#pragma unroll
            for (int ks = 0; ks < 4; ++ks) {
                const bf16x8_t a = *(const bf16x8_t*)(k2s + (kt * 16 + fr) * KS_STRIDE + ks * 32 + fq * 8);
                acc = __builtin_amdgcn_mfma_f32_16x16x32_bf16(a, bq[4 + ks], acc, 0, 0, 0);
            }
            s[kt * 4 + 0] = acc[0]; s[kt * 4 + 1] = acc[1]; s[kt * 4 + 2] = acc[2]; s[kt * 4 + 3] = acc[3];
        }
        { float ck[16]; top16_keys(s, fq, lane, ck);
          if (fq == 0) {
#pragma unroll
              for (int i = 0; i < 16; ++i) v2[fr * 16 + i] = ck[i]; } }
        __builtin_amdgcn_wave_barrier();
        const uint4 tw = *(const uint4*)(ctab + fq * 16);
        const unsigned twd[4] = {tw.x, tw.y, tw.z, tw.w};
        float ck3[16];
        const float padv = __builtin_bit_cast(float, __builtin_bit_cast(unsigned, v1[fr * 16 + 15]) & ~127u) + __builtin_bit_cast(float, __builtin_bit_cast(unsigned, v2[fr * 16 + 15]) & ~127u) - 1.0f;
#pragma unroll
        for (int k = 0; k < 16; ++k) {
            const unsigned ab = k < 13 ? (twd[k >> 2] >> (8 * (k & 3))) & 0xffu : 0xffu;
            const float ka = __builtin_bit_cast(float, __builtin_bit_cast(unsigned, v1[fr * 16 + ((ab >> 4) & 15u)]) & ~127u);
            const float kb = __builtin_bit_cast(float, __builtin_bit_cast(unsigned, v2[fr * 16 + (ab & 15u)]) & ~127u);
            const float cvv = ab == 0xffu ? padv : ka + kb;
            ck3[k] = __builtin_bit_cast(float, (__builtin_bit_cast(unsigned, cvv) & ~255u) | ab);
        }
        sort16_desc(ck3);
        xmerge16_desc(ck3, lane);
        float tv[4]; int tc[4];
#pragma unroll
        for (int k = 0; k < 4; ++k) {
            const float kk = fq == 0 ? ck3[k] : (fq == 1 ? ck3[4 + k] : (fq == 2 ? ck3[8 + k] : ck3[12 + k]));
            tv[k] = __builtin_bit_cast(float, __builtin_bit_cast(unsigned, kk) & ~255u); tc[k] = (int)(__builtin_bit_cast(unsigned, kk) & 255u);
        }
        float mx = fmaxf(fmaxf(tv[0], tv[1]), fmaxf(tv[2], tv[3]));
        mx = fmaxf(mx, shx(mx, 16, lane)); mx = fmaxf(mx, shx(mx, 32, lane));
        float ex[4], den = 0.f;
#pragma unroll
        for (int k = 0; k < 4; ++k) { ex[k] = expf(tv[k] - mx); den += ex[k]; }
        den += shx(den, 16, lane); den += shx(den, 32, lane);
        const float inv = 1.0f / den;
        int4 eo; float4 go;
#define TK_EID(c) ((int)(__builtin_bit_cast(unsigned, v1[fr * 16 + ((c) >> 4)]) & 127u) * 128 + (int)(__builtin_bit_cast(unsigned, v2[fr * 16 + ((c) & 15)]) & 127u))
        eo.x = TK_EID(tc[0]); eo.y = TK_EID(tc[1]); eo.z = TK_EID(tc[2]); eo.w = TK_EID(tc[3]);
#undef TK_EID
        go = make_float4(ex[0] * inv, ex[1] * inv, ex[2] * inv, ex[3] * inv);
        *(int4*)(p->EIDX + item * 16 + fq * 4) = eo;
        *(float4*)(p->GATE + item * 16 + fq * 4) = go;
        __builtin_amdgcn_wave_barrier();
    }
    __syncthreads();
}

typedef unsigned u32x4_t __attribute__((ext_vector_type(4)));
using bf16x2_t = __attribute__((ext_vector_type(2))) __bf16;
__device__ __forceinline__ float dot2bf(unsigned a, unsigned b, float acc) { return __builtin_amdgcn_fdot2_f32_bf16(__builtin_bit_cast(bf16x2_t, a), __builtin_bit_cast(bf16x2_t, b), acc, false); }
struct RowBf { u32x4_t a, b; };
__device__ __forceinline__ RowBf ld_row(const bf16* tab, int e, int lane) {
    const u32x4_t* r = (const u32x4_t*)(tab + (size_t)e * D) + lane;
    RowBf x; x.a = r[0]; x.b = r[64]; return x;
}
__device__ __forceinline__ float row_dot(const RowBf& x, const RowBf& u) {
    float d = 0.f;
#pragma unroll
    for (int k = 0; k < 4; ++k) { d = dot2bf(x.a[k], u.a[k], d); d = dot2bf(x.b[k], u.b[k], d); }
    return d;
}
__device__ __forceinline__ void row_axpy(float (&acc)[16], float a, const RowBf& v) {
#pragma unroll
    for (int k = 0; k < 4; ++k) {
        acc[2 * k] += a * bflo(v.a[k]); acc[2 * k + 1] += a * bfhi(v.a[k]);
        acc[8 + 2 * k] += a * bflo(v.b[k]); acc[8 + 2 * k + 1] += a * bfhi(v.b[k]);
    }
}
__device__ __forceinline__ float transpose_reduce16(float (&part)[16], int lane) {
#pragma unroll
    for (int st = 32, n = 8; n >= 1; st >>= 1, n >>= 1) {
        const bool up = (lane & st) != 0;
#pragma unroll
        for (int s = 0; s < n; ++s) {
            const float lo = part[s], hi = part[s + n];
            const float recv = shx(up ? lo : hi, st, lane);
            part[s] = (up ? hi : lo) + recv;
        }
    }
    float v = part[0];
    v += shx(v, 2, lane); v += shx(v, 1, lane);
    return v;
}
typedef float f32x2_t __attribute__((ext_vector_type(2)));
__device__ __forceinline__ float transpose_reduce8(float (&part)[8], int lane) {
#pragma unroll
    for (int st = 32, n = 4; n >= 1; st >>= 1, n >>= 1) {
        const bool up = (lane & st) != 0;
#pragma unroll
        for (int s = 0; s < n; ++s) {
            const float lo = part[s], hi = part[s + n];
            const float recv = shx(up ? lo : hi, st, lane);
            part[s] = (up ? hi : lo) + recv;
        }
    }
    float v = part[0];
    v += shx(v, 4, lane); v += shx(v, 2, lane); v += shx(v, 1, lane);
    return v;
}
typedef int v4i_t __attribute__((ext_vector_type(4)));
typedef unsigned u32x4v __attribute__((ext_vector_type(4)));
constexpr int EXU_CAP = 880, EXU_TROW = 528, EXU_WAVE = 8 * EXU_CAP + 16 * EXU_TROW;
__device__ __forceinline__ void phase_expert_u(KP p, int wv, int l, int bid, int nb, float* lds) {
    const int lane = tid_opaque(wv) & 63, w = __builtin_amdgcn_readfirstlane(tid_opaque(wv) >> 6);
    const int G8 = nb >> 3;
    if (bid >= G8 * 8) return;
    const int rng = bid & 3, r = lane & 15, g = lane >> 4;
    const unsigned char* U = p->U8 + (size_t)l * PEER_N * 512;
    const float* SU = p->SU + (size_t)l * PEER_N; const float* SV = p->SV + (size_t)l * PEER_N;
    unsigned char* wl = (unsigned char*)lds + w * EXU_WAVE;
    unsigned* lpk = (unsigned*)wl; float* lgt = (float*)(wl + 4 * EXU_CAP); unsigned char* tile = wl + 8 * EXU_CAP;
    const unsigned long long ltmask = (1ull << lane) - 1ull;
    const int tstride = 2 * G8 * NW, Tn = (l == DEPTH - 1) ? TL : T, t0 = ((bid >> 3) * 2 + ((bid >> 2) & 1)) * NW + w;
    if (t0 >= Tn) return;
    const int nitem = (Tn - t0 + tstride - 1) / tstride;
    const int ngrp_ = (nitem + 15) >> 4, EXU_GRP = (nitem + ngrp_ - 1) / ngrp_;
    int i0 = 0;
    v4i_t afr[16]; float2 sxv; int e0[16], e1[16];
#define EXU_FETCH(ib) do { const int nt_ = nitem - (ib) < EXU_GRP ? nitem - (ib) : EXU_GRP; \
        const unsigned char* xa_ = p->XQ + (size_t)(t0 + ((ib) + (r < nt_ ? r : nt_ - 1)) * tstride) * D + g * 16; \
        _Pragma("unroll") for (int ks = 0; ks < 16; ++ks) afr[ks] = *(const v4i_t*)(xa_ + ks * 64); \
        sxv = p->SX[t0 + ((ib) + (lane < nt_ ? lane : nt_ - 1)) * tstride];        \
        _Pragma("unroll") for (int j = 0; j < 16; ++j) if (j < nt_) { const size_t tb_ = (size_t)(t0 + ((ib) + j) * tstride) * NSEL; \
            e0[j] = p->EIDX[tb_ + lane]; e1[j] = p->EIDX[tb_ + 64 + lane]; } } while (0)
    EXU_FETCH(0);
    while (i0 < nitem) {
        const int nt = nitem - i0 < EXU_GRP ? nitem - i0 : EXU_GRP;
        int cnt = 0, ndone = 0; bool open = true;
#pragma unroll
        for (int j = 0; j < 16; ++j) {
            const bool in0 = (e0[j] >> 12) == rng, in1 = (e1[j] >> 12) == rng;
            const unsigned long long m0 = __ballot(in0), m1 = __ballot(in1);
            const int c0 = __popcll(m0), c = c0 + __popcll(m1);
            open = open && j < nt && cnt + c <= EXU_CAP;
            if (open) {
                if (in0) { const int pos = cnt + __popcll(m0 & ltmask); lpk[pos] = (unsigned)e0[j] | ((unsigned)j << 14) | ((unsigned)lane << 18); }
                if (in1) { const int pos = cnt + c0 + __popcll(m1 & ltmask); lpk[pos] = (unsigned)e1[j] | ((unsigned)j << 14) | ((unsigned)(lane + 64) << 18); }
                cnt += c; ndone = j + 1;
            }
        }
        __builtin_amdgcn_wave_barrier();
        const int ntile = (cnt + 15) >> 4;
        u32x4v rwA[8], rwB[8]; unsigned pkA = 0u, pkB = 0u; float suA = 0.f, suB = 0.f;
        const int lhalf = lane >> 5, loff = (lane & 31) * 16;
#define EXU_ISSUE(q, RW, PKV, SUV) do { const int idx_ = 16 * (q) + r < cnt ? 16 * (q) + r : cnt - 1; \
            PKV = lpk[idx_]; const unsigned e_ = PKV & 0x3fffu; \
            _Pragma("unroll") for (int k = 0; k < 8; ++k) { \
                const int ea_ = __builtin_amdgcn_readlane((int)PKV, 2 * k) & 0x3fff, eb_ = __builtin_amdgcn_readlane((int)PKV, 2 * k + 1) & 0x3fff; \
                RW[k] = *(const u32x4v*)(U + ((size_t)(lhalf ? eb_ : ea_) << 9) + loff); } \
            SUV = SU[e_]; } while (0)
#define EXU_TILE(q, RW, PKV, SUV) do { \
            _Pragma("unroll") for (int k = 0; k < 8; ++k) *(u32x4v*)(tile + (2 * k + lhalf) * EXU_TROW + loff) = RW[k]; \
            const unsigned pk = PKV; const float su = SUV; \
            __builtin_amdgcn_wave_barrier(); \
            if ((q) + 2 < ntile) EXU_ISSUE((q) + 2, RW, PKV, SUV); \
            v4i_t acc = {0, 0, 0, 0}; \
            _Pragma("unroll") for (int ks = 0; ks < 8; ++ks) { \
                const u32x4v bp = *(const u32x4v*)(tile + r * EXU_TROW + ks * 64 + g * 16); \
                const u32x4v blo = bp & 0x0f0f0f0fu, bhi = (bp >> 4) & 0x0f0f0f0fu; \
                acc = __builtin_amdgcn_mfma_i32_16x16x64_i8(afr[ks], __builtin_bit_cast(v4i_t, blo), acc, 0, 0, 0); \
                acc = __builtin_amdgcn_mfma_i32_16x16x64_i8(afr[8 + ks], __builtin_bit_cast(v4i_t, bhi), acc, 0, 0, 0); } \
            const int j = (int)((pk >> 14) & 15u); \
            const int d = (j & 2) ? ((j & 1) ? acc[3] : acc[2]) : ((j & 1) ? acc[1] : acc[0]); \
            const float sx = shf(sxv.x, j), sb = shf(sxv.y, j); \
            if (g == (j >> 2) && 16 * (q) + r < cnt) lgt[16 * (q) + r] = ((float)d * sx - sb) * su;        \
            __builtin_amdgcn_wave_barrier(); } while (0)
        if (ntile > 0) EXU_ISSUE(0, rwA, pkA, suA);
        if (ntile > 1) EXU_ISSUE(1, rwB, pkB, suB);
#pragma unroll 1
        for (int q = 0; q < ntile; q += 2) {
            EXU_TILE(q, rwA, pkA, suA);
            if (q + 1 < ntile) EXU_TILE(q + 1, rwB, pkB, suB);
        }
#undef EXU_TILE
#undef EXU_ISSUE
        const int i0n = i0 + (ndone > 0 ? ndone : 1);
        if (i0n < nitem) EXU_FETCH(i0n);
#pragma unroll 1
        for (int base = 0; base < cnt; base += 256) {
            size_t ao[4]; float gt[4], sv[4], pre[4];
#pragma unroll
            for (int k = 0; k < 4; ++k) {
                const int idx = base + 64 * k + lane, ic = idx < cnt ? idx : cnt - 1;
                const unsigned pk = lpk[ic]; const int e = (int)(pk & 0x3fffu), j = (int)((pk >> 14) & 15u), slot = (int)(pk >> 18);
                ao[k] = (size_t)(t0 + (i0 + j) * tstride) * NSEL + slot;
                pre[k] = lgt[ic];
                gt[k] = p->GATE[ao[k]]; sv[k] = SV[e];
            }
#pragma unroll
            for (int k = 0; k < 4; ++k)
                if (base + 64 * k + lane < cnt) p->ACT[ao[k]] = gelu_tanh(pre[k]) * gt[k] * sv[k];
        }
        __builtin_amdgcn_wave_barrier();
        i0 = i0n;
    }
#undef EXU_FETCH
}
#define EXV_ROW_FMA(RVK, AVK) do { const f32x2_t a2_ = {(AVK), (AVK)}; \
        _Pragma("unroll") for (int d_ = 0; d_ < 4; ++d_) { \
            acc[4 * d_ + 0] += a2_ * __builtin_amdgcn_cvt_scalef32_pk_f32_fp4((RVK)[d_], 1.0f, 0); acc[4 * d_ + 1] += a2_ * __builtin_amdgcn_cvt_scalef32_pk_f32_fp4((RVK)[d_], 1.0f, 1); \
            acc[4 * d_ + 2] += a2_ * __builtin_amdgcn_cvt_scalef32_pk_f32_fp4((RVK)[d_], 1.0f, 2); acc[4 * d_ + 3] += a2_ * __builtin_amdgcn_cvt_scalef32_pk_f32_fp4((RVK)[d_], 1.0f, 3); } \
        __builtin_amdgcn_sched_barrier(0);         } while (0)
#define EXV_STORE(yr_) do { _Pragma("unroll") for (int d_ = 0; d_ < 4; ++d_) \
        *(uint4*)((yr_) + 8 * d_) = make_uint4(pk2(acc[4 * d_].x, acc[4 * d_].y), pk2(acc[4 * d_ + 1].x, acc[4 * d_ + 1].y), pk2(acc[4 * d_ + 2].x, acc[4 * d_ + 2].y), pk2(acc[4 * d_ + 3].x, acc[4 * d_ + 3].y)); } while (0)
__device__ __forceinline__ void phase_expert_v(KP p, int wv, int l, int bid, int nb) {
    const int lane = tid_opaque(wv) & 63, w = __builtin_amdgcn_readfirstlane(tid_opaque(wv) >> 6);
    const int G8 = nb >> 3;
    if (bid >= G8 * 8) return;
    const int sl = bid & 3, q = lane >> 3, c = lane & 7;
    const __amdgpu_buffer_rsrc_t rsV = __builtin_amdgcn_make_buffer_rsrc((void*)(p->V8 + (size_t)l * PEER_N * 512), 0, PEER_N * 512, 0x00020000);
    const int coff = sl * 128 + c * 16, ycol = sl * 256 + c * 32;
    const int tstride = 2 * G8 * NW, Tn = (l == DEPTH - 1) ? TL : T, t0 = ((bid >> 3) * 2 + ((bid >> 2) & 1)) * NW + w;
    const int nitem = t0 < Tn ? (Tn - t0 + tstride - 1) / tstride : 0;
    const int nfull = ((nitem & 7) == 1 || (nitem & 7) == 2) ? (nitem & ~7) : nitem;
    int4 en[4]; float4 an[4];
#define EXV_LISTS(jj) do { const int tq_ = t0 + ((jj) + q < nitem ? (jj) + q : nitem - 1) * tstride; \
        const int4* ep_ = (const int4*)(p->EIDX + (size_t)tq_ * NSEL + c * 16); const float4* ap_ = (const float4*)(p->ACT + (size_t)tq_ * NSEL + c * 16); \
        _Pragma("unroll") for (int k = 0; k < 4; ++k) { en[k] = ep_[k]; an[k] = ap_[k]; } } while (0)
    if (nfull > 0) EXV_LISTS(0);
    for (int j0 = 0; j0 < nfull; j0 += 8) {
        const bool valid = j0 + q < nitem;
        const int t = t0 + (valid ? j0 + q : nitem - 1) * tstride;
        int e[16]; float a[16];
#pragma unroll
        for (int k = 0; k < 4; ++k) {
            e[k * 4 + 0] = en[k].x << 9; e[k * 4 + 1] = en[k].y << 9; e[k * 4 + 2] = en[k].z << 9; e[k * 4 + 3] = en[k].w << 9;
            a[k * 4 + 0] = an[k].x; a[k * 4 + 1] = an[k].y; a[k * 4 + 2] = an[k].z; a[k * 4 + 3] = an[k].w; }
        f32x2_t acc[16];
#pragma unroll
        for (int k = 0; k < 16; ++k) acc[k] = (f32x2_t){0.f, 0.f};
#pragma unroll 1
        for (int cc = 0; cc < 8; ++cc) {
            const int baddr = ((lane & 56) | cc) << 2;
#pragma unroll
            for (int hb = 0; hb < 2; ++hb) {
                u32x4v rv[8]; float av[8];
#pragma unroll
                for (int k = 0; k < 8; ++k) {
                    const int j = hb * 8 + k;
                    const int eo = __builtin_amdgcn_ds_bpermute(baddr, e[j]);
                    av[k] = __builtin_bit_cast(float, __builtin_amdgcn_ds_bpermute(baddr, __builtin_bit_cast(int, a[j])));
                    rv[k] = __builtin_amdgcn_raw_buffer_load_b128(rsV, eo + coff, 0, 0);
                }
                if (hb == 1 && cc == 7 && j0 + 8 < nfull) { EXV_LISTS(j0 + 8); __builtin_amdgcn_sched_barrier(0); }
#pragma unroll
                for (int k = 0; k < 8; ++k) EXV_ROW_FMA(rv[k], av[k]);
            }
        }
        if (valid) { bf16* yr = p->Y + (size_t)t * D + ycol; EXV_STORE(yr); }
    }
#undef EXV_LISTS
    if (nfull < nitem) {
        const int q2 = lane >> 5, sg = (lane >> 3) & 3;
        const bool valid = nfull + q2 < nitem;
        const int t = t0 + (valid ? nfull + q2 : nitem - 1) * tstride;
        const int4 ev = *(const int4*)(p->EIDX + (size_t)t * NSEL + sg * 32 + c * 4); const float4 av4 = *(const float4*)(p->ACT + (size_t)t * NSEL + sg * 32 + c * 4);
        const int e0 = ev.x << 9, e1 = ev.y << 9, e2 = ev.z << 9, e3 = ev.w << 9;
        f32x2_t acc[16];
#pragma unroll
        for (int k = 0; k < 16; ++k) acc[k] = (f32x2_t){0.f, 0.f};
#pragma unroll 1
        for (int cc = 0; cc < 8; cc += 2) {
            u32x4v rv[8]; float av[8];
#pragma unroll
            for (int k = 0; k < 8; ++k) {
                const int baddr = ((lane & 56) | (cc + (k >> 2))) << 2;
                const int ej = (k & 3) == 0 ? e0 : ((k & 3) == 1 ? e1 : ((k & 3) == 2 ? e2 : e3));
                const float aj = (k & 3) == 0 ? av4.x : ((k & 3) == 1 ? av4.y : ((k & 3) == 2 ? av4.z : av4.w));
                const int eo = __builtin_amdgcn_ds_bpermute(baddr, ej);
                av[k] = __builtin_bit_cast(float, __builtin_amdgcn_ds_bpermute(baddr, __builtin_bit_cast(int, aj)));
                rv[k] = __builtin_amdgcn_raw_buffer_load_b128(rsV, eo + coff, 0, 0);
            }
#pragma unroll
            for (int k = 0; k < 8; ++k) EXV_ROW_FMA(rv[k], av[k]);
        }
#pragma unroll
        for (int k = 0; k < 16; ++k) {
            acc[k].x += shx(acc[k].x, 8, lane); acc[k].y += shx(acc[k].y, 8, lane);
            acc[k].x += shx(acc[k].x, 16, lane); acc[k].y += shx(acc[k].y, 16, lane);
        }
        if (valid && sg == 0) { bf16* yr = p->Y + (size_t)t * D + ycol; EXV_STORE(yr); }
    }
}
#undef EXV_ROW_FMA
#undef EXV_STORE

__device__ __forceinline__ void phase_ln2(KP p, int wv, int l, int bid, int nb) {
    const int lane = tid_opaque(wv) & 63, w = tid_opaque(wv) >> 6;
    const int Tn = (l == DEPTH - 1) ? TL : T;
    const int rfirst = bid * NW + w, rstep = nb * NW;
    if (rfirst >= Tn) return;
    float g[16], b[16], c[16], sh[16], sc[16];
    row_load(p->lnf_g + l * D, g, lane); row_load(p->lnf_b + l * D, b, lane);
    int cur_mi = -1;
    uint2 xr[4], yr[4];
    raw_load_bf(p->X1 + (size_t)rfirst * D, xr, lane); raw_load_bf(p->Y + (size_t)rfirst * D, yr, lane);
#pragma unroll 1
    for (int r = rfirst; r < Tn; r += rstep) {
        float v[16], a[16];
        raw_to_f(xr, v); raw_to_f(yr, a);
        { const int rn = r + rstep < Tn ? r + rstep : r; raw_load_bf(p->X1 + (size_t)rn * D, xr, lane); raw_load_bf(p->Y + (size_t)rn * D, yr, lane); }
        const int mi = mod_idx(r);
        if (mi != cur_mi) {
            cur_mi = mi;
            row_load(p->mod + ((size_t)l * 3 + mi) * 6144 + 5120, c, lane);
            if (l < DEPTH - 1) { const float* m2 = p->mod + ((size_t)(l + 1) * 3 + mi) * 6144; row_load(m2, sh, lane); row_load(m2 + 1024, sc, lane); }
        }
#pragma unroll
        for (int i = 0; i < 16; ++i) v[i] = ALPHA * v[i] + c[i] * a[i];
        row_ln(v, lane);
#pragma unroll
        for (int i = 0; i < 16; ++i) v[i] = v[i] * g[i] + b[i];
        if (l == DEPTH - 1) { row_store(p->out + (size_t)r * D, v, lane); continue; }
        row_store_bf(p->X + (size_t)r * D, v, lane);
        row_ln(v, lane);
#pragma unroll
        for (int i = 0; i < 16; ++i) v[i] = v[i] * (1.0f + sc[i]) + sh[i];
        row_store_bf(p->H + (size_t)r * D, v, lane);
    }
}

__global__ void __launch_bounds__(NT, 2) mega(Params p_unused) {
    extern __shared__ __attribute__((aligned(16))) unsigned char lds_raw[];
    cg::grid_group grid = cg::this_grid();
    const int bid = blockIdx.x, nb = gridDim.x;
    const int wv = __builtin_amdgcn_readfirstlane(threadIdx.x >> 6);
    float* lds = (float*)lds_raw;
    LAS unsigned char* ldsl = (LAS unsigned char*)lds_raw;
    volatile LAS unsigned* MISC = (volatile LAS unsigned*)(ldsl + MISC_OFF);
    for (int u = threadIdx.x; u < 64; u += NT) ((LAS unsigned*)(ldsl + MISC_OFF))[u] = 0u;
    __syncthreads();
#define IS_LEAD() (wv == 0 && lane_opaque() == 0)
    (void)xcd_barrier_post(kparams()->ctl + CW_BAR, MISC + 8, IS_LEAD());
#define GRID_BAR() do { XcdBarrier b_; b_.bar = kparams()->ctl + CW_BAR; b_.x = xb_xcc_id(); b_.st = MISC + 8; b_.lead = IS_LEAD(); xcd_barrier(b_); } while (0)

    phase_mod1(kparams(), wv, bid, nb, lds);
    phase_weights(kparams(), wv, bid, nb, lds);
    if (kparams()->ctl == nullptr) grid.sync();
    GRID_BAR();
    phase_mod2(kparams(), wv, bid, nb);
    GRID_BAR();
    phase_lnmod(kparams(), wv, 0, bid, nb);
    GRID_BAR();
#define CTX_LAG(l) ((l) < DEPTH - 1 && nb >= 64 && (T - TL) == 512)
#define LAYER_BODY(l) do { \
        { KP p = kparams(); \
            pg8::Gemm g{p->H, p->WtIn + (size_t)l * DIN * D, T, DIN, D}; pg8::StaticOrder S; S.init(T, DIN, nb, bid); \
            pg8::EpiInProj E{p->P, p->rope}; \
            pg8::gemm_phase<pg8::EpiInProj, pg8::StaticOrder, true, true>(ldsl, g, S, E, wv); \
            { const int busy3 = 66 * 9 - 2 * nb;                       \
              if (busy3 > 0 && busy3 < nb) { if (bid >= busy3) phase_tables(p, wv, l, bid - busy3, nb - busy3); } else phase_tables(p, wv, l, bid, nb); } \
        } \
        GRID_BAR(); \
        phase_mix_a(kparams(), wv, l, bid, nb, lds); \
        GRID_BAR(); \
        phase_ret_scan(kparams(), wv, l, bid, nb); \
        GRID_BAR(); \
        phase_ret_out(kparams(), wv, l, bid, nb, lds); \
        GRID_BAR(); \
          \
          \
        { KP p = kparams(); \
            pg8::Gemm g{p->MIX, p->WtOut + (size_t)l * D * D, CTX_LAG(l) ? TL : ((l == DEPTH - 1) ? TL : T), D, D}; pg8::StaticOrder S; S.init(g.M, D, nb, bid); \
            pg8::EpiBf16Plain E{p->Y, D}; \
            pg8::gemm_phase<pg8::EpiBf16Plain, pg8::StaticOrder, true, true>(ldsl, g, S, E, wv); \
        } \
        GRID_BAR(); \
        if (CTX_LAG(l)) { \
            if (bid < 8) { KP p = kparams(); \
                pg8::Gemm g{p->MIX + (size_t)TL * D, p->WtOut + (size_t)l * D * D, T - TL, D, D}; pg8::StaticOrder S; S.init(T - TL, D, 8, bid); \
                pg8::EpiBf16Plain E{p->Y + (size_t)TL * D, D}; \
                pg8::gemm_phase<pg8::EpiBf16Plain, pg8::StaticOrder, true, true>(ldsl, g, S, E, wv); \
            } else phase_ln1(kparams(), wv, l, bid - 8, nb - 8, 0, TL); \
        } else phase_ln1(kparams(), wv, l, bid, nb, 0, (l == DEPTH - 1) ? TL : T); \
        GRID_BAR(); \
        { KP p = kparams(); \
            if (CTX_LAG(l)) phase_ln1(p, wv, l, bid, nb, TL, T); \
            pg8::Gemm g{p->H, p->WtQ + (size_t)l * 2048 * D, CTX_LAG(l) ? TL : ((l == DEPTH - 1) ? TL : T), 2048, D}; pg8::StaticOrder S; S.init(g.M, 2048, nb, bid); \
            pg8::EpiBf16Plain E{p->Qb, 2048}; \
            pg8::gemm_phase<pg8::EpiBf16Plain, pg8::StaticOrder, true, true>(ldsl, g, S, E, wv); \
        } \
        GRID_BAR(); \
        if (CTX_LAG(l)) { \
            if (bid < 16) { KP p = kparams(); \
                pg8::Gemm g{p->H + (size_t)TL * D, p->WtQ + (size_t)l * 2048 * D, T - TL, 2048, D}; pg8::StaticOrder S; S.init(T - TL, 2048, 16, bid); \
                pg8::EpiBf16Plain E{p->Qb + (size_t)TL * 2048, 2048}; \
                pg8::gemm_phase<pg8::EpiBf16Plain, pg8::StaticOrder, true, true>(ldsl, g, S, E, wv); \
                asm volatile("s_waitcnt vmcnt(0)" ::: "memory"); __syncthreads();        \
                pg8::Unit u_; (void)S.next(0, u_); \
                phase_topk(p, wv, l, 0, 1, 16, (TL + u_.pm * 256) * 8 + u_.pn, 8, lds); \
            } else phase_topk(kparams(), wv, l, bid - 16, nb - 16, TL * 8 / 16, 0, 1, lds); \
        } else phase_topk(kparams(), wv, l, bid, nb, ((l == DEPTH - 1) ? TL : T) * 8 / 16, 0, 1, lds); \
        GRID_BAR(); \
        phase_expert_u(kparams(), wv, l, bid, nb, lds); \
        GRID_BAR(); \
        phase_expert_v(kparams(), wv, l, bid, nb); \
        GRID_BAR(); \
        phase_ln2(kparams(), wv, l, bid, nb); \
        if (l + 1 < DEPTH) GRID_BAR(); \
    } while (0)
    LAYER_BODY(0); LAYER_BODY(1); LAYER_BODY(2); LAYER_BODY(3);
#undef LAYER_BODY
#undef CTX_LAG
}

extern "C" void kernel_launch(void* const* d_in, const int* in_sizes, int n_in, void* d_out, int out_size, void* d_ws, size_t ws_size, hipStream_t stream) {
    static int grid_blocks = 0;
    if (!grid_blocks) {
        int dev = 0, cus = 0, per_cu = 0;
        (void)hipGetDevice(&dev);
        (void)hipDeviceGetAttribute(&cus, hipDeviceAttributeMultiprocessorCount, dev);
        (void)hipFuncSetAttribute((const void*)mega, hipFuncAttributeMaxDynamicSharedMemorySize, LDS_BYTES);
        (void)hipOccupancyMaxActiveBlocksPerMultiprocessor(&per_cu, mega, NT, LDS_BYTES);
        if (per_cu < 1) { fprintf(stderr, "occupancy query says %d blocks per CU\n", per_cu); per_cu = 1; }
        grid_blocks = cus;
    }
    Params p{};
    const float** ins = (const float**)&p;
    for (int i = 0; i < 22; ++i) ins[i] = (const float*)d_in[i];
    p.out = (float*)d_out;
    char* ws = (char*)d_ws;
    size_t off = 0;
    auto carve = [&](size_t bytes) { void* r = ws + off; off += (bytes + 255) & ~(size_t)255; return r; };
    p.ctl = (unsigned*)carve(CTL_BYTES);
    p.modp = (float*)carve((size_t)16 * DEPTH * 3 * 6144 * 4);
    p.mod = (float*)carve((size_t)DEPTH * 3 * 6144 * 4);
    p.rope = (float*)carve((size_t)192 * 16 * 2 * 4);
    p.WtIn = (bf16*)carve((size_t)DEPTH * DIN * D * 2);
    p.WtOut = (bf16*)carve((size_t)DEPTH * D * D * 2);
    p.WtQ = (bf16*)carve((size_t)DEPTH * 2048 * D * 2);
    p.X = (bf16*)carve((size_t)T * D * 2);
    p.H = (bf16*)carve((size_t)T * D * 2);
    p.P = (bf16*)carve((size_t)T * DIN * 2);
    p.KV = (float*)carve((size_t)2 * NB * NPOS * 4 * 4096 * 4);
    p.MIX = (bf16*)carve((size_t)T * D * 2);
    p.ST16 = (bf16*)carve((size_t)2 * NB * NPOS * 4 * 4096 * 2);
    p.Qb = (bf16*)carve((size_t)T * 2048 * 2);
    p.U8 = (unsigned char*)carve((size_t)DEPTH * PEER_N * D);
    p.V8 = (unsigned char*)carve((size_t)DEPTH * PEER_N * D);
    p.XQ = (unsigned char*)carve((size_t)T * D);
    p.SX = (float2*)carve((size_t)T * 8);
    p.SU = (float*)carve((size_t)DEPTH * PEER_N * 4);
    p.SV = (float*)carve((size_t)DEPTH * PEER_N * 4);
    p.Y = (bf16*)carve((size_t)T * D * 2);
    p.X1 = (bf16*)carve((size_t)T * D * 2);
    p.GATE = (float*)carve((size_t)T * NSEL * 4);
    p.ACT = (float*)carve((size_t)T * NSEL * 4);
    p.EIDX = (int*)carve((size_t)T * NSEL * 4);
    if (off > ws_size) { fprintf(stderr, "workspace too small: need %zu have %zu\n", off, ws_size); return; }
    (void)hipMemsetAsync(p.ctl, 0, CTL_BYTES, stream);
    void* args[] = {&p};
    hipError_t e = hipLaunchCooperativeKernel((void*)mega, dim3(grid_blocks), dim3(NT), args, LDS_BYTES, stream);
    if (e != hipSuccess) fprintf(stderr, "cooperative launch failed: %s (grid %d)\n", hipGetErrorString(e), grid_blocks);
}
```
